# Optimizing an MI355X kernel written in HIP

```python
import math
import jax
import jax.numpy as jnp
from jax import lax
import numpy as np

D_MODEL = 2048
BATCH = 2
SEQ = 4096
DEPTH = 1
DEC_BATCH = 128
DEC_SEQ = 1
PAST_LEN = 2048
PAGE_SIZE = 128

HEAD_DIM = 128
N_HEADS = D_MODEL // 256
N_KV = N_HEADS // 4
GQA_R = N_HEADS // N_KV
D_NSA = N_HEADS * HEAD_DIM
D_GM = D_MODEL // 2
SGU_GROUPS = D_GM // 128
SGU_GW = D_GM // SGU_GROUPS
CHUNK = 128
CMP_LEN = 32
CMP_STRIDE = 16
SEL_LEN = 64
N_SEL = 16
WINDOW = 512
N_BUCKETS = 32
MAX_DIST = 128
D_FF = 4 * D_MODEL
QBLOCK = 128
EPS = 1e-6
NEG = -1e30
FORCE = 1e6
N_IN = 2 * D_GM + D_NSA + 3 * 2 * N_KV * HEAD_DIM + 3 * N_HEADS + 2 * D_MODEL

kernel_name = 'hybrid_gmlp_nsa_decode_step'


def rmsnorm(x, g):
    xf = x.astype(jnp.float32)
    y = xf * lax.rsqrt(jnp.mean(xf * xf, axis=-1, keepdims=True) + EPS)
    return y.astype(x.dtype) * g


def t5_bucket(rel):
    n = jnp.maximum(rel, 0)
    max_exact = N_BUCKETS // 2
    nf = jnp.maximum(n, 1).astype(jnp.float32)
    large = max_exact + (jnp.log(nf / max_exact) / math.log(MAX_DIST / max_exact)
                         * (N_BUCKETS - max_exact)).astype(jnp.int32)
    large = jnp.minimum(large, N_BUCKETS - 1)
    return jnp.where(n < max_exact, n, large)


def masked_softmax(s, mask):
    s = jnp.where(mask, s.astype(jnp.float32), NEG)
    p = jax.nn.softmax(s, axis=-1)
    return jnp.where(mask, p, 0.0)


def split_in(z):
    kvw = 2 * N_KV * HEAD_DIM
    sizes = (2 * D_GM, D_NSA, kvw, kvw, kvw, 3 * N_HEADS, D_MODEL, D_MODEL)
    cuts = [int(c) for c in np.cumsum(sizes)[:-1]]
    return jnp.split(z, cuts, axis=-1)


def project(x, g_mix_norm, w_in, g_sgu, g_q):
    B, T = x.shape[:2]
    z = rmsnorm(x, g_mix_norm) @ w_in
    uv, q, kvc, kvs, kvw, g_nsa, g_a, g_b = split_in(z)
    uv = jax.nn.gelu(uv)
    u = uv[..., :D_GM]
    v = rmsnorm(uv[..., D_GM:], g_sgu)
    q = rmsnorm(q.reshape(B, T, N_KV, GQA_R, HEAD_DIM), g_q) * (HEAD_DIM ** -0.5)
    rows = lambda a: a.reshape(B, T, 2, N_KV, HEAD_DIM)
    gates = jax.nn.sigmoid(g_nsa).reshape(B, T, N_KV, GQA_R, 3)
    return u, v, q, rows(kvc), rows(kvs), rows(kvw), gates, g_a, g_b


def spatial_gate(u, v, w_sgu, b_sgu):
    B, NCH, Tc = v.shape[:3]
    mask = jnp.tril(jnp.ones((Tc, Tc), dtype=bool))
    wm = jnp.where(mask, w_sgu[:, :Tc, :Tc], 0.0)
    vg = v.reshape(B, NCH, Tc, SGU_GROUPS, SGU_GW)
    s = jnp.einsum('gts,bnsgc->bntgc', wm, vg) + b_sgu[:, :Tc].T[:, :, None]
    return u * s.reshape(B, NCH, Tc, D_GM)


def compress(k, w, pos):
    B, L = k.shape[:2]
    r = CMP_LEN // CMP_STRIDE
    n = (L - CMP_LEN) // CMP_STRIDE + 1
    seg = k[:, :(n + r - 1) * CMP_STRIDE].reshape(B, n + r - 1, CMP_STRIDE, N_KV, HEAD_DIM)
    w_seg = w.reshape(r, CMP_STRIDE, HEAD_DIM, HEAD_DIM)
    p_seg = pos.reshape(r, CMP_STRIDE, 1, HEAD_DIM)
    out = jnp.einsum('bnsgd,sde->bnge', seg[:, 0:n] + p_seg[0], w_seg[0])
    for m in range(1, r):
        out = out + jnp.einsum('bnsgd,sde->bnge', seg[:, m:m + n] + p_seg[m], w_seg[m])
    return out


def nsa_keys(kvc, kvs, g_k, pos_cmp_k, w_cmp_k, pos_cmp_v, w_cmp_v):
    kc = rmsnorm(compress(kvc[:, :, 0], w_cmp_k, pos_cmp_k), g_k[0])
    vc = compress(kvc[:, :, 1], w_cmp_v, pos_cmp_v)
    c_end = jnp.arange(kc.shape[1]) * CMP_STRIDE + (CMP_LEN - 1)
    B, L = kvs.shape[:2]
    ns = -(-L // SEL_LEN)
    kvs = jnp.pad(kvs, ((0, 0), (0, ns * SEL_LEN - L), (0, 0), (0, 0), (0, 0)))
    to_blocks = lambda a: jnp.transpose(a.reshape(B, ns, SEL_LEN, N_KV, HEAD_DIM), (0, 3, 1, 2, 4))
    ks = to_blocks(rmsnorm(kvs[:, :, 0], g_k[1]))
    vs = to_blocks(kvs[:, :, 1])
    return kc, vc, c_end, ks, vs


def overlap(nc, ns):
    i = jnp.arange(nc)[:, None] * CMP_STRIDE
    j = jnp.arange(ns)[None, :] * SEL_LEN
    return ((i < j + SEL_LEN) & (i + CMP_LEN > j)).astype(jnp.float32)


def nsa_block(q, q_pos, gates, kc, vc, c_end, ks, vs, kw, vw, kw_pos, rel_bias):
    B, Tq = q.shape[:2]
    bt = rel_bias.reshape(N_BUCKETS, N_KV, GQA_R)
    rel_c = q_pos[:, None] - c_end[None, :]
    bias_c = jnp.transpose(bt[t5_bucket(rel_c)], (2, 3, 0, 1))
    s_c = jnp.einsum('btgrd,bcgd->bgrtc', q, kc) + bias_c
    p_c = masked_softmax(s_c, rel_c >= 0)
    o_c = jnp.einsum('bgrtc,bcgd->btgrd', p_c.astype(vc.dtype), vc)
    ns = ks.shape[2]
    n_pick = min(N_SEL, ns)
    imp = jnp.einsum('bgrtc,cj->bgtj', p_c, overlap(kc.shape[1], ns))
    blk = jnp.arange(ns)[None, :]
    cur = (q_pos // SEL_LEN)[:, None]
    forced = (blk == 0) | (blk == cur) | (blk == cur - 1)
    eligible = blk * SEL_LEN <= q_pos[:, None]
    imp = jnp.where(forced, FORCE, jnp.where(eligible, imp, -1.0))
    _, idx = lax.top_k(imp, n_pick)
    bi = jnp.arange(B)[:, None, None, None]
    gi = jnp.arange(N_KV)[None, :, None, None]
    k_sel = ks[bi, gi, idx]
    v_sel = vs[bi, gi, idx]
    k_pos = idx[..., None] * SEL_LEN + jnp.arange(SEL_LEN)
    rel_s = q_pos[None, None, :, None, None] - k_pos
    bias_s = jnp.moveaxis(jnp.transpose(bt, (1, 0, 2))[gi[..., None], t5_bucket(rel_s)], -1, 2)
    s_s = jnp.einsum('btgrd,bgtnsd->bgrtns', q, k_sel) + bias_s
    p_s = masked_softmax(s_s.reshape(B, N_KV, GQA_R, Tq, -1),
                         (rel_s >= 0).reshape(B, N_KV, 1, Tq, -1))
    o_s = jnp.einsum('bgrtk,bgtkd->btgrd', p_s.astype(vs.dtype),
                     v_sel.reshape(B, N_KV, Tq, -1, HEAD_DIM))
    rel_w = q_pos[:, None] - kw_pos[None, :]
    mask_w = (rel_w >= 0) & (rel_w < WINDOW) & (kw_pos[None, :] >= 0)
    bias_w = jnp.transpose(bt[t5_bucket(rel_w)], (2, 3, 0, 1))
    s_w = jnp.einsum('btgrd,bkgd->bgrtk', q, kw) + bias_w
    p_w = masked_softmax(s_w, mask_w)
    o_w = jnp.einsum('bgrtk,bkgd->btgrd', p_w.astype(vw.dtype), vw)
    return gates[..., 0:1] * o_c + gates[..., 1:2] * o_s + gates[..., 2:3] * o_w


def merge_ffn(x, o_a, o_b, g_a, g_b, w_proj_gmlp, w_proj_nsa, w_out, g_mlp_norm, w_up, w_down):
    mix = jax.nn.sigmoid(g_a) * (o_a @ w_proj_gmlp) + jax.nn.sigmoid(g_b) * (o_b @ w_proj_nsa)
    x = x + mix @ w_out
    hm = rmsnorm(x, g_mlp_norm)
    return x + jnp.square(jax.nn.relu(hm @ w_up)) @ w_down


def layer_prompt(x, rel_bias, g_mix_norm, w_in, g_sgu, w_sgu, b_sgu, g_q, g_k, pos_cmp_k, w_cmp_k,
                 pos_cmp_v, w_cmp_v, w_proj_gmlp, w_proj_nsa, w_out, g_mlp_norm, w_up, w_down):
    B, T = x.shape[:2]
    u, v, q, kvc, kvs, kvw, gates, g_a, g_b = project(x, g_mix_norm, w_in, g_sgu, g_q)
    n_ch = T // CHUNK
    o_a = spatial_gate(u.reshape(B, n_ch, CHUNK, D_GM), v.reshape(B, n_ch, CHUNK, D_GM),
                       w_sgu, b_sgu).reshape(B, T, D_GM)
    kc, vc, c_end, ks, vs = nsa_keys(kvc, kvs, g_k, pos_cmp_k, w_cmp_k, pos_cmp_v, w_cmp_v)
    pad = ((0, 0), (WINDOW, 0), (0, 0), (0, 0))
    kw = jnp.pad(rmsnorm(kvw[:, :, 0], g_k[2]), pad)
    vw = jnp.pad(kvw[:, :, 1], pad)

    def query_block(qb):
        t0 = qb * QBLOCK
        cut = lambda a, n: lax.dynamic_slice_in_dim(a, t0, n, axis=1)
        return nsa_block(cut(q, QBLOCK), t0 + jnp.arange(QBLOCK), cut(gates, QBLOCK), kc, vc, c_end,
                         ks, vs, cut(kw, WINDOW + QBLOCK), cut(vw, WINDOW + QBLOCK),
                         t0 - WINDOW + jnp.arange(WINDOW + QBLOCK), rel_bias)

    o_b = lax.map(query_block, jnp.arange(T // QBLOCK))
    o_b = jnp.moveaxis(o_b, 0, 1).reshape(B, T, D_NSA)
    y = merge_ffn(x, o_a, o_b, g_a, g_b, w_proj_gmlp, w_proj_nsa, w_out, g_mlp_norm, w_up, w_down)
    return y, kvc, kvs, kvw[:, T - min(WINDOW, T):], v[:, ((T - 1) // CHUNK) * CHUNK:]


def layer_sample(x, cache_c, cache_s, win_buf, page_table, rel_bias, g_mix_norm, w_in, g_sgu, w_sgu,
                 b_sgu, g_q, g_k, pos_cmp_k, w_cmp_k, pos_cmp_v, w_cmp_v, w_proj_gmlp, w_proj_nsa,
                 w_out, g_mlp_norm, w_up, w_down):
    B, T = x.shape[:2]
    u, v, q, kvc, kvs, kvw, gates, g_a, g_b = project(x, g_mix_norm, w_in, g_sgu, g_q)
    o_a = spatial_gate(u[:, None], v[:, None], w_sgu, b_sgu).reshape(B, T, D_GM)
    gather = lambda cache: cache[page_table].reshape(B, -1, 2, N_KV, HEAD_DIM)
    full_c = jnp.concatenate([gather(cache_c), kvc], axis=1)
    full_s = jnp.concatenate([gather(cache_s), kvs], axis=1)
    kc, vc, c_end, ks, vs = nsa_keys(full_c, full_s, g_k, pos_cmp_k, w_cmp_k, pos_cmp_v, w_cmp_v)
    nb = win_buf.shape[1]
    full_w = jnp.concatenate([win_buf, kvw], axis=1)
    kw = rmsnorm(full_w[:, :, 0], g_k[2])
    vw = full_w[:, :, 1]
    o_b = nsa_block(q, PAST_LEN + jnp.arange(T), gates, kc, vc, c_end, ks, vs, kw, vw,
                    PAST_LEN - nb + jnp.arange(nb + T), rel_bias).reshape(B, T, D_NSA)
    y = merge_ffn(x, o_a, o_b, g_a, g_b, w_proj_gmlp, w_proj_nsa, w_out, g_mlp_norm, w_up, w_down)
    return y, kvc, kvs, full_w[:, nb + T - min(WINDOW, PAST_LEN + T):], v


def setup_inputs(seed: int = 0) -> dict:
    key = jax.random.key(seed)
    ks = jax.random.split(key, 32)
    n_pages = PAST_LEN // PAGE_SIZE
    n_pool = (5 * DEC_BATCH * n_pages) // 4
    win_buf = min(WINDOW, PAST_LEN)
    nrm = lambda k, shape, scale: jax.random.normal(k, shape, jnp.float32) * scale
    gain = lambda k, shape: 1.0 + 0.02 * jax.random.normal(k, shape, jnp.float32)
    page_table = jax.random.permutation(ks[0], n_pool)[:DEC_BATCH * n_pages]
    page_table = page_table.reshape(DEC_BATCH, n_pages).astype(jnp.int32)
    return {
        'x_prompt': nrm(ks[1], (BATCH, SEQ, D_MODEL), 1.0),
        'x_sample': nrm(ks[2], (DEC_BATCH, DEC_SEQ, D_MODEL), 1.0),
        'cache_cmp_kv': nrm(ks[3], (DEPTH, n_pool, PAGE_SIZE, 2, N_KV, HEAD_DIM), 1.0),
        'cache_sel_kv': nrm(ks[4], (DEPTH, n_pool, PAGE_SIZE, 2, N_KV, HEAD_DIM), 1.0),
        'state_win_kv': nrm(ks[5], (DEPTH, DEC_BATCH, win_buf, 2, N_KV, HEAD_DIM), 1.0),
        'page_table': page_table,
        'rel_bias': nrm(ks[6], (N_BUCKETS, N_HEADS), 0.5),
        'g_mix_norm': gain(ks[7], (DEPTH, D_MODEL)),
        'w_in': nrm(ks[8], (DEPTH, D_MODEL, N_IN), D_MODEL ** -0.5),
        'g_sgu': gain(ks[9], (DEPTH, D_GM)),
        'w_sgu': nrm(ks[10], (DEPTH, SGU_GROUPS, CHUNK, CHUNK), 0.5 * CHUNK ** -0.5),
        'b_sgu': 1.0 + nrm(ks[11], (DEPTH, SGU_GROUPS, CHUNK), 0.1),
        'g_q': gain(ks[12], (DEPTH, HEAD_DIM)),
        'g_k': gain(ks[13], (DEPTH, 3, HEAD_DIM)),
        'pos_cmp_k': nrm(ks[14], (DEPTH, CMP_LEN, HEAD_DIM), 0.1),
        'w_cmp_k': nrm(ks[15], (DEPTH, CMP_LEN, HEAD_DIM, HEAD_DIM), (CMP_LEN * HEAD_DIM) ** -0.5),
        'pos_cmp_v': nrm(ks[16], (DEPTH, CMP_LEN, HEAD_DIM), 0.1),
        'w_cmp_v': nrm(ks[17], (DEPTH, CMP_LEN, HEAD_DIM, HEAD_DIM), (CMP_LEN * HEAD_DIM) ** -0.5),
        'w_proj_gmlp': nrm(ks[18], (DEPTH, D_GM, D_MODEL), D_GM ** -0.5),
        'w_proj_nsa': nrm(ks[19], (DEPTH, D_NSA, D_MODEL), D_NSA ** -0.5),
        'w_out': nrm(ks[20], (DEPTH, D_MODEL, D_MODEL), D_MODEL ** -0.5),
        'g_mlp_norm': gain(ks[21], (DEPTH, D_MODEL)),
        'w_up': nrm(ks[22], (DEPTH, D_MODEL, D_FF), D_MODEL ** -0.5),
        'w_down': nrm(ks[23], (DEPTH, D_FF, D_MODEL), D_FF ** -0.5),
    }


def reference(x_prompt, x_sample, cache_cmp_kv, cache_sel_kv, state_win_kv, page_table, rel_bias,
              g_mix_norm, w_in, g_sgu, w_sgu, b_sgu, g_q, g_k, pos_cmp_k, w_cmp_k, pos_cmp_v, w_cmp_v,
              w_proj_gmlp, w_proj_nsa, w_out, g_mlp_norm, w_up, w_down):
    x_p, x_s = x_prompt, x_sample
    outs = [[] for _ in range(8)]
    for l in range(DEPTH):
        lw = (g_mix_norm[l], w_in[l], g_sgu[l], w_sgu[l], b_sgu[l], g_q[l], g_k[l], pos_cmp_k[l],
              w_cmp_k[l], pos_cmp_v[l], w_cmp_v[l], w_proj_gmlp[l], w_proj_nsa[l], w_out[l],
              g_mlp_norm[l], w_up[l], w_down[l])
        x_p, pc, ps, pw, pv = layer_prompt(x_p, rel_bias, *lw)
        x_s, sc, ss, sw, sv = layer_sample(x_s, cache_cmp_kv[l], cache_sel_kv[l], state_win_kv[l],
                                           page_table, rel_bias, *lw)
        for lst, a in zip(outs, (pc, ps, pw, pv, sc, ss, sw, sv)):
            lst.append(a)
    p_cmp, p_sel, p_win, p_v, s_cmp, s_sel, s_win, s_v = [jnp.stack(a) for a in outs]
    return (x_p, x_s, p_cmp, p_sel, p_win, p_v, s_cmp, s_sel, s_win, s_v)
```

```cpp
#include <hip/hip_runtime.h>
#include <cstdio>
#include <cstdint>
namespace pg8 {
#define PG8_LAS __attribute__((address_space(3)))
typedef unsigned short bf16_t;
typedef short bf16x8 __attribute__((ext_vector_type(8)));
typedef float f32x4 __attribute__((ext_vector_type(4)));
typedef unsigned u32x4 __attribute__((ext_vector_type(4)));
constexpr int BM = 256, BK = 64, HALF = 128, HTB = HALF * BK * 2  , STAGE_BYTES = 8 * HTB, NXCD = 8, WGM = 8;

__host__ __device__ __forceinline__ int lds_byte(int r, int c) { const int st = (r >> 4) * 2 + (c >> 5), rr = r & 15, cc = c & 31, ob = rr * 64 + cc * 2; return st * 1024 + (ob ^ (((ob >> 9) & 1) << 5)); }
__host__ __device__ __forceinline__ void stage_rc(int b, int& R, int& C) { const int st = b / 1024, sb = b % 1024, swz = sb ^ (((sb >> 9) & 1) << 5); R = (st >> 1) * 16 + swz / 64; C = (st & 1) * 32 + (swz % 64) / 2; }
__host__ __device__ __forceinline__ int perm32(int rho) { const int n = rho >> 4, i = rho & 15; return 8 * (i >> 2) + 4 * n + (i & 3); }

struct Unit { int pm, pn; };
struct Gemm { const bf16_t* A; const bf16_t* Bt; int M, N, K; };

struct StaticOrder {
    int nM, nN, nwg, G, c;
    __host__ __device__ void init(int M, int N, int G_, int c_) { nM = M / BM; nN = N / BM; nwg = nM * nN; G = G_; c = c_; }
    __host__ __device__ bool next(int i, Unit& u) const {
        const long L = (long)i * G + c; if (L >= nwg) return false;
        int wgid = (int)L; { const int q = nwg / NXCD, r = nwg % NXCD, xcd = wgid % NXCD, off = wgid / NXCD; wgid = (xcd < r ? xcd * (q + 1) : r * (q + 1) + (xcd - r) * q) + off; }
        const int nig = WGM * nN, gid = wgid / nig, fm = gid * WGM, gsz = (nM - fm) < WGM ? (nM - fm) : WGM;
        u.pm = fm + ((wgid % nig) % gsz); u.pn = (wgid % nig) / gsz; return true;
    }
    __device__ __forceinline__ void a_ready(const Unit&) const {}
    __device__ __forceinline__ void done(const Unit&) const {}
};

__device__ __forceinline__ unsigned cvt_pk_bf16(float lo, float hi) { unsigned r; asm volatile("v_cvt_pk_bf16_f32 %0, %1, %2" : "=v"(r) : "v"(lo), "v"(hi)); return r; }
typedef float f32x2 __attribute__((ext_vector_type(2)));
template <class Epi, class Sched, bool ALIGN_EPI = false, bool SP2 = false>
__device__ __forceinline__ void gemm_phase(PG8_LAS unsigned char* lds, const Gemm g, const Sched& S, const Epi& E) {
    const int tid = threadIdx.x, wid = __builtin_amdgcn_readfirstlane(tid >> 6), lane = tid & 63, wr = wid >> 2, wc = wid & 3, fr = lane & 15, fq = lane >> 4;
    const int K = g.K, nt = K / BK;
    unsigned voffA[2], voffB[2];
#pragma unroll
    for (int i = 0; i < 2; ++i) { int R, C; stage_rc(tid * 16 + i * 8192, R, C); const int Rb = Epi::PERM ? ((R & ~31) + perm32(R & 31)) : R;
        voffA[i] = (unsigned)(R * K + C) * 2u; voffB[i] = (unsigned)(Rb * K + C) * 2u; }
    const size_t kstep = (size_t)(BK * 2);
    const size_t hstep = (size_t)HALF * K * 2;
    const size_t tstep = 2 * hstep;
    const unsigned ldsw = (unsigned)wid * 1024u;
    const int aoff = lds_byte(wr * 64 + fr, fq * 8), boff = lds_byte(wc * 32 + fr, fq * 8);
#define PG8_SA(b, h) (((b) * 2 + (h)) * HTB)
#define PG8_SB(b, h) ((4 + (b) * 2 + (h)) * HTB)
#define PG8_STAGE(bufoff, gbase, voff) do { _Pragma("unroll") for (int _i = 0; _i < 2; ++_i) \
        __builtin_amdgcn_global_load_lds((const unsigned*)((const char*)(gbase) + (voff)[_i]), (PG8_LAS unsigned*)(lds + (bufoff) + ldsw + _i * 8192), 16, 0, 0); } while (0)
#define PG8_LDA(dst, b, h) do { _Pragma("unroll") for (int m = 0; m < 4; ++m) _Pragma("unroll") for (int k = 0; k < 2; ++k) dst[m][k] = *(const PG8_LAS bf16x8*)(lds + PG8_SA(b, h) + aoff + m * 2048 + k * 1024); } while (0)
#define PG8_LDB(dst, b, h) do { _Pragma("unroll") for (int n = 0; n < 2; ++n) _Pragma("unroll") for (int k = 0; k < 2; ++k) dst[n][k] = *(const PG8_LAS bf16x8*)(lds + PG8_SB(b, h) + boff + n * 2048 + k * 1024); } while (0)
#define PG8_MMA(ai, bj, At, Bt) do { __builtin_amdgcn_s_setprio(1); _Pragma("unroll") for (int m = 0; m < 4; ++m) _Pragma("unroll") for (int n = 0; n < 2; ++n) _Pragma("unroll") for (int k = 0; k < 2; ++k) \
        acc[ai][bj][m][n] = __builtin_amdgcn_mfma_f32_16x16x32_bf16(Bt[n][k], At[m][k], acc[ai][bj][m][n], 0, 0, 0); __builtin_amdgcn_s_setprio(0); } while (0)
#define PG8_WAIT_V(n) asm volatile("s_waitcnt vmcnt(" #n ")" ::: "memory")
#define PG8_WAIT_L(n) asm volatile("s_waitcnt lgkmcnt(" #n ")" ::: "memory")
#define PG8_BAR __builtin_amdgcn_s_barrier()
#define PG8_SCHED __builtin_amdgcn_sched_barrier(0)
    Unit cur, nxt; int ui = 0;
    if (!S.next(0, cur)) return;
    f32x4 acc[2][2][4][2];
#pragma unroll
    for (int a = 0; a < 2; ++a)
#pragma unroll
        for (int b = 0; b < 2; ++b)
#pragma unroll
            for (int m = 0; m < 4; ++m)
#pragma unroll
                for (int n = 0; n < 2; ++n) acc[a][b][m][n] = (f32x4){0.f, 0.f, 0.f, 0.f};
    bf16x8 At[4][2], B0[2][2], B1[2][2];
    const char* cA = (const char*)g.A + (size_t)cur.pm * tstep; const char* cB = (const char*)g.Bt + (size_t)cur.pn * tstep;
    S.a_ready(cur);
    if constexpr (SP2) {
        PG8_STAGE(PG8_SB(0, 0), cB, voffB); PG8_STAGE(PG8_SB(0, 1), cB + hstep, voffB); PG8_STAGE(PG8_SA(0, 0), cA, voffA); PG8_STAGE(PG8_SA(0, 1), cA + hstep, voffA);
        if (wr == 1) PG8_BAR;
        PG8_WAIT_V(2); PG8_BAR;
        PG8_STAGE(PG8_SB(1, 0), cB + kstep, voffB); PG8_STAGE(PG8_SA(1, 0), cA + kstep, voffA); PG8_STAGE(PG8_SB(1, 1), cB + hstep + kstep, voffB);
        PG8_WAIT_V(6); PG8_BAR;
    } else {
        PG8_STAGE(PG8_SB(0, 0), cB, voffB); PG8_STAGE(PG8_SA(0, 0), cA, voffA); PG8_STAGE(PG8_SB(0, 1), cB + hstep, voffB); PG8_STAGE(PG8_SA(0, 1), cA + hstep, voffA);
        if (wr == 1) PG8_BAR;
        PG8_WAIT_V(4); PG8_BAR;
        PG8_STAGE(PG8_SB(1, 0), cB + kstep, voffB); PG8_STAGE(PG8_SA(1, 0), cA + kstep, voffA); PG8_STAGE(PG8_SB(1, 1), cB + hstep + kstep, voffB);
        PG8_WAIT_V(6); PG8_BAR;
    }
    for (;;) {
        const bool has_next = S.next(ui + 1, nxt);
        const char* nA = has_next ? (const char*)g.A + (size_t)nxt.pm * tstep : cA; const char* nB = has_next ? (const char*)g.Bt + (size_t)nxt.pn * tstep : cB;
        for (int t = 0; t < nt; t += 2) {
            const bool last = (t == nt - 2);
            const char* a1 = cA + (size_t)(t + 1) * kstep;
            const char* a2 = last ? nA : cA + (size_t)(t + 2) * kstep; const char* b2 = last ? nB : cB + (size_t)(t + 2) * kstep;
            const char* a3 = a2 + kstep; const char* b3 = b2 + kstep;
            if (last && has_next) S.a_ready(nxt);
            if constexpr (SP2) {
            PG8_LDB(B0, 0, 0); PG8_LDB(B1, 0, 1); PG8_SCHED; PG8_LDA(At, 0, 0); PG8_STAGE(PG8_SA(1, 1), a1 + hstep, voffA);
            PG8_WAIT_V(8); PG8_WAIT_L(0); PG8_BAR; PG8_MMA(0, 0, At, B0); PG8_MMA(0, 1, At, B1); PG8_BAR; PG8_SCHED;
            PG8_LDA(At, 0, 1); PG8_STAGE(PG8_SB(0, 0), b2, voffB); PG8_STAGE(PG8_SB(0, 1), b2 + hstep, voffB); PG8_STAGE(PG8_SA(0, 0), a2, voffA);
            PG8_WAIT_V(8); PG8_WAIT_L(0); PG8_BAR; PG8_MMA(1, 0, At, B0); PG8_MMA(1, 1, At, B1); PG8_BAR; PG8_SCHED;
            PG8_LDB(B0, 1, 0); PG8_LDB(B1, 1, 1); PG8_SCHED; PG8_LDA(At, 1, 0); PG8_STAGE(PG8_SA(0, 1), a2 + hstep, voffA);
            PG8_WAIT_V(8); PG8_WAIT_L(0); PG8_BAR; PG8_MMA(0, 0, At, B0); PG8_MMA(0, 1, At, B1); PG8_BAR; PG8_SCHED;
            PG8_LDA(At, 1, 1); PG8_STAGE(PG8_SB(1, 0), b3, voffB); PG8_STAGE(PG8_SB(1, 1), b3 + hstep, voffB); PG8_STAGE(PG8_SA(1, 0), a3, voffA);
            PG8_WAIT_V(8); PG8_WAIT_L(0); PG8_BAR; PG8_MMA(1, 0, At, B0); PG8_MMA(1, 1, At, B1); PG8_BAR; PG8_SCHED;
            } else {
            PG8_LDB(B0, 0, 0); PG8_SCHED; PG8_LDA(At, 0, 0); PG8_STAGE(PG8_SA(1, 1), a1 + hstep, voffA);
            PG8_WAIT_L(8); PG8_BAR; PG8_WAIT_L(0); PG8_MMA(0, 0, At, B0); PG8_BAR; PG8_SCHED;
            PG8_LDB(B1, 0, 1); PG8_STAGE(PG8_SB(0, 0), b2, voffB);
            PG8_BAR; PG8_WAIT_L(0); PG8_MMA(0, 1, At, B1); PG8_BAR;
            PG8_LDA(At, 0, 1); PG8_STAGE(PG8_SA(0, 0), a2, voffA);
            PG8_BAR; PG8_WAIT_L(0); PG8_MMA(1, 0, At, B0); PG8_BAR; PG8_SCHED;
            PG8_STAGE(PG8_SB(0, 1), b2 + hstep, voffB);
            PG8_WAIT_V(6); PG8_BAR; PG8_MMA(1, 1, At, B1); PG8_BAR;
            PG8_LDB(B0, 1, 0); PG8_SCHED; PG8_LDA(At, 1, 0); PG8_STAGE(PG8_SA(0, 1), a2 + hstep, voffA);
            PG8_WAIT_L(8); PG8_BAR; PG8_WAIT_L(0); PG8_MMA(0, 0, At, B0); PG8_BAR; PG8_SCHED;
            PG8_LDB(B1, 1, 1); PG8_STAGE(PG8_SB(1, 0), b3, voffB);
            PG8_BAR; PG8_WAIT_L(0); PG8_MMA(0, 1, At, B1); PG8_BAR;
            PG8_LDA(At, 1, 1); PG8_STAGE(PG8_SA(1, 0), a3, voffA);
            PG8_BAR; PG8_WAIT_L(0); PG8_MMA(1, 0, At, B0); PG8_BAR; PG8_SCHED;
            PG8_STAGE(PG8_SB(1, 1), b3 + hstep, voffB);
            PG8_WAIT_V(6); PG8_BAR; PG8_MMA(1, 1, At, B1); PG8_BAR;
            }
        }
        if constexpr (ALIGN_EPI) { if (wr == 0) PG8_BAR; }
        if constexpr (!Epi::AFTER_DRAIN) { E(acc, cur, wr, wc, fr, fq); S.done(cur); }
        if (!has_next) break;
#pragma unroll
        for (int a = 0; a < 2; ++a)
#pragma unroll
            for (int b = 0; b < 2; ++b)
#pragma unroll
                for (int m = 0; m < 4; ++m)
#pragma unroll
                    for (int n = 0; n < 2; ++n) acc[a][b][m][n] = (f32x4){0.f, 0.f, 0.f, 0.f};
        cur = nxt; cA = nA; cB = nB; ++ui;
        if constexpr (ALIGN_EPI) { if (wr == 1) PG8_BAR; }
    }
    PG8_WAIT_V(0);
    if constexpr (!ALIGN_EPI) { if (wr == 0) PG8_BAR; }
    PG8_BAR;
    if constexpr (Epi::AFTER_DRAIN) { E.fused(acc, cur, wr, wc, fr, fq, lds, wid, lane); S.done(cur); }
#undef PG8_SA
#undef PG8_SB
#undef PG8_STAGE
#undef PG8_LDA
#undef PG8_LDB
#undef PG8_MMA
#undef PG8_WAIT_V
#undef PG8_WAIT_L
#undef PG8_BAR
#undef PG8_SCHED
}
}
#define GAS __attribute__((address_space(1)))
#define LAS __attribute__((address_space(3)))
typedef unsigned short bf16;
typedef unsigned v4u __attribute__((ext_vector_type(4)));
typedef float f32x4 __attribute__((ext_vector_type(4)));
typedef short bf16x8 __attribute__((ext_vector_type(8)));
typedef GAS unsigned gu32;
typedef GAS unsigned long long gu64;
#define RLX_AGENT __ATOMIC_RELAXED, __HIP_MEMORY_SCOPE_AGENT
#define LDS_WAIT() asm volatile("s_waitcnt lgkmcnt(0)" ::: "memory")
#define VM_WAIT() asm volatile("s_waitcnt vmcnt(0)" ::: "memory")
__device__ __forceinline__ unsigned long long rt() { return __builtin_amdgcn_s_memrealtime(); }
__device__ __forceinline__ unsigned f2bf(float f) { unsigned u = __builtin_bit_cast(unsigned, f); return (u + 0x7fffu + ((u >> 16) & 1u)) >> 16; }
__device__ __forceinline__ unsigned pk2(float lo, float hi) { return f2bf(lo) | (f2bf(hi) << 16); }

#define XB_TMO      128
#define XB_XCNT(j)  (256  + 64 * (j))
#define XB_XSUB(j)  (1280 + 64 * (j))
#define XB_XGEN(j)  (2304 + 64 * (j))
#define XB_TOP      3328
#define XB_TOPGEN   3392
#define XCD_BAR_WORDS 3456
#define XB_SPIN_CAP (1u << 24)

__device__ __forceinline__ unsigned xb_ld(unsigned* p)              { return __hip_atomic_load(p, __ATOMIC_RELAXED, __HIP_MEMORY_SCOPE_AGENT); }
__device__ __forceinline__ unsigned xb_add(unsigned* p, unsigned v) { return __hip_atomic_fetch_add(p, v, __ATOMIC_RELAXED, __HIP_MEMORY_SCOPE_AGENT); }
__device__ __forceinline__ unsigned xb_xcc_id() { return (unsigned)__builtin_amdgcn_s_getreg((3 << 11) | 20) & 0xFu; }
#define XB_SPIN(cond, bar) do { unsigned _sp = 0; while (cond) { __builtin_amdgcn_s_sleep(1); \
    if ((++_sp & 255u) == 0u) { if (xb_ld(&(bar)[XB_TMO])) break; if (_sp > XB_SPIN_CAP) { atomicAdd(&(bar)[XB_TMO], 1u); break; } } } } while (0)

struct XcdBarrier {
    unsigned* bar; unsigned x;
    volatile LAS unsigned* st;
};

__device__ __forceinline__ XcdBarrier xcd_barrier_post(unsigned* bar, volatile LAS unsigned* st) {
    XcdBarrier b; b.bar = bar; b.x = xb_xcc_id(); b.st = st;
    if (threadIdx.x == 0) (void)xb_add(&bar[XB_XCNT(b.x)], 1u);
    return b;
}
__device__ __forceinline__ void xcd_barrier_complete(unsigned* bar, unsigned x, unsigned& nloc, unsigned& nx) {
    const unsigned G = gridDim.x * gridDim.y * gridDim.z;
    unsigned sum, cnt, mine, sp = 0u;
    for (;;) {
        sum = 0u; cnt = 0u; mine = 0u;
#pragma unroll
        for (unsigned j = 0; j < 16; ++j) { const unsigned c = xb_ld(&bar[XB_XCNT(j)]); sum += c; cnt += (c > 0u) ? 1u : 0u; mine = (j == x) ? c : mine; }
        if (sum == G) break;
        __builtin_amdgcn_s_sleep(1);
        if ((++sp & 255u) == 0u) { if (xb_ld(&bar[XB_TMO])) break; if (sp > XB_SPIN_CAP) { atomicAdd(&bar[XB_TMO], 1u); break; } }
    }
    nloc = mine > 0u ? mine : 1u; nx = cnt > 0u ? cnt : 1u;
}

__device__ __forceinline__ void xcd_barrier(const XcdBarrier& b) {
    asm volatile("s_waitcnt vmcnt(0)" ::: "memory");
    __syncthreads();
    if (threadIdx.x == 0) {
        unsigned* bar = b.bar;
        __builtin_amdgcn_s_waitcnt(0);
        unsigned nloc = b.st[0], nx = b.st[1];
        if (nloc == 0u) { xcd_barrier_complete(bar, b.x, nloc, nx); b.st[0] = nloc; b.st[1] = nx; }
        const unsigned old = xb_add(&bar[XB_XSUB(b.x)], 1u);
        const unsigned gen = old / nloc;
        if (old + 1u == (gen + 1u) * nloc) {
            __builtin_amdgcn_fence(__ATOMIC_RELEASE, "agent");
            asm volatile("s_waitcnt vmcnt(0)" ::: "memory");
            const unsigned og = xb_add(&bar[XB_TOP], 1u);
            const unsigned tg = og / nx;
            if (og + 1u == (tg + 1u) * nx) xb_add(&bar[XB_TOPGEN], 1u);
            else XB_SPIN(xb_ld(&bar[XB_TOPGEN]) == tg, bar);
            __builtin_amdgcn_fence(__ATOMIC_ACQUIRE, "agent");
            xb_add(&bar[XB_XGEN(b.x)], 1u);
            asm volatile("s_waitcnt vmcnt(0)" ::: "memory");
        } else {
            XB_SPIN(xb_ld(&bar[XB_XGEN(b.x)]) == gen, bar);
            __builtin_amdgcn_fence(__ATOMIC_ACQUIRE, "agent");
            asm volatile("s_waitcnt vmcnt(0)" ::: "memory");
        }
    }
    __syncthreads();
}

constexpr int T = 4096, NBATCH = 2, MPROMPT = 8192, MSAMP = 128, MREAL = 8320, MPAD = 8448;
constexpr int DM = 2048, DG = 1024, DQ = 1024, DFF = 8192, NIN = 8728, NINP = 8960;
constexpr int PASTLEN = 2048;
constexpr float EPS = 1e-6f;
constexpr float LOG2E = 1.4426950408889634f;
constexpr float QSCALE = 0.08838834764831845f * 1.4426950408889634f;
constexpr int NWAVES = 8;

constexpr size_t O_YP = 0, O_YS = 16777216, O_PCMP = O_YS + 262144, O_PSEL = O_PCMP + 4194304, O_PWIN = O_PSEL + 4194304,
                 O_PSGU = O_PWIN + 524288, O_SCMP = O_PSGU + 262144, O_SSEL = O_SCMP + 65536, O_SWIN = O_SSEL + 65536,
                 O_SSGU = O_SWIN + 33554432, O_END = O_SSGU + 131072;
static_assert(O_END == 60030976, "output size");

constexpr size_t MiB = 1ull << 20;
constexpr size_t al(size_t x) { return (x + MiB - 1) / MiB * MiB; }
constexpr size_t WS_CTL = 0, CTL_ZERO_BYTES = 1 * MiB;
constexpr size_t WS_WIN  = 1 * MiB;
constexpr size_t WS_WG   = WS_WIN  + al((size_t)NINP * DM * 2);
constexpr size_t WS_WN   = WS_WG   + al((size_t)DM * DG * 2);
constexpr size_t WS_WO   = WS_WN   + al((size_t)DM * DQ * 2);
constexpr size_t WS_WUP  = WS_WO   + al((size_t)DM * DM * 2);
constexpr size_t WS_WDN  = WS_WUP  + al((size_t)DFF * DM * 2);
constexpr size_t WS_WC   = WS_WDN  + al((size_t)DM * DFF * 2);
constexpr size_t WS_XB   = WS_WC   + al((size_t)512 * 2048 * 2);
constexpr size_t WS_RSTD1= WS_XB   + al((size_t)MPAD * DM * 2);
constexpr size_t WS_U    = WS_RSTD1+ al((size_t)MPAD * 4);
constexpr size_t WS_VG   = WS_U    + al((size_t)MPAD * DG * 2);
constexpr size_t WS_VSS  = WS_VG   + al((size_t)MPAD * DG * 2);
constexpr size_t WS_RSTDV= WS_VSS  + al((size_t)MPAD * 32 * 4);
constexpr size_t WS_QRAW = WS_RSTDV+ al((size_t)MPAD * 4);
constexpr size_t WS_KVWR = WS_QRAW + al((size_t)MPAD * DQ * 4);
constexpr size_t WS_GA   = WS_KVWR + al((size_t)MPAD * 512 * 4);
constexpr size_t WS_GB   = WS_GA   + al((size_t)MPAD * DM * 2);
constexpr size_t WS_GN   = WS_GB   + al((size_t)MPAD * DM * 2);
constexpr size_t WS_QN   = WS_GN   + al((size_t)MPAD * 32 * 4);
constexpr size_t WS_KS   = WS_QN   + al((size_t)MPAD * DQ * 2);
constexpr size_t WS_VS   = WS_KS   + 4 * MiB;
constexpr size_t WS_KW   = WS_VS   + 4 * MiB;
constexpr size_t WS_VW   = WS_KW   + 4 * MiB;
constexpr size_t WS_ACP  = WS_VW   + 4 * MiB;
constexpr size_t WS_ACS  = WS_ACP  + 8 * MiB;
constexpr size_t WS_YCP  = WS_ACS  + 256 * MiB;
constexpr size_t WS_YCS  = WS_YCP  + 2 * MiB;
constexpr size_t WS_KCP  = WS_YCS  + 64 * MiB;
constexpr size_t WS_VCP  = WS_KCP  + 1 * MiB;
constexpr size_t WS_KCS  = WS_VCP  + 1 * MiB;
constexpr size_t WS_VCS  = WS_KCS  + 8 * MiB;
constexpr size_t WS_CBP  = WS_VCS  + 8 * MiB;
constexpr size_t WS_WMB  = WS_CBP  + 1 * MiB;
constexpr size_t WS_BLUT = WS_WMB  + 1 * MiB;
constexpr size_t WS_OA   = WS_BLUT + 1 * MiB;
constexpr size_t WS_OB   = WS_OA   + al((size_t)MPAD * DG * 2);
constexpr size_t WS_MIXA = WS_OB   + al((size_t)MPAD * DQ * 2);
constexpr size_t WS_MIX  = WS_MIXA + al((size_t)MPAD * DM * 2);
constexpr size_t WS_X1B  = WS_MIX  + al((size_t)MPAD * DM * 2);
constexpr size_t WS_X1F  = WS_X1B  + al((size_t)MPAD * DM * 2);
constexpr size_t WS_X1SS = WS_X1F  + al((size_t)128 * DM * 4);
constexpr size_t WS_H    = WS_X1SS + al((size_t)MPAD * 32 * 4);
constexpr size_t WS_END  = WS_H    + al((size_t)MPAD * DFF * 2);

constexpr int CW_TMO = 0, CW_CODE = 1;
constexpr int CW_BAR = 4096;
static_assert((CW_BAR + 16 * 3456) * 4 <= (int)CTL_ZERO_BYTES, "CTL words inside the memset region");

constexpr int RING_OFF = 0, RING_BYTES = 131072;
constexpr int LDSCTL_OFF = RING_BYTES, MISC_OFF = LDSCTL_OFF + 320;
constexpr int LDS_BYTES = 147456;
static_assert(MISC_OFF + 128 <= LDS_BYTES, "LDS map");

__constant__ unsigned char kBkt[128] = {0, 1, 2, 3, 4, 5, 6, 7, 8, 9, 10, 11, 12, 13, 14, 15, 16, 16, 16, 17, 17, 18, 18, 18, 19, 19, 19, 20, 20, 20, 20, 21, 21, 21, 21, 22, 22, 22, 22, 22, 23, 23, 23, 23, 23, 23, 24, 24, 24, 24, 24, 24, 25, 25, 25, 25, 25, 25, 25, 26, 26, 26, 26, 26, 26, 26, 26, 27, 27, 27, 27, 27, 27, 27, 27, 27, 27, 28, 28, 28, 28, 28, 28, 28, 28, 28, 28, 29, 29, 29, 29, 29, 29, 29, 29, 29, 29, 29, 29, 30, 30, 30, 30, 30, 30, 30, 30, 30, 30, 30, 30, 30, 30, 31, 31, 31, 31, 31, 31, 31, 31, 31, 31, 31, 31, 31, 31, 31};

typedef unsigned v2u __attribute__((ext_vector_type(2)));
struct Ctx {
    const float* in[24]; float* out; unsigned char* ws;
    LAS unsigned char* lds;
    int tid, lane, wave, vcu, G;
};
#define IN_XP 0
#define IN_XS 1
#define IN_CCMP 2
#define IN_CSEL 3
#define IN_WINB 4
#define IN_PT 5
#define IN_RELB 6
#define IN_GMIX 7
#define IN_WIN 8
#define IN_GSGU 9
#define IN_WSGU 10
#define IN_BSGU 11
#define IN_GQ 12
#define IN_GK 13
#define IN_POSK 14
#define IN_WCK 15
#define IN_POSV 16
#define IN_WCV 17
#define IN_WPG 18
#define IN_WPN 19
#define IN_WOUT 20
#define IN_GMLP 21
#define IN_WUP 22
#define IN_WDN 23

__device__ __forceinline__ float bf2f(unsigned short b) { return __uint_as_float((unsigned)b << 16); }
__device__ __forceinline__ float bflo(unsigned w) { return __uint_as_float(w << 16); }
__device__ __forceinline__ float bfhi(unsigned w) { return __uint_as_float(w & 0xffff0000u); }
__device__ __forceinline__ void unpack8(v4u w, float (&f)[8]) {
    f[0] = bflo(w.x); f[1] = bfhi(w.x); f[2] = bflo(w.y); f[3] = bfhi(w.y); f[4] = bflo(w.z); f[5] = bfhi(w.z); f[6] = bflo(w.w); f[7] = bfhi(w.w);
}
__device__ __forceinline__ v4u pack8f(const float (&f)[8]) { v4u w; w.x = pk2(f[0], f[1]); w.y = pk2(f[2], f[3]); w.z = pk2(f[4], f[5]); w.w = pk2(f[6], f[7]); return w; }
__device__ __forceinline__ float wave_sum(float v) {
#pragma unroll
    for (int o = 1; o < 64; o <<= 1) v += __shfl_xor(v, o);
    return v;
}
__device__ __forceinline__ float wave_max(float v) {
#pragma unroll
    for (int o = 1; o < 64; o <<= 1) v = fmaxf(v, __shfl_xor(v, o));
    return v;
}
__device__ __forceinline__ float sigmoidf_(float x) { return 1.0f / (1.0f + __expf(-x)); }
__device__ __forceinline__ float gelu_tanh(float x) {
    const float u = 0.7978845608028654f * (x + 0.044715f * x * x * x);
    return x / (1.0f + __expf(-2.0f * u));
}

__device__ __forceinline__ void tr_item(const float* W, int ldw, int srccol0, int nvalid, const float* kscale, bf16* WT, int K, int dst_row0, int k0, LAS float* scr, int lane) {
    const int n = lane & 31;
#pragma unroll 8
    for (int i = 0; i < 32; ++i) { const int kk = 2 * i + (lane >> 5); float v = 0.f;
        if (n < nvalid) { v = W[(size_t)(k0 + kk) * ldw + srccol0 + n]; if (kscale) v *= kscale[k0 + kk]; }
        scr[kk * 33 + n] = v; }
    LDS_WAIT(); asm volatile("" ::: "memory");
    const int c = lane & 7;
#pragma unroll
    for (int j = 0; j < 4; ++j) { const int nn = (lane >> 3) + 8 * j; const LAS float* s = scr + (8 * c) * 33 + nn;
        v4u o; o.x = pk2(s[0 * 33], s[1 * 33]); o.y = pk2(s[2 * 33], s[3 * 33]); o.z = pk2(s[4 * 33], s[5 * 33]); o.w = pk2(s[6 * 33], s[7 * 33]);
        *(GAS v4u*)(WT + (size_t)(dst_row0 + nn) * K + k0 + 8 * c) = o; }
    LDS_WAIT(); asm volatile("" ::: "memory");
}

__device__ __forceinline__ void p0_prologue(const Ctx& C) {
    unsigned char* ws = C.ws;
    LAS float* scr = (LAS float*)(C.lds + RING_OFF + C.wave * 16384);
    const int gw = C.vcu * NWAVES + C.wave, NGW = C.G * NWAVES, lane = C.lane;
    constexpr int I_IN = 32 * 280, I_PG = 16 * 64, I_PN = 16 * 64, I_OUT = 32 * 64, I_UP = 32 * 256, I_DN = 128 * 64, I_C = 4 * 128;
    constexpr int NITEMS = I_IN + I_PG + I_PN + I_OUT + I_UP + I_DN + I_C;
    for (int it = gw; it < NITEMS; it += NGW) {
        int r = it;
        if (r < I_IN) { const int kb = r / 280, nb = r % 280, n0 = nb * 32;
            const int src = n0 < 4608 ? n0 : (n0 < 8704 ? n0 + 24 : n0 - 8704 + 4608);
            const int nv = n0 < 8704 ? 32 : (n0 == 8704 ? 24 : 0);
            tr_item(C.in[IN_WIN], NIN, src, nv, C.in[IN_GMIX], (bf16*)(ws + WS_WIN), DM, n0, kb * 64, scr, lane); continue; } r -= I_IN;
        if (r < I_PG) { const int kb = r / 64, nb = r % 64; tr_item(C.in[IN_WPG], DM, nb * 32, 32, nullptr, (bf16*)(ws + WS_WG), DG, nb * 32, kb * 64, scr, lane); continue; } r -= I_PG;
        if (r < I_PN) { const int kb = r / 64, nb = r % 64; tr_item(C.in[IN_WPN], DM, nb * 32, 32, nullptr, (bf16*)(ws + WS_WN), DQ, nb * 32, kb * 64, scr, lane); continue; } r -= I_PN;
        if (r < I_OUT) { const int kb = r / 64, nb = r % 64; tr_item(C.in[IN_WOUT], DM, nb * 32, 32, nullptr, (bf16*)(ws + WS_WO), DM, nb * 32, kb * 64, scr, lane); continue; } r -= I_OUT;
        if (r < I_UP) { const int kb = r / 256, nb = r % 256; tr_item(C.in[IN_WUP], DFF, nb * 32, 32, C.in[IN_GMLP], (bf16*)(ws + WS_WUP), DM, nb * 32, kb * 64, scr, lane); continue; } r -= I_UP;
        if (r < I_DN) { const int kb = r / 64, nb = r % 64; tr_item(C.in[IN_WDN], DM, nb * 32, 32, nullptr, (bf16*)(ws + WS_WDN), DFF, nb * 32, kb * 64, scr, lane); continue; } r -= I_DN;
        { const int sub = r / 128, rr = r % 128, kv = sub >> 1, hf = sub & 1, kb = rr / 4, nb = rr % 4;
          const float* W = (kv ? C.in[IN_WCV] : C.in[IN_WCK]) + (size_t)hf * 2048 * 128;
          tr_item(W, 128, nb * 32, 32, nullptr, (bf16*)(ws + WS_WC), 2048, kv * 256 + hf * 128 + nb * 32, kb * 64, scr, lane); }
    }
    {
        bf16* XB = (bf16*)(ws + WS_XB); float* RS = (float*)(ws + WS_RSTD1);
        for (int m = gw; m < MPAD; m += NGW) {
            GAS v2u* o8 = (GAS v2u*)(XB + (size_t)m * DM) + lane;
            if (m >= MREAL) {
#pragma unroll
                for (int j = 0; j < 8; ++j) o8[64 * j] = (v2u){0u, 0u};
                if (lane == 0) RS[m] = 0.f; continue; }
            const float* xr = m < MPROMPT ? C.in[IN_XP] + (size_t)m * DM : C.in[IN_XS] + (size_t)(m - MPROMPT) * DM;
            const GAS f32x4* x4 = (const GAS f32x4*)xr + lane; f32x4 v[8]; float s = 0.f;
#pragma unroll
            for (int j = 0; j < 8; ++j) { v[j] = x4[64 * j]; s += (v[j].x * v[j].x + v[j].y * v[j].y) + (v[j].z * v[j].z + v[j].w * v[j].w); }
            s = wave_sum(s);
#pragma unroll
            for (int j = 0; j < 8; ++j) o8[64 * j] = (v2u){pk2(v[j].x, v[j].y), pk2(v[j].z, v[j].w)};
            if (lane == 0) RS[m] = rsqrtf(s * (1.0f / DM) + EPS);
        }
    }
    {
        float* CBP = (float*)(ws + WS_CBP);
        for (int it = gw; it < 64; it += NGW) { const int kv = it >> 5, eb = (it >> 4) & 1, kc = it & 15, e = eb * 64 + lane;
            const float* pos = kv ? C.in[IN_POSV] : C.in[IN_POSK]; const float* W = kv ? C.in[IN_WCV] : C.in[IN_WCK]; float a = 0.f;
#pragma unroll 8
            for (int k = kc * 256; k < kc * 256 + 256; ++k) a += pos[k] * W[(size_t)k * 128 + e];
            CBP[(kv * 16 + kc) * 128 + e] = a; }
    }
    {
        const float* cc = C.in[IN_CCMP]; const int* pt = (const int*)C.in[IN_PT]; bf16* ACS = (bf16*)(ws + WS_ACS);
        const int kvg = lane >> 4, d = (lane & 15) * 8;
        for (int it = gw; it < 128 * 16 * 8; it += NGW) { const int b = it >> 7, p = (it >> 3) & 15, sg = it & 7, page = pt[b * 16 + p], j = p * 8 + sg;
            const float* src = cc + ((size_t)page * 128 + sg * 16) * 512 + lane * 8;
            bf16* dst = ACS + (size_t)((b * 4 + kvg) * 128 + j) * 2048 + d;
#pragma unroll 4
            for (int s = 0; s < 16; ++s) { const f32x4 a = *(const GAS f32x4*)(src + s * 512), c2 = *(const GAS f32x4*)(src + s * 512 + 4);
                v4u o; o.x = pk2(a.x, a.y); o.y = pk2(a.z, a.w); o.z = pk2(c2.x, c2.y); o.w = pk2(c2.z, c2.w);
                *(GAS v4u*)(dst + s * 128) = o; } }
    }
    {
        const GAS f32x4* src = (const GAS f32x4*)C.in[IN_WINB]; GAS f32x4* dst = (GAS f32x4*)(C.out + O_SWIN);
        const int total = 128 * 65408;
        for (int i = gw * 64 + lane; i < total; i += NGW * 64) { const int b = i / 65408, r = i - b * 65408; dst[b * 65536 + r] = src[b * 65536 + 128 + r]; }
    }
    {
        const float* w = C.in[IN_WSGU]; bf16* WMB = (bf16*)(ws + WS_WMB);
        for (int i = gw * 64 + lane; i < 8 * 128 * 128 / 8; i += NGW * 64) { const int e0 = i * 8, t = (e0 >> 7) & 127, s0 = e0 & 127; float f[8];
#pragma unroll
            for (int k = 0; k < 8; ++k) f[k] = (s0 + k <= t) ? w[e0 + k] : 0.f;
            *(GAS v4u*)(WMB + e0) = pack8f(f); }
        float* BL = (float*)(ws + WS_BLUT); const float* rb = C.in[IN_RELB];
        for (int i = gw * 64 + lane; i < 8 * 132; i += NGW * 64) { const int h = i / 132, rel = i % 132; const int bk = rel < 128 ? kBkt[rel] : 31; BL[i] = rb[bk * 8 + h] * LOG2E; }
        GAS v4u* oa = (GAS v4u*)((bf16*)(ws + WS_OA) + (size_t)MREAL * DG); GAS v4u* ob = (GAS v4u*)((bf16*)(ws + WS_OB) + (size_t)MREAL * DQ);
        for (int i = gw * 64 + lane; i < 128 * 1024 / 8; i += NGW * 64) { oa[i] = (v4u){0u, 0u, 0u, 0u}; ob[i] = (v4u){0u, 0u, 0u, 0u}; }
    }
}

namespace epi {
using pg8::f32x4; using pg8::Unit; using pg8::cvt_pk_bf16;
typedef unsigned u32x4 __attribute__((ext_vector_type(4)));
__device__ __forceinline__ u32x4 pack8v(f32x4 a, f32x4 b) { u32x4 w; w.x = cvt_pk_bf16(a[0], a[1]); w.y = cvt_pk_bf16(a[2], a[3]); w.z = cvt_pk_bf16(b[0], b[1]); w.w = cvt_pk_bf16(b[2], b[3]); return w; }

struct EpiIn {
    static constexpr bool PERM = true, AFTER_DRAIN = false;
    const float* rstd; bf16* U; bf16* VG; float* VSS; float* QRAW; float* KVWR; bf16* GA; bf16* GB; float* GN; float* out;
    __device__ __forceinline__ void operator()(const f32x4 (&acc)[2][2][4][2], const Unit& u, int wr, int wc, int fr, int fq) const {
        const int row0 = u.pm * 256 + wr * 64 + fr, cl = wc * 32 + 8 * fq, pn = u.pn;
#pragma unroll
        for (int ai = 0; ai < 2; ++ai)
#pragma unroll
            for (int m = 0; m < 4; ++m) { const int row = row0 + ai * 128 + m * 16; const float rs = rstd[row];
#pragma unroll
                for (int bj = 0; bj < 2; ++bj) { f32x4 v0 = acc[ai][bj][m][0] * rs, v1 = acc[ai][bj][m][1] * rs; const int c = cl + bj * 128;
                    if (pn < 8) {
#pragma unroll
                        for (int k = 0; k < 4; ++k) { v0[k] = gelu_tanh(v0[k]); v1[k] = gelu_tanh(v1[k]); }
                        if (pn < 4) *(u32x4*)(U + (size_t)row * DG + pn * 256 + c) = pack8v(v0, v1);
                        else { *(u32x4*)(VG + (size_t)row * DG + (pn - 4) * 256 + c) = pack8v(v0, v1);
                            float ss = (v0[0] * v0[0] + v0[1] * v0[1]) + (v0[2] * v0[2] + v0[3] * v0[3]) + (v1[0] * v1[0] + v1[1] * v1[1]) + (v1[2] * v1[2] + v1[3] * v1[3]);
                            ss += __shfl_xor(ss, 16); ss += __shfl_xor(ss, 32);
                            if (fq == 0) VSS[(size_t)row * 32 + (pn - 4) * 8 + bj * 4 + wc] = ss; }
                    } else if (pn < 12) { float* q = QRAW + (size_t)row * DQ + (pn - 8) * 256 + c; *(f32x4*)q = v0; *(f32x4*)(q + 4) = v1;
                    } else if (pn < 16) {
                        const int cc = ((pn - 12) & 1) * 256 + c; float* o = nullptr;
                        if (row < MPROMPT) o = out + (pn < 14 ? O_PCMP : O_PSEL) + (size_t)row * 512 + cc;
                        else if (row < MREAL) o = out + (pn < 14 ? O_SCMP : O_SSEL) + (size_t)(row - MPROMPT) * 512 + cc;
                        if (o) { *(f32x4*)o = v0; *(f32x4*)(o + 4) = v1; }
                    } else if (pn < 18) { float* o = KVWR + (size_t)row * 512 + (pn - 16) * 256 + c; *(f32x4*)o = v0; *(f32x4*)(o + 4) = v1;
                    } else if (pn < 34) {
#pragma unroll
                        for (int k = 0; k < 4; ++k) { v0[k] = sigmoidf_(v0[k]); v1[k] = sigmoidf_(v1[k]); }
                        bf16* g = (pn < 26 ? GA + (size_t)row * DM + (pn - 18) * 256 : GB + (size_t)row * DM + (pn - 26) * 256) + c; *(u32x4*)g = pack8v(v0, v1);
                    } else { if (c < 24) {
#pragma unroll
                        for (int k = 0; k < 4; ++k) { v0[k] = sigmoidf_(v0[k]); v1[k] = sigmoidf_(v1[k]); }
                        float* o = GN + (size_t)row * 32 + c; *(f32x4*)o = v0; *(f32x4*)(o + 4) = v1; } }
                } }
    }
};
struct EpiCmp {
    static constexpr bool PERM = false, AFTER_DRAIN = false;
    float* YC; int segmask;
    __device__ __forceinline__ void operator()(const f32x4 (&acc)[2][2][4][2], const Unit& u, int wr, int wc, int fr, int fq) const {
        const int row0 = u.pm * 256 + wr * 64 + fr, cl = wc * 32 + 4 * fq;
#pragma unroll
        for (int ai = 0; ai < 2; ++ai)
#pragma unroll
            for (int m = 0; m < 4; ++m) { const int row = row0 + ai * 128 + m * 16;
#pragma unroll
                for (int n = 0; n < 2; ++n) { *(f32x4*)(YC + (size_t)row * 256 + cl + n * 16) = acc[ai][0][m][n];
                    if ((row & segmask) != 0) *(f32x4*)(YC + (size_t)(row - 1) * 256 + 128 + cl + n * 16) = acc[ai][1][m][n]; } }
    }
};
struct EpiMixA {
    static constexpr bool PERM = true, AFTER_DRAIN = false;
    const bf16* GA; bf16* MIXA;
    __device__ __forceinline__ void operator()(const f32x4 (&acc)[2][2][4][2], const Unit& u, int wr, int wc, int fr, int fq) const {
        const int row0 = u.pm * 256 + wr * 64 + fr, c0 = u.pn * 256 + wc * 32 + 8 * fq;
#pragma unroll
        for (int ai = 0; ai < 2; ++ai)
#pragma unroll
            for (int m = 0; m < 4; ++m) { const size_t ro = (size_t)(row0 + ai * 128 + m * 16) * DM;
#pragma unroll
                for (int bj = 0; bj < 2; ++bj) { const size_t o = ro + c0 + bj * 128; float g[8]; unpack8(*(const v4u*)(GA + o), g);
                    f32x4 v0 = acc[ai][bj][m][0], v1 = acc[ai][bj][m][1];
                    v0[0] *= g[0]; v0[1] *= g[1]; v0[2] *= g[2]; v0[3] *= g[3]; v1[0] *= g[4]; v1[1] *= g[5]; v1[2] *= g[6]; v1[3] *= g[7];
                    *(u32x4*)(MIXA + o) = pack8v(v0, v1); } }
    }
};
struct EpiMixB {
    static constexpr bool PERM = true, AFTER_DRAIN = false;
    const bf16* GB; const bf16* MIXA; bf16* MIX;
    __device__ __forceinline__ void operator()(const f32x4 (&acc)[2][2][4][2], const Unit& u, int wr, int wc, int fr, int fq) const {
        const int row0 = u.pm * 256 + wr * 64 + fr, c0 = u.pn * 256 + wc * 32 + 8 * fq;
#pragma unroll
        for (int ai = 0; ai < 2; ++ai)
#pragma unroll
            for (int m = 0; m < 4; ++m) { const size_t ro = (size_t)(row0 + ai * 128 + m * 16) * DM;
#pragma unroll
                for (int bj = 0; bj < 2; ++bj) { const size_t o = ro + c0 + bj * 128; float g[8], a[8]; unpack8(*(const v4u*)(GB + o), g); unpack8(*(const v4u*)(MIXA + o), a);
                    f32x4 v0 = acc[ai][bj][m][0], v1 = acc[ai][bj][m][1];
                    v0[0] = a[0] + v0[0] * g[0]; v0[1] = a[1] + v0[1] * g[1]; v0[2] = a[2] + v0[2] * g[2]; v0[3] = a[3] + v0[3] * g[3];
                    v1[0] = a[4] + v1[0] * g[4]; v1[1] = a[5] + v1[1] * g[5]; v1[2] = a[6] + v1[2] * g[6]; v1[3] = a[7] + v1[3] * g[7];
                    *(u32x4*)(MIX + o) = pack8v(v0, v1); } }
    }
};
struct EpiOut {
    static constexpr bool PERM = true, AFTER_DRAIN = false;
    const float* xp; const float* xs; float* out; bf16* X1B; float* SS;
    __device__ __forceinline__ void operator()(const f32x4 (&acc)[2][2][4][2], const Unit& u, int wr, int wc, int fr, int fq) const {
        const int row0 = u.pm * 256 + wr * 64 + fr, c0 = u.pn * 256 + wc * 32 + 8 * fq;
#pragma unroll
        for (int ai = 0; ai < 2; ++ai)
#pragma unroll
            for (int m = 0; m < 4; ++m) { const int row = row0 + ai * 128 + m * 16; float ss = 0.f;
                const float* xr = row < MPROMPT ? xp + (size_t)row * DM : (row < MREAL ? xs + (size_t)(row - MPROMPT) * DM : nullptr);
                float* yr = row < MPROMPT ? out + O_YP + (size_t)row * DM : (row < MREAL ? out + O_YS + (size_t)(row - MPROMPT) * DM : nullptr);
#pragma unroll
                for (int bj = 0; bj < 2; ++bj) { const int c = c0 + bj * 128; f32x4 v0 = acc[ai][bj][m][0], v1 = acc[ai][bj][m][1];
                    if (xr) { v0 += *(const f32x4*)(xr + c); v1 += *(const f32x4*)(xr + c + 4); *(f32x4*)(yr + c) = v0; *(f32x4*)(yr + c + 4) = v1; }
                    *(u32x4*)(X1B + (size_t)row * DM + c) = pack8v(v0, v1);
                    ss += (v0[0] * v0[0] + v0[1] * v0[1]) + (v0[2] * v0[2] + v0[3] * v0[3]) + (v1[0] * v1[0] + v1[1] * v1[1]) + (v1[2] * v1[2] + v1[3] * v1[3]); }
                ss += __shfl_xor(ss, 16); ss += __shfl_xor(ss, 32);
                if (fq == 0) SS[(size_t)row * 32 + u.pn * 4 + wc] = ss; }
    }
};
struct EpiUp {
    static constexpr bool PERM = true, AFTER_DRAIN = false;
    const float* SS; bf16* H;
    __device__ __forceinline__ void operator()(const f32x4 (&acc)[2][2][4][2], const Unit& u, int wr, int wc, int fr, int fq) const {
        const int row0 = u.pm * 256 + wr * 64 + fr, c0 = u.pn * 256 + wc * 32 + 8 * fq;
#pragma unroll
        for (int ai = 0; ai < 2; ++ai)
#pragma unroll
            for (int m = 0; m < 4; ++m) { const int row = row0 + ai * 128 + m * 16; const f32x4* sp = (const f32x4*)(SS + (size_t)row * 32); f32x4 s4 = sp[0];
#pragma unroll
                for (int k = 1; k < 8; ++k) s4 += sp[k];
                const float rs = rsqrtf(((s4[0] + s4[1]) + (s4[2] + s4[3])) * (1.0f / DM) + EPS);
#pragma unroll
                for (int bj = 0; bj < 2; ++bj) { f32x4 v0 = acc[ai][bj][m][0] * rs, v1 = acc[ai][bj][m][1] * rs;
#pragma unroll
                    for (int k = 0; k < 4; ++k) { const float a = fmaxf(v0[k], 0.f), b = fmaxf(v1[k], 0.f); v0[k] = a * a; v1[k] = b * b; }
                    *(u32x4*)(H + (size_t)row * DFF + c0 + bj * 128) = pack8v(v0, v1); } }
    }
};
struct EpiDown {
    static constexpr bool PERM = true, AFTER_DRAIN = false;
    float* out;
    __device__ __forceinline__ void operator()(const f32x4 (&acc)[2][2][4][2], const Unit& u, int wr, int wc, int fr, int fq) const {
        const int row0 = u.pm * 256 + wr * 64 + fr, c0 = u.pn * 256 + wc * 32 + 8 * fq;
#pragma unroll
        for (int ai = 0; ai < 2; ++ai)
#pragma unroll
            for (int m = 0; m < 4; ++m) { const int row = row0 + ai * 128 + m * 16;
                float* yr = row < MPROMPT ? out + O_YP + (size_t)row * DM : (row < MREAL ? out + O_YS + (size_t)(row - MPROMPT) * DM : nullptr);
                if (yr) {
#pragma unroll
                    for (int bj = 0; bj < 2; ++bj) { float* p = yr + c0 + bj * 128; const f32x4 a = *(const f32x4*)p, b = *(const f32x4*)(p + 4);
                        *(f32x4*)p = a + acc[ai][bj][m][0]; *(f32x4*)(p + 4) = b + acc[ai][bj][m][1]; } } }
    }
};
struct CmpOrder {
    int n, G, c, shift;
    __device__ __forceinline__ bool next(int i, Unit& u) const { const int L = i * G + c; if (L >= n) return false; u.pm = L; u.pn = (L >> shift) & 1; return true; }
    __device__ __forceinline__ void a_ready(const Unit&) const {}
    __device__ __forceinline__ void done(const Unit&) const {}
};
}

__device__ __forceinline__ float grp_sum8(float v) { v += __shfl_xor(v, 1); v += __shfl_xor(v, 2); v += __shfl_xor(v, 4); return v; }
__device__ __forceinline__ float grp_sum16(float v) { v = grp_sum8(v); v += __shfl_xor(v, 8); return v; }
__device__ __forceinline__ float grp_sum32(float v) { v = grp_sum16(v); v += __shfl_xor(v, 16); return v; }

__device__ __forceinline__ void p2_post(const Ctx& C) {
    unsigned char* ws = C.ws; const int gw = C.vcu * NWAVES + C.wave, NGW = C.G * NWAVES, lane = C.lane;
    const float* QRAW = (const float*)(ws + WS_QRAW); bf16* QN = (bf16*)(ws + WS_QN); const float* KVWR = (const float*)(ws + WS_KVWR);
    const float* gq = C.in[IN_GQ]; const float* gk = C.in[IN_GK];
    for (int row = gw; row < MREAL; row += NGW) {
        const bool pr = row < MPROMPT; const int b = row >> 12, t = row & 4095, bs = row - MPROMPT;
        { const GAS f32x4* q4 = (const GAS f32x4*)(QRAW + (size_t)row * DQ + lane * 16); f32x4 v[4]; float ss = 0.f;
#pragma unroll
          for (int j = 0; j < 4; ++j) { v[j] = q4[j]; ss += (v[j].x * v[j].x + v[j].y * v[j].y) + (v[j].z * v[j].z + v[j].w * v[j].w); }
          ss = grp_sum8(ss); const float rs = rsqrtf(ss * (1.0f / 128) + EPS) * QSCALE; const float* g = gq + (lane & 7) * 16; float f[16];
#pragma unroll
          for (int j = 0; j < 4; ++j) { f[4 * j] = v[j].x * rs * g[4 * j]; f[4 * j + 1] = v[j].y * rs * g[4 * j + 1]; f[4 * j + 2] = v[j].z * rs * g[4 * j + 2]; f[4 * j + 3] = v[j].w * rs * g[4 * j + 3]; }
          GAS v4u* o = (GAS v4u*)(QN + (size_t)row * DQ + lane * 16);
          o[0] = (v4u){pk2(f[0], f[1]), pk2(f[2], f[3]), pk2(f[4], f[5]), pk2(f[6], f[7])}; o[1] = (v4u){pk2(f[8], f[9]), pk2(f[10], f[11]), pk2(f[12], f[13]), pk2(f[14], f[15])}; }
        const int kv = lane >> 5, g = (lane >> 4) & 1, d = (lane & 15) * 8;
        if (pr) { const float* src = C.out + O_PSEL + (size_t)row * 512 + lane * 8; const f32x4 a = *(const GAS f32x4*)src, c2 = *(const GAS f32x4*)(src + 4);
            float ss = (a.x * a.x + a.y * a.y) + (a.z * a.z + a.w * a.w) + (c2.x * c2.x + c2.y * c2.y) + (c2.z * c2.z + c2.w * c2.w); ss = grp_sum16(ss);
            const float rs = kv == 0 ? rsqrtf(ss * (1.0f / 128) + EPS) : 1.f; const float* gg = gk + 128 + d; float f[8] = {a.x, a.y, a.z, a.w, c2.x, c2.y, c2.z, c2.w};
#pragma unroll
            for (int k = 0; k < 8; ++k) f[k] = kv == 0 ? f[k] * rs * gg[k] : f[k];
            bf16* dst = (bf16*)(ws + (kv == 0 ? WS_KS : WS_VS)) + ((size_t)(b * 2 + g) * T + t) * 128 + d; *(GAS v4u*)dst = pack8f(f); }
        { const float* src = KVWR + (size_t)row * 512 + lane * 8; const f32x4 a = *(const GAS f32x4*)src, c2 = *(const GAS f32x4*)(src + 4);
          if (pr) { float ss = (a.x * a.x + a.y * a.y) + (a.z * a.z + a.w * a.w) + (c2.x * c2.x + c2.y * c2.y) + (c2.z * c2.z + c2.w * c2.w); ss = grp_sum16(ss);
            const float rs = kv == 0 ? rsqrtf(ss * (1.0f / 128) + EPS) : 1.f; const float* gg = gk + 256 + d; float f[8] = {a.x, a.y, a.z, a.w, c2.x, c2.y, c2.z, c2.w};
#pragma unroll
            for (int k = 0; k < 8; ++k) f[k] = kv == 0 ? f[k] * rs * gg[k] : f[k];
            bf16* dst = (bf16*)(ws + (kv == 0 ? WS_KW : WS_VW)) + ((size_t)(b * 2 + g) * T + t) * 128 + d; *(GAS v4u*)dst = pack8f(f);
            if (t >= T - 512) { float* o = C.out + O_PWIN + ((size_t)b * 512 + (t - (T - 512))) * 512 + lane * 8; *(GAS f32x4*)o = a; *(GAS f32x4*)(o + 4) = c2; }
          } else { float* o = C.out + O_SWIN + ((size_t)bs * 512 + 511) * 512 + lane * 8; *(GAS f32x4*)o = a; *(GAS f32x4*)(o + 4) = c2; } }
        if (pr) { const float* src = C.out + O_PCMP + (size_t)row * 512 + lane * 8; const f32x4 a = *(const GAS f32x4*)src, c2 = *(const GAS f32x4*)(src + 4);
            bf16* dst = (bf16*)(ws + WS_ACP) + (size_t)(((b * 2 + kv) * 2 + g) * 256 + (t >> 4)) * 2048 + (t & 15) * 128 + d;
            *(GAS v4u*)dst = (v4u){pk2(a.x, a.y), pk2(a.z, a.w), pk2(c2.x, c2.y), pk2(c2.z, c2.w)}; }
        { float s = lane < 32 ? ((const float*)(ws + WS_VSS))[(size_t)row * 32 + lane] : 0.f; s = wave_sum(s); if (lane == 0) ((float*)(ws + WS_RSTDV))[row] = rsqrtf(s * (1.0f / DG) + EPS); }
    }
}

__device__ __forceinline__ void p4_cmp_combine(const Ctx& C) {
    unsigned char* ws = C.ws; const int ghw = (C.vcu * NWAVES + C.wave) * 2 + (C.lane >> 5), NGHW = C.G * NWAVES * 2, l32 = C.lane & 31, e = l32 * 4;
    const float* CBP = (const float*)(ws + WS_CBP); const float* gk0 = C.in[IN_GK];
    f32x4 cb0 = {0.f, 0.f, 0.f, 0.f}, cb1 = {0.f, 0.f, 0.f, 0.f};
#pragma unroll
    for (int kc = 0; kc < 16; ++kc) { cb0 += *(const GAS f32x4*)(CBP + kc * 128 + e); cb1 += *(const GAS f32x4*)(CBP + (16 + kc) * 128 + e); }
    const f32x4 g4 = *(const GAS f32x4*)(gk0 + e);
    for (int r = ghw; r < 2048 + 65536; r += NGHW) {
        const bool pr = r < 2048; const int rr = pr ? r : r - 2048; const int segs = pr ? 256 : 128;
        const int j = rr & (segs - 1), grp = rr / segs, g = grp & 1, kv = (grp >> 1) & 1, b = grp >> 2;
        const float* Y = (const float*)(ws + (pr ? WS_YCP : WS_YCS)) + (size_t)rr * 256;
        f32x4 v = {0.f, 0.f, 0.f, 0.f};
        if (j < segs - 1) { v = *(const GAS f32x4*)(Y + e) + *(const GAS f32x4*)(Y + 128 + e) + (kv ? cb1 : cb0); }
        float ss = (v.x * v.x + v.y * v.y) + (v.z * v.z + v.w * v.w); ss = grp_sum32(ss);
        if (kv == 0) { const float rs = rsqrtf(ss * (1.0f / 128) + EPS); v = v * rs * g4; }
        bf16* dst = (bf16*)(ws + (pr ? (kv ? WS_VCP : WS_KCP) : (kv ? WS_VCS : WS_KCS))) + ((size_t)(b * 2 + g) * segs + j) * 128 + e;
        *(GAS v2u*)dst = (v2u){pk2(v.x, v.y), pk2(v.z, v.w)};
    }
}

typedef short s16x4 __attribute__((ext_vector_type(4)));
typedef float f32x16 __attribute__((ext_vector_type(16)));
__device__ __forceinline__ int v_st(int k, int c) { const int kk = (k & ~0xC) | ((k & 4) << 1) | ((k & 8) >> 1); return ((kk >> 3) * 4 + (c >> 5)) * 512 + ((kk & 7) * 32 + (c & 31)) * 2; }
__device__ __forceinline__ int v_rd_base(int lane) { return ((lane & 3) << 3) | (((lane >> 2) & 3) << 6) | (((lane >> 4) & 1) << 5) | (((lane >> 5) & 1) << 8); }
constexpr int v_rd_off(int d0, int ks, int half) { return d0 * 512 + ks * 4096 + half * 2048; }
__device__ __forceinline__ int crow(int r, int hi) { return (r & 3) + 8 * (r >> 2) + 4 * hi; }
#define SBAR() __builtin_amdgcn_sched_barrier(0)
__device__ __forceinline__ void pv_tile(f32x16* o, int vb0, bf16x8 pa0, bf16x8 pa1, bf16x8 pa2, bf16x8 pa3) {
#define TRRD(dst, off) asm volatile("ds_read_b64_tr_b16 %0, %1 offset:%2" : "=&v"(dst) : "v"(vb0), "i"(off) : "memory")
#define PV_D0(d0) do { s16x4 l0, l1, l2, l3, h0, h1, h2, h3; constexpr int b_ = v_rd_off(d0, 0, 0); \
        TRRD(l0, b_); TRRD(h0, b_ + 2048); TRRD(l1, b_ + 4096); TRRD(h1, b_ + 6144); TRRD(l2, b_ + 8192); TRRD(h2, b_ + 10240); TRRD(l3, b_ + 12288); TRRD(h3, b_ + 14336); \
        asm volatile("s_waitcnt lgkmcnt(0)" ::: "memory"); SBAR(); \
        o[d0] = __builtin_amdgcn_mfma_f32_32x32x16_bf16(pa0, (bf16x8){l0[0], l0[1], l0[2], l0[3], h0[0], h0[1], h0[2], h0[3]}, o[d0], 0, 0, 0); \
        o[d0] = __builtin_amdgcn_mfma_f32_32x32x16_bf16(pa1, (bf16x8){l1[0], l1[1], l1[2], l1[3], h1[0], h1[1], h1[2], h1[3]}, o[d0], 0, 0, 0); \
        o[d0] = __builtin_amdgcn_mfma_f32_32x32x16_bf16(pa2, (bf16x8){l2[0], l2[1], l2[2], l2[3], h2[0], h2[1], h2[2], h2[3]}, o[d0], 0, 0, 0); \
        o[d0] = __builtin_amdgcn_mfma_f32_32x32x16_bf16(pa3, (bf16x8){l3[0], l3[1], l3[2], l3[3], h3[0], h3[1], h3[2], h3[3]}, o[d0], 0, 0, 0); } while (0)
    PV_D0(0); PV_D0(1); PV_D0(2); PV_D0(3);
#undef PV_D0
#undef TRRD
}

__device__ __forceinline__ void p4_sgu(const Ctx& C) {
    unsigned char* ws = C.ws; const int tid = C.tid, lane = C.lane, wave = C.wave, r32 = lane & 31, hi = lane >> 5;
    const bf16* U = (const bf16*)(ws + WS_U); const bf16* VG = (const bf16*)(ws + WS_VG); const float* RV = (const float*)(ws + WS_RSTDV);
    const bf16* WMB = (const bf16*)(ws + WS_WMB); bf16* OA = (bf16*)(ws + WS_OA);
    const float* gs = C.in[IN_GSGU]; const float* bs = C.in[IN_BSGU];
    LAS unsigned char* Vl = C.lds + RING_OFF;
    for (int unit = C.vcu; unit < 256; unit += C.G) {
        const int n = unit >> 2, gp = unit & 3, rowbase = n * 128; const bool last = (n & 31) == 31; const int bb = n >> 5;
        __syncthreads();
        { const int sr = tid >> 4, sc = (tid & 15) * 8;
#pragma unroll
          for (int gl = 0; gl < 2; ++gl) { const int g = gp * 2 + gl; float gg[8];
#pragma unroll
              for (int k = 0; k < 8; ++k) gg[k] = gs[g * 128 + sc + k];
#pragma unroll
              for (int q = 0; q < 4; ++q) { const int s = q * 32 + sr, st = s >> 6, row = rowbase + s; float f[8];
                  unpack8(*(const GAS v4u*)(VG + (size_t)row * DG + g * 128 + sc), f); const float rs = RV[row];
#pragma unroll
                  for (int k = 0; k < 8; ++k) f[k] = f[k] * rs * gg[k];
                  *(LAS v4u*)(Vl + (gl * 2 + st) * 16384 + v_st(s & 63, sc)) = pack8f(f);
                  if (last) { float* o = C.out + O_PSGU + ((size_t)bb * 128 + s) * DG + g * 128 + sc; *(GAS f32x4*)o = (f32x4){f[0], f[1], f[2], f[3]}; *(GAS f32x4*)(o + 4) = (f32x4){f[4], f[5], f[6], f[7]}; } } } }
        __syncthreads();
        const int tb = wave & 3, gl = wave >> 2, g = gp * 2 + gl;
        f32x16 o[4];
#pragma unroll
        for (int d0 = 0; d0 < 4; ++d0)
#pragma unroll
            for (int r = 0; r < 16; ++r) o[d0][r] = 0.f;
#pragma unroll
        for (int st = 0; st < 2; ++st) if (64 * st <= 32 * tb + 31) {
            const bf16* wp = WMB + ((size_t)g * 128 + tb * 32 + r32) * 128 + st * 64 + hi * 8;
            const bf16x8 pa0 = *(const GAS bf16x8*)(wp), pa1 = *(const GAS bf16x8*)(wp + 16), pa2 = *(const GAS bf16x8*)(wp + 32), pa3 = *(const GAS bf16x8*)(wp + 48);
            const int vb0 = (int)(unsigned)(uintptr_t)(Vl + (gl * 2 + st) * 16384) + v_rd_base(lane);
            pv_tile(o, vb0, pa0, pa1, pa2, pa3);
        }
#pragma unroll
        for (int r = 0; r < 16; ++r) { const int trow = tb * 32 + crow(r, hi); const float bv = bs[g * 128 + trow]; const size_t ro = (size_t)(rowbase + trow) * DG + g * 128;
#pragma unroll
            for (int d0 = 0; d0 < 4; ++d0) { const int c = d0 * 32 + r32; const float v = (o[d0][r] + bv) * bf2f(U[ro + c]); const float vn = __shfl_xor(v, 1);
                if ((r32 & 1) == 0) *(GAS unsigned*)(OA + ro + c) = pk2(v, vn); } }
    }
    { const int gt = C.vcu * 512 + tid, NT = C.G * 512; const float* w = C.in[IN_WSGU];
      for (int i = gt; i < MSAMP * DG / 8; i += NT) { const int r = i >> 7, c = (i & 127) * 8, row = MPROMPT + r, g = c >> 7; float f[8], uu[8];
          unpack8(*(const GAS v4u*)(VG + (size_t)row * DG + c), f); unpack8(*(const GAS v4u*)(U + (size_t)row * DG + c), uu); const float rs = RV[row], w00 = w[g * 16384], b0 = bs[g * 128];
#pragma unroll
          for (int k = 0; k < 8; ++k) { f[k] = f[k] * rs * gs[c + k]; uu[k] = uu[k] * (w00 * f[k] + b0); }
          float* o = C.out + O_SSGU + (size_t)r * DG + c; *(GAS f32x4*)o = (f32x4){f[0], f[1], f[2], f[3]}; *(GAS f32x4*)(o + 4) = (f32x4){f[4], f[5], f[6], f[7]};
          *(GAS v4u*)(OA + (size_t)row * DG + c) = pack8f(uu); } }
}

struct AttItem { const bf16* q; int t; int ncmp; const bf16* kc; const bf16* vc; int nblk; const float* gates; bf16* out; const float* blut; };

__device__ __forceinline__ void ld8f(const float* p, float (&f)[8]) { const f32x4 a = *(const GAS f32x4*)p, b = *(const GAS f32x4*)(p + 4); f[0] = a.x; f[1] = a.y; f[2] = a.z; f[3] = a.w; f[4] = b.x; f[5] = b.y; f[6] = b.z; f[7] = b.w; }
struct PromptKV {
    const bf16 *ks, *vs, *kw, *vw;
    static constexpr bool NORM = false;
    __device__ __forceinline__ void selK(int pos, int d8, float (&k)[8]) const { unpack8(*(const GAS v4u*)(ks + (size_t)pos * 128 + d8), k); }
    __device__ __forceinline__ void selV(int pos, int d8, float (&k)[8]) const { unpack8(*(const GAS v4u*)(vs + (size_t)pos * 128 + d8), k); }
    __device__ __forceinline__ void winK(int pos, int d8, float (&k)[8]) const { unpack8(*(const GAS v4u*)(kw + (size_t)pos * 128 + d8), k); }
    __device__ __forceinline__ void winV(int pos, int d8, float (&k)[8]) const { unpack8(*(const GAS v4u*)(vw + (size_t)pos * 128 + d8), k); }
};
struct SampleKV {
    const float* csel; const int* pt; const float* nsel; const float* win; const float* nwin;
    static constexpr bool NORM = true;
    __device__ __forceinline__ const float* selp(int pos) const { return pos < PASTLEN ? csel + ((size_t)pt[pos >> 7] * 128 + (pos & 127)) * 512 : nsel; }
    __device__ __forceinline__ const float* winp(int pos) const { return pos < PASTLEN ? win + (size_t)(pos - (PASTLEN - 512)) * 512 : nwin; }
    __device__ __forceinline__ void selK(int pos, int d8, float (&k)[8]) const { ld8f(selp(pos) + d8, k); }
    __device__ __forceinline__ void selV(int pos, int d8, float (&k)[8]) const { ld8f(selp(pos) + 256 + d8, k); }
    __device__ __forceinline__ void winK(int pos, int d8, float (&k)[8]) const { ld8f(winp(pos) + d8, k); }
    __device__ __forceinline__ void winV(int pos, int d8, float (&k)[8]) const { ld8f(winp(pos) + 256 + d8, k); }
};
template <bool NORM>
__device__ __forceinline__ void score4(const float (&k)[8], const float (&gkv)[8], const float (&q)[4][8], float (&s)[4]) {
    float kk[8]; float ss = 0.f;
#pragma unroll
    for (int i = 0; i < 8; ++i) { if (NORM) { ss += k[i] * k[i]; kk[i] = k[i] * gkv[i]; } else kk[i] = k[i]; }
#pragma unroll
    for (int h = 0; h < 4; ++h) { float a = 0.f;
#pragma unroll
        for (int i = 0; i < 8; ++i) a += q[h][i] * kk[i];
        s[h] = grp_sum16(a); }
    if (NORM) { ss = grp_sum16(ss); const float rs = rsqrtf(ss * (1.0f / 128) + EPS);
#pragma unroll
        for (int h = 0; h < 4; ++h) s[h] *= rs; }
}
__device__ __forceinline__ void online4(const float (&s)[4], bool valid, float (&m)[4], float (&l)[4], float (&o)[4][8], const float (&v)[8]) {
#pragma unroll
    for (int h = 0; h < 4; ++h) { const float sv = valid ? s[h] : -__builtin_inff(); const float mn = fmaxf(m[h], sv);
        const float al = __builtin_amdgcn_exp2f(m[h] - mn), p = __builtin_amdgcn_exp2f(sv - mn); m[h] = mn; l[h] = l[h] * al + p;
#pragma unroll
        for (int i = 0; i < 8; ++i) o[h][i] = o[h][i] * al + p * v[i]; }
}
__device__ __forceinline__ void merge_store(float (&m)[4], float (&l)[4], float (&o)[4][8], LAS float* Cmb, int wave, int lane) {
#pragma unroll
    for (int h = 0; h < 4; ++h) { float M = fmaxf(m[h], __shfl_xor(m[h], 16)); M = fmaxf(M, __shfl_xor(M, 32));
        const float sc = __builtin_amdgcn_exp2f(m[h] - M); float ll = l[h] * sc; ll += __shfl_xor(ll, 16); ll += __shfl_xor(ll, 32);
        LAS float* dst = Cmb + (wave * 4 + h) * 132;
#pragma unroll
        for (int i = 0; i < 8; ++i) { float x = o[h][i] * sc; x += __shfl_xor(x, 16); x += __shfl_xor(x, 32); if (lane < 16) dst[lane * 8 + i] = x; }
        if (lane == 0) { dst[128] = M; dst[129] = ll; } }
}
__device__ __forceinline__ float combine8(const LAS float* Cmb, int hh, int dd) {
    float M = -1e30f;
#pragma unroll
    for (int w = 0; w < 8; ++w) M = fmaxf(M, Cmb[(w * 4 + hh) * 132 + 128]);
    float L = 0.f, O = 0.f;
#pragma unroll
    for (int w = 0; w < 8; ++w) { const LAS float* p = Cmb + (w * 4 + hh) * 132; const float sc = __builtin_amdgcn_exp2f(p[128] - M); L += p[129] * sc; O += p[dd] * sc; }
    return L > 0.f ? O / L : 0.f;
}

template <class KV>
__device__ __forceinline__ void nsa_item(const Ctx& C, const AttItem& it, const KV& kv, const float* gk1, const float* gk2) {
    const int tid = C.tid, lane = C.lane, wave = C.wave, grp = lane >> 4, d8 = (lane & 15) * 8, t = it.t;
    LAS float* Sc = (LAS float*)(C.lds + RING_OFF);
    LAS float* Cmb = (LAS float*)(C.lds + RING_OFF + 4096);
    const float NEG = -__builtin_inff();
    float q[4][8];
#pragma unroll
    for (int h = 0; h < 4; ++h) unpack8(*(const GAS v4u*)(it.q + h * 128 + d8), q[h]);
    const int hh = tid >> 7, dd = tid & 127;
    const float g0 = it.gates[hh * 3 + 0], g1 = it.gates[hh * 3 + 1], g2 = it.gates[hh * 3 + 2];
    float res = 0.f;
    float m[4], l[4], o[4][8], gkv[8];
#pragma unroll
    for (int i = 0; i < 8; ++i) gkv[i] = 1.f;

    int nvis = t >= 31 ? (t - 31) / 16 + 1 : 0; if (nvis > it.ncmp) nvis = it.ncmp;
    const int nch = (nvis + 3) >> 2;
    for (int ch = wave; ch < 64; ch += 8) {
        const int c = ch * 4 + grp; float s[4] = {NEG, NEG, NEG, NEG};
        if (ch < nch) {
            const bool valid = c < nvis; const int cc = valid ? c : 0; float k[8]; unpack8(*(const GAS v4u*)(it.kc + (size_t)cc * 128 + d8), k);
            float sc[4]; score4<false>(k, gkv, q, sc);
            const int rel = t - (16 * c + 31); const int ri = rel < 0 ? 0 : (rel > 128 ? 128 : rel);
#pragma unroll
            for (int h = 0; h < 4; ++h) s[h] = valid ? sc[h] + it.blut[h * 132 + ri] : NEG;
        }
        if ((lane & 15) == 0) {
#pragma unroll
            for (int h = 0; h < 4; ++h) Sc[h * 256 + c] = s[h]; }
    }
    __syncthreads();
    float mh[4], il[4];
#pragma unroll
    for (int h = 0; h < 4; ++h) { const f32x4 v = *(const LAS f32x4*)(Sc + h * 256 + lane * 4); float mx = fmaxf(fmaxf(v.x, v.y), fmaxf(v.z, v.w)); mx = fmaxf(wave_max(mx), -1e30f);
        float e = (__builtin_amdgcn_exp2f(v.x - mx) + __builtin_amdgcn_exp2f(v.y - mx)) + (__builtin_amdgcn_exp2f(v.z - mx) + __builtin_amdgcn_exp2f(v.w - mx)); e = wave_sum(e);
        mh[h] = mx; il[h] = e > 0.f ? 1.0f / e : 0.f; }
    float imp = 0.f;
#pragma unroll
    for (int h = 0; h < 4; ++h) { float a = 0.f;
#pragma unroll
        for (int k = 0; k < 5; ++k) { const int c = 4 * lane - 1 + k; if (c >= 0) a += __builtin_amdgcn_exp2f(Sc[h * 256 + c] - mh[h]); }
        imp += a * il[h]; }
    unsigned long long mask;
    { const int j = lane, cur = t >> 6; const bool forced = (j == 0) || (j == cur) || (j == cur - 1), elig = 64 * j <= t, exists = j < it.nblk;
      const float val = exists ? (forced ? 1e6f : (elig ? imp : -1.f)) : -2.f; int rank = 0;
#pragma unroll
      for (int jp = 0; jp < 64; ++jp) { const float ov = __int_as_float(__builtin_amdgcn_readlane(__float_as_int(val), jp)); rank += (ov > val || (ov == val && jp < j)) ? 1 : 0; }
      mask = __ballot(rank < 16 && elig && exists); }
#pragma unroll
    for (int h = 0; h < 4; ++h) { m[h] = mh[h]; l[h] = 0.f;
#pragma unroll
        for (int i = 0; i < 8; ++i) o[h][i] = 0.f; }
    for (int ch = wave; ch < nch; ch += 8) {
        const int c = ch * 4 + grp; const bool valid = c < nvis; const int cc = valid ? c : 0; float v[8]; unpack8(*(const GAS v4u*)(it.vc + (size_t)cc * 128 + d8), v);
#pragma unroll
        for (int h = 0; h < 4; ++h) { const float p = valid ? __builtin_amdgcn_exp2f(Sc[h * 256 + cc] - mh[h]) : 0.f; l[h] += p;
#pragma unroll
            for (int i = 0; i < 8; ++i) o[h][i] += p * v[i]; }
    }
    merge_store(m, l, o, Cmb, wave, lane);
    __syncthreads();
    res += g0 * combine8(Cmb, hh, dd);
    __syncthreads();

#pragma unroll
    for (int h = 0; h < 4; ++h) { m[h] = -1e30f; l[h] = 0.f;
#pragma unroll
        for (int i = 0; i < 8; ++i) o[h][i] = 0.f; }
    if (KV::NORM) {
#pragma unroll
        for (int i = 0; i < 8; ++i) gkv[i] = gk1[d8 + i]; }
    for (unsigned long long m2 = mask; m2; m2 &= m2 - 1) {
        const int blk = __builtin_ctzll(m2);
        for (int c16 = wave; c16 < 16; c16 += 8) {
            const int pos = blk * 64 + c16 * 4 + grp; const bool valid = pos <= t; float k[8], v[8], sc[4];
            kv.selK(pos, d8, k); kv.selV(pos, d8, v); score4<KV::NORM>(k, gkv, q, sc);
            const int rel = t - pos; const int ri = rel < 0 ? 0 : (rel > 128 ? 128 : rel);
#pragma unroll
            for (int h = 0; h < 4; ++h) sc[h] += it.blut[h * 132 + ri];
            online4(sc, valid, m, l, o, v);
        }
    }
    merge_store(m, l, o, Cmb, wave, lane);
    __syncthreads();
    res += g1 * combine8(Cmb, hh, dd);
    __syncthreads();

#pragma unroll
    for (int h = 0; h < 4; ++h) { m[h] = -1e30f; l[h] = 0.f;
#pragma unroll
        for (int i = 0; i < 8; ++i) o[h][i] = 0.f; }
    if (KV::NORM) {
#pragma unroll
        for (int i = 0; i < 8; ++i) gkv[i] = gk2[d8 + i]; }
    const int wlo = t - 511 < 0 ? 0 : t - 511, nchw = (t - wlo + 4) >> 2;
    for (int ch = wave; ch < nchw; ch += 8) {
        const int pos = wlo + ch * 4 + grp; const bool valid = pos <= t; const int pp = valid ? pos : t; float k[8], v[8], sc[4];
        kv.winK(pp, d8, k); kv.winV(pp, d8, v); score4<KV::NORM>(k, gkv, q, sc);
        const int rel = t - pp; const int ri = rel > 128 ? 128 : rel;
#pragma unroll
        for (int h = 0; h < 4; ++h) sc[h] += it.blut[h * 132 + ri];
        online4(sc, valid, m, l, o, v);
    }
    merge_store(m, l, o, Cmb, wave, lane);
    __syncthreads();
    res += g2 * combine8(Cmb, hh, dd);
    it.out[hh * 128 + dd] = (bf16)f2bf(res);
    __syncthreads();
}

__device__ __forceinline__ void p5_attn_naive(const Ctx& C) {
    unsigned char* ws = C.ws;
    const bf16* QN = (const bf16*)(ws + WS_QN); const float* GN = (const float*)(ws + WS_GN); bf16* OB = (bf16*)(ws + WS_OB); const float* BL = (const float*)(ws + WS_BLUT);
    const float* gk = C.in[IN_GK];
    for (int item = C.vcu; item < 256 + 16384; item += C.G) {
        if (item < 256) { const int b = item >> 1, g = item & 1, row = MPROMPT + b;
            AttItem it{QN + (size_t)row * DQ + g * 512, PASTLEN, 127, (const bf16*)(ws + WS_KCS) + (size_t)(b * 2 + g) * 128 * 128, (const bf16*)(ws + WS_VCS) + (size_t)(b * 2 + g) * 128 * 128, 33,
                       GN + (size_t)row * 32 + g * 12, OB + (size_t)row * DQ + g * 512, BL + g * 4 * 132};
            SampleKV kv{C.in[IN_CSEL] + g * 128, (const int*)C.in[IN_PT] + b * 16, C.out + O_SSEL + (size_t)b * 512 + g * 128, C.in[IN_WINB] + (size_t)b * 512 * 512 + g * 128,
                        (const float*)(ws + WS_KVWR) + (size_t)row * 512 + g * 128};
            nsa_item<SampleKV>(C, it, kv, gk + 128, gk + 256);
        } else { const int idx = item - 256, b = idx >> 13, g = (idx >> 12) & 1, t = idx & 4095, row = b * T + t; const size_t kb = (size_t)(b * 2 + g) * T * 128;
            AttItem it{QN + (size_t)row * DQ + g * 512, t, 255, (const bf16*)(ws + WS_KCP) + (size_t)(b * 2 + g) * 256 * 128, (const bf16*)(ws + WS_VCP) + (size_t)(b * 2 + g) * 256 * 128, 64,
                       GN + (size_t)row * 32 + g * 12, OB + (size_t)row * DQ + g * 512, BL + g * 4 * 132};
            PromptKV kv{(const bf16*)(ws + WS_KS) + kb, (const bf16*)(ws + WS_VS) + kb, (const bf16*)(ws + WS_KW) + kb, (const bf16*)(ws + WS_VW) + kb};
            nsa_item<PromptKV>(C, it, kv, gk + 128, gk + 256);
        }
    }
}

#ifndef MK_N_LAUNCHES
#define MK_N_LAUNCHES 1
#endif
constexpr int NPHASES = 10;
struct Args { const float* in[24]; float* out; unsigned char* ws; int ph_lo, ph_hi; };
static_assert(sizeof(Args) == 24 * 8 + 8 + 8 + 8, "no padding bytes in the kernel argument struct");

__global__ void __launch_bounds__(NWAVES * 64, 2) nsa_fwd(Args args) {
    extern __shared__ __attribute__((aligned(16))) unsigned char lds_raw[];
    Ctx C;
#pragma unroll
    for (int i = 0; i < 24; ++i) C.in[i] = args.in[i];
    C.out = args.out; C.ws = args.ws; C.lds = (LAS unsigned char*)lds_raw;
    C.tid = threadIdx.x; C.lane = C.tid & 63; C.wave = __builtin_amdgcn_readfirstlane(C.tid >> 6);
    C.G = gridDim.x; { const int bx = blockIdx.x; C.vcu = (C.G % 8 == 0) ? (bx % 8) * (C.G / 8) + bx / 8 : bx; }
    volatile LAS unsigned* MISC = (volatile LAS unsigned*)(C.lds + MISC_OFF);
    gu32* ctl = (gu32*)(args.ws + WS_CTL);
    for (int u = C.tid; u < (LDS_BYTES - LDSCTL_OFF) / 4; u += NWAVES * 64) ((LAS unsigned*)(C.lds + LDSCTL_OFF))[u] = 0u;
    __syncthreads();
    const int lo = args.ph_lo, hi = args.ph_hi;
    XcdBarrier bar; bar.bar = (unsigned*)(ctl + CW_BAR); bar.x = 0; bar.st = nullptr;
    if (hi - lo > 1) bar = xcd_barrier_post((unsigned*)(ctl + CW_BAR), MISC + 8);
#define IN(k) (lo <= (k) && (k) < hi)
#define SEAM(k) do { if (IN(k) && IN((k) + 1)) xcd_barrier(bar); } while (0)
    unsigned char* ws = args.ws;
    LAS unsigned char* ring = C.lds + RING_OFF;

    if (IN(0)) { p0_prologue(C); } SEAM(0);

    if (IN(1)) {
        pg8::Gemm g{(const bf16*)(ws + WS_XB), (const bf16*)(ws + WS_WIN), MPAD, NINP, DM}; pg8::StaticOrder S; S.init(MPAD, NINP, C.G, (int)blockIdx.x);
        epi::EpiIn E{(const float*)(ws + WS_RSTD1), (bf16*)(ws + WS_U), (bf16*)(ws + WS_VG), (float*)(ws + WS_VSS), (float*)(ws + WS_QRAW), (float*)(ws + WS_KVWR),
                     (bf16*)(ws + WS_GA), (bf16*)(ws + WS_GB), (float*)(ws + WS_GN), C.out};
        pg8::gemm_phase<epi::EpiIn, pg8::StaticOrder, true, true>(ring, g, S, E);
    } SEAM(1);

    if (IN(2)) { p2_post(C); } SEAM(2);

    if (IN(3)) {
        { pg8::Gemm g{(const bf16*)(ws + WS_ACS), (const bf16*)(ws + WS_WC), 65536, 512, 2048}; epi::CmpOrder S{256, C.G, (int)blockIdx.x, 0};
          epi::EpiCmp E{(float*)(ws + WS_YCS), 127};
          pg8::gemm_phase<epi::EpiCmp, epi::CmpOrder, true, true>(ring, g, S, E); }
        { pg8::Gemm g{(const bf16*)(ws + WS_ACP), (const bf16*)(ws + WS_WC), 2048, 512, 2048}; epi::CmpOrder S{8, C.G, (int)blockIdx.x, 1};
          epi::EpiCmp E{(float*)(ws + WS_YCP), 255};
          pg8::gemm_phase<epi::EpiCmp, epi::CmpOrder, true, true>(ring, g, S, E); }
    } SEAM(3);

    if (IN(4)) { p4_cmp_combine(C); p4_sgu(C); } SEAM(4);

    if (IN(5)) { p5_attn_naive(C); } SEAM(5);

    if (IN(6)) {
        { pg8::Gemm g{(const bf16*)(ws + WS_OA), (const bf16*)(ws + WS_WG), MPAD, DM, DG}; pg8::StaticOrder S; S.init(MPAD, DM, C.G, (int)blockIdx.x);
          epi::EpiMixA E{(const bf16*)(ws + WS_GA), (bf16*)(ws + WS_MIXA)};
          pg8::gemm_phase<epi::EpiMixA, pg8::StaticOrder, true, true>(ring, g, S, E); }
        { pg8::Gemm g{(const bf16*)(ws + WS_OB), (const bf16*)(ws + WS_WN), MPAD, DM, DQ}; pg8::StaticOrder S; S.init(MPAD, DM, C.G, (int)blockIdx.x);
          epi::EpiMixB E{(const bf16*)(ws + WS_GB), (const bf16*)(ws + WS_MIXA), (bf16*)(ws + WS_MIX)};
          pg8::gemm_phase<epi::EpiMixB, pg8::StaticOrder, true, true>(ring, g, S, E); }
    } SEAM(6);

    if (IN(7)) {
        pg8::Gemm g{(const bf16*)(ws + WS_MIX), (const bf16*)(ws + WS_WO), MPAD, DM, DM}; pg8::StaticOrder S; S.init(MPAD, DM, C.G, (int)blockIdx.x);
        epi::EpiOut E{C.in[IN_XP], C.in[IN_XS], C.out, (bf16*)(ws + WS_X1B), (float*)(ws + WS_X1SS)};
        pg8::gemm_phase<epi::EpiOut, pg8::StaticOrder, true, true>(ring, g, S, E);
    } SEAM(7);

    if (IN(8)) {
        pg8::Gemm g{(const bf16*)(ws + WS_X1B), (const bf16*)(ws + WS_WUP), MPAD, DFF, DM}; pg8::StaticOrder S; S.init(MPAD, DFF, C.G, (int)blockIdx.x);
        epi::EpiUp E{(const float*)(ws + WS_X1SS), (bf16*)(ws + WS_H)};
        pg8::gemm_phase<epi::EpiUp, pg8::StaticOrder, true, true>(ring, g, S, E);
    } SEAM(8);

    if (IN(9)) {
        pg8::Gemm g{(const bf16*)(ws + WS_H), (const bf16*)(ws + WS_WDN), MPAD, DM, DFF}; pg8::StaticOrder S; S.init(MPAD, DM, C.G, (int)blockIdx.x);
        epi::EpiDown E{C.out};
        pg8::gemm_phase<epi::EpiDown, pg8::StaticOrder, true, true>(ring, g, S, E);
    }
#undef IN
#undef SEAM
}

extern "C" void kernel_launch(void* const* d_in, const int* in_sizes, int n_in, void* d_out, int out_size, void* d_ws, size_t ws_size, hipStream_t stream) {
    static int grid = 0;
    if (grid == 0) {
        if (n_in != 24 || out_size != (int)O_END || ws_size < WS_END) {
            fprintf(stderr, "kernel_launch: built for 24 inputs, %zu outputs, >= %zu bytes of workspace; got n_in %d out %d ws %zu; nothing launched\n", (size_t)O_END, (size_t)WS_END, n_in, out_size, ws_size);
            grid = -1; return; }
        int dev = 0, cus = 0, per_cu = 0;
        if (hipGetDevice(&dev) != hipSuccess || hipDeviceGetAttribute(&cus, hipDeviceAttributeMultiprocessorCount, dev) != hipSuccess) { fprintf(stderr, "kernel_launch: device query failed\n"); grid = -1; return; }
        if (hipFuncSetAttribute((const void*)nsa_fwd, hipFuncAttributeMaxDynamicSharedMemorySize, LDS_BYTES) != hipSuccess) { fprintf(stderr, "kernel_launch: hipFuncSetAttribute failed\n"); grid = -1; return; }
        if (hipOccupancyMaxActiveBlocksPerMultiprocessor(&per_cu, (const void*)nsa_fwd, NWAVES * 64, LDS_BYTES) != hipSuccess || per_cu < 1)
            fprintf(stderr, "kernel_launch: note: occupancy query reports %d workgroups per CU\n", per_cu);
        (void)hipGetLastError();
        grid = cus;
    }
    if (grid < 0) return;
    if (hipMemsetAsync((char*)d_ws + WS_CTL, 0, CTL_ZERO_BYTES, stream) != hipSuccess) { fprintf(stderr, "kernel_launch: memset failed\n"); return; }
    Args a{};
    for (int i = 0; i < 24; ++i) a.in[i] = (const float*)d_in[i];
    a.out = (float*)d_out; a.ws = (unsigned char*)d_ws;
    const int nl = MK_N_LAUNCHES;
    for (int li = 0; li < nl; ++li) {
        a.ph_lo = nl == 1 ? 0 : li; a.ph_hi = nl == 1 ? NPHASES : li + 1;
        hipLaunchKernelGGL(nsa_fwd, dim3(grid), dim3(NWAVES * 64), LDS_BYTES, stream, a);
        const hipError_t le = hipPeekAtLastError();
        if (le != hipSuccess) { fprintf(stderr, "kernel_launch: launch %d failed: %s\n", li, hipGetErrorName(le)); break; }
    }
}
```

```cpp
#include <hip/hip_runtime.h>
#include <cstdio>
#include <cstdint>
namespace pg8 {
#define PG8_LAS __attribute__((address_space(3)))
typedef unsigned short bf16_t;
typedef short bf16x8 __attribute__((ext_vector_type(8)));
typedef float f32x4 __attribute__((ext_vector_type(4)));
typedef unsigned u32x4 __attribute__((ext_vector_type(4)));
constexpr int BM = 256, BK = 64, HALF = 128, HTB = HALF * BK * 2  , STAGE_BYTES = 8 * HTB, NXCD = 8, WGM = 8;

__host__ __device__ __forceinline__ int lds_byte(int r, int c) { const int st = (r >> 4) * 2 + (c >> 5), rr = r & 15, cc = c & 31, ob = rr * 64 + cc * 2; return st * 1024 + (ob ^ (((ob >> 9) & 1) << 5)); }
__host__ __device__ __forceinline__ void stage_rc(int b, int& R, int& C) { const int st = b / 1024, sb = b % 1024, swz = sb ^ (((sb >> 9) & 1) << 5); R = (st >> 1) * 16 + swz / 64; C = (st & 1) * 32 + (swz % 64) / 2; }
__host__ __device__ __forceinline__ int perm32(int rho) { const int n = rho >> 4, i = rho & 15; return 8 * (i >> 2) + 4 * n + (i & 3); }

struct Unit { int pm, pn; };
struct Gemm { const bf16_t* A; const bf16_t* Bt; int M, N, K, lda, ldb; int tileA = 0, tileB = 0; };

struct StaticOrder {
    int nM, nN, nwg, G, c;
    __host__ __device__ void init(int M, int N, int G_, int c_) { nM = M / BM; nN = N / BM; nwg = nM * nN; G = G_; c = c_; }
    __host__ __device__ bool next(int i, Unit& u) const {
        const long L = (long)i * G + c; if (L >= nwg) return false;
        int wgid = (int)L; { const int q = nwg / NXCD, r = nwg % NXCD, xcd = wgid % NXCD, off = wgid / NXCD; wgid = (xcd < r ? xcd * (q + 1) : r * (q + 1) + (xcd - r) * q) + off; }
        const int nig = WGM * nN, gid = wgid / nig, fm = gid * WGM, gsz = (nM - fm) < WGM ? (nM - fm) : WGM;
        u.pm = fm + ((wgid % nig) % gsz); u.pn = (wgid % nig) / gsz; return true;
    }
    __device__ __forceinline__ void a_ready(const Unit&) const {}
    __device__ __forceinline__ void done(const Unit&) const {}
};

__device__ __forceinline__ unsigned cvt_pk_bf16(float lo, float hi) { unsigned r; asm volatile("v_cvt_pk_bf16_f32 %0, %1, %2" : "=v"(r) : "v"(lo), "v"(hi)); return r; }
typedef float f32x2 __attribute__((ext_vector_type(2)));
template <class Epi, class Sched, bool ALIGN_EPI = false, bool SP2 = false>
__device__ __forceinline__ void gemm_phase(PG8_LAS unsigned char* lds, const Gemm g, const Sched& S, const Epi& E, const int tid) {
    const int wid = __builtin_amdgcn_readfirstlane(tid >> 6), lane = tid & 63, wr = wid >> 2, wc = wid & 3, fr = lane & 15, fq = lane >> 4;
    const int K = g.K, nt = K / BK;
    unsigned voffA[2], voffB[2];
#pragma unroll
    for (int i = 0; i < 2; ++i) { int R, C; stage_rc(tid * 16 + i * 8192, R, C); const int Rb = Epi::PERM ? ((R & ~31) + perm32(R & 31)) : R;
        voffA[i] = (unsigned)(R * (g.tileA ? 64 : g.lda) + C) * 2u; voffB[i] = (unsigned)(Rb * (g.tileB ? 64 : g.ldb) + C) * 2u; }
    const size_t kstepA = g.tileA ? (size_t)32768 : (size_t)(BK * 2), kstepB = g.tileB ? (size_t)32768 : (size_t)(BK * 2);
    const size_t hstepA = g.tileA ? (size_t)16384 : (size_t)HALF * g.lda * 2, hstepB = g.tileB ? (size_t)16384 : (size_t)HALF * g.ldb * 2;
    const size_t tstepA = g.tileA ? (size_t)(g.K / BK) * 32768 : 2 * hstepA, tstepB = g.tileB ? (size_t)(g.K / BK) * 32768 : 2 * hstepB;
    const unsigned ldsw = (unsigned)wid * 1024u;
    const int aoff = lds_byte(wr * 64 + fr, fq * 8), boff = lds_byte(wc * 32 + fr, fq * 8);
#define PG8_SA(b, h) (((b) * 2 + (h)) * HTB)
#define PG8_SB(b, h) ((4 + (b) * 2 + (h)) * HTB)
#define PG8_STAGE(bufoff, gbase, voff) do { _Pragma("unroll") for (int _i = 0; _i < 2; ++_i) \
        __builtin_amdgcn_global_load_lds((const unsigned*)((const char*)(gbase) + (voff)[_i]), (PG8_LAS unsigned*)(lds + (bufoff) + ldsw + _i * 8192), 16, 0, 0); } while (0)
#define PG8_LDA(dst, b, h) do { _Pragma("unroll") for (int m = 0; m < 4; ++m) _Pragma("unroll") for (int k = 0; k < 2; ++k) dst[m][k] = *(const PG8_LAS bf16x8*)(lds + PG8_SA(b, h) + aoff + m * 2048 + k * 1024); } while (0)
#define PG8_LDB(dst, b, h) do { _Pragma("unroll") for (int n = 0; n < 2; ++n) _Pragma("unroll") for (int k = 0; k < 2; ++k) dst[n][k] = *(const PG8_LAS bf16x8*)(lds + PG8_SB(b, h) + boff + n * 2048 + k * 1024); } while (0)
#define PG8_MMA(ai, bj, At, Bt) do { __builtin_amdgcn_s_setprio(1); _Pragma("unroll") for (int m = 0; m < 4; ++m) _Pragma("unroll") for (int n = 0; n < 2; ++n) _Pragma("unroll") for (int k = 0; k < 2; ++k) \
        acc[ai][bj][m][n] = __builtin_amdgcn_mfma_f32_16x16x32_bf16(Bt[n][k], At[m][k], acc[ai][bj][m][n], 0, 0, 0); __builtin_amdgcn_s_setprio(0); } while (0)
#define PG8_WAIT_V(n) asm volatile("s_waitcnt vmcnt(" #n ")" ::: "memory")
#define PG8_WAIT_L(n) asm volatile("s_waitcnt lgkmcnt(" #n ")" ::: "memory")
#define PG8_BAR __builtin_amdgcn_s_barrier()
#define PG8_SCHED __builtin_amdgcn_sched_barrier(0)
    Unit cur, nxt; int ui = 0;
    if (!S.next(0, cur)) return;
    f32x4 acc[2][2][4][2];
#pragma unroll
    for (int a = 0; a < 2; ++a)
#pragma unroll
        for (int b = 0; b < 2; ++b)
#pragma unroll
            for (int m = 0; m < 4; ++m)
#pragma unroll
                for (int n = 0; n < 2; ++n) acc[a][b][m][n] = (f32x4){0.f, 0.f, 0.f, 0.f};
    bf16x8 At[4][2], B0[2][2], B1[2][2];
    const char* cA = (const char*)g.A + (size_t)cur.pm * tstepA; const char* cB = (const char*)g.Bt + (size_t)cur.pn * tstepB;
    S.a_ready(cur);
    if constexpr (SP2) {
        PG8_STAGE(PG8_SB(0, 0), cB, voffB); PG8_STAGE(PG8_SB(0, 1), cB + hstepB, voffB); PG8_STAGE(PG8_SA(0, 0), cA, voffA); PG8_STAGE(PG8_SA(0, 1), cA + hstepA, voffA);
        if (wr == 1) PG8_BAR;
        PG8_WAIT_V(2); PG8_BAR;
        PG8_STAGE(PG8_SB(1, 0), cB + kstepB, voffB); PG8_STAGE(PG8_SA(1, 0), cA + kstepA, voffA); PG8_STAGE(PG8_SB(1, 1), cB + hstepB + kstepB, voffB);
        PG8_WAIT_V(6); PG8_BAR;
    } else {
        PG8_STAGE(PG8_SB(0, 0), cB, voffB); PG8_STAGE(PG8_SA(0, 0), cA, voffA); PG8_STAGE(PG8_SB(0, 1), cB + hstepB, voffB); PG8_STAGE(PG8_SA(0, 1), cA + hstepA, voffA);
        if (wr == 1) PG8_BAR;
        PG8_WAIT_V(4); PG8_BAR;
        PG8_STAGE(PG8_SB(1, 0), cB + kstepB, voffB); PG8_STAGE(PG8_SA(1, 0), cA + kstepA, voffA); PG8_STAGE(PG8_SB(1, 1), cB + hstepB + kstepB, voffB);
        PG8_WAIT_V(6); PG8_BAR;
    }
    for (;;) {
        const bool has_next = S.next(ui + 1, nxt);
        const char* nA = has_next ? (const char*)g.A + (size_t)nxt.pm * tstepA : cA; const char* nB = has_next ? (const char*)g.Bt + (size_t)nxt.pn * tstepB : cB;
        for (int t = 0; t < nt; t += 2) {
            const bool last = (t == nt - 2);
            const char* a1 = cA + (size_t)(t + 1) * kstepA;
            const char* a2 = last ? nA : cA + (size_t)(t + 2) * kstepA; const char* b2 = last ? nB : cB + (size_t)(t + 2) * kstepB;
            const char* a3 = a2 + kstepA; const char* b3 = b2 + kstepB;
            if (last && has_next) S.a_ready(nxt);
            if constexpr (SP2) {
            PG8_LDB(B0, 0, 0); PG8_LDB(B1, 0, 1); PG8_SCHED; PG8_LDA(At, 0, 0); PG8_STAGE(PG8_SA(1, 1), a1 + hstepA, voffA);
            PG8_WAIT_V(8); PG8_WAIT_L(0); PG8_BAR; PG8_MMA(0, 0, At, B0); PG8_MMA(0, 1, At, B1); PG8_BAR; PG8_SCHED;
            PG8_LDA(At, 0, 1); PG8_STAGE(PG8_SB(0, 0), b2, voffB); PG8_STAGE(PG8_SB(0, 1), b2 + hstepB, voffB); PG8_STAGE(PG8_SA(0, 0), a2, voffA);
            PG8_WAIT_V(8); PG8_WAIT_L(0); PG8_BAR; PG8_MMA(1, 0, At, B0); PG8_MMA(1, 1, At, B1); PG8_BAR; PG8_SCHED;
            PG8_LDB(B0, 1, 0); PG8_LDB(B1, 1, 1); PG8_SCHED; PG8_LDA(At, 1, 0); PG8_STAGE(PG8_SA(0, 1), a2 + hstepA, voffA);
            PG8_WAIT_V(8); PG8_WAIT_L(0); PG8_BAR; PG8_MMA(0, 0, At, B0); PG8_MMA(0, 1, At, B1); PG8_BAR; PG8_SCHED;
            PG8_LDA(At, 1, 1); PG8_STAGE(PG8_SB(1, 0), b3, voffB); PG8_STAGE(PG8_SB(1, 1), b3 + hstepB, voffB); PG8_STAGE(PG8_SA(1, 0), a3, voffA);
            PG8_WAIT_V(8); PG8_WAIT_L(0); PG8_BAR; PG8_MMA(1, 0, At, B0); PG8_MMA(1, 1, At, B1); PG8_BAR; PG8_SCHED;
            } else {
            PG8_LDB(B0, 0, 0); PG8_SCHED; PG8_LDA(At, 0, 0); PG8_STAGE(PG8_SA(1, 1), a1 + hstepA, voffA);
            PG8_WAIT_L(8); PG8_BAR; PG8_WAIT_L(0); PG8_MMA(0, 0, At, B0); PG8_BAR; PG8_SCHED;
            PG8_LDB(B1, 0, 1); PG8_STAGE(PG8_SB(0, 0), b2, voffB);
            PG8_BAR; PG8_WAIT_L(0); PG8_MMA(0, 1, At, B1); PG8_BAR;
            PG8_LDA(At, 0, 1); PG8_STAGE(PG8_SA(0, 0), a2, voffA);
            PG8_BAR; PG8_WAIT_L(0); PG8_MMA(1, 0, At, B0); PG8_BAR; PG8_SCHED;
            PG8_STAGE(PG8_SB(0, 1), b2 + hstepB, voffB);
            PG8_WAIT_V(6); PG8_BAR; PG8_MMA(1, 1, At, B1); PG8_BAR;
            PG8_LDB(B0, 1, 0); PG8_SCHED; PG8_LDA(At, 1, 0); PG8_STAGE(PG8_SA(0, 1), a2 + hstepA, voffA);
            PG8_WAIT_L(8); PG8_BAR; PG8_WAIT_L(0); PG8_MMA(0, 0, At, B0); PG8_BAR; PG8_SCHED;
            PG8_LDB(B1, 1, 1); PG8_STAGE(PG8_SB(1, 0), b3, voffB);
            PG8_BAR; PG8_WAIT_L(0); PG8_MMA(0, 1, At, B1); PG8_BAR;
            PG8_LDA(At, 1, 1); PG8_STAGE(PG8_SA(1, 0), a3, voffA);
            PG8_BAR; PG8_WAIT_L(0); PG8_MMA(1, 0, At, B0); PG8_BAR; PG8_SCHED;
            PG8_STAGE(PG8_SB(1, 1), b3 + hstepB, voffB);
            PG8_WAIT_V(6); PG8_BAR; PG8_MMA(1, 1, At, B1); PG8_BAR;
            }
        }
        if constexpr (ALIGN_EPI) { if (wr == 0) PG8_BAR; }
        if constexpr (!Epi::AFTER_DRAIN) { E(acc, cur, wr, wc, fr, fq); S.done(cur); }
        if (!has_next) break;
#pragma unroll
        for (int a = 0; a < 2; ++a)
#pragma unroll
            for (int b = 0; b < 2; ++b)
#pragma unroll
                for (int m = 0; m < 4; ++m)
#pragma unroll
                    for (int n = 0; n < 2; ++n) acc[a][b][m][n] = (f32x4){0.f, 0.f, 0.f, 0.f};
        cur = nxt; cA = nA; cB = nB; ++ui;
        if constexpr (ALIGN_EPI) { if (wr == 1) PG8_BAR; }
    }
    PG8_WAIT_V(0);
    if constexpr (!ALIGN_EPI) { if (wr == 0) PG8_BAR; }
    PG8_BAR;
    if constexpr (Epi::AFTER_DRAIN) { E.fused(acc, cur, wr, wc, fr, fq, lds, wid, lane); S.done(cur); }
#undef PG8_SA
#undef PG8_SB
#undef PG8_STAGE
#undef PG8_LDA
#undef PG8_LDB
#undef PG8_MMA
#undef PG8_WAIT_V
#undef PG8_WAIT_L
#undef PG8_BAR
#undef PG8_SCHED
}
}
#define GAS __attribute__((address_space(1)))
#define LAS __attribute__((address_space(3)))
typedef unsigned short bf16;
typedef unsigned v4u __attribute__((ext_vector_type(4)));
typedef float f32x4 __attribute__((ext_vector_type(4)));
typedef short bf16x8 __attribute__((ext_vector_type(8)));
typedef GAS unsigned gu32;
typedef GAS unsigned long long gu64;
#define RLX_AGENT __ATOMIC_RELAXED, __HIP_MEMORY_SCOPE_AGENT
#define LDS_WAIT() asm volatile("s_waitcnt lgkmcnt(0)" ::: "memory")
#define VM_WAIT() asm volatile("s_waitcnt vmcnt(0)" ::: "memory")
__device__ __forceinline__ unsigned long long rt() { return __builtin_amdgcn_s_memrealtime(); }
__device__ __forceinline__ unsigned f2bf(float f) { unsigned u = __builtin_bit_cast(unsigned, f); return (u + 0x7fffu + ((u >> 16) & 1u)) >> 16; }
__device__ __forceinline__ unsigned pk2(float lo, float hi) { return f2bf(lo) | (f2bf(hi) << 16); }

#define XB_TMO      128
#define XB_XCNT(j)  (256  + 64 * (j))
#define XB_XSUB(j)  (1280 + 64 * (j))
#define XB_XGEN(j)  (2304 + 64 * (j))
#define XB_TOP      3328
#define XB_TOPGEN   3392
#define XCD_BAR_WORDS 3456
#define XB_SPIN_CAP (1u << 24)

__device__ __forceinline__ unsigned xb_ld(unsigned* p)              { return __hip_atomic_load(p, __ATOMIC_RELAXED, __HIP_MEMORY_SCOPE_AGENT); }
__device__ __forceinline__ unsigned xb_add(unsigned* p, unsigned v) { return __hip_atomic_fetch_add(p, v, __ATOMIC_RELAXED, __HIP_MEMORY_SCOPE_AGENT); }
__device__ __forceinline__ unsigned xb_xcc_id() { return (unsigned)__builtin_amdgcn_s_getreg((3 << 11) | 20) & 0xFu; }
#define XB_SPIN(cond, bar) do { unsigned _sp = 0; while (cond) { __builtin_amdgcn_s_sleep(1); \
    if ((++_sp & 255u) == 0u) { if (xb_ld(&(bar)[XB_TMO])) break; if (_sp > XB_SPIN_CAP) { atomicAdd(&(bar)[XB_TMO], 1u); break; } } } } while (0)

__device__ __forceinline__ unsigned xb_lane() { unsigned l_; asm volatile("v_mbcnt_lo_u32_b32 %0, -1, 0\n\tv_mbcnt_hi_u32_b32 %0, -1, %0" : "=&v"(l_)); return l_; }
struct XcdBarrier {
    unsigned* bar; unsigned x; unsigned w;
    volatile LAS unsigned* st;
};

__device__ __forceinline__ XcdBarrier xcd_barrier_post(unsigned* bar, volatile LAS unsigned* st) {
    XcdBarrier b; b.bar = bar; b.x = xb_xcc_id(); b.st = st; b.w = (unsigned)__builtin_amdgcn_readfirstlane(threadIdx.x >> 6);
    if (threadIdx.x == 0) (void)xb_add(&bar[XB_XCNT(b.x)], 1u);
    return b;
}
__device__ __forceinline__ void xcd_barrier_complete(unsigned* bar, unsigned x, unsigned& nloc, unsigned& nx) {
    const unsigned G = gridDim.x * gridDim.y * gridDim.z;
    unsigned sum, cnt, mine, sp = 0u;
    for (;;) {
        sum = 0u; cnt = 0u; mine = 0u;
#pragma unroll
        for (unsigned j = 0; j < 16; ++j) { const unsigned c = xb_ld(&bar[XB_XCNT(j)]); sum += c; cnt += (c > 0u) ? 1u : 0u; mine = (j == x) ? c : mine; }
        if (sum == G) break;
        __builtin_amdgcn_s_sleep(1);
        if ((++sp & 255u) == 0u) { if (xb_ld(&bar[XB_TMO])) break; if (sp > XB_SPIN_CAP) { atomicAdd(&bar[XB_TMO], 1u); break; } }
    }
    nloc = mine > 0u ? mine : 1u; nx = cnt > 0u ? cnt : 1u;
}

__device__ __forceinline__ void xcd_barrier(const XcdBarrier& b) {
    asm volatile("s_waitcnt vmcnt(0)" ::: "memory");
    __syncthreads();
    if (b.w == 0u && xb_lane() == 0u) {
        unsigned* bar = b.bar;
        __builtin_amdgcn_s_waitcnt(0);
        unsigned nloc = b.st[0], nx = b.st[1];
        if (nloc == 0u) { xcd_barrier_complete(bar, b.x, nloc, nx); b.st[0] = nloc; b.st[1] = nx; }
        const unsigned old = xb_add(&bar[XB_XSUB(b.x)], 1u);
        const unsigned gen = old / nloc;
        if (old + 1u == (gen + 1u) * nloc) {
            __builtin_amdgcn_fence(__ATOMIC_RELEASE, "agent");
            asm volatile("s_waitcnt vmcnt(0)" ::: "memory");
            const unsigned og = xb_add(&bar[XB_TOP], 1u);
            const unsigned tg = og / nx;
            if (og + 1u == (tg + 1u) * nx) xb_add(&bar[XB_TOPGEN], 1u);
            else XB_SPIN(xb_ld(&bar[XB_TOPGEN]) == tg, bar);
            __builtin_amdgcn_fence(__ATOMIC_ACQUIRE, "agent");
            xb_add(&bar[XB_XGEN(b.x)], 1u);
            asm volatile("s_waitcnt vmcnt(0)" ::: "memory");
        } else {
            XB_SPIN(xb_ld(&bar[XB_XGEN(b.x)]) == gen, bar);
            __builtin_amdgcn_fence(__ATOMIC_ACQUIRE, "agent");
            asm volatile("s_waitcnt vmcnt(0)" ::: "memory");
        }
    }
    __syncthreads();
}
#ifndef PROBE_MASK
#define PROBE_MASK 0
#endif

constexpr int T = 4096, NBATCH = 2, MPROMPT = 8192, MSAMP = 128, MREAL = 8320, MPAD = 8448;
constexpr int DM = 2048, DG = 1024, DQ = 1024, DFF = 8192, NIN = 8728, NINP = 8960;
constexpr int PASTLEN = 2048;
constexpr float EPS = 1e-6f;
constexpr float LOG2E = 1.4426950408889634f;
constexpr float QSCALE = 0.08838834764831845f * 1.4426950408889634f;
constexpr int NWAVES = 8;
constexpr int LD2 = DM + 64, LD1 = DG + 64, LD8 = DFF + 64;

constexpr size_t O_YP = 0, O_YS = 16777216, O_PCMP = O_YS + 262144, O_PSEL = O_PCMP + 4194304, O_PWIN = O_PSEL + 4194304,
                 O_PSGU = O_PWIN + 524288, O_SCMP = O_PSGU + 262144, O_SSEL = O_SCMP + 65536, O_SWIN = O_SSEL + 65536,
                 O_SSGU = O_SWIN + 33554432, O_END = O_SSGU + 131072;
static_assert(O_END == 60030976, "output size");

constexpr size_t MiB = 1ull << 20;
constexpr size_t al(size_t x) { return (x + MiB - 1) / MiB * MiB; }
constexpr size_t WS_CTL = 0, CTL_ZERO_BYTES = 1 * MiB;
constexpr size_t WS_WIN  = 1 * MiB;
constexpr size_t WS_WG   = WS_WIN  + al((size_t)NINP * LD2 * 2);
constexpr size_t WS_WN   = WS_WG   + al((size_t)DM * LD1 * 2);
constexpr size_t WS_WO   = WS_WN   + al((size_t)DM * LD1 * 2);
constexpr size_t WS_WUP  = WS_WO   + al((size_t)DM * LD2 * 2);
constexpr size_t WS_WDN  = WS_WUP  + al((size_t)DFF * LD2 * 2);
constexpr size_t WS_WC   = WS_WDN  + al((size_t)DM * LD8 * 2);
constexpr size_t WS_XB   = WS_WC   + al((size_t)512 * LD2 * 2);
constexpr size_t WS_RSTD1= WS_XB   + al((size_t)MPAD * LD2 * 2);
constexpr size_t WS_U    = WS_RSTD1+ al((size_t)MPAD * 4);
constexpr size_t WS_VG   = WS_U    + al((size_t)MPAD * DG * 2);
constexpr size_t WS_VSS  = WS_VG   + al((size_t)MPAD * DG * 2);
constexpr size_t WS_RSTDV= WS_VSS  + al((size_t)MPAD * 32 * 4);
constexpr size_t WS_QRAW = WS_RSTDV+ al((size_t)MPAD * 4);
constexpr size_t WS_KVWR = WS_QRAW + al((size_t)MPAD * DQ * 4);
constexpr size_t WS_GA   = WS_KVWR + al((size_t)MPAD * 512 * 4);
constexpr size_t WS_GB   = WS_GA   + al((size_t)MPAD * DM * 2);
constexpr size_t WS_GN   = WS_GB   + al((size_t)MPAD * DM * 2);
constexpr size_t WS_QN   = WS_GN   + al((size_t)MPAD * 32 * 4);
constexpr size_t WS_KS   = WS_QN   + al((size_t)MPAD * DQ * 2);
constexpr size_t WS_VS   = WS_KS   + 4 * MiB;
constexpr size_t WS_KW   = WS_VS   + 4 * MiB;
constexpr size_t WS_VW   = WS_KW   + 4 * MiB;
constexpr size_t WS_ACP  = WS_VW   + 4 * MiB;
constexpr size_t WS_ACS  = WS_ACP  + al((size_t)2048 * LD2 * 2);
constexpr size_t WS_YCP  = WS_ACS  + al((size_t)65536 * LD2 * 2);
constexpr size_t WS_YCS  = WS_YCP  + 2 * MiB;
constexpr size_t WS_KCP  = WS_YCS  + 64 * MiB;
constexpr size_t WS_VCP  = WS_KCP  + 1 * MiB;
constexpr size_t WS_KCS  = WS_VCP  + 1 * MiB;
constexpr size_t WS_VCS  = WS_KCS  + 8 * MiB;
constexpr size_t WS_CBP  = WS_VCS  + 8 * MiB;
constexpr size_t WS_WMB  = WS_CBP  + 1 * MiB;
constexpr size_t WS_BLUT = WS_WMB  + 1 * MiB;
constexpr size_t WS_OA   = WS_BLUT + 1 * MiB;
constexpr size_t WS_OB   = WS_OA   + al((size_t)MPAD * LD1 * 2);
constexpr size_t WS_MIXA = WS_OB   + al((size_t)MPAD * LD1 * 2);
constexpr size_t WS_MIX  = WS_MIXA + al((size_t)MPAD * DM * 2);
constexpr size_t WS_X1B  = WS_MIX  + al((size_t)MPAD * LD2 * 2);
constexpr size_t WS_X1F  = WS_X1B  + al((size_t)MPAD * LD2 * 2);
constexpr size_t WS_X1SS = WS_X1F  + al((size_t)128 * DM * 4);
constexpr size_t WS_H    = WS_X1SS + al((size_t)MPAD * 32 * 4);
constexpr size_t WS_OT   = WS_H    + al((size_t)MPAD * LD8 * 2);
constexpr size_t WS_SPART= WS_OT   + 32 * MiB;
constexpr int LDS_X = DM + 64, LDS_G = DG + 64, LDS_H = DFF + 64;
constexpr size_t WS_SXB  = WS_SPART+ 4 * MiB;
constexpr size_t WS_SOA  = WS_SXB  + 1 * MiB;
constexpr size_t WS_SOB  = WS_SOA  + 1 * MiB;
constexpr size_t WS_SMIX = WS_SOB  + 1 * MiB;
constexpr size_t WS_SX1B = WS_SMIX + 1 * MiB;
constexpr size_t WS_SH   = WS_SX1B + 1 * MiB;
constexpr size_t WS_DUMMY= WS_SH   + 3 * MiB;
constexpr size_t WS_END  = WS_DUMMY+ 72 * MiB;

constexpr int CW_TMO = 0, CW_CODE = 1;
constexpr int CW_BAR = 4096;
constexpr int CW_Q5 = 8192;
constexpr int CW_FLAG = 16384;
constexpr int CW_TICK = 65536;
static_assert((CW_TICK + 64 * 64) * 4 <= (int)CTL_ZERO_BYTES && (CW_BAR + 16 * 3456) * 4 <= (int)CTL_ZERO_BYTES, "CTL words inside the memset region");

constexpr int RING_OFF = 0, RING_BYTES = 131072;
constexpr int LDSCTL_OFF = RING_BYTES, MISC_OFF = LDSCTL_OFF + 320;
constexpr int LDS_BYTES = 147456;
static_assert(MISC_OFF + 128 <= LDS_BYTES, "LDS map");

__constant__ unsigned char kBkt[128] = {0, 1, 2, 3, 4, 5, 6, 7, 8, 9, 10, 11, 12, 13, 14, 15, 16, 16, 16, 17, 17, 18, 18, 18, 19, 19, 19, 20, 20, 20, 20, 21, 21, 21, 21, 22, 22, 22, 22, 22, 23, 23, 23, 23, 23, 23, 24, 24, 24, 24, 24, 24, 25, 25, 25, 25, 25, 25, 25, 26, 26, 26, 26, 26, 26, 26, 26, 27, 27, 27, 27, 27, 27, 27, 27, 27, 27, 28, 28, 28, 28, 28, 28, 28, 28, 28, 28, 29, 29, 29, 29, 29, 29, 29, 29, 29, 29, 29, 29, 30, 30, 30, 30, 30, 30, 30, 30, 30, 30, 30, 30, 30, 30, 31, 31, 31, 31, 31, 31, 31, 31, 31, 31, 31, 31, 31, 31, 31};

__host__ __device__ __forceinline__ size_t tm_idx(int row, int col, int nkt) { return ((size_t)((row >> 8) * nkt + (col >> 6)) * 256 + (row & 255)) * 64 + (col & 63); }

typedef unsigned v2u __attribute__((ext_vector_type(2)));
struct Ctx {
    const float* const* in; float* out; unsigned char* ws;
    LAS unsigned char* lds;
    int tid, lane, wave, vcu, G;
};
__device__ __forceinline__ int lane_now() { int l_; asm volatile("v_mbcnt_lo_u32_b32 %0, -1, 0\n\tv_mbcnt_hi_u32_b32 %0, -1, %0" : "=&v"(l_) : : "memory"); return l_; }
__device__ __forceinline__ Ctx fresh(const Ctx& C) { Ctx L = C; const int l_ = lane_now(); L.lane = l_; L.tid = C.wave * 64 + l_; return L; }
#define IN_XP 0
#define IN_XS 1
#define IN_CCMP 2
#define IN_CSEL 3
#define IN_WINB 4
#define IN_PT 5
#define IN_RELB 6
#define IN_GMIX 7
#define IN_WIN 8
#define IN_GSGU 9
#define IN_WSGU 10
#define IN_BSGU 11
#define IN_GQ 12
#define IN_GK 13
#define IN_POSK 14
#define IN_WCK 15
#define IN_POSV 16
#define IN_WCV 17
#define IN_WPG 18
#define IN_WPN 19
#define IN_WOUT 20
#define IN_GMLP 21
#define IN_WUP 22
#define IN_WDN 23

__device__ __forceinline__ float bf2f(unsigned short b) { return __uint_as_float((unsigned)b << 16); }
__device__ __forceinline__ float bflo(unsigned w) { return __uint_as_float(w << 16); }
__device__ __forceinline__ float bfhi(unsigned w) { return __uint_as_float(w & 0xffff0000u); }
__device__ __forceinline__ void unpack8(v4u w, float (&f)[8]) {
    f[0] = bflo(w.x); f[1] = bfhi(w.x); f[2] = bflo(w.y); f[3] = bfhi(w.y); f[4] = bflo(w.z); f[5] = bfhi(w.z); f[6] = bflo(w.w); f[7] = bfhi(w.w);
}
__device__ __forceinline__ v4u pack8f(const float (&f)[8]) { v4u w; w.x = pk2(f[0], f[1]); w.y = pk2(f[2], f[3]); w.z = pk2(f[4], f[5]); w.w = pk2(f[6], f[7]); return w; }
__device__ __forceinline__ float wave_sum(float v) {
#pragma unroll
    for (int o = 1; o < 64; o <<= 1) v += __shfl_xor(v, o);
    return v;
}
__device__ __forceinline__ float wave_max(float v) {
#pragma unroll
    for (int o = 1; o < 64; o <<= 1) v = fmaxf(v, __shfl_xor(v, o));
    return v;
}
__device__ __forceinline__ float sigmoidf_(float x) { return 1.0f / (1.0f + __expf(-x)); }
__device__ __forceinline__ float gelu_tanh(float x) {
    const float u = 0.7978845608028654f * (x + 0.044715f * x * x * x);
    return x / (1.0f + __expf(-2.0f * u));
}

__device__ __forceinline__ void tr_item(const float* W, int ldw, int srccol0, int nvalid, const float* kscale, bf16* WT, int nkt, int dst_row0, int k0, LAS float* scr, int lane) {
    const int n = lane & 31;
    float vv[32];
#pragma unroll
    for (int i = 0; i < 32; ++i) { const int kk = 2 * i + (lane >> 5); vv[i] = (n < nvalid) ? __builtin_nontemporal_load(W + (size_t)(k0 + kk) * ldw + srccol0 + n) : 0.f; }
    if (kscale) {
#pragma unroll
        for (int i = 0; i < 32; ++i) vv[i] *= kscale[k0 + 2 * i + (lane >> 5)]; }
#pragma unroll
    for (int i = 0; i < 32; ++i) scr[(2 * i + (lane >> 5)) * 33 + n] = vv[i];
    LDS_WAIT(); asm volatile("" ::: "memory");
    const int c = lane & 7;
#pragma unroll
    for (int j = 0; j < 4; ++j) { const int nn = (lane >> 3) + 8 * j; const LAS float* s = scr + (8 * c) * 33 + nn;
        v4u o; o.x = pk2(s[0 * 33], s[1 * 33]); o.y = pk2(s[2 * 33], s[3 * 33]); o.z = pk2(s[4 * 33], s[5 * 33]); o.w = pk2(s[6 * 33], s[7 * 33]);
        { const int n_ = dst_row0 + nn; *(GAS v4u*)(WT + ((size_t)((n_ >> 8) * nkt + (k0 >> 6)) * 256 + (n_ & 255)) * 64 + 8 * c) = o; } }
    LDS_WAIT(); asm volatile("" ::: "memory");
}

constexpr int I_IN = 32 * 280, I_PG = 16 * 64, I_PN = 16 * 64, I_OUT = 32 * 64, I_UP = 32 * 256, I_DN = 128 * 64, I_C = 4 * 128;
constexpr int I_LATE = I_PG + I_PN + I_OUT + I_UP + I_DN;
__device__ __forceinline__ void w_item_in(const Ctx& C, int r, LAS float* scr) {
    const int kb = r / 280, nb = r % 280, n0 = nb * 32;
    const int src = n0 < 4608 ? n0 : (n0 < 8704 ? n0 + 24 : n0 - 8704 + 4608);
    const int nv = n0 < 8704 ? 32 : (n0 == 8704 ? 24 : 0);
    tr_item(C.in[IN_WIN], NIN, src, nv, C.in[IN_GMIX], (bf16*)(C.ws + WS_WIN), DM / 64, n0, kb * 64, scr, C.lane);
}
__device__ __forceinline__ void w_item_cmp(const Ctx& C, int r, LAS float* scr) {
    const int sub = r / 128, rr = r % 128, kv = sub >> 1, hf = sub & 1, kb = rr / 4, nb = rr % 4;
    const float* W = (kv ? C.in[IN_WCV] : C.in[IN_WCK]) + (size_t)hf * 2048 * 128;
    tr_item(W, 128, nb * 32, 32, nullptr, (bf16*)(C.ws + WS_WC), 2048 / 64, kv * 256 + hf * 128 + nb * 32, kb * 64, scr, C.lane);
}
__device__ __forceinline__ void w_item_late(const Ctx& C, int r, LAS float* scr) {
    unsigned char* ws = C.ws; const int lane = C.lane;
    if (r < I_PG) { const int kb = r / 64, nb = r % 64; tr_item(C.in[IN_WPG], DM, nb * 32, 32, nullptr, (bf16*)(ws + WS_WG), DG / 64, nb * 32, kb * 64, scr, lane); return; } r -= I_PG;
    if (r < I_PN) { const int kb = r / 64, nb = r % 64; tr_item(C.in[IN_WPN], DM, nb * 32, 32, nullptr, (bf16*)(ws + WS_WN), DQ / 64, nb * 32, kb * 64, scr, lane); return; } r -= I_PN;
    if (r < I_OUT) { const int kb = r / 64, nb = r % 64; tr_item(C.in[IN_WOUT], DM, nb * 32, 32, nullptr, (bf16*)(ws + WS_WO), DM / 64, nb * 32, kb * 64, scr, lane); return; } r -= I_OUT;
    if (r < I_UP) { const int kb = r / 256, nb = r % 256; tr_item(C.in[IN_WUP], DFF, nb * 32, 32, C.in[IN_GMLP], (bf16*)(ws + WS_WUP), DM / 64, nb * 32, kb * 64, scr, lane); return; } r -= I_UP;
    { const int kb = r / 64, nb = r % 64; tr_item(C.in[IN_WDN], DM, nb * 32, 32, nullptr, (bf16*)(ws + WS_WDN), DFF / 64, nb * 32, kb * 64, scr, lane); }
}
__device__ __forceinline__ void gather_item(const Ctx& C, int it) {
    const int lane = C.lane, kvg = lane >> 4, d = (lane & 15) * 8;
    const int b = it >> 7, p = (it >> 3) & 15, sg = it & 7, page = ((const int*)C.in[IN_PT])[b * 16 + p], j = p * 8 + sg;
    const float* src = C.in[IN_CCMP] + ((size_t)page * 128 + sg * 16) * 512 + lane * 8;
    bf16* dst = (bf16*)(C.ws + WS_ACS) + (size_t)((b * 4 + kvg) * 128 + j) * LD2 + d;
#pragma unroll
    for (int h = 0; h < 2; ++h) { f32x4 a[8], c2[8];
#pragma unroll
        for (int s = 0; s < 8; ++s) { a[s] = __builtin_nontemporal_load((const GAS f32x4*)(src + (h * 8 + s) * 512)); c2[s] = __builtin_nontemporal_load((const GAS f32x4*)(src + (h * 8 + s) * 512 + 4)); }
#pragma unroll
        for (int s = 0; s < 8; ++s) { v4u o; o.x = pk2(a[s].x, a[s].y); o.y = pk2(a[s].z, a[s].w); o.z = pk2(c2[s].x, c2[s].y); o.w = pk2(c2[s].z, c2[s].w);
            *(GAS v4u*)(dst + (h * 8 + s) * 128) = o; } }
}
constexpr int WINCOPY_F4 = 128 * 65408, WINCOPY_CHUNK = 16384, WINCOPY_ITEMS = (WINCOPY_F4 + WINCOPY_CHUNK - 1) / WINCOPY_CHUNK;
__device__ __forceinline__ void wincopy_item(const Ctx& C, int chunk) {
    const GAS f32x4* src = (const GAS f32x4*)C.in[IN_WINB]; GAS f32x4* dst = (GAS f32x4*)(C.out + O_SWIN);
    const int base = chunk * WINCOPY_CHUNK + C.tid;
#pragma unroll
    for (int h = 0; h < 2; ++h) { f32x4 v[16];
#pragma unroll
        for (int k = 0; k < 16; ++k) { const int i = base + (h * 16 + k) * NWAVES * 64; if (i < WINCOPY_F4) { const int b = i / 65408, r = i - b * 65408; v[k] = __builtin_nontemporal_load(src + b * 65536 + 128 + r); } }
#pragma unroll
        for (int k = 0; k < 16; ++k) { const int i = base + (h * 16 + k) * NWAVES * 64; if (i < WINCOPY_F4) { const int b = i / 65408, r = i - b * 65408; __builtin_nontemporal_store(v[k], dst + b * 65536 + r); } } }
}

__device__ __forceinline__ void p0_prologue(const Ctx& C) {
    unsigned char* ws = C.ws;
    LAS float* scr = (LAS float*)(C.lds + RING_OFF + C.wave * 16384);
    const int gw = C.vcu * NWAVES + C.wave, NGW = C.G * NWAVES, lane = C.lane;
    for (int rep = 0; rep < (((PROBE_MASK >> 10) & 1) ? 2 : 1); ++rep)
    for (int it = gw; it < I_IN + I_C; it += NGW) { if (it < I_IN) w_item_in(C, it, scr); else w_item_cmp(C, it - I_IN, scr); }
    {
        bf16* XB = (bf16*)(ws + WS_XB); float* RS = (float*)(ws + WS_RSTD1);
        for (int rep = 0; rep < (((PROBE_MASK >> 12) & 1) ? 2 : 1); ++rep)
        for (int m = gw; m < MREAL; m += NGW) {
            const bool pr_ = m < MPROMPT;
            GAS v2u* o8 = pr_ ? (GAS v2u*)(XB + tm_idx(m, 4 * (lane & 15), DM / 64)) + 0 : (GAS v2u*)((bf16*)(ws + WS_SXB) + (size_t)(m - MPROMPT) * LDS_X) + lane;
            const float* xr = m < MPROMPT ? C.in[IN_XP] + (size_t)m * DM : C.in[IN_XS] + (size_t)(m - MPROMPT) * DM;
            const GAS f32x4* x4 = (const GAS f32x4*)xr + lane; f32x4 v[8]; float s = 0.f;
#pragma unroll
            for (int j = 0; j < 8; ++j) { v[j] = x4[64 * j]; s += (v[j].x * v[j].x + v[j].y * v[j].y) + (v[j].z * v[j].z + v[j].w * v[j].w); }
            s = wave_sum(s);
#pragma unroll
            for (int j = 0; j < 8; ++j) o8[pr_ ? (size_t)((lane >> 4) + 4 * j) * 4096 : (size_t)64 * j] = (v2u){pk2(v[j].x, v[j].y), pk2(v[j].z, v[j].w)};
            if (lane == 0) RS[m] = rsqrtf(s * (1.0f / DM) + EPS);
        }
    }
    {
        float* CBP = (float*)(ws + WS_CBP);
        for (int it = gw; it < 64; it += NGW) { const int kv = it >> 5, eb = (it >> 4) & 1, kc = it & 15, e = eb * 64 + lane;
            const float* pos = kv ? C.in[IN_POSV] : C.in[IN_POSK]; const float* W = kv ? C.in[IN_WCV] : C.in[IN_WCK]; float a = 0.f;
#pragma unroll 8
            for (int k = kc * 256; k < kc * 256 + 256; ++k) a += pos[k] * W[(size_t)k * 128 + e];
            CBP[(kv * 16 + kc) * 128 + e] = a; }
    }
    {
        const float* w = C.in[IN_WSGU]; bf16* WMB = (bf16*)(ws + WS_WMB);
        for (int i = gw * 64 + lane; i < 8 * 128 * 128 / 8; i += NGW * 64) { const int e0 = i * 8, t = (e0 >> 7) & 127, s0 = e0 & 127; float f[8];
#pragma unroll
            for (int k = 0; k < 8; ++k) f[k] = (s0 + k <= t) ? w[e0 + k] : 0.f;
            *(GAS v4u*)(WMB + e0) = pack8f(f); }
        float* BL = (float*)(ws + WS_BLUT); const float* rb = C.in[IN_RELB];
        for (int i = gw * 64 + lane; i < 8 * 132; i += NGW * 64) { const int h = i / 132, rel = i % 132; const int bk = rel < 128 ? kBkt[rel] : 31; BL[i] = rb[bk * 8 + h] * LOG2E; }
    }
}

namespace epi {
using pg8::f32x4; using pg8::Unit; using pg8::cvt_pk_bf16;
typedef unsigned u32x4 __attribute__((ext_vector_type(4)));
__device__ __forceinline__ u32x4 pack8v(f32x4 a, f32x4 b) { u32x4 w; w.x = cvt_pk_bf16(a[0], a[1]); w.y = cvt_pk_bf16(a[2], a[3]); w.z = cvt_pk_bf16(b[0], b[1]); w.w = cvt_pk_bf16(b[2], b[3]); return w; }

struct EpiIn {
    static constexpr bool PERM = true, AFTER_DRAIN = false;
    const float* rstd; bf16* U; bf16* VG; float* VSS; float* QRAW; float* KVWR; bf16* GA; bf16* GB; float* GN; float* out; bf16* ACP;
    __device__ __forceinline__ void operator()(const f32x4 (&acc)[2][2][4][2], const Unit& u, int wr, int wc, int fr, int fq) const {
        const int row0 = u.pm * 256 + wr * 64 + fr, cl = wc * 32 + 8 * fq, pn = u.pn;
#pragma unroll
        for (int ai = 0; ai < 2; ++ai)
#pragma unroll
            for (int m = 0; m < 4; ++m) { const int row = row0 + ai * 128 + m * 16; const float rs = rstd[row];
#pragma unroll
                for (int bj = 0; bj < 2; ++bj) { f32x4 v0 = acc[ai][bj][m][0] * rs, v1 = acc[ai][bj][m][1] * rs; const int c = cl + bj * 128;
                    if (pn < 8) {
#pragma unroll
                        for (int k = 0; k < 4; ++k) { v0[k] = gelu_tanh(v0[k]); v1[k] = gelu_tanh(v1[k]); }
                        if (pn < 4) *(u32x4*)(U + (size_t)row * DG + pn * 256 + c) = pack8v(v0, v1);
                        else { *(u32x4*)(VG + (size_t)row * DG + (pn - 4) * 256 + c) = pack8v(v0, v1);
                            float ss = (v0[0] * v0[0] + v0[1] * v0[1]) + (v0[2] * v0[2] + v0[3] * v0[3]) + (v1[0] * v1[0] + v1[1] * v1[1]) + (v1[2] * v1[2] + v1[3] * v1[3]);
                            ss += __shfl_xor(ss, 16); ss += __shfl_xor(ss, 32);
                            if (fq == 0) VSS[(size_t)row * 32 + (pn - 4) * 8 + bj * 4 + wc] = ss; }
                    } else if (pn < 12) { float* q = QRAW + (size_t)row * DQ + (pn - 8) * 256 + c; *(f32x4*)q = v0; *(f32x4*)(q + 4) = v1;
                    } else if (pn < 16) {
                        const int cc = ((pn - 12) & 1) * 256 + c; float* o = nullptr;
                        if (row < MPROMPT) o = out + (pn < 14 ? O_PCMP : O_PSEL) + (size_t)row * 512 + cc;
                        else if (row < MREAL) o = out + (pn < 14 ? O_SCMP : O_SSEL) + (size_t)(row - MPROMPT) * 512 + cc;
                        if (o) { *(f32x4*)o = v0; *(f32x4*)(o + 4) = v1; }
                        if (pn < 14 && row < MPROMPT) {
                            const int b_ = row >> 12, t_ = row & 4095;
                            *(u32x4*)(ACP + tm_idx(((b_ * 2 + (cc >> 8)) * 2 + ((cc >> 7) & 1)) * 256 + (t_ >> 4), (t_ & 15) * 128 + (cc & 127), 2048 / 64)) = pack8v(v0, v1); }
                    } else if (pn < 18) { float* o = KVWR + (size_t)row * 512 + (pn - 16) * 256 + c; *(f32x4*)o = v0; *(f32x4*)(o + 4) = v1;
                    } else if (pn < 34) {
#pragma unroll
                        for (int k = 0; k < 4; ++k) { v0[k] = sigmoidf_(v0[k]); v1[k] = sigmoidf_(v1[k]); }
                        bf16* g = (pn < 26 ? GA + (size_t)row * DM + (pn - 18) * 256 : GB + (size_t)row * DM + (pn - 26) * 256) + c; *(u32x4*)g = pack8v(v0, v1);
                    } else { if (c < 24) {
#pragma unroll
                        for (int k = 0; k < 4; ++k) { v0[k] = sigmoidf_(v0[k]); v1[k] = sigmoidf_(v1[k]); }
                        float* o = GN + (size_t)row * 32 + c; *(f32x4*)o = v0; *(f32x4*)(o + 4) = v1; } }
                } }
    }
};
struct EpiCmp {
    static constexpr bool PERM = false, AFTER_DRAIN = false;
    float* YC; int segmask;
    __device__ __forceinline__ void operator()(const f32x4 (&acc)[2][2][4][2], const Unit& u, int wr, int wc, int fr, int fq) const {
        const int row0 = u.pm * 256 + wr * 64 + fr, cl = wc * 32 + 4 * fq;
#pragma unroll
        for (int ai = 0; ai < 2; ++ai)
#pragma unroll
            for (int m = 0; m < 4; ++m) { const int row = row0 + ai * 128 + m * 16;
#pragma unroll
                for (int n = 0; n < 2; ++n) { *(f32x4*)(YC + (size_t)row * 256 + cl + n * 16) = acc[ai][0][m][n];
                    if ((row & segmask) != 0) *(f32x4*)(YC + (size_t)(row - 1) * 256 + 128 + cl + n * 16) = acc[ai][1][m][n]; } }
    }
};
struct EpiMixA {
    static constexpr bool PERM = true, AFTER_DRAIN = false;
    const bf16* GA; bf16* MIXA;
    __device__ __forceinline__ void operator()(const f32x4 (&acc)[2][2][4][2], const Unit& u, int wr, int wc, int fr, int fq) const {
        const int row0 = u.pm * 256 + wr * 64 + fr, c0 = u.pn * 256 + wc * 32 + 8 * fq;
#pragma unroll
        for (int ai = 0; ai < 2; ++ai) { v4u gv[4][2];
#pragma unroll
            for (int m = 0; m < 4; ++m)
#pragma unroll
                for (int bj = 0; bj < 2; ++bj) gv[m][bj] = *(const v4u*)(GA + (size_t)(row0 + ai * 128 + m * 16) * DM + c0 + bj * 128);
#pragma unroll
            for (int m = 0; m < 4; ++m) { const size_t ro = (size_t)(row0 + ai * 128 + m * 16) * DM;
#pragma unroll
                for (int bj = 0; bj < 2; ++bj) { const size_t o = ro + c0 + bj * 128; float g[8]; unpack8(gv[m][bj], g);
                    f32x4 v0 = acc[ai][bj][m][0], v1 = acc[ai][bj][m][1];
                    v0[0] *= g[0]; v0[1] *= g[1]; v0[2] *= g[2]; v0[3] *= g[3]; v1[0] *= g[4]; v1[1] *= g[5]; v1[2] *= g[6]; v1[3] *= g[7];
                    *(u32x4*)(MIXA + o) = pack8v(v0, v1); } } }
    }
};
struct EpiMixB {
    static constexpr bool PERM = true, AFTER_DRAIN = false;
    const bf16* GB; const bf16* MIXA; bf16* MIX;
    __device__ __forceinline__ void operator()(const f32x4 (&acc)[2][2][4][2], const Unit& u, int wr, int wc, int fr, int fq) const {
        const int row0 = u.pm * 256 + wr * 64 + fr, c0 = u.pn * 256 + wc * 32 + 8 * fq;
#pragma unroll
        for (int ai = 0; ai < 2; ++ai) { v4u gv[4][2], av[4][2];
#pragma unroll
            for (int m = 0; m < 4; ++m)
#pragma unroll
                for (int bj = 0; bj < 2; ++bj) { const size_t o = (size_t)(row0 + ai * 128 + m * 16) * DM + c0 + bj * 128; gv[m][bj] = *(const v4u*)(GB + o); av[m][bj] = *(const v4u*)(MIXA + o); }
#pragma unroll
            for (int m = 0; m < 4; ++m)
#pragma unroll
                for (int bj = 0; bj < 2; ++bj) { float g[8], a[8]; unpack8(gv[m][bj], g); unpack8(av[m][bj], a);
                    f32x4 v0 = acc[ai][bj][m][0], v1 = acc[ai][bj][m][1];
                    v0[0] = a[0] + v0[0] * g[0]; v0[1] = a[1] + v0[1] * g[1]; v0[2] = a[2] + v0[2] * g[2]; v0[3] = a[3] + v0[3] * g[3];
                    v1[0] = a[4] + v1[0] * g[4]; v1[1] = a[5] + v1[1] * g[5]; v1[2] = a[6] + v1[2] * g[6]; v1[3] = a[7] + v1[3] * g[7];
                    *(u32x4*)(MIX + tm_idx(row0 + ai * 128 + m * 16, c0 + bj * 128, DM / 64)) = pack8v(v0, v1); } }
    }
};
struct EpiOut {
    static constexpr bool PERM = true, AFTER_DRAIN = false;
    const bf16* XB; float* out; bf16* X1B; float* SS;
    __device__ __forceinline__ void operator()(const f32x4 (&acc)[2][2][4][2], const Unit& u, int wr, int wc, int fr, int fq) const {
        const int row0 = u.pm * 256 + wr * 64 + fr, c0 = u.pn * 256 + wc * 32 + 8 * fq;
#pragma unroll
        for (int ai = 0; ai < 2; ++ai) { u32x4 xw[4][2];
#pragma unroll
            for (int m = 0; m < 4; ++m)
#pragma unroll
                for (int bj = 0; bj < 2; ++bj) xw[m][bj] = *(const u32x4*)(XB + tm_idx(row0 + ai * 128 + m * 16, c0 + bj * 128, DM / 64));
#pragma unroll
            for (int m = 0; m < 4; ++m) { const int row = row0 + ai * 128 + m * 16; float ss = 0.f;
#pragma unroll
                for (int bj = 0; bj < 2; ++bj) { const int c = c0 + bj * 128; const u32x4 w = xw[m][bj];
                    const f32x4 x0 = {__uint_as_float(w.x << 16), __uint_as_float(w.x & 0xffff0000u), __uint_as_float(w.y << 16), __uint_as_float(w.y & 0xffff0000u)};
                    const f32x4 x1 = {__uint_as_float(w.z << 16), __uint_as_float(w.z & 0xffff0000u), __uint_as_float(w.w << 16), __uint_as_float(w.w & 0xffff0000u)};
                    const f32x4 v0 = acc[ai][bj][m][0] + x0, v1 = acc[ai][bj][m][1] + x1;
                    *(u32x4*)(X1B + tm_idx(row, c, DM / 64)) = pack8v(v0, v1);
                    ss += (v0[0] * v0[0] + v0[1] * v0[1]) + (v0[2] * v0[2] + v0[3] * v0[3]) + (v1[0] * v1[0] + v1[1] * v1[1]) + (v1[2] * v1[2] + v1[3] * v1[3]); }
                ss += __shfl_xor(ss, 16); ss += __shfl_xor(ss, 32);
                if (fq == 0) SS[(size_t)row * 32 + u.pn * 4 + wc] = ss; } }
    }
};
struct EpiUp {
    static constexpr bool PERM = true, AFTER_DRAIN = false;
    const float* SS; bf16* H;
    __device__ __forceinline__ void operator()(const f32x4 (&acc)[2][2][4][2], const Unit& u, int wr, int wc, int fr, int fq) const {
        const int row0 = u.pm * 256 + wr * 64 + fr, c0 = u.pn * 256 + wc * 32 + 8 * fq;
#pragma unroll
        for (int ai = 0; ai < 2; ++ai)
#pragma unroll
            for (int m = 0; m < 4; ++m) { const int row = row0 + ai * 128 + m * 16; const f32x4* sp = (const f32x4*)(SS + (size_t)row * 32) + 2 * fq;
                const f32x4 s4 = sp[0] + sp[1]; float st = (s4[0] + s4[1]) + (s4[2] + s4[3]); st += __shfl_xor(st, 16); st += __shfl_xor(st, 32);
                const float rs = rsqrtf(st * (1.0f / DM) + EPS);
#pragma unroll
                for (int bj = 0; bj < 2; ++bj) { f32x4 v0 = acc[ai][bj][m][0] * rs, v1 = acc[ai][bj][m][1] * rs;
#pragma unroll
                    for (int k = 0; k < 4; ++k) { const float a = fmaxf(v0[k], 0.f), b = fmaxf(v1[k], 0.f); v0[k] = a * a; v1[k] = b * b; }
                    { const int col = c0 + bj * 128; *(u32x4*)(H + ((size_t)((row >> 8) * (DFF / 64) + (col >> 6)) * 256 + (row & 255)) * 64 + (col & 63)) = pack8v(v0, v1); } } }
    }
};
struct EpiDown {
    static constexpr bool PERM = true, AFTER_DRAIN = false;
    float* out; const bf16* X1B;
    __device__ __forceinline__ void operator()(const f32x4 (&acc)[2][2][4][2], const Unit& u, int wr, int wc, int fr, int fq) const {
        const int row0 = u.pm * 256 + wr * 64 + fr, c0 = u.pn * 256 + wc * 32 + 8 * fq;
#pragma unroll
        for (int ai = 0; ai < 2; ++ai) { u32x4 xv[4][2];
#pragma unroll
            for (int m = 0; m < 4; ++m)
#pragma unroll
                for (int bj = 0; bj < 2; ++bj) xv[m][bj] = *(const u32x4*)(X1B + tm_idx(row0 + ai * 128 + m * 16, c0 + bj * 128, DM / 64));
#pragma unroll
            for (int m = 0; m < 4; ++m)
#pragma unroll
                for (int bj = 0; bj < 2; ++bj) { float* p = out + O_YP + (size_t)(row0 + ai * 128 + m * 16) * DM + c0 + bj * 128; const u32x4 w = xv[m][bj];
                    const f32x4 x0 = {__uint_as_float(w.x << 16), __uint_as_float(w.x & 0xffff0000u), __uint_as_float(w.y << 16), __uint_as_float(w.y & 0xffff0000u)};
                    const f32x4 x1 = {__uint_as_float(w.z << 16), __uint_as_float(w.z & 0xffff0000u), __uint_as_float(w.w << 16), __uint_as_float(w.w & 0xffff0000u)};
                    *(f32x4*)p = x0 + acc[ai][bj][m][0]; *(f32x4*)(p + 4) = x1 + acc[ai][bj][m][1]; } }
    }
};
struct CmpOrder {
    int n, G, c, shift;
    __device__ __forceinline__ bool next(int i, Unit& u) const { const int L = i * G + c; if (L >= n) return false; u.pm = L; u.pn = (L >> shift) & 1; return true; }
    __device__ __forceinline__ void a_ready(const Unit&) const {}
    __device__ __forceinline__ void done(const Unit&) const {}
};
}

__device__ __forceinline__ float grp_sum8(float v) { v += __shfl_xor(v, 1); v += __shfl_xor(v, 2); v += __shfl_xor(v, 4); return v; }
__device__ __forceinline__ float grp_sum16(float v) { v = grp_sum8(v); v += __shfl_xor(v, 8); return v; }
__device__ __forceinline__ float grp_sum32(float v) { v = grp_sum16(v); v += __shfl_xor(v, 16); return v; }

__device__ __forceinline__ void p2_post(const Ctx& C, int idx, int nblk) {
    unsigned char* ws = C.ws; const int gw = idx * NWAVES + C.wave, NGW = nblk * NWAVES, lane = C.lane;
    const float* QRAW = (const float*)(ws + WS_QRAW); bf16* QN = (bf16*)(ws + WS_QN); const float* KVWR = (const float*)(ws + WS_KVWR);
    const float* gq = C.in[IN_GQ]; const float* gk = C.in[IN_GK];
    const int kv = lane >> 5, g = (lane >> 4) & 1, d = (lane & 15) * 8;
    for (int row = gw; row < MREAL; row += NGW) {
        const bool pr = row < MPROMPT; const int b = row >> 12, t = row & 4095, bs = row - MPROMPT;
        const GAS f32x4* q4 = (const GAS f32x4*)(QRAW + (size_t)row * DQ + lane * 16); f32x4 v[4];
#pragma unroll
        for (int j2 = 0; j2 < 4; ++j2) v[j2] = q4[j2];
        const float* wsrc = KVWR + (size_t)row * 512 + lane * 8; const f32x4 wa = *(const GAS f32x4*)wsrc, wc2 = *(const GAS f32x4*)(wsrc + 4);
        f32x4 sa = {0.f, 0.f, 0.f, 0.f}, sc2 = sa;
        if (pr) { const float* ssrc = C.out + O_PSEL + (size_t)row * 512 + lane * 8; sa = *(const GAS f32x4*)ssrc; sc2 = *(const GAS f32x4*)(ssrc + 4);
 }
        float vs = lane < 32 ? ((const float*)(ws + WS_VSS))[(size_t)row * 32 + lane] : 0.f;
        { float ss = 0.f;
#pragma unroll
          for (int j2 = 0; j2 < 4; ++j2) ss += (v[j2].x * v[j2].x + v[j2].y * v[j2].y) + (v[j2].z * v[j2].z + v[j2].w * v[j2].w);
          ss = grp_sum8(ss); const float rs = rsqrtf(ss * (1.0f / 128) + EPS) * QSCALE; const float* gg = gq + (lane & 7) * 16; float f[16];
#pragma unroll
          for (int j2 = 0; j2 < 4; ++j2) { f[4 * j2] = v[j2].x * rs * gg[4 * j2]; f[4 * j2 + 1] = v[j2].y * rs * gg[4 * j2 + 1]; f[4 * j2 + 2] = v[j2].z * rs * gg[4 * j2 + 2]; f[4 * j2 + 3] = v[j2].w * rs * gg[4 * j2 + 3]; }
          GAS v4u* o = (GAS v4u*)(QN + (size_t)row * DQ + lane * 16);
          o[0] = (v4u){pk2(f[0], f[1]), pk2(f[2], f[3]), pk2(f[4], f[5]), pk2(f[6], f[7])}; o[1] = (v4u){pk2(f[8], f[9]), pk2(f[10], f[11]), pk2(f[12], f[13]), pk2(f[14], f[15])}; }
        if (pr) { float ss = (sa.x * sa.x + sa.y * sa.y) + (sa.z * sa.z + sa.w * sa.w) + (sc2.x * sc2.x + sc2.y * sc2.y) + (sc2.z * sc2.z + sc2.w * sc2.w); ss = grp_sum16(ss);
            const float rs = kv == 0 ? rsqrtf(ss * (1.0f / 128) + EPS) : 1.f; const float* gg = gk + 128 + d; float f[8] = {sa.x, sa.y, sa.z, sa.w, sc2.x, sc2.y, sc2.z, sc2.w};
#pragma unroll
            for (int k = 0; k < 8; ++k) f[k] = kv == 0 ? f[k] * rs * gg[k] : f[k];
            bf16* dst = (bf16*)(ws + (kv == 0 ? WS_KS : WS_VS)) + ((size_t)(b * 2 + g) * T + t) * 128 + d; *(GAS v4u*)dst = pack8f(f); }
        if (pr) { float ss = (wa.x * wa.x + wa.y * wa.y) + (wa.z * wa.z + wa.w * wa.w) + (wc2.x * wc2.x + wc2.y * wc2.y) + (wc2.z * wc2.z + wc2.w * wc2.w); ss = grp_sum16(ss);
            const float rs = kv == 0 ? rsqrtf(ss * (1.0f / 128) + EPS) : 1.f; const float* gg = gk + 256 + d; float f[8] = {wa.x, wa.y, wa.z, wa.w, wc2.x, wc2.y, wc2.z, wc2.w};
#pragma unroll
            for (int k = 0; k < 8; ++k) f[k] = kv == 0 ? f[k] * rs * gg[k] : f[k];
            bf16* dst = (bf16*)(ws + (kv == 0 ? WS_KW : WS_VW)) + ((size_t)(b * 2 + g) * T + t) * 128 + d; *(GAS v4u*)dst = pack8f(f);
            if (t >= T - 512) { float* o = C.out + O_PWIN + ((size_t)b * 512 + (t - (T - 512))) * 512 + lane * 8; *(GAS f32x4*)o = wa; *(GAS f32x4*)(o + 4) = wc2; }
        } else { float* o = C.out + O_SWIN + ((size_t)bs * 512 + 511) * 512 + lane * 8; *(GAS f32x4*)o = wa; *(GAS f32x4*)(o + 4) = wc2; }
        { vs = wave_sum(vs); if (lane == 0) ((float*)(ws + WS_RSTDV))[row] = rsqrtf(vs * (1.0f / DG) + EPS); }
    }
}

__device__ __forceinline__ float shx(float v, int mask, int lane) { return __int_as_float(__builtin_amdgcn_ds_bpermute((lane ^ mask) << 2, __float_as_int(v))); }
template <bool WT = false>
__device__ __forceinline__ void cmp_combine_rows(const Ctx& C, bool pr, int row0, int nrows) {
    unsigned char* ws = C.ws; const int hw = C.wave * 2 + (C.lane >> 5), l32 = C.lane & 31, e = l32 * 4;
    const float* CBP = (const float*)(ws + WS_CBP); const float* gk0 = C.in[IN_GK];
    f32x4 cb0 = {0.f, 0.f, 0.f, 0.f}, cb1 = {0.f, 0.f, 0.f, 0.f};
#pragma unroll
    for (int kc = 0; kc < 16; ++kc) { cb0 += *(const GAS f32x4*)(CBP + kc * 128 + e); cb1 += *(const GAS f32x4*)(CBP + (16 + kc) * 128 + e); }
    const f32x4 g4 = *(const GAS f32x4*)(gk0 + e);
    const int segs = pr ? 256 : 128;
    for (int rr = row0 + hw; rr < row0 + nrows; rr += 16) {
        const int j = rr & (segs - 1), grp = rr / segs, g = grp & 1, kv = (grp >> 1) & 1, b = grp >> 2;
        const float* Y = (const float*)(ws + (pr ? WS_YCP : WS_YCS)) + (size_t)rr * 256;
        f32x4 v = {0.f, 0.f, 0.f, 0.f};
        if (j < segs - 1) { v = *(const GAS f32x4*)(Y + e) + *(const GAS f32x4*)(Y + 128 + e) + (kv ? cb1 : cb0); }
        float ss = (v.x * v.x + v.y * v.y) + (v.z * v.z + v.w * v.w);
#pragma unroll
        for (int o = 1; o < 32; o <<= 1) ss += shx(ss, o, C.lane);
        if (kv == 0) { const float rs = rsqrtf(ss * (1.0f / 128) + EPS); v = v * rs * g4; }
        bf16* dst = (bf16*)(ws + (pr ? (kv ? WS_VCP : WS_KCP) : (kv ? WS_VCS : WS_KCS))) + ((size_t)(b * 2 + g) * segs + j) * 128 + e;
        if (WT) __hip_atomic_store((gu64*)dst, ((unsigned long long)pk2(v.z, v.w) << 32) | pk2(v.x, v.y), RLX_AGENT); else *(GAS v2u*)dst = (v2u){pk2(v.x, v.y), pk2(v.z, v.w)};
    }
}

typedef short s16x4 __attribute__((ext_vector_type(4)));
typedef float f32x16 __attribute__((ext_vector_type(16)));
__device__ __forceinline__ int v_st(int k, int c) { const int kk = (k & ~0xC) | ((k & 4) << 1) | ((k & 8) >> 1); return ((kk >> 3) * 4 + (c >> 5)) * 512 + ((kk & 7) * 32 + (c & 31)) * 2; }
__device__ __forceinline__ int v_rd_base(int lane) { return ((lane & 3) << 3) | (((lane >> 2) & 3) << 6) | (((lane >> 4) & 1) << 5) | (((lane >> 5) & 1) << 8); }
constexpr int v_rd_off(int d0, int ks, int half) { return d0 * 512 + ks * 4096 + half * 2048; }
__device__ __forceinline__ int crow(int r, int hi) { return (r & 3) + 8 * (r >> 2) + 4 * hi; }
#define SBAR() __builtin_amdgcn_sched_barrier(0)
__device__ __forceinline__ void pv_tile(f32x16* o, int vb0, bf16x8 pa0, bf16x8 pa1, bf16x8 pa2, bf16x8 pa3) {
#define TRRD(dst, off) asm volatile("ds_read_b64_tr_b16 %0, %1 offset:%2" : "=&v"(dst) : "v"(vb0), "i"(off) : "memory")
#define PV_D0(d0) do { s16x4 l0, l1, l2, l3, h0, h1, h2, h3; constexpr int b_ = v_rd_off(d0, 0, 0); \
        TRRD(l0, b_); TRRD(h0, b_ + 2048); TRRD(l1, b_ + 4096); TRRD(h1, b_ + 6144); TRRD(l2, b_ + 8192); TRRD(h2, b_ + 10240); TRRD(l3, b_ + 12288); TRRD(h3, b_ + 14336); \
        asm volatile("s_waitcnt lgkmcnt(0)" ::: "memory"); SBAR(); \
        o[d0] = __builtin_amdgcn_mfma_f32_32x32x16_bf16(pa0, (bf16x8){l0[0], l0[1], l0[2], l0[3], h0[0], h0[1], h0[2], h0[3]}, o[d0], 0, 0, 0); \
        o[d0] = __builtin_amdgcn_mfma_f32_32x32x16_bf16(pa1, (bf16x8){l1[0], l1[1], l1[2], l1[3], h1[0], h1[1], h1[2], h1[3]}, o[d0], 0, 0, 0); \
        o[d0] = __builtin_amdgcn_mfma_f32_32x32x16_bf16(pa2, (bf16x8){l2[0], l2[1], l2[2], l2[3], h2[0], h2[1], h2[2], h2[3]}, o[d0], 0, 0, 0); \
        o[d0] = __builtin_amdgcn_mfma_f32_32x32x16_bf16(pa3, (bf16x8){l3[0], l3[1], l3[2], l3[3], h3[0], h3[1], h3[2], h3[3]}, o[d0], 0, 0, 0); } while (0)
    PV_D0(0); PV_D0(1); PV_D0(2); PV_D0(3);
#undef PV_D0
#undef TRRD
}

__device__ __forceinline__ float rstd_v(const float* VSS, int row) { const GAS f32x4* p = (const GAS f32x4*)(VSS + (size_t)row * 32); f32x4 s = p[0];
#pragma unroll
    for (int k = 1; k < 8; ++k) s += p[k];
    return rsqrtf(((s.x + s.y) + (s.z + s.w)) * (1.0f / DG) + EPS); }
__device__ __forceinline__ void p4_sgu(const Ctx& C, int idx, int nblk) {
    unsigned char* ws = C.ws; const int tid = C.tid, lane = C.lane, wave = C.wave, r32 = lane & 31, hi = lane >> 5;
    const bf16* U = (const bf16*)(ws + WS_U); const bf16* VG = (const bf16*)(ws + WS_VG); const float* VSS = (const float*)(ws + WS_VSS);
    const bf16* WMB = (const bf16*)(ws + WS_WMB); bf16* OA = (bf16*)(ws + WS_OA);
    const float* gs = C.in[IN_GSGU]; const float* bs = C.in[IN_BSGU];
    LAS unsigned char* Vl = C.lds + RING_OFF;
    for (int unit = idx; unit < 256; unit += nblk) {
        const int n = unit >> 2, gp = unit & 3, rowbase = n * 128; const bool last = (n & 31) == 31; const int bb = n >> 5;
        __syncthreads();
        { const int sr = tid >> 4, sc = (tid & 15) * 8;
#pragma unroll
          for (int gl = 0; gl < 2; ++gl) { const int g = gp * 2 + gl; float gg[8];
#pragma unroll
              for (int k = 0; k < 8; ++k) gg[k] = gs[g * 128 + sc + k];
#pragma unroll
              for (int q = 0; q < 4; ++q) { const int s = q * 32 + sr, st = s >> 6, row = rowbase + s; float f[8];
                  unpack8(*(const GAS v4u*)(VG + (size_t)row * DG + g * 128 + sc), f); const float rs = rstd_v(VSS, row);
#pragma unroll
                  for (int k = 0; k < 8; ++k) f[k] = f[k] * rs * gg[k];
                  *(LAS v4u*)(Vl + (gl * 2 + st) * 16384 + v_st(s & 63, sc)) = pack8f(f);
                  if (last) { float* o = C.out + O_PSGU + ((size_t)bb * 128 + s) * DG + g * 128 + sc; *(GAS f32x4*)o = (f32x4){f[0], f[1], f[2], f[3]}; *(GAS f32x4*)(o + 4) = (f32x4){f[4], f[5], f[6], f[7]}; } } } }
        __syncthreads();
        const int tb = wave & 3, gl = wave >> 2, g = gp * 2 + gl;
        f32x16 o[4];
#pragma unroll
        for (int d0 = 0; d0 < 4; ++d0)
#pragma unroll
            for (int r = 0; r < 16; ++r) o[d0][r] = 0.f;
#pragma unroll
        for (int st = 0; st < 2; ++st) if (64 * st <= 32 * tb + 31) {
            const bf16* wp = WMB + ((size_t)g * 128 + tb * 32 + r32) * 128 + st * 64 + hi * 8;
            const bf16x8 pa0 = *(const GAS bf16x8*)(wp), pa1 = *(const GAS bf16x8*)(wp + 16), pa2 = *(const GAS bf16x8*)(wp + 32), pa3 = *(const GAS bf16x8*)(wp + 48);
            const int vb0 = (int)(unsigned)(uintptr_t)(Vl + (gl * 2 + st) * 16384) + v_rd_base(lane);
            pv_tile(o, vb0, pa0, pa1, pa2, pa3);
        }
#pragma unroll
        for (int r = 0; r < 16; ++r) { const int trow = tb * 32 + crow(r, hi); const float bv = bs[g * 128 + trow]; const size_t ro = (size_t)(rowbase + trow) * DG + g * 128, roa = (size_t)(rowbase + trow) * LD1 + g * 128;
#pragma unroll
            for (int d0 = 0; d0 < 4; ++d0) { const int c = d0 * 32 + r32; const float v = (o[d0][r] + bv) * bf2f(U[ro + c]); const float vn = __shfl_xor(v, 1);
                if ((r32 & 1) == 0) *(GAS unsigned*)(OA + tm_idx(rowbase + trow, g * 128 + c, DG / 64)) = pk2(v, vn); } }
    }
    { const int gt = idx * 512 + tid, NT = nblk * 512; const float* w = C.in[IN_WSGU];
      for (int i = gt; i < MSAMP * DG / 8; i += NT) { const int r = i >> 7, c = (i & 127) * 8, row = MPROMPT + r, g = c >> 7; float f[8], uu[8];
          unpack8(*(const GAS v4u*)(VG + (size_t)row * DG + c), f); unpack8(*(const GAS v4u*)(U + (size_t)row * DG + c), uu); const float rs = rstd_v(VSS, row), w00 = w[g * 16384], b0 = bs[g * 128];
#pragma unroll
          for (int k = 0; k < 8; ++k) { f[k] = f[k] * rs * gs[c + k]; uu[k] = uu[k] * (w00 * f[k] + b0); }
          float* o = C.out + O_SSGU + (size_t)r * DG + c; *(GAS f32x4*)o = (f32x4){f[0], f[1], f[2], f[3]}; *(GAS f32x4*)(o + 4) = (f32x4){f[4], f[5], f[6], f[7]};
          *(GAS v4u*)((bf16*)(ws + WS_SOA) + (size_t)r * LDS_G + c) = pack8f(uu); } }
}

struct AttItem { const bf16* q; int t; int ncmp; const bf16* kc; const bf16* vc; int nblk; const float* gates; bf16* out; const float* blut; };

__device__ __forceinline__ void ld8f(const float* p, float (&f)[8]) { const f32x4 a = *(const GAS f32x4*)p, b = *(const GAS f32x4*)(p + 4); f[0] = a.x; f[1] = a.y; f[2] = a.z; f[3] = a.w; f[4] = b.x; f[5] = b.y; f[6] = b.z; f[7] = b.w; }
struct PromptKV {
    const bf16 *ks, *vs, *kw, *vw;
    static constexpr bool NORM = false;
    __device__ __forceinline__ void selK(int pos, int d8, float (&k)[8]) const { unpack8(*(const GAS v4u*)(ks + (size_t)pos * 128 + d8), k); }
    __device__ __forceinline__ void selV(int pos, int d8, float (&k)[8]) const { unpack8(*(const GAS v4u*)(vs + (size_t)pos * 128 + d8), k); }
    __device__ __forceinline__ void winK(int pos, int d8, float (&k)[8]) const { unpack8(*(const GAS v4u*)(kw + (size_t)pos * 128 + d8), k); }
    __device__ __forceinline__ void winV(int pos, int d8, float (&k)[8]) const { unpack8(*(const GAS v4u*)(vw + (size_t)pos * 128 + d8), k); }
};
struct SampleKV {
    const float* csel; const int* pt; const float* nsel; const float* win; const float* nwin;
    static constexpr bool NORM = true;
    __device__ __forceinline__ const float* selp(int pos) const { return pos < PASTLEN ? csel + ((size_t)pt[pos >> 7] * 128 + (pos & 127)) * 512 : nsel; }
    __device__ __forceinline__ const float* winp(int pos) const { return pos < PASTLEN ? win + (size_t)(pos - (PASTLEN - 512)) * 512 : nwin; }
    __device__ __forceinline__ void selK(int pos, int d8, float (&k)[8]) const { ld8f(selp(pos) + d8, k); }
    __device__ __forceinline__ void selV(int pos, int d8, float (&k)[8]) const { ld8f(selp(pos) + 256 + d8, k); }
    __device__ __forceinline__ void winK(int pos, int d8, float (&k)[8]) const { ld8f(winp(pos) + d8, k); }
    __device__ __forceinline__ void winV(int pos, int d8, float (&k)[8]) const { ld8f(winp(pos) + 256 + d8, k); }
};
#define DPP_ADD(x, ctrl) ((x) + __int_as_float(__builtin_amdgcn_update_dpp(0, __float_as_int(x), (ctrl), 0xF, 0xF, true)))
__device__ __forceinline__ float row_sum16(float x) { x = DPP_ADD(x, 0xB1); x = DPP_ADD(x, 0x4E); x = DPP_ADD(x, 0x141); x = DPP_ADD(x, 0x140); return x; }
template <bool NORM>
__device__ __forceinline__ void score4(const float (&k)[8], const float (&gkv)[8], const float (&q)[4][8], float (&s)[4]) {
    float kk[8]; float ss = 0.f;
#pragma unroll
    for (int i = 0; i < 8; ++i) { if (NORM) { ss += k[i] * k[i]; kk[i] = k[i] * gkv[i]; } else kk[i] = k[i]; }
#pragma unroll
    for (int h = 0; h < 4; ++h) { float a = 0.f;
#pragma unroll
        for (int i = 0; i < 8; ++i) a += q[h][i] * kk[i];
        s[h] = row_sum16(a); }
    if (NORM) { ss = row_sum16(ss); const float rs = rsqrtf(ss * (1.0f / 128) + EPS);
#pragma unroll
        for (int h = 0; h < 4; ++h) s[h] *= rs; }
}
__device__ __forceinline__ void online4(const float (&s)[4], bool valid, float (&m)[4], float (&l)[4], float (&o)[4][8], const float (&v)[8]) {
#pragma unroll
    for (int h = 0; h < 4; ++h) { const float sv = valid ? s[h] : -__builtin_inff(); const float mn = fmaxf(m[h], sv);
        const float al = __builtin_amdgcn_exp2f(m[h] - mn), p = __builtin_amdgcn_exp2f(sv - mn); m[h] = mn; l[h] = l[h] * al + p;
#pragma unroll
        for (int i = 0; i < 8; ++i) o[h][i] = o[h][i] * al + p * v[i]; }
}
__device__ __forceinline__ void merge_store(float (&m)[4], float (&l)[4], float (&o)[4][8], LAS float* Cmb, int wave, int lane) {
#pragma unroll
    for (int h = 0; h < 4; ++h) { float M = fmaxf(m[h], __shfl_xor(m[h], 16)); M = fmaxf(M, __shfl_xor(M, 32));
        const float sc = __builtin_amdgcn_exp2f(m[h] - M); float ll = l[h] * sc; ll += __shfl_xor(ll, 16); ll += __shfl_xor(ll, 32);
        LAS float* dst = Cmb + (wave * 4 + h) * 132;
#pragma unroll
        for (int i = 0; i < 8; ++i) { float x = o[h][i] * sc; x += __shfl_xor(x, 16); x += __shfl_xor(x, 32); if (lane < 16) dst[lane * 8 + i] = x; }
        if (lane == 0) { dst[128] = M; dst[129] = ll; } }
}
__device__ __forceinline__ float combine8(const LAS float* Cmb, int hh, int dd) {
    float M = -1e30f;
#pragma unroll
    for (int w = 0; w < 8; ++w) M = fmaxf(M, Cmb[(w * 4 + hh) * 132 + 128]);
    float L = 0.f, O = 0.f;
#pragma unroll
    for (int w = 0; w < 8; ++w) { const LAS float* p = Cmb + (w * 4 + hh) * 132; const float sc = __builtin_amdgcn_exp2f(p[128] - M); L += p[129] * sc; O += p[dd] * sc; }
    return L > 0.f ? O / L : 0.f;
}

template <class KV, bool WIN>
__device__ __forceinline__ void nsa_stream(const KV& kv, int total, int wave, int grp, int d8, int t, int wlo, const LAS int* sl, const float (&gkv)[8], const float (&q)[4][8],
                                           const float* blut, float (&m)[4], float (&l)[4], float (&o)[4][8]) {
    const int nper = total > wave ? (total - wave + 7) >> 3 : 0;
    float kA[2][8], vA[2][8], kB[2][8], vB[2][8]; int ppA[2], ppB[2]; bool okA[2], okB[2];
#define NS_LOAD(K_, V_, PP_, OK_, i0_) do { _Pragma("unroll") for (int u = 0; u < 2; ++u) { const int ch = wave + 8 * ((i0_) + u); const bool in = (i0_) + u < nper; \
            int pos; if (WIN) pos = wlo + ch * 4 + grp; else pos = sl[in ? (ch >> 4) : 0] * 64 + (ch & 15) * 4 + grp; \
            OK_[u] = in && pos <= t; PP_[u] = OK_[u] ? pos : t; \
            if (WIN) { kv.winK(PP_[u], d8, K_[u]); kv.winV(PP_[u], d8, V_[u]); } else { kv.selK(PP_[u], d8, K_[u]); kv.selV(PP_[u], d8, V_[u]); } } } while (0)
#define NS_COMP(K_, V_, PP_, OK_, i0_) do { _Pragma("unroll") for (int u = 0; u < 2; ++u) if ((i0_) + u < nper) { float sc[4]; score4<KV::NORM>(K_[u], gkv, q, sc); \
            const int rel = t - PP_[u]; const int ri = rel > 128 ? 128 : rel; \
            _Pragma("unroll") for (int h = 0; h < 4; ++h) sc[h] += blut[h * 132 + ri]; \
            online4(sc, OK_[u], m, l, o, V_[u]); } } while (0)
    if (nper > 0) NS_LOAD(kA, vA, ppA, okA, 0);
    for (int i0 = 0; i0 < nper; i0 += 4) {
        if (i0 + 2 < nper) NS_LOAD(kB, vB, ppB, okB, i0 + 2);
        NS_COMP(kA, vA, ppA, okA, i0);
        if (i0 + 4 < nper) NS_LOAD(kA, vA, ppA, okA, i0 + 4);
        if (i0 + 2 < nper) NS_COMP(kB, vB, ppB, okB, i0 + 2);
    }
#undef NS_LOAD
#undef NS_COMP
}

template <class KV>
__device__ __forceinline__ void nsa_item(const Ctx& C, const AttItem& it, const KV& kv, const float* gk1, const float* gk2) {
    const int tid = C.tid, lane = C.lane, wave = C.wave, grp = lane >> 4, d8 = (lane & 15) * 8, t = it.t;
    LAS float* Sc = (LAS float*)(C.lds + RING_OFF);
    LAS float* Cmb = (LAS float*)(C.lds + RING_OFF + 4096);
    LAS int* sl = (LAS int*)(C.lds + RING_OFF + 4096 + 16896);
    const float NEG = -__builtin_inff();
    float q[4][8];
#pragma unroll
    for (int h = 0; h < 4; ++h) unpack8(*(const GAS v4u*)(it.q + h * 128 + d8), q[h]);
    const int hh = tid >> 7, dd = tid & 127;
    const float g0 = it.gates[hh * 3 + 0], g1 = it.gates[hh * 3 + 1], g2 = it.gates[hh * 3 + 2];
    float res = 0.f;
    float m[4], l[4], o[4][8], gkv[8];
#pragma unroll
    for (int i = 0; i < 8; ++i) gkv[i] = 1.f;

    int nvis = t >= 31 ? (t - 31) / 16 + 1 : 0; if (nvis > it.ncmp) nvis = it.ncmp;
    const int nch = (nvis + 3) >> 2;
    for (int ch = wave; ch < 64; ch += 8) {
        const int c = ch * 4 + grp; float s[4] = {NEG, NEG, NEG, NEG};
        if (ch < nch) {
            const bool valid = c < nvis; const int cc = valid ? c : 0; float k[8]; unpack8(*(const GAS v4u*)(it.kc + (size_t)cc * 128 + d8), k);
            float sc[4]; score4<false>(k, gkv, q, sc);
            const int rel = t - (16 * c + 31); const int ri = rel < 0 ? 0 : (rel > 128 ? 128 : rel);
#pragma unroll
            for (int h = 0; h < 4; ++h) s[h] = valid ? sc[h] + it.blut[h * 132 + ri] : NEG;
        }
        if ((lane & 15) == 0) {
#pragma unroll
            for (int h = 0; h < 4; ++h) Sc[h * 256 + c] = s[h]; }
    }
    __syncthreads();
    float mh[4], il[4];
#pragma unroll
    for (int h = 0; h < 4; ++h) { const f32x4 v = *(const LAS f32x4*)(Sc + h * 256 + lane * 4); float mx = fmaxf(fmaxf(v.x, v.y), fmaxf(v.z, v.w)); mx = fmaxf(wave_max(mx), -1e30f);
        float e = (__builtin_amdgcn_exp2f(v.x - mx) + __builtin_amdgcn_exp2f(v.y - mx)) + (__builtin_amdgcn_exp2f(v.z - mx) + __builtin_amdgcn_exp2f(v.w - mx)); e = wave_sum(e);
        mh[h] = mx; il[h] = e > 0.f ? 1.0f / e : 0.f; }
    float imp = 0.f;
#pragma unroll
    for (int h = 0; h < 4; ++h) { float a = 0.f;
#pragma unroll
        for (int k = 0; k < 5; ++k) { const int c = 4 * lane - 1 + k; if (c >= 0) a += __builtin_amdgcn_exp2f(Sc[h * 256 + c] - mh[h]); }
        imp += a * il[h]; }
    unsigned long long mask;
    { const int j = lane, cur = t >> 6; const bool forced = (j == 0) || (j == cur) || (j == cur - 1), elig = 64 * j <= t, exists = j < it.nblk;
      const float val = exists ? (forced ? 1e6f : (elig ? imp : -1.f)) : -2.f; int rank = 0;
      const int key = (int)((__float_as_uint(val) & ~63u) | (unsigned)(63 - j));
#pragma unroll
      for (int jp = 0; jp < 64; ++jp) rank += (__builtin_amdgcn_readlane(key, jp) > key) ? 1 : 0;
      const bool sel_ = rank < 16 && elig && exists; mask = __ballot(sel_);
      if (wave == 0 && sel_) sl[__builtin_popcountll(mask & ((1ull << j) - 1ull))] = j; }
#pragma unroll
    for (int h = 0; h < 4; ++h) { m[h] = mh[h]; l[h] = 0.f;
#pragma unroll
        for (int i = 0; i < 8; ++i) o[h][i] = 0.f; }
    for (int ch = wave; ch < nch; ch += 8) {
        const int c = ch * 4 + grp; const bool valid = c < nvis; const int cc = valid ? c : 0; float v[8]; unpack8(*(const GAS v4u*)(it.vc + (size_t)cc * 128 + d8), v);
#pragma unroll
        for (int h = 0; h < 4; ++h) { const float p = valid ? __builtin_amdgcn_exp2f(Sc[h * 256 + cc] - mh[h]) : 0.f; l[h] += p;
#pragma unroll
            for (int i = 0; i < 8; ++i) o[h][i] += p * v[i]; }
    }
    merge_store(m, l, o, Cmb, wave, lane);
    __syncthreads();
    res += g0 * combine8(Cmb, hh, dd);
    __syncthreads();

#pragma unroll
    for (int h = 0; h < 4; ++h) { m[h] = -1e30f; l[h] = 0.f;
#pragma unroll
        for (int i = 0; i < 8; ++i) o[h][i] = 0.f; }
    if (KV::NORM) {
#pragma unroll
        for (int i = 0; i < 8; ++i) gkv[i] = gk1[d8 + i]; }
    nsa_stream<KV, false>(kv, __builtin_popcountll(mask) * 16, wave, grp, d8, t, 0, sl, gkv, q, it.blut, m, l, o);
    merge_store(m, l, o, Cmb, wave, lane);
    __syncthreads();
    res += g1 * combine8(Cmb, hh, dd);
    __syncthreads();

#pragma unroll
    for (int h = 0; h < 4; ++h) { m[h] = -1e30f; l[h] = 0.f;
#pragma unroll
        for (int i = 0; i < 8; ++i) o[h][i] = 0.f; }
    if (KV::NORM) {
#pragma unroll
        for (int i = 0; i < 8; ++i) gkv[i] = gk2[d8 + i]; }
    const int wlo = t - 511 < 0 ? 0 : t - 511, nchw = (t - wlo + 4) >> 2;
    nsa_stream<KV, true>(kv, nchw, wave, grp, d8, t, wlo, sl, gkv, q, it.blut, m, l, o);
    merge_store(m, l, o, Cmb, wave, lane);
    __syncthreads();
    res += g2 * combine8(Cmb, hh, dd);
    it.out[hh * 128 + dd] = (bf16)f2bf(res);
    __syncthreads();
}


#define KSWZ(row, colB) ((row) * 256 + ((colB) ^ (((row) & 7) << 4)))
constexpr int AT_V = 0, AT_K = 32768, AT_PC = 65536, AT_X = 131584, AT_BLUT = AT_X, AT_SELM = AT_X + 2176, AT_WS = AT_SELM + 512;
static_assert(AT_WS + 8 * 256 + 64 <= LDS_BYTES && AT_X >= MISC_OFF + 128 && AT_PC + 64 * 256 * 4 <= LDSCTL_OFF, "attention LDS map");

__device__ __forceinline__ unsigned cvtpk(float lo, float hi) { unsigned r; asm volatile("v_cvt_pk_bf16_f32 %0, %1, %2" : "=v"(r) : "v"(lo), "v"(hi)); return r; }
__device__ __forceinline__ float swap_max(float x) { auto rr = __builtin_amdgcn_permlane32_swap(__float_as_uint(x), __float_as_uint(x), false, false); return fmaxf(__uint_as_float(rr[0]), __uint_as_float(rr[1])); }
__device__ __forceinline__ float swap_add(float x) { auto rr = __builtin_amdgcn_permlane32_swap(__float_as_uint(x), __float_as_uint(x), false, false); return __uint_as_float(rr[0]) + __uint_as_float(rr[1]); }
__device__ __forceinline__ float quad_sum(float x) {
    x += __int_as_float(__builtin_amdgcn_update_dpp(0, __float_as_int(x), 0xB1, 0xF, 0xF, true));
    x += __int_as_float(__builtin_amdgcn_update_dpp(0, __float_as_int(x), 0x4E, 0xF, 0xF, true));
    return x;
}
__device__ __forceinline__ void qkt_tile(f32x16& p0, f32x16& p1, const LAS unsigned char* Kt, int r32, int hi, const bf16x8 (&qr)[8]) {
#pragma unroll
    for (int r = 0; r < 16; ++r) { p0[r] = 0.f; p1[r] = 0.f; }
    const LAS unsigned char* kb[4];
#pragma unroll
    for (int dd = 0; dd < 4; ++dd) kb[dd] = Kt + KSWZ(r32, (dd * 16 + hi * 8) * 2);
#pragma unroll
    for (int d0 = 0; d0 < 8; ++d0) { const LAS unsigned char* a = kb[d0 & 3] + (d0 >> 2) * 128;
        const bf16x8 b0 = *(const LAS bf16x8*)a, b1 = *(const LAS bf16x8*)(a + 32 * 256);
        p0 = __builtin_amdgcn_mfma_f32_32x32x16_bf16(b0, qr[d0], p0, 0, 0, 0);
        p1 = __builtin_amdgcn_mfma_f32_32x32x16_bf16(b1, qr[d0], p1, 0, 0, 0); }
}
template <int MODE>
__device__ __forceinline__ void fix_tile(f32x16& p0, f32x16& p1, int tile, int tq, int tmin, int head, int hi, bool bit, const LAS float* lut) {
    const float NEG = -__builtin_inff(); const float c31 = lut[head * 132 + 128];
    bool fast;
    if (MODE == 0) fast = tmin - 16 * (64 * tile + 63) - 31 >= 128;
    else if (MODE == 2) fast = tmin - (64 * tile + 63) >= 128;
    else fast = (tmin - (64 * tile + 63) >= 128) && (tmin + 7 - 64 * tile < 512);
    if (fast) {
        if (MODE == 2) {
#pragma unroll
            for (int r = 0; r < 16; ++r) { p0[r] = bit ? p0[r] + c31 : NEG; p1[r] = bit ? p1[r] + c31 : NEG; }
        } else {
#pragma unroll
            for (int r = 0; r < 16; ++r) { p0[r] += c31; p1[r] += c31; }
        }
        return;
    }
    const LAS float* lh = lut + head * 132;
#pragma unroll
    for (int hf = 0; hf < 2; ++hf)
#pragma unroll
        for (int r = 0; r < 16; ++r) { const int cr = (r & 3) + 8 * (r >> 2); int rel;
            if (MODE == 0) rel = tq - 31 - 16 * (64 * tile + 32 * hf + 4 * hi + cr); else rel = tq - (64 * tile + 32 * hf + 4 * hi + cr);
            bool valid;
            if (MODE == 0) valid = rel >= 0; else if (MODE == 2) valid = rel >= 0 && bit; else valid = (unsigned)rel < 512u;
            const int ri = rel < 0 ? 0 : (rel > 128 ? 128 : rel); const float bv = lh[ri];
            if (hf == 0) p0[r] = valid ? p0[r] + bv : NEG; else p1[r] = valid ? p1[r] + bv : NEG; }
}
__device__ __forceinline__ void softmax_tile(f32x16& p0, f32x16& p1, float& m_reg, float& l_reg, float& alpha, bf16x8& pa0, bf16x8& pa1, bf16x8& pa2, bf16x8& pa3) {
    float pmax = p0[0];
#pragma unroll
    for (int r = 1; r < 16; ++r) pmax = fmaxf(pmax, p0[r]);
#pragma unroll
    for (int r = 0; r < 16; ++r) pmax = fmaxf(pmax, p1[r]);
    pmax = swap_max(pmax);
    const float mn = fmaxf(m_reg, pmax); alpha = __builtin_amdgcn_exp2f(m_reg - mn); m_reg = mn;
    float ps = 0.f;
#pragma unroll
    for (int r = 0; r < 16; ++r) { p0[r] = __builtin_amdgcn_exp2f(p0[r] - mn); p1[r] = __builtin_amdgcn_exp2f(p1[r] - mn); ps += p0[r] + p1[r]; }
    ps = swap_add(ps); l_reg = l_reg * alpha + ps;
#define PK4(P, B_, OUT) do { unsigned a0 = cvtpk(P[B_+0], P[B_+1]), a1 = cvtpk(P[B_+2], P[B_+3]); unsigned b0 = cvtpk(P[B_+4], P[B_+5]), b1 = cvtpk(P[B_+6], P[B_+7]); \
        auto r0 = __builtin_amdgcn_permlane32_swap(a0, b0, false, false); auto r1 = __builtin_amdgcn_permlane32_swap(a1, b1, false, false); \
        v4u w = {r0[0], r1[0], r0[1], r1[1]}; OUT = __builtin_bit_cast(bf16x8, w); } while (0)
    PK4(p0, 0, pa0); PK4(p0, 8, pa1); PK4(p1, 0, pa2); PK4(p1, 8, pa3);
#undef PK4
}

struct FlashSt {
    bf16x8 qr[8];
    int tq, tmin, head;
};
template <int MODE, bool PASS2, int ACC>
__device__ __forceinline__ void flash_branch(const Ctx& C, FlashSt& S, const bf16* Kb, const bf16* Vb, int j_lo, int j_hi, float gate, unsigned long long mymask, unsigned long long wor,
                                             float& m_reg, float& l_reg, float* OT, bf16* OBrow) {
    const int tid = C.tid, lane = C.lane, wave = C.wave, r32 = lane & 31, hi = lane >> 5;
    LAS unsigned char* Vl = C.lds + AT_V; LAS unsigned char* Kl = C.lds + AT_K; LAS float* Pc = (LAS float*)(C.lds + AT_PC);
    const LAS float* lut = (const LAS float*)(C.lds + AT_BLUT); LAS float* wsl = (LAS float*)(C.lds + AT_WS) + wave * 64;
    const int vb0 = (int)(unsigned)(uintptr_t)Vl + v_rd_base(lane);
    f32x16 o[4];
    if (!PASS2) {
#pragma unroll
        for (int d0 = 0; d0 < 4; ++d0)
#pragma unroll
            for (int r = 0; r < 16; ++r) o[d0][r] = 0.f;
        m_reg = -1e30f; l_reg = 0.f; }
    const float inv_l = PASS2 ? (l_reg > 0.f ? 1.0f / l_reg : 0.f) : 0.f;
    const int n = j_hi - j_lo;
    const int lrow = wave * 4 + (lane >> 4);
    const unsigned ksrc = (unsigned)(lrow * 256 + ((((lane & 15) << 4)) ^ ((lrow & 7) << 4)));
    const int vkk = (((wave * 2 + (lane >> 5)) >> 2) << 3) + ((lane & 31) >> 2);
    const int vk = (vkk & ~0xC) | ((vkk & 4) << 1) | ((vkk & 8) >> 1);
    const unsigned vsrc = (unsigned)(vk * 256 + ((((wave * 2 + (lane >> 5)) & 3) * 32 + (lane & 3) * 8) * 2));
#define ST_DMA(tile, bf) do { const char* kp = (const char*)(Kb + (size_t)(tile) * 64 * 128) + ksrc; \
        __builtin_amdgcn_global_load_lds((const unsigned*)kp, (LAS unsigned*)(Kl + (bf) * 16384 + wave * 1024), 16, 0, 0); \
        __builtin_amdgcn_global_load_lds((const unsigned*)(kp + 8192), (LAS unsigned*)(Kl + (bf) * 16384 + 8192 + wave * 1024), 16, 0, 0); \
        if (!PASS2) { const char* vp = (const char*)(Vb + (size_t)(tile) * 64 * 128) + vsrc; \
            __builtin_amdgcn_global_load_lds((const unsigned*)vp, (LAS unsigned*)(Vl + (bf) * 16384 + wave * 1024), 16, 0, 0); \
            __builtin_amdgcn_global_load_lds((const unsigned*)(vp + 8192), (LAS unsigned*)(Vl + (bf) * 16384 + 8192 + wave * 1024), 16, 0, 0); } } while (0)
    if (n > 0) ST_DMA(j_lo, 0);
    asm volatile("s_waitcnt vmcnt(0)" ::: "memory");
    __syncthreads();
    for (int i = 0; i < n; ++i) {
        const int tile = j_lo + i, buf = i & 1;
        if (i + 1 < n) ST_DMA(tile + 1, buf ^ 1);
        bool act;
        if (PASS2) act = true; else if (MODE == 0) act = 16 * (64 * tile) + 31 <= S.tmin + 7; else if (MODE == 2) act = (wor >> tile) & 1ull; else act = true;
        if (act) {
            f32x16 p0, p1; qkt_tile(p0, p1, Kl + buf * 16384, r32, hi, S.qr);
            const bool bit = MODE == 2 ? ((mymask >> tile) & 1ull) != 0ull : true;
            fix_tile<MODE>(p0, p1, tile, S.tq, S.tmin, S.head, hi, bit, lut);
            if (PASS2) {
#pragma unroll
                for (int r = 0; r < 16; ++r) { p0[r] = quad_sum(__builtin_amdgcn_exp2f(p0[r] - m_reg) * inv_l); p1[r] = quad_sum(__builtin_amdgcn_exp2f(p1[r] - m_reg) * inv_l); }
                if ((r32 & 3) == 0) { LAS float* pr = Pc + (wave * 8 + (r32 >> 2)) * 256 + tile * 64 + 4 * hi;
#pragma unroll
                    for (int r = 0; r < 16; ++r) { const int cr = (r & 3) + 8 * (r >> 2); pr[cr] = p0[r]; pr[32 + cr] = p1[r]; } }
            } else {
                float alpha; bf16x8 pa0, pa1, pa2, pa3;
                softmax_tile(p0, p1, m_reg, l_reg, alpha, pa0, pa1, pa2, pa3);
                if (__any(alpha < 1.f)) { if (hi == 0) wsl[r32] = alpha; asm volatile("s_waitcnt lgkmcnt(0)" ::: "memory"); const LAS float* wh = wsl + 4 * hi;
#pragma unroll
                    for (int r = 0; r < 16; ++r) { const float a = wh[(r & 3) + 8 * (r >> 2)];
#pragma unroll
                        for (int d0 = 0; d0 < 4; ++d0) o[d0][r] *= a; }
                    asm volatile("s_waitcnt lgkmcnt(0)" ::: "memory"); }
                pv_tile(o, vb0 + buf * 16384, pa0, pa1, pa2, pa3);
            }
        }
        asm volatile("s_waitcnt vmcnt(0)" ::: "memory");
        __syncthreads();
    }
#undef ST_DMA
    if (!PASS2) {
        const float scl = l_reg > 0.f ? gate / l_reg : 0.f;
        if (hi == 0) wsl[32 + r32] = scl; asm volatile("s_waitcnt lgkmcnt(0)" ::: "memory");
        const LAS float* wh = wsl + 32 + 4 * hi; GAS float* otl = (GAS float*)OT + (size_t)(4 * hi) * 128 + r32; GAS bf16* obl = (GAS bf16*)OBrow + (size_t)hi * 64 + r32;
        asm volatile("" : "+v"(otl), "+v"(obl));
#pragma unroll
        for (int r = 0; r < 16; ++r) { const int cr = (r & 3) + 8 * (r >> 2); const float a = wh[cr];
#pragma unroll
            for (int d0 = 0; d0 < 4; ++d0) { float v = o[d0][r] * a; if (ACC > 0) v += otl[cr * 128 + d0 * 32];
                if (ACC < 2) otl[cr * 128 + d0 * 32] = v;
                else { const float vn = __shfl_xor(v, 1); if ((r32 & 1) == 0) *(GAS unsigned*)(obl + ((r & 3) * 2 + (d0 >> 1)) * 16384 + (2 * (r >> 2)) * 64 + (d0 & 1) * 32) = cvtpk(v, vn); } } }
        asm volatile("s_waitcnt lgkmcnt(0)" ::: "memory");
    }
}

__device__ __forceinline__ void flash_unit(const Ctx& C, int b, int g, int qb) {
    unsigned char* ws = C.ws; const int tid = C.tid, lane = C.lane, wave = C.wave, r32 = lane & 31, hi = lane >> 5, t0 = qb * 64;
    LAS float* lut = (LAS float*)(C.lds + AT_BLUT); LAS float* Pc = (LAS float*)(C.lds + AT_PC); LAS unsigned long long* selm = (LAS unsigned long long*)(C.lds + AT_SELM);
    const float* BL = (const float*)(ws + WS_BLUT) + g * 4 * 132;
    for (int i = tid; i < 4 * 132; i += NWAVES * 64) lut[i] = BL[i];
    FlashSt S; S.tmin = t0 + wave * 8; S.tq = S.tmin + (r32 >> 2); S.head = r32 & 3;
    const int row = b * T + S.tq;
    { const bf16* qp = (const bf16*)(ws + WS_QN) + (size_t)row * DQ + (g * 4 + S.head) * 128 + hi * 8;
#pragma unroll
      for (int d0 = 0; d0 < 8; ++d0) S.qr[d0] = *(const GAS bf16x8*)(qp + d0 * 16); }
    const float* gn = (const float*)(ws + WS_GN) + (size_t)row * 32 + (g * 4 + S.head) * 3; const float gc = gn[0], gsel = gn[1], gw = gn[2];
    const size_t kvb = (size_t)(b * 2 + g) * T * 128, cb = (size_t)(b * 2 + g) * 256 * 128;
    const int cmax = (t0 + 63 - 31) >> 4;
    const int nct = (cmax >> 6) + 1;
    float m_c, l_c;
    float* OT = (float*)(ws + WS_OT) + ((size_t)blockIdx.x * 8 + wave) * 32 * 128;
    bf16* OBrow = (bf16*)(ws + WS_OB) + tm_idx(b * T + S.tmin, g * 512, DQ / 64);
    flash_branch<0, false, 0>(C, S, (const bf16*)(ws + WS_KCP) + cb, (const bf16*)(ws + WS_VCP) + cb, 0, nct, gc, 0ull, 0ull, m_c, l_c, OT, OBrow);
    flash_branch<0, true, 0>(C, S, (const bf16*)(ws + WS_KCP) + cb, nullptr, 0, nct, 0.f, 0ull, 0ull, m_c, l_c, OT, OBrow);
    unsigned long long wor = 0ull;
    { asm volatile("s_waitcnt lgkmcnt(0)" ::: "memory");
      const int ncomp = nct * 64;
#pragma unroll 1
      for (int qi = 0; qi < 8; ++qi) { const int ql = wave * 8 + qi, t = t0 + ql; const LAS float* pr = Pc + ql * 256; float imp = 0.f;
#pragma unroll
          for (int k = 0; k < 5; ++k) { const int c = 4 * lane - 1 + k; if (c >= 0 && c < ncomp) imp += pr[c]; }
          const int j = lane, cur = t >> 6; const bool forced = (j == 0) || (j == cur) || (j == cur - 1), elig = 64 * j <= t;
          const float val = forced ? 1e6f : (elig ? imp : -1.f); int rank = 0;
          const int key = (int)((__float_as_uint(val) & ~63u) | (unsigned)(63 - j));
#pragma unroll
          for (int jp = 0; jp < 64; ++jp) rank += (__builtin_amdgcn_readlane(key, jp) > key) ? 1 : 0;
          const unsigned long long mk = __ballot(rank < 16 && elig); wor |= mk;
          if (lane == 0) selm[ql] = mk; }
      asm volatile("s_waitcnt lgkmcnt(0)" ::: "memory"); }
    const unsigned long long mymask = selm[wave * 8 + (r32 >> 2)];
    float m_s, l_s;
    flash_branch<2, false, 1>(C, S, (const bf16*)(ws + WS_KS) + kvb, (const bf16*)(ws + WS_VS) + kvb, 0, qb + 1, gsel, mymask, wor, m_s, l_s, OT, OBrow);
    flash_branch<3, false, 2>(C, S, (const bf16*)(ws + WS_KW) + kvb, (const bf16*)(ws + WS_VW) + kvb, qb >= 8 ? qb - 8 : 0, qb + 1, gw, 0ull, 0ull, m_s, l_s, OT, OBrow);
    __syncthreads();
}


template <bool SPLIT = false>
__device__ __forceinline__ void skinny_core(const Ctx& C, const bf16* A, int lda, const bf16* Bs, int kbeg, int Kw, float (&out)[8], float* out2 = nullptr) {
    const int lane = C.lane, wave = C.wave, r32 = lane & 31, hi = lane >> 5, tid = C.tid;
    f32x16 acc[4];
#pragma unroll
    for (int rb = 0; rb < 4; ++rb)
#pragma unroll
        for (int r = 0; r < 16; ++r) acc[rb][r] = 0.f;
    const GAS bf16* ap0 = (const GAS bf16*)A + (size_t)r32 * lda + kbeg + hi * 32;
    const GAS bf16* bp = (const GAS bf16*)Bs + (size_t)r32 * 64 + (size_t)(kbeg >> 6) * 16384 + hi * 32;
    const GAS bf16* ap1 = ap0 + (size_t)32 * lda; const GAS bf16* ap2 = ap0 + (size_t)64 * lda; const GAS bf16* ap3 = ap0 + (size_t)96 * lda;
    asm volatile("" : "+v"(ap0), "+v"(ap1), "+v"(ap2), "+v"(ap3), "+v"(bp));
    bf16x8 a0[4][2], b0[2], a1[4][2], b1[2];
#define SK_OFF(st) ((((st) >> 1) << 6) + (((st) & 1) << 4))
#define SK_LOAD(a, b, st) do { const int k_ = SK_OFF(st), kb_ = (((st) >> 1) << 14) + (((st) & 1) << 4); _Pragma("unroll") for (int j = 0; j < 2; ++j) b[j] = *(const GAS bf16x8*)(bp + kb_ + 8 * j); \
        _Pragma("unroll") for (int j = 0; j < 2; ++j) { a[0][j] = *(const GAS bf16x8*)(ap0 + k_ + 8 * j); a[1][j] = *(const GAS bf16x8*)(ap1 + k_ + 8 * j); a[2][j] = *(const GAS bf16x8*)(ap2 + k_ + 8 * j); a[3][j] = *(const GAS bf16x8*)(ap3 + k_ + 8 * j); } } while (0)
#define SK_MMA(a, b) do { _Pragma("unroll") for (int j = 0; j < 2; ++j) _Pragma("unroll") for (int rb = 0; rb < 4; ++rb) acc[rb] = __builtin_amdgcn_mfma_f32_32x32x16_bf16(a[rb][j], b[j], acc[rb], 0, 0, 0); } while (0)
    const int ns = Kw >> 5;
    SK_LOAD(a0, b0, 0);
    for (int st = 0; st < ns; st += 2) {
        if (st + 1 < ns) SK_LOAD(a1, b1, st + 1);
        SK_MMA(a0, b0);
        if (st + 2 < ns) SK_LOAD(a0, b0, st + 2);
        if (st + 1 < ns) SK_MMA(a1, b1);
    }
#undef SK_OFF
#undef SK_LOAD
#undef SK_MMA
    LAS float* Red = (LAS float*)(C.lds + RING_OFF);
    LAS float* wr_ = Red + (wave * 128 + 4 * hi) * 32 + r32;
#pragma unroll
    for (int rb = 0; rb < 4; ++rb)
#pragma unroll
        for (int r = 0; r < 16; ++r) wr_[(32 * rb + (r & 3) + 8 * (r >> 2)) * 32] = acc[rb][r];
    __syncthreads();
    const LAS float* rd = Red + (tid >> 2) * 32 + (tid & 3) * 8;
    f32x4 s0 = *(const LAS f32x4*)rd, s1 = *(const LAS f32x4*)(rd + 4);
#pragma unroll
    for (int w = 1; w < (SPLIT ? 4 : 8); ++w) { s0 += *(const LAS f32x4*)(rd + w * 4096); s1 += *(const LAS f32x4*)(rd + w * 4096 + 4); }
    out[0] = s0.x; out[1] = s0.y; out[2] = s0.z; out[3] = s0.w; out[4] = s1.x; out[5] = s1.y; out[6] = s1.z; out[7] = s1.w;
    if (SPLIT) { f32x4 t0 = *(const LAS f32x4*)(rd + 4 * 4096), t1 = *(const LAS f32x4*)(rd + 4 * 4096 + 4);
#pragma unroll
        for (int w = 5; w < 8; ++w) { t0 += *(const LAS f32x4*)(rd + w * 4096); t1 += *(const LAS f32x4*)(rd + w * 4096 + 4); }
        out2[0] = t0.x; out2[1] = t0.y; out2[2] = t0.z; out2[3] = t0.w; out2[4] = t1.x; out2[5] = t1.y; out2[6] = t1.z; out2[7] = t1.w; }
    __syncthreads();
}
__device__ __forceinline__ void st8f(float* p, const float (&v)[8]) { *(GAS f32x4*)p = (f32x4){v[0], v[1], v[2], v[3]}; *(GAS f32x4*)(p + 4) = (f32x4){v[4], v[5], v[6], v[7]}; }

__device__ __forceinline__ void s_in(const Ctx& C, int idx, int nblk) {
    unsigned char* ws = C.ws; const int tid = C.tid, row = tid >> 2, c8 = (tid & 3) * 8, rg = MPROMPT + row;
    const float rs = ((const float*)(ws + WS_RSTD1))[rg];
    for (int u = idx; u < 273; u += nblk) {
        float v[8]; skinny_core(C, (const bf16*)(ws + WS_SXB), LDS_X, (const bf16*)(ws + WS_WIN) + ((size_t)(u >> 3) * (DM / 64) * 256 + (u & 7) * 32) * 64, C.wave * 256, 256, v);
        const int n = u * 32 + c8;
#pragma unroll
        for (int k = 0; k < 8; ++k) v[k] *= rs;
        if (n < 2048) {
#pragma unroll
            for (int k = 0; k < 8; ++k) v[k] = gelu_tanh(v[k]);
            if (n < 1024) *(GAS v4u*)((bf16*)(ws + WS_U) + (size_t)rg * DG + n) = pack8f(v);
            else { *(GAS v4u*)((bf16*)(ws + WS_VG) + (size_t)rg * DG + n - 1024) = pack8f(v); float ss = 0.f;
#pragma unroll
                for (int k = 0; k < 8; ++k) ss += v[k] * v[k];
                ss += __shfl_xor(ss, 1); ss += __shfl_xor(ss, 2);
                if ((tid & 3) == 0) ((float*)(ws + WS_VSS))[(size_t)rg * 32 + (n - 1024) / 32] = ss; }
        } else if (n < 3072) st8f((float*)(ws + WS_QRAW) + (size_t)rg * DQ + n - 2048, v);
        else if (n < 3584) st8f(C.out + O_SCMP + (size_t)row * 512 + n - 3072, v);
        else if (n < 4096) st8f(C.out + O_SSEL + (size_t)row * 512 + n - 3584, v);
        else if (n < 4608) st8f((float*)(ws + WS_KVWR) + (size_t)rg * 512 + n - 4096, v);
        else if (n < 8704) {
#pragma unroll
            for (int k = 0; k < 8; ++k) v[k] = sigmoidf_(v[k]);
            if (n < 6656) *(GAS v4u*)((bf16*)(ws + WS_GA) + (size_t)rg * DM + n - 4608) = pack8f(v); else *(GAS v4u*)((bf16*)(ws + WS_GB) + (size_t)rg * DM + n - 6656) = pack8f(v);
        } else if (n < 8728) {
#pragma unroll
            for (int k = 0; k < 8; ++k) v[k] = sigmoidf_(v[k]);
            st8f((float*)(ws + WS_GN) + (size_t)rg * 32 + n - 8704, v); }
    }
}
__device__ __forceinline__ void s_proj(const Ctx& C) {
    unsigned char* ws = C.ws; const int tid = C.tid, row = tid >> 2, c8 = (tid & 3) * 8, rg = MPROMPT + row;
    for (int u = blockIdx.x; u < 64; u += C.G) {
        float a[8], b[8], ga[8], gb[8]; const int n = u * 32 + c8;
        { const bool pb = C.wave >= 4;
          skinny_core<true>(C, (const bf16*)(ws + (pb ? WS_SOB : WS_SOA)), LDS_G, (const bf16*)(ws + (pb ? WS_WN : WS_WG)) + ((size_t)(u >> 3) * (DG / 64) * 256 + (u & 7) * 32) * 64, (C.wave & 3) * 256, 256, a, b); }
        unpack8(*(const GAS v4u*)((const bf16*)(ws + WS_GA) + (size_t)rg * DM + n), ga); unpack8(*(const GAS v4u*)((const bf16*)(ws + WS_GB) + (size_t)rg * DM + n), gb);
#pragma unroll
        for (int k = 0; k < 8; ++k) a[k] = ga[k] * a[k] + gb[k] * b[k];
        *(GAS v4u*)((bf16*)(ws + WS_SMIX) + (size_t)row * LDS_X + n) = pack8f(a);
    }
}
__device__ __forceinline__ void s_out(const Ctx& C) {
    unsigned char* ws = C.ws; const int tid = C.tid, row = tid >> 2, c8 = (tid & 3) * 8, rg = MPROMPT + row;
    for (int u = blockIdx.x; u < 64; u += C.G) {
        float v[8], x[8]; const int n = u * 32 + c8;
        skinny_core(C, (const bf16*)(ws + WS_SMIX), LDS_X, (const bf16*)(ws + WS_WO) + ((size_t)(u >> 3) * (DM / 64) * 256 + (u & 7) * 32) * 64, C.wave * 256, 256, v);
        ld8f(C.in[IN_XS] + (size_t)row * DM + n, x); float ss = 0.f;
#pragma unroll
        for (int k = 0; k < 8; ++k) { v[k] += x[k]; ss += v[k] * v[k]; }
        st8f(C.out + O_YS + (size_t)row * DM + n, v); *(GAS v4u*)((bf16*)(ws + WS_SX1B) + (size_t)row * LDS_X + n) = pack8f(v);
        ss += __shfl_xor(ss, 1); ss += __shfl_xor(ss, 2);
        if ((tid & 3) == 0) ((float*)(ws + WS_X1SS))[(size_t)MPROMPT * 32 + row * 64 + u] = ss;
    }
}
__device__ __forceinline__ void s_up(const Ctx& C) {
    unsigned char* ws = C.ws; const int tid = C.tid, row = tid >> 2, c8 = (tid & 3) * 8, rg = MPROMPT + row;
    float rs; { const GAS f32x4* sp = (const GAS f32x4*)((const float*)(ws + WS_X1SS) + (size_t)MPROMPT * 32 + row * 64); f32x4 s4 = sp[0];
#pragma unroll
        for (int k = 1; k < 16; ++k) s4 += sp[k];
        rs = rsqrtf(((s4.x + s4.y) + (s4.z + s4.w)) * (1.0f / DM) + EPS); }
    for (int u = blockIdx.x; u < 256; u += C.G) {
        float v[8]; skinny_core(C, (const bf16*)(ws + WS_SX1B), LDS_X, (const bf16*)(ws + WS_WUP) + ((size_t)(u >> 3) * (DM / 64) * 256 + (u & 7) * 32) * 64, C.wave * 256, 256, v);
#pragma unroll
        for (int k = 0; k < 8; ++k) { const float a = fmaxf(v[k] * rs, 0.f); v[k] = a * a; }
        *(GAS v4u*)((bf16*)(ws + WS_SH) + (size_t)row * LDS_H + u * 32 + c8) = pack8f(v);
    }
}
__device__ __forceinline__ void s_down(const Ctx& C) {
    unsigned char* ws = C.ws; const int tid = C.tid, row = tid >> 2, c8 = (tid & 3) * 8, rg = MPROMPT + row;
    float* PART = (float*)(ws + WS_SPART); gu32* tick = (gu32*)(ws + WS_CTL) + CW_TICK; LAS unsigned* flag = (LAS unsigned*)(C.lds + AT_X);
    for (int u = blockIdx.x; u < 256; u += C.G) { const int strip = u >> 2, kq = u & 3;
        float v[8]; skinny_core(C, (const bf16*)(ws + WS_SH), LDS_H, (const bf16*)(ws + WS_WDN) + ((size_t)(strip >> 3) * (DFF / 64) * 256 + (strip & 7) * 32) * 64, kq * 2048 + C.wave * 256, 256, v);
        { gu64* pp = (gu64*)(PART + ((size_t)(strip * 4 + kq) * 128 + row) * 32 + c8);
#pragma unroll
          for (int q = 0; q < 4; ++q) __hip_atomic_store(pp + q, ((unsigned long long)__float_as_uint(v[2 * q + 1]) << 32) | __float_as_uint(v[2 * q]), RLX_AGENT); }
        asm volatile("s_waitcnt vmcnt(0)" ::: "memory"); __syncthreads();
        if (tid == 0) { const unsigned old = __hip_atomic_fetch_add(tick + strip * 64, 1u, __ATOMIC_RELAXED, __HIP_MEMORY_SCOPE_AGENT); flag[0] = old; }
        __syncthreads();
        const bool last = flag[0] == 3u;
        __syncthreads();
        if (last) { __builtin_amdgcn_fence(__ATOMIC_ACQUIRE, "agent"); asm volatile("s_waitcnt vmcnt(0)" ::: "memory");
            float* y = C.out + O_YS + (size_t)row * DM + strip * 32 + c8; float acc[8]; ld8f(y, acc);
#pragma unroll
            for (int q = 0; q < 4; ++q) { const gu64* pp = (const gu64*)(PART + ((size_t)(strip * 4 + q) * 128 + row) * 32 + c8);
#pragma unroll
                for (int k = 0; k < 4; ++k) { const unsigned long long w = __hip_atomic_load(pp + k, RLX_AGENT); acc[2 * k] += __uint_as_float((unsigned)w); acc[2 * k + 1] += __uint_as_float((unsigned)(w >> 32)); } }
            st8f(y, acc); }
    }
}

__device__ __forceinline__ void fused_cmp_unit(const Ctx& C, int L, const epi::EpiCmp& E) {
    using pg8::bf16x8; using pg8::f32x4; using pg8::HTB;
    LAS unsigned char* lds = C.lds + RING_OFF;
    const Ctx Lf = fresh(C);
    const int tid = Lf.tid, wid = C.wave, lane = Lf.lane, wr = wid >> 2, wc = wid & 3, fr = lane & 15, fq = lane >> 4;
    const int b = L >> 1, kv = L & 1;
    const int* pt = (const int*)C.in[IN_PT] + b * 16;
    unsigned aofg[2][2], voffB[2];
#pragma unroll
    for (int i = 0; i < 2; ++i) { int R, Cx; pg8::stage_rc(tid * 16 + i * 8192, R, Cx);
        const unsigned page = (unsigned)pt[R >> 3];
#pragma unroll
        for (int h = 0; h < 2; ++h) aofg[h][i] = (((page * 128u + (unsigned)(R & 7) * 16u) * 512u) + (unsigned)((kv * 2 + h) * 128 + Cx)) * 4u;
        voffB[i] = (unsigned)(R * 64 + Cx) * 2u; }
    const char* cA = (const char*)C.in[IN_CCMP];
    const char* cB = (const char*)(C.ws + WS_WC) + (size_t)kv * 32 * 32768;
    const size_t hstepB = 16384;
    const int aoff = pg8::lds_byte(wr * 64 + fr, fq * 8), boff = pg8::lds_byte(wc * 32 + fr, fq * 8);
#define FC_SA(bf, h) (((bf) * 2 + (h)) * HTB)
#define FC_SB(bf, h) ((4 + (bf) * 2 + (h)) * HTB)
#define FC_LOADA(kt) do { const unsigned ko_ = (unsigned)((kt) >> 1) * 2048u + (unsigned)((kt) & 1) * 256u; \
        _Pragma("unroll") for (int h = 0; h < 2; ++h) _Pragma("unroll") for (int i = 0; i < 2; ++i) { const char* p_ = cA + aofg[h][i] + ko_; \
            ar[h][i][0] = *(const GAS f32x4*)p_; ar[h][i][1] = *(const GAS f32x4*)(p_ + 16); } } while (0)
#define FC_WRITEA(bf) do { _Pragma("unroll") for (int h = 0; h < 2; ++h) _Pragma("unroll") for (int i = 0; i < 2; ++i) { v4u w_; \
            w_.x = pk2(ar[h][i][0].x, ar[h][i][0].y); w_.y = pk2(ar[h][i][0].z, ar[h][i][0].w); w_.z = pk2(ar[h][i][1].x, ar[h][i][1].y); w_.w = pk2(ar[h][i][1].z, ar[h][i][1].w); \
            *(LAS v4u*)(lds + FC_SA(bf, h) + tid * 16 + i * 8192) = w_; } } while (0)
#define FC_DMAB(kt, bf) do { _Pragma("unroll") for (int h = 0; h < 2; ++h) _Pragma("unroll") for (int i = 0; i < 2; ++i) \
            __builtin_amdgcn_global_load_lds((const unsigned*)(cB + h * hstepB + (size_t)(kt) * 32768 + voffB[i]), (LAS unsigned*)(lds + FC_SB(bf, h) + wid * 1024 + i * 8192), 16, 0, 0); } while (0)
#define FC_LDA(dst, bf, h) do { _Pragma("unroll") for (int m = 0; m < 4; ++m) _Pragma("unroll") for (int k = 0; k < 2; ++k) dst[m][k] = *(const LAS bf16x8*)(lds + FC_SA(bf, h) + aoff + m * 2048 + k * 1024); } while (0)
#define FC_LDB(dst, bf, h) do { _Pragma("unroll") for (int n = 0; n < 2; ++n) _Pragma("unroll") for (int k = 0; k < 2; ++k) dst[n][k] = *(const LAS bf16x8*)(lds + FC_SB(bf, h) + boff + n * 2048 + k * 1024); } while (0)
#define FC_MMA(ai, bj, At_, Bt_) do { _Pragma("unroll") for (int m = 0; m < 4; ++m) _Pragma("unroll") for (int n = 0; n < 2; ++n) _Pragma("unroll") for (int k = 0; k < 2; ++k) \
        acc[ai][bj][m][n] = __builtin_amdgcn_mfma_f32_16x16x32_bf16(Bt_[n][k], At_[m][k], acc[ai][bj][m][n], 0, 0, 0); } while (0)
    f32x4 acc[2][2][4][2];
#pragma unroll
    for (int a = 0; a < 2; ++a)
#pragma unroll
        for (int bb = 0; bb < 2; ++bb)
#pragma unroll
            for (int m = 0; m < 4; ++m)
#pragma unroll
                for (int n = 0; n < 2; ++n) acc[a][bb][m][n] = (f32x4){0.f, 0.f, 0.f, 0.f};
    f32x4 ar[2][2][2];
    bf16x8 At[4][2], B0[2][2];
    __syncthreads();
    FC_LOADA(0); FC_DMAB(0, 0); FC_WRITEA(0);
    asm volatile("s_waitcnt vmcnt(0) lgkmcnt(0)" ::: "memory"); __syncthreads();
#pragma unroll 1
    for (int kt = 0; kt < 32; ++kt) { const int bf = kt & 1;
        if (kt + 1 < 32) { FC_LOADA(kt + 1); FC_DMAB(kt + 1, bf ^ 1); }
        FC_LDB(B0, bf, 0); FC_LDA(At, bf, 0); FC_MMA(0, 0, At, B0);
        FC_LDA(At, bf, 1); FC_MMA(1, 0, At, B0);
        FC_LDB(B0, bf, 1); FC_MMA(1, 1, At, B0);
        FC_LDA(At, bf, 0); FC_MMA(0, 1, At, B0);
        if (kt + 1 < 32) FC_WRITEA(bf ^ 1);
        asm volatile("s_waitcnt vmcnt(0) lgkmcnt(0)" ::: "memory"); __syncthreads();
    }
    const pg8::Unit u{L, kv};
    { const Ctx Le = fresh(C); E(acc, u, wr, wc, Le.lane & 15, Le.lane >> 4); }
#undef FC_SA
#undef FC_SB
#undef FC_LOADA
#undef FC_WRITEA
#undef FC_DMAB
#undef FC_LDA
#undef FC_LDB
#undef FC_MMA
}

constexpr int LATE_P1 = 4096;
constexpr int WINCOPY_P2 = 0;
constexpr int LATE_P2 = I_LATE - LATE_P1;
constexpr int LATE_P12 = LATE_P1 + LATE_P2;
constexpr int NLATE_W = (I_LATE - LATE_P12 + 31) / 32, P5_HEAVY = 160, P5_SAMP0 = P5_HEAVY, P5_LIGHT0 = P5_SAMP0 + 256, P5_STREAM0 = P5_LIGHT0 + (256 - P5_HEAVY),
              P5_ITEMS = P5_STREAM0 + NLATE_W + WINCOPY_ITEMS - WINCOPY_P2;
__device__ __forceinline__ void p5_attn_flash(const Ctx& C, const int it_lo = 0, const int it_hi = P5_ITEMS) {
    unsigned char* ws = C.ws; gu32* ctl = (gu32*)(ws + WS_CTL); gu32* qa = ctl + CW_Q5;
    LAS float* scr = (LAS float*)(C.lds + RING_OFF + C.wave * 16384);
    for (;;) {
        gu32* qa_ = qa; unsigned qo_ = AT_WS + 2048; asm volatile("" : "+s"(qa_), "+s"(qo_));
        LAS unsigned* qf_ = (LAS unsigned*)(C.lds + qo_);
        __syncthreads();
        if (C.wave == 0 && lane_now() == 0) qf_[0] = __hip_atomic_fetch_add(qa_, 1u, __ATOMIC_RELAXED, __HIP_MEMORY_SCOPE_AGENT);
        __syncthreads();
        const int it = __builtin_amdgcn_readfirstlane((int)qf_[0]) + it_lo;
        if (it >= it_hi) break;
        const Ctx L = fresh(C);
        if (it < P5_HEAVY || (it >= P5_LIGHT0 && it < P5_STREAM0)) { const int un = it < P5_HEAVY ? it : it - P5_LIGHT0 + P5_HEAVY;
            const int qb_ = 63 - (un >> 2), bg = un & 3; flash_unit(L, bg >> 1, bg & 1, qb_); }
        else if (it < P5_LIGHT0) { const int si = it - P5_SAMP0, b = si >> 1, g = si & 1, row = MPROMPT + b;
            AttItem ai{(const bf16*)(ws + WS_QN) + (size_t)row * DQ + g * 512, PASTLEN, 127, (const bf16*)(ws + WS_KCS) + (size_t)(b * 2 + g) * 128 * 128, (const bf16*)(ws + WS_VCS) + (size_t)(b * 2 + g) * 128 * 128, 33,
                       (const float*)(ws + WS_GN) + (size_t)row * 32 + g * 12, (bf16*)(ws + WS_SOB) + (size_t)b * LDS_G + g * 512, (const float*)(ws + WS_BLUT) + g * 4 * 132};
            SampleKV kv{C.in[IN_CSEL] + g * 128, (const int*)C.in[IN_PT] + b * 16, C.out + O_SSEL + (size_t)b * 512 + g * 128, C.in[IN_WINB] + (size_t)b * 512 * 512 + g * 128,
                        (const float*)(ws + WS_KVWR) + (size_t)row * 512 + g * 128};
            nsa_item<SampleKV>(L, ai, kv, C.in[IN_GK] + 128, C.in[IN_GK] + 256); }
        else if (it < P5_STREAM0 + NLATE_W) { const int base = LATE_P12 + (it - P5_STREAM0) * 32;
#pragma unroll 1
            for (int k = 0; k < 4; ++k) { const int r = base + k * 8 + C.wave; if (r < I_LATE) w_item_late(L, r, scr); } }
        else wincopy_item(L, WINCOPY_P2 + it - P5_STREAM0 - NLATE_W);
    }
}

#ifndef MK_N_LAUNCHES
#define MK_N_LAUNCHES 1
#endif
constexpr int NPHASES = 10;

__device__ __forceinline__ void ph1(const Ctx& C, LAS unsigned char* ring) { unsigned char* ws = C.ws;
    pg8::Gemm g{(const bf16*)(ws + WS_XB), (const bf16*)(ws + WS_WIN), MPROMPT, NINP, DM, LD2, LD2, 1, 1}; pg8::StaticOrder S; S.init(MPROMPT, NINP, C.G, (int)blockIdx.x);
    epi::EpiIn E{(const float*)(ws + WS_RSTD1), (bf16*)(ws + WS_U), (bf16*)(ws + WS_VG), (float*)(ws + WS_VSS), (float*)(ws + WS_QRAW), (float*)(ws + WS_KVWR),
                 (bf16*)(ws + WS_GA), (bf16*)(ws + WS_GB), (float*)(ws + WS_GN), C.out, (bf16*)(ws + WS_ACP)};
    pg8::gemm_phase<epi::EpiIn, pg8::StaticOrder, true, true>(ring, g, S, E, C.tid);
    { const int nu = (MPROMPT / 256) * (NINP / 256), full = nu % C.G, nlight = full ? C.G - full : C.G, idx = full ? (int)blockIdx.x - full : (int)blockIdx.x;
      if (idx >= 0) { s_in(C, idx, nlight);
          const Ctx L = fresh(C); LAS float* scr = (LAS float*)(C.lds + RING_OFF + C.wave * 16384); __syncthreads();
          for (int r = idx * NWAVES + C.wave; r < LATE_P1; r += nlight * NWAVES) w_item_late(L, r, scr); } } }
__device__ __forceinline__ void ph2(const Ctx& C, LAS unsigned char* ring) { unsigned char* ws = C.ws;
    { const int skip = C.G > 32 ? 16 : 0; if ((int)blockIdx.x >= skip) p2_post(C, (int)blockIdx.x - skip, C.G - skip); }
    { epi::EpiCmp E{(float*)(ws + WS_YCS), 127};
      for (int Lu = (int)blockIdx.x; Lu < 256; Lu += C.G) { fused_cmp_unit(C, Lu, E);
          asm volatile("s_waitcnt vmcnt(0)" ::: "memory"); __syncthreads();
          const Ctx Lc = fresh(C);
          cmp_combine_rows(Lc, false, Lu * 256, 256); } }
    __syncthreads();
    const int ngb = C.G > 16 ? 8 : 0;
    if (ngb == 0 || (int)blockIdx.x < ngb) {
        { pg8::Gemm g{(const bf16*)(ws + WS_ACP), (const bf16*)(ws + WS_WC), 2048, 512, 2048, LD2, LD2, 1, 1}; epi::CmpOrder S{8, C.G, (int)blockIdx.x, 1};
          epi::EpiCmp E{(float*)(ws + WS_YCP), 255};
          const Ctx Lg = fresh(C); pg8::gemm_phase<epi::EpiCmp, epi::CmpOrder, true, true>(ring, g, S, E, Lg.tid); }
        asm volatile("s_waitcnt vmcnt(0)" ::: "memory"); __syncthreads();
        const Ctx Lc = fresh(C);
        for (int L = (int)blockIdx.x; L < 8; L += C.G) cmp_combine_rows(Lc, true, L * 256, 256); }
    { const Ctx Ls = fresh(C);
      if (ngb == 0) p4_sgu(Ls, (int)blockIdx.x, C.G); else if ((int)blockIdx.x >= ngb) p4_sgu(Ls, (int)blockIdx.x - ngb, C.G - ngb); }
    { const int skip = C.G > 32 ? 16 : 0;
      if ((int)blockIdx.x >= skip) { const Ctx L = fresh(C); LAS float* scr = (LAS float*)(C.lds + RING_OFF + C.wave * 16384); __syncthreads();
          for (int r = LATE_P1 + ((int)blockIdx.x - skip) * NWAVES + C.wave; r < LATE_P12; r += (C.G - skip) * NWAVES) w_item_late(L, r, scr);
          for (int c = (int)blockIdx.x - skip; c < WINCOPY_P2; c += C.G - skip) wincopy_item(L, c); } } }
__device__ __forceinline__ void ph6(const Ctx& C, LAS unsigned char* ring) { unsigned char* ws = C.ws;
    { pg8::Gemm g{(const bf16*)(ws + WS_OA), (const bf16*)(ws + WS_WG), MPROMPT, DM, DG, LD1, LD1, 1, 1}; pg8::StaticOrder S; S.init(MPROMPT, DM, C.G, (int)blockIdx.x);
      epi::EpiMixA E{(const bf16*)(ws + WS_GA), (bf16*)(ws + WS_MIXA)};
      pg8::gemm_phase<epi::EpiMixA, pg8::StaticOrder, true, true>(ring, g, S, E, C.tid); }
    { pg8::Gemm g{(const bf16*)(ws + WS_OB), (const bf16*)(ws + WS_WN), MPROMPT, DM, DQ, LD1, LD1, 1, 1}; pg8::StaticOrder S; S.init(MPROMPT, DM, C.G, (int)blockIdx.x);
      epi::EpiMixB E{(const bf16*)(ws + WS_GB), (const bf16*)(ws + WS_MIXA), (bf16*)(ws + WS_MIX)};
      pg8::gemm_phase<epi::EpiMixB, pg8::StaticOrder, true, true>(ring, g, S, E, C.tid); }
    s_proj(C); }
__device__ __forceinline__ void ph7(const Ctx& C, LAS unsigned char* ring) { unsigned char* ws = C.ws;
    pg8::Gemm g{(const bf16*)(ws + WS_MIX), (const bf16*)(ws + WS_WO), MPROMPT, DM, DM, LD2, LD2, 1, 1}; pg8::StaticOrder S; S.init(MPROMPT, DM, C.G, (int)blockIdx.x);
    epi::EpiOut E{(const bf16*)(ws + WS_XB), C.out, (bf16*)(ws + WS_X1B), (float*)(ws + WS_X1SS)};
    pg8::gemm_phase<epi::EpiOut, pg8::StaticOrder, true, true>(ring, g, S, E, C.tid);
    s_out(C); }
__device__ __forceinline__ void ph8(const Ctx& C, LAS unsigned char* ring) { unsigned char* ws = C.ws;
    pg8::Gemm g{(const bf16*)(ws + WS_X1B), (const bf16*)(ws + WS_WUP), MPROMPT, DFF, DM, LD2, LD2, 1, 1}; pg8::StaticOrder S; S.init(MPROMPT, DFF, C.G, (int)blockIdx.x);
    epi::EpiUp E{(const float*)(ws + WS_X1SS), (bf16*)(ws + WS_H)};
    pg8::gemm_phase<epi::EpiUp, pg8::StaticOrder, true, true>(ring, g, S, E, C.tid);
    s_up(C); }
template <bool DUMMY>
__device__ __forceinline__ void ph9(const Ctx& C, LAS unsigned char* ring) { unsigned char* ws = C.ws;
    pg8::Gemm g{(const bf16*)(ws + WS_H), (const bf16*)(ws + WS_WDN), MPROMPT, DM, DFF, LD8, LD8, 1, 1}; pg8::StaticOrder S; S.init(MPROMPT, DM, C.G, (int)blockIdx.x);
    epi::EpiDown E{DUMMY ? (float*)(ws + WS_DUMMY) : C.out, (const bf16*)(ws + WS_X1B)};
    pg8::gemm_phase<epi::EpiDown, pg8::StaticOrder, true, true>(ring, g, S, E, C.tid);
    if (!DUMMY) s_down(C); }

struct Args { const float* in[24]; float* out; unsigned char* ws; int ph_lo, ph_hi; };
static_assert(sizeof(Args) == 24 * 8 + 8 + 8 + 8, "no padding bytes in the kernel argument struct");

__global__ void __launch_bounds__(NWAVES * 64, 2) nsa_fwd(Args args) {
    extern __shared__ __attribute__((aligned(16))) unsigned char lds_raw[];
    Ctx C;
    C.in = args.in;
    C.out = args.out; C.ws = args.ws; C.lds = (LAS unsigned char*)lds_raw;
    C.tid = threadIdx.x; C.lane = C.tid & 63; C.wave = __builtin_amdgcn_readfirstlane(C.tid >> 6);
    C.G = gridDim.x; { const int bx = blockIdx.x; C.vcu = (C.G % 8 == 0) ? (bx % 8) * (C.G / 8) + bx / 8 : bx; }
    volatile LAS unsigned* MISC = (volatile LAS unsigned*)(C.lds + MISC_OFF);
    gu32* ctl = (gu32*)(args.ws + WS_CTL);
    for (int u = C.tid; u < (LDS_BYTES - LDSCTL_OFF) / 4; u += NWAVES * 64) ((LAS unsigned*)(C.lds + LDSCTL_OFF))[u] = 0u;
    __syncthreads();
    const int lo = args.ph_lo, hi = args.ph_hi;
    XcdBarrier bar; bar.bar = (unsigned*)(ctl + CW_BAR); bar.x = 0; bar.w = 0; bar.st = nullptr;
    if (hi - lo > 1) bar = xcd_barrier_post((unsigned*)(ctl + CW_BAR), MISC + 8);
#ifndef ONLY_PHASES
#define ONLY_PHASES 0x3ff
#endif
#define IN(k) (((ONLY_PHASES >> (k)) & 1) && lo <= (k) && (k) < hi)
#ifndef PROBE_SLACK
#define PROBE_SLACK -1
#endif
#ifndef PROBE_SLACK_PH
#define PROBE_SLACK_PH 2
#endif
#if PROBE_SLACK >= 0
    unsigned long long ps0_ = 0;
#define SEAM2(k, n) do { if (IN(k) && IN(n)) { if ((k) == PROBE_SLACK_PH) { __syncthreads(); ps0_ = __builtin_amdgcn_s_memrealtime(); } xcd_barrier(bar); \
        if ((k) == PROBE_SLACK_PH) { if ((int)blockIdx.x == PROBE_SLACK && C.wave == 0) { const unsigned long long d_ = __builtin_amdgcn_s_memrealtime() - ps0_, t0_ = __builtin_amdgcn_s_memrealtime(); \
                while (__builtin_amdgcn_s_memrealtime() - t0_ < d_ * 10ull) __builtin_amdgcn_s_sleep(16); } \
            xcd_barrier(bar); } } } while (0)
#else
#define SEAM2(k, n) do { if (IN(k) && IN(n)) xcd_barrier(bar); } while (0)
#endif
#define SEAM(k) SEAM2(k, (k) + 1)
    LAS unsigned char* ring = C.lds + RING_OFF;

#define PROBE2(k, call) do { if ((PROBE_MASK >> (k)) & 1) { xcd_barrier(bar); call; } } while (0)
    if (IN(0)) { p0_prologue(fresh(C)); PROBE2(0, p0_prologue(fresh(C))); } SEAM(0);
    if (IN(1)) { ph1(fresh(C), ring); PROBE2(1, ph1(fresh(C), ring)); } SEAM(1);
    if (IN(2)) { ph2(fresh(C), ring); PROBE2(2, ph2(fresh(C), ring)); } SEAM2(2, 5);
    if (IN(5)) { p5_attn_flash(fresh(C));
#define P5_RERUN(lo_, hi_) do { xcd_barrier(bar); if (blockIdx.x == 0 && C.wave == 0 && lane_now() == 0) __hip_atomic_store(ctl + CW_Q5, 0u, RLX_AGENT); xcd_barrier(bar); p5_attn_flash(fresh(C), lo_, hi_); } while (0)
        if ((PROBE_MASK >> 5) & 1) P5_RERUN(0, P5_ITEMS);
        if ((PROBE_MASK >> 13) & 1) { P5_RERUN(0, P5_HEAVY); }
        if ((PROBE_MASK >> 14) & 1) { P5_RERUN(P5_SAMP0, P5_LIGHT0); }
        if ((PROBE_MASK >> 15) & 1) { P5_RERUN(P5_STREAM0, P5_ITEMS); }
} SEAM(5);
    if (IN(6)) { ph6(fresh(C), ring); PROBE2(6, ph6(fresh(C), ring)); } SEAM(6);
    if (IN(7)) { ph7(fresh(C), ring); PROBE2(7, ph7(fresh(C), ring)); } SEAM(7);
#if (PROBE_MASK >> 20) & 1
    long long pc0_ = 0; unsigned long long pr0_ = 0; if (IN(8)) { pc0_ = clock64(); pr0_ = __builtin_amdgcn_s_memrealtime(); }
#endif
    if (IN(8)) { ph8(fresh(C), ring); PROBE2(8, ph8(fresh(C), ring)); }
#if (PROBE_MASK >> 20) & 1
    if (IN(8) && blockIdx.x == 0 && C.wave == 0) { const long long dc_ = clock64() - pc0_; const unsigned long long dr_ = __builtin_amdgcn_s_memrealtime() - pr0_;
        const unsigned long long mhz_ = (unsigned long long)dc_ * 100ull / (dr_ ? dr_ : 1ull); const unsigned long long t0_ = __builtin_amdgcn_s_memrealtime();
        while (__builtin_amdgcn_s_memrealtime() - t0_ < mhz_ * 100ull) __builtin_amdgcn_s_sleep(16); }
#endif
    SEAM(8);
    if (IN(9)) { PROBE2(9, ph9<true>(fresh(C), ring)); if ((PROBE_MASK >> 9) & 1) xcd_barrier(bar); ph9<false>(fresh(C), ring); }
#undef PROBE2
#undef IN
#undef SEAM
#undef SEAM2
}

extern "C" void kernel_launch(void* const* d_in, const int* in_sizes, int n_in, void* d_out, int out_size, void* d_ws, size_t ws_size, hipStream_t stream) {
    static int grid = 0;
    if (grid == 0) {
        if (n_in != 24 || out_size != (int)O_END || ws_size < WS_END) {
            fprintf(stderr, "kernel_launch: built for 24 inputs, %zu outputs, >= %zu bytes of workspace; got n_in %d out %d ws %zu; nothing launched\n", (size_t)O_END, (size_t)WS_END, n_in, out_size, ws_size);
            grid = -1; return; }
        int dev = 0, cus = 0, per_cu = 0;
        if (hipGetDevice(&dev) != hipSuccess || hipDeviceGetAttribute(&cus, hipDeviceAttributeMultiprocessorCount, dev) != hipSuccess) { fprintf(stderr, "kernel_launch: device query failed\n"); grid = -1; return; }
        if (hipFuncSetAttribute((const void*)nsa_fwd, hipFuncAttributeMaxDynamicSharedMemorySize, LDS_BYTES) != hipSuccess) { fprintf(stderr, "kernel_launch: hipFuncSetAttribute failed\n"); grid = -1; return; }
        if (hipOccupancyMaxActiveBlocksPerMultiprocessor(&per_cu, (const void*)nsa_fwd, NWAVES * 64, LDS_BYTES) != hipSuccess || per_cu < 1)
            fprintf(stderr, "kernel_launch: note: occupancy query reports %d workgroups per CU\n", per_cu);
        (void)hipGetLastError();
        grid = cus;
    }
    if (grid < 0) return;
    if (hipMemsetAsync((char*)d_ws + WS_CTL, 0, CTL_ZERO_BYTES, stream) != hipSuccess) { fprintf(stderr, "kernel_launch: memset failed\n"); return; }
    Args a{};
    for (int i = 0; i < 24; ++i) a.in[i] = (const float*)d_in[i];
    a.out = (float*)d_out; a.ws = (unsigned char*)d_ws;
    const int nl = MK_N_LAUNCHES;
    for (int li = 0; li < nl; ++li) {
        a.ph_lo = nl == 1 ? 0 : li; a.ph_hi = nl == 1 ? NPHASES : li + 1;
        hipLaunchKernelGGL(nsa_fwd, dim3(grid), dim3(NWAVES * 64), LDS_BYTES, stream, a);
        const hipError_t le = hipPeekAtLastError();
        if (le != hipSuccess) { fprintf(stderr, "kernel_launch: launch %d failed: %s\n", li, hipGetErrorName(le)); break; }
    }
}
```

```cpp
#include <hip/hip_runtime.h>
#include <cstdio>
#include <cstdint>
namespace pg8 {
#define PG8_LAS __attribute__((address_space(3)))
typedef unsigned short bf16_t;
typedef short bf16x8 __attribute__((ext_vector_type(8)));
typedef float f32x4 __attribute__((ext_vector_type(4)));
typedef unsigned u32x4 __attribute__((ext_vector_type(4)));
constexpr int BM = 256, BK = 64, HALF = 128, HTB = HALF * BK * 2  , STAGE_BYTES = 8 * HTB, NXCD = 8, WGM = 8;

__host__ __device__ __forceinline__ int lds_byte(int r, int c) { const int st = (r >> 4) * 2 + (c >> 5), rr = r & 15, cc = c & 31, ob = rr * 64 + cc * 2; return st * 1024 + (ob ^ (((ob >> 9) & 1) << 5)); }
__host__ __device__ __forceinline__ void stage_rc(int b, int& R, int& C) { const int st = b / 1024, sb = b % 1024, swz = sb ^ (((sb >> 9) & 1) << 5); R = (st >> 1) * 16 + swz / 64; C = (st & 1) * 32 + (swz % 64) / 2; }
__host__ __device__ __forceinline__ int perm32(int rho) { const int n = rho >> 4, i = rho & 15; return 8 * (i >> 2) + 4 * n + (i & 3); }

struct Unit { int pm, pn; };
struct Gemm { const bf16_t* A; const bf16_t* Bt; int M, N, K, lda, ldb; int tileA = 0, tileB = 0; };

struct StaticOrder {
    int nM, nN, nwg, G, c;
    __host__ __device__ void init(int M, int N, int G_, int c_) { nM = M / BM; nN = N / BM; nwg = nM * nN; G = G_; c = c_; }
    __host__ __device__ bool next(int i, Unit& u) const {
        const long L = (long)i * G + c; if (L >= nwg) return false;
        int wgid = (int)L; { const int q = nwg / NXCD, r = nwg % NXCD, xcd = wgid % NXCD, off = wgid / NXCD; wgid = (xcd < r ? xcd * (q + 1) : r * (q + 1) + (xcd - r) * q) + off; }
        const int nig = WGM * nN, gid = wgid / nig, fm = gid * WGM, gsz = (nM - fm) < WGM ? (nM - fm) : WGM;
        u.pm = fm + ((wgid % nig) % gsz); u.pn = (wgid % nig) / gsz; return true;
    }
    __device__ __forceinline__ void a_ready(const Unit&) const {}
    __device__ __forceinline__ void done(const Unit&) const {}
};

__device__ __forceinline__ unsigned cvt_pk_bf16(float lo, float hi) { unsigned r; asm volatile("v_cvt_pk_bf16_f32 %0, %1, %2" : "=v"(r) : "v"(lo), "v"(hi)); return r; }
typedef float f32x2 __attribute__((ext_vector_type(2)));
template <class Epi, class Sched, bool ALIGN_EPI = false, bool SP2 = false>
__device__ __forceinline__ void gemm_phase(PG8_LAS unsigned char* lds, const Gemm g, const Sched& S, const Epi& E, const int tid) {
    const int wid = __builtin_amdgcn_readfirstlane(tid >> 6), lane = tid & 63, wr = wid >> 2, wc = wid & 3, fr = lane & 15, fq = lane >> 4;
    const int K = g.K, nt = K / BK;
    unsigned voffA[2], voffB[2];
#pragma unroll
    for (int i = 0; i < 2; ++i) { int R, C; stage_rc(tid * 16 + i * 8192, R, C); const int Rb = Epi::PERM ? ((R & ~31) + perm32(R & 31)) : R;
        voffA[i] = (unsigned)(R * (g.tileA ? 64 : g.lda) + C) * 2u; voffB[i] = (unsigned)(Rb * (g.tileB ? 64 : g.ldb) + C) * 2u; }
    const size_t kstepA = g.tileA ? (size_t)32768 : (size_t)(BK * 2), kstepB = g.tileB ? (size_t)32768 : (size_t)(BK * 2);
    const size_t hstepA = g.tileA ? (size_t)16384 : (size_t)HALF * g.lda * 2, hstepB = g.tileB ? (size_t)16384 : (size_t)HALF * g.ldb * 2;
    const size_t tstepA = g.tileA ? (size_t)(g.K / BK) * 32768 : 2 * hstepA, tstepB = g.tileB ? (size_t)(g.K / BK) * 32768 : 2 * hstepB;
    const unsigned ldsw = (unsigned)wid * 1024u;
    const int aoff = lds_byte(wr * 64 + fr, fq * 8), boff = lds_byte(wc * 32 + fr, fq * 8);
#define PG8_SA(b, h) (((b) * 2 + (h)) * HTB)
#define PG8_SB(b, h) ((4 + (b) * 2 + (h)) * HTB)
#define PG8_STAGE(bufoff, gbase, voff) do { _Pragma("unroll") for (int _i = 0; _i < 2; ++_i) \
        __builtin_amdgcn_global_load_lds((const unsigned*)((const char*)(gbase) + (voff)[_i]), (PG8_LAS unsigned*)(lds + (bufoff) + ldsw + _i * 8192), 16, 0, 0); } while (0)
#define PG8_LDA(dst, b, h) do { _Pragma("unroll") for (int m = 0; m < 4; ++m) _Pragma("unroll") for (int k = 0; k < 2; ++k) dst[m][k] = *(const PG8_LAS bf16x8*)(lds + PG8_SA(b, h) + aoff + m * 2048 + k * 1024); } while (0)
#define PG8_LDB(dst, b, h) do { _Pragma("unroll") for (int n = 0; n < 2; ++n) _Pragma("unroll") for (int k = 0; k < 2; ++k) dst[n][k] = *(const PG8_LAS bf16x8*)(lds + PG8_SB(b, h) + boff + n * 2048 + k * 1024); } while (0)
#define PG8_MMA(ai, bj, At, Bt) do { __builtin_amdgcn_s_setprio(1); _Pragma("unroll") for (int m = 0; m < 4; ++m) _Pragma("unroll") for (int n = 0; n < 2; ++n) _Pragma("unroll") for (int k = 0; k < 2; ++k) \
        acc[ai][bj][m][n] = __builtin_amdgcn_mfma_f32_16x16x32_bf16(Bt[n][k], At[m][k], acc[ai][bj][m][n], 0, 0, 0); __builtin_amdgcn_s_setprio(0); } while (0)
#define PG8_WAIT_V(n) asm volatile("s_waitcnt vmcnt(" #n ")" ::: "memory")
#define PG8_WAIT_L(n) asm volatile("s_waitcnt lgkmcnt(" #n ")" ::: "memory")
#define PG8_BAR __builtin_amdgcn_s_barrier()
#define PG8_SCHED __builtin_amdgcn_sched_barrier(0)
    Unit cur, nxt; int ui = 0;
    if (!S.next(0, cur)) return;
    f32x4 acc[2][2][4][2];
#pragma unroll
    for (int a = 0; a < 2; ++a)
#pragma unroll
        for (int b = 0; b < 2; ++b)
#pragma unroll
            for (int m = 0; m < 4; ++m)
#pragma unroll
                for (int n = 0; n < 2; ++n) acc[a][b][m][n] = (f32x4){0.f, 0.f, 0.f, 0.f};
    bf16x8 At[4][2], B0[2][2], B1[2][2];
    const char* cA = (const char*)g.A + (size_t)cur.pm * tstepA; const char* cB = (const char*)g.Bt + (size_t)cur.pn * tstepB;
    S.a_ready(cur);
    if constexpr (SP2) {
        PG8_STAGE(PG8_SB(0, 0), cB, voffB); PG8_STAGE(PG8_SB(0, 1), cB + hstepB, voffB); PG8_STAGE(PG8_SA(0, 0), cA, voffA); PG8_STAGE(PG8_SA(0, 1), cA + hstepA, voffA);
        if (wr == 1) PG8_BAR;
        PG8_WAIT_V(2); PG8_BAR;
        PG8_STAGE(PG8_SB(1, 0), cB + kstepB, voffB); PG8_STAGE(PG8_SA(1, 0), cA + kstepA, voffA); PG8_STAGE(PG8_SB(1, 1), cB + hstepB + kstepB, voffB);
        PG8_WAIT_V(6); PG8_BAR;
    } else {
        PG8_STAGE(PG8_SB(0, 0), cB, voffB); PG8_STAGE(PG8_SA(0, 0), cA, voffA); PG8_STAGE(PG8_SB(0, 1), cB + hstepB, voffB); PG8_STAGE(PG8_SA(0, 1), cA + hstepA, voffA);
        if (wr == 1) PG8_BAR;
        PG8_WAIT_V(4); PG8_BAR;
        PG8_STAGE(PG8_SB(1, 0), cB + kstepB, voffB); PG8_STAGE(PG8_SA(1, 0), cA + kstepA, voffA); PG8_STAGE(PG8_SB(1, 1), cB + hstepB + kstepB, voffB);
        PG8_WAIT_V(6); PG8_BAR;
    }
    for (;;) {
        const bool has_next = S.next(ui + 1, nxt);
        const char* nA = has_next ? (const char*)g.A + (size_t)nxt.pm * tstepA : cA; const char* nB = has_next ? (const char*)g.Bt + (size_t)nxt.pn * tstepB : cB;
        for (int t = 0; t < nt; t += 2) {
            const bool last = (t == nt - 2);
            const char* a1 = cA + (size_t)(t + 1) * kstepA;
            const char* a2 = last ? nA : cA + (size_t)(t + 2) * kstepA; const char* b2 = last ? nB : cB + (size_t)(t + 2) * kstepB;
            const char* a3 = a2 + kstepA; const char* b3 = b2 + kstepB;
            if (last && has_next) S.a_ready(nxt);
            if constexpr (SP2) {
            PG8_LDB(B0, 0, 0); PG8_LDB(B1, 0, 1); PG8_SCHED; PG8_LDA(At, 0, 0); PG8_STAGE(PG8_SA(1, 1), a1 + hstepA, voffA);
            PG8_WAIT_V(8); PG8_WAIT_L(0); PG8_BAR; PG8_MMA(0, 0, At, B0); PG8_MMA(0, 1, At, B1); PG8_BAR; PG8_SCHED;
            PG8_LDA(At, 0, 1); PG8_STAGE(PG8_SB(0, 0), b2, voffB); PG8_STAGE(PG8_SB(0, 1), b2 + hstepB, voffB); PG8_STAGE(PG8_SA(0, 0), a2, voffA);
            PG8_WAIT_V(8); PG8_WAIT_L(0); PG8_BAR; PG8_MMA(1, 0, At, B0); PG8_MMA(1, 1, At, B1); PG8_BAR; PG8_SCHED;
            PG8_LDB(B0, 1, 0); PG8_LDB(B1, 1, 1); PG8_SCHED; PG8_LDA(At, 1, 0); PG8_STAGE(PG8_SA(0, 1), a2 + hstepA, voffA);
            PG8_WAIT_V(8); PG8_WAIT_L(0); PG8_BAR; PG8_MMA(0, 0, At, B0); PG8_MMA(0, 1, At, B1); PG8_BAR; PG8_SCHED;
            PG8_LDA(At, 1, 1); PG8_STAGE(PG8_SB(1, 0), b3, voffB); PG8_STAGE(PG8_SB(1, 1), b3 + hstepB, voffB); PG8_STAGE(PG8_SA(1, 0), a3, voffA);
            PG8_WAIT_V(8); PG8_WAIT_L(0); PG8_BAR; PG8_MMA(1, 0, At, B0); PG8_MMA(1, 1, At, B1); PG8_BAR; PG8_SCHED;
            } else {
            PG8_LDB(B0, 0, 0); PG8_SCHED; PG8_LDA(At, 0, 0); PG8_STAGE(PG8_SA(1, 1), a1 + hstepA, voffA);
            PG8_WAIT_L(8); PG8_BAR; PG8_WAIT_L(0); PG8_MMA(0, 0, At, B0); PG8_BAR; PG8_SCHED;
            PG8_LDB(B1, 0, 1); PG8_STAGE(PG8_SB(0, 0), b2, voffB);
            PG8_BAR; PG8_WAIT_L(0); PG8_MMA(0, 1, At, B1); PG8_BAR;
            PG8_LDA(At, 0, 1); PG8_STAGE(PG8_SA(0, 0), a2, voffA);
            PG8_BAR; PG8_WAIT_L(0); PG8_MMA(1, 0, At, B0); PG8_BAR; PG8_SCHED;
            PG8_STAGE(PG8_SB(0, 1), b2 + hstepB, voffB);
            PG8_WAIT_V(6); PG8_BAR; PG8_MMA(1, 1, At, B1); PG8_BAR;
            PG8_LDB(B0, 1, 0); PG8_SCHED; PG8_LDA(At, 1, 0); PG8_STAGE(PG8_SA(0, 1), a2 + hstepA, voffA);
            PG8_WAIT_L(8); PG8_BAR; PG8_WAIT_L(0); PG8_MMA(0, 0, At, B0); PG8_BAR; PG8_SCHED;
            PG8_LDB(B1, 1, 1); PG8_STAGE(PG8_SB(1, 0), b3, voffB);
            PG8_BAR; PG8_WAIT_L(0); PG8_MMA(0, 1, At, B1); PG8_BAR;
            PG8_LDA(At, 1, 1); PG8_STAGE(PG8_SA(1, 0), a3, voffA);
            PG8_BAR; PG8_WAIT_L(0); PG8_MMA(1, 0, At, B0); PG8_BAR; PG8_SCHED;
            PG8_STAGE(PG8_SB(1, 1), b3 + hstepB, voffB);
            PG8_WAIT_V(6); PG8_BAR; PG8_MMA(1, 1, At, B1); PG8_BAR;
            }
        }
        if constexpr (ALIGN_EPI) { if (wr == 0) PG8_BAR; }
        if constexpr (!Epi::AFTER_DRAIN) { E(acc, cur, wr, wc, fr, fq); S.done(cur); }
        if (!has_next) break;
#pragma unroll
        for (int a = 0; a < 2; ++a)
#pragma unroll
            for (int b = 0; b < 2; ++b)
#pragma unroll
                for (int m = 0; m < 4; ++m)
#pragma unroll
                    for (int n = 0; n < 2; ++n) acc[a][b][m][n] = (f32x4){0.f, 0.f, 0.f, 0.f};
        cur = nxt; cA = nA; cB = nB; ++ui;
        if constexpr (ALIGN_EPI) { if (wr == 1) PG8_BAR; }
    }
    PG8_WAIT_V(0);
    if constexpr (!ALIGN_EPI) { if (wr == 0) PG8_BAR; }
    PG8_BAR;
    if constexpr (Epi::AFTER_DRAIN) { E.fused(acc, cur, wr, wc, fr, fq, lds, wid, lane); S.done(cur); }
#undef PG8_SA
#undef PG8_SB
#undef PG8_STAGE
#undef PG8_LDA
#undef PG8_LDB
#undef PG8_MMA
#undef PG8_WAIT_V
#undef PG8_WAIT_L
#undef PG8_BAR
#undef PG8_SCHED
}
}
#define GAS __attribute__((address_space(1)))
#define LAS __attribute__((address_space(3)))
typedef unsigned short bf16;
typedef unsigned v4u __attribute__((ext_vector_type(4)));
typedef float f32x4 __attribute__((ext_vector_type(4)));
typedef short bf16x8 __attribute__((ext_vector_type(8)));
typedef GAS unsigned gu32;
typedef GAS unsigned long long gu64;
#define RLX_AGENT __ATOMIC_RELAXED, __HIP_MEMORY_SCOPE_AGENT
#define LDS_WAIT() asm volatile("s_waitcnt lgkmcnt(0)" ::: "memory")
#define VM_WAIT() asm volatile("s_waitcnt vmcnt(0)" ::: "memory")
__device__ __forceinline__ unsigned long long rt() { return __builtin_amdgcn_s_memrealtime(); }
__device__ __forceinline__ unsigned f2bf(float f) { unsigned u = __builtin_bit_cast(unsigned, f); return (u + 0x7fffu + ((u >> 16) & 1u)) >> 16; }
__device__ __forceinline__ unsigned pk2(float lo, float hi) { return f2bf(lo) | (f2bf(hi) << 16); }

#define XB_TMO      128
#define XB_XCNT(j)  (256  + 64 * (j))
#define XB_XSUB(j)  (1280 + 64 * (j))
#define XB_XGEN(j)  (2304 + 64 * (j))
#define XB_TOP      3328
#define XB_TOPGEN   3392
#define XCD_BAR_WORDS 3456
#define XB_SPIN_CAP (1u << 24)

__device__ __forceinline__ unsigned xb_ld(unsigned* p)              { return __hip_atomic_load(p, __ATOMIC_RELAXED, __HIP_MEMORY_SCOPE_AGENT); }
__device__ __forceinline__ unsigned xb_add(unsigned* p, unsigned v) { return __hip_atomic_fetch_add(p, v, __ATOMIC_RELAXED, __HIP_MEMORY_SCOPE_AGENT); }
__device__ __forceinline__ unsigned xb_xcc_id() { return (unsigned)__builtin_amdgcn_s_getreg((3 << 11) | 20) & 0xFu; }
#define XB_SPIN(cond, bar) do { unsigned _sp = 0; while (cond) { __builtin_amdgcn_s_sleep(1); \
    if ((++_sp & 255u) == 0u) { if (xb_ld(&(bar)[XB_TMO])) break; if (_sp > XB_SPIN_CAP) { atomicAdd(&(bar)[XB_TMO], 1u); break; } } } } while (0)

__device__ __forceinline__ unsigned xb_lane() { unsigned l_; asm volatile("v_mbcnt_lo_u32_b32 %0, -1, 0\n\tv_mbcnt_hi_u32_b32 %0, -1, %0" : "=&v"(l_)); return l_; }
struct XcdBarrier {
    unsigned* bar; unsigned x; unsigned w;
    volatile LAS unsigned* st;
};

__device__ __forceinline__ XcdBarrier xcd_barrier_post(unsigned* bar, volatile LAS unsigned* st) {
    XcdBarrier b; b.bar = bar; b.x = xb_xcc_id(); b.st = st; b.w = (unsigned)__builtin_amdgcn_readfirstlane(threadIdx.x >> 6);
    if (threadIdx.x == 0) (void)xb_add(&bar[XB_XCNT(b.x)], 1u);
    return b;
}
__device__ __forceinline__ void xcd_barrier_complete(unsigned* bar, unsigned x, unsigned& nloc, unsigned& nx) {
    const unsigned G = gridDim.x * gridDim.y * gridDim.z;
    unsigned sum, cnt, mine, sp = 0u;
    for (;;) {
        sum = 0u; cnt = 0u; mine = 0u;
#pragma unroll
        for (unsigned j = 0; j < 16; ++j) { const unsigned c = xb_ld(&bar[XB_XCNT(j)]); sum += c; cnt += (c > 0u) ? 1u : 0u; mine = (j == x) ? c : mine; }
        if (sum == G) break;
        __builtin_amdgcn_s_sleep(1);
        if ((++sp & 255u) == 0u) { if (xb_ld(&bar[XB_TMO])) break; if (sp > XB_SPIN_CAP) { atomicAdd(&bar[XB_TMO], 1u); break; } }
    }
    nloc = mine > 0u ? mine : 1u; nx = cnt > 0u ? cnt : 1u;
}

__device__ __forceinline__ void xcd_barrier(const XcdBarrier& b) {
    asm volatile("s_waitcnt vmcnt(0)" ::: "memory");
    __syncthreads();
    if (b.w == 0u && xb_lane() == 0u) {
        unsigned* bar = b.bar;
        __builtin_amdgcn_s_waitcnt(0);
        unsigned nloc = b.st[0], nx = b.st[1];
        if (nloc == 0u) { xcd_barrier_complete(bar, b.x, nloc, nx); b.st[0] = nloc; b.st[1] = nx; }
        const unsigned old = xb_add(&bar[XB_XSUB(b.x)], 1u);
        const unsigned gen = old / nloc;
        if (old + 1u == (gen + 1u) * nloc) {
            __builtin_amdgcn_fence(__ATOMIC_RELEASE, "agent");
            asm volatile("s_waitcnt vmcnt(0)" ::: "memory");
            const unsigned og = xb_add(&bar[XB_TOP], 1u);
            const unsigned tg = og / nx;
            if (og + 1u == (tg + 1u) * nx) xb_add(&bar[XB_TOPGEN], 1u);
            else XB_SPIN(xb_ld(&bar[XB_TOPGEN]) == tg, bar);
            __builtin_amdgcn_fence(__ATOMIC_ACQUIRE, "agent");
            xb_add(&bar[XB_XGEN(b.x)], 1u);
            asm volatile("s_waitcnt vmcnt(0)" ::: "memory");
        } else {
            XB_SPIN(xb_ld(&bar[XB_XGEN(b.x)]) == gen, bar);
            __builtin_amdgcn_fence(__ATOMIC_ACQUIRE, "agent");
            asm volatile("s_waitcnt vmcnt(0)" ::: "memory");
        }
    }
    __syncthreads();
}
#ifndef PROBE_MASK
#define PROBE_MASK 0
#endif

constexpr int T = 4096, NBATCH = 2, MPROMPT = 8192, MSAMP = 128, MREAL = 8320, MPAD = 8448;
constexpr int DM = 2048, DG = 1024, DQ = 1024, DFF = 8192, NIN = 8728, NINP = 8960;
constexpr int PASTLEN = 2048;
constexpr float EPS = 1e-6f;
constexpr float LOG2E = 1.4426950408889634f;
constexpr float QSCALE = 0.08838834764831845f * 1.4426950408889634f;
constexpr int NWAVES = 8;
constexpr int LD2 = DM + 64, LD1 = DG + 64, LD8 = DFF + 64;

constexpr size_t O_YP = 0, O_YS = 16777216, O_PCMP = O_YS + 262144, O_PSEL = O_PCMP + 4194304, O_PWIN = O_PSEL + 4194304,
                 O_PSGU = O_PWIN + 524288, O_SCMP = O_PSGU + 262144, O_SSEL = O_SCMP + 65536, O_SWIN = O_SSEL + 65536,
                 O_SSGU = O_SWIN + 33554432, O_END = O_SSGU + 131072;
static_assert(O_END == 60030976, "output size");

constexpr size_t MiB = 1ull << 20;
constexpr size_t al(size_t x) { return (x + MiB - 1) / MiB * MiB; }
constexpr size_t WS_CTL = 0, CTL_ZERO_BYTES = 1 * MiB;
constexpr size_t WS_WIN  = 1 * MiB;
constexpr size_t WS_WG   = WS_WIN  + al((size_t)NINP * LD2 * 2);
constexpr size_t WS_WN   = WS_WG   + al((size_t)DM * LD1 * 2);
constexpr size_t WS_WO   = WS_WN   + al((size_t)DM * LD1 * 2);
constexpr size_t WS_WUP  = WS_WO   + al((size_t)DM * LD2 * 2);
constexpr size_t WS_WDN  = WS_WUP  + al((size_t)DFF * LD2 * 2);
constexpr size_t WS_WC   = WS_WDN  + al((size_t)DM * LD8 * 2);
constexpr size_t WS_XB   = WS_WC   + al((size_t)512 * LD2 * 2);
constexpr size_t WS_RSTD1= WS_XB   + al((size_t)MPAD * LD2 * 2);
constexpr size_t WS_U    = WS_RSTD1+ al((size_t)MPAD * 4);
constexpr size_t WS_VG   = WS_U    + al((size_t)MPAD * DG * 2);
constexpr size_t WS_VSS  = WS_VG   + al((size_t)MPAD * DG * 2);
constexpr size_t WS_RSTDV= WS_VSS  + al((size_t)MPAD * 32 * 4);
constexpr size_t WS_QRAW = WS_RSTDV+ al((size_t)MPAD * 4);
constexpr size_t WS_KVWR = WS_QRAW + al((size_t)MPAD * DQ * 4);
constexpr size_t WS_GA   = WS_KVWR + al((size_t)MPAD * 512 * 4);
constexpr size_t WS_GB   = WS_GA   + al((size_t)MPAD * DM * 2);
constexpr size_t WS_GN   = WS_GB   + al((size_t)MPAD * DM * 2);
constexpr size_t WS_QN   = WS_GN   + al((size_t)MPAD * 32 * 4);
constexpr size_t WS_KS   = WS_QN   + al((size_t)MPAD * DQ * 2);
constexpr size_t WS_VS   = WS_KS   + 4 * MiB;
constexpr size_t WS_KW   = WS_VS   + 4 * MiB;
constexpr size_t WS_VW   = WS_KW   + 4 * MiB;
constexpr size_t WS_ACP  = WS_VW   + 4 * MiB;
constexpr size_t WS_ACS  = WS_ACP  + al((size_t)2048 * LD2 * 2);
constexpr size_t WS_YCP  = WS_ACS  + al((size_t)65536 * LD2 * 2);
constexpr size_t WS_YCS  = WS_YCP  + 2 * MiB;
constexpr size_t WS_KCP  = WS_YCS  + 64 * MiB;
constexpr size_t WS_VCP  = WS_KCP  + 1 * MiB;
constexpr size_t WS_KCS  = WS_VCP  + 1 * MiB;
constexpr size_t WS_VCS  = WS_KCS  + 8 * MiB;
constexpr size_t WS_CBP  = WS_VCS  + 8 * MiB;
constexpr size_t WS_WMB  = WS_CBP  + 1 * MiB;
constexpr size_t WS_BLUT = WS_WMB  + 1 * MiB;
constexpr size_t WS_OA   = WS_BLUT + 1 * MiB;
constexpr size_t WS_OB   = WS_OA   + al((size_t)MPAD * LD1 * 2);
constexpr size_t WS_MIXA = WS_OB   + al((size_t)MPAD * LD1 * 2);
constexpr size_t WS_MIX  = WS_MIXA + al((size_t)MPAD * DM * 2);
constexpr size_t WS_X1B  = WS_MIX  + al((size_t)MPAD * LD2 * 2);
constexpr size_t WS_X1F  = WS_X1B  + al((size_t)MPAD * LD2 * 2);
constexpr size_t WS_X1SS = WS_X1F  + al((size_t)128 * DM * 4);
constexpr size_t WS_H    = WS_X1SS + al((size_t)MPAD * 32 * 4);
constexpr size_t WS_OT   = WS_H    + al((size_t)MPAD * LD8 * 2);
constexpr size_t WS_SPART= WS_OT   + 32 * MiB;
constexpr int LDS_X = DM + 64, LDS_G = DG + 64, LDS_H = DFF + 64;
constexpr size_t WS_SXB  = WS_SPART+ 4 * MiB;
constexpr size_t WS_SOA  = WS_SXB  + 1 * MiB;
constexpr size_t WS_SOB  = WS_SOA  + 1 * MiB;
constexpr size_t WS_SMIX = WS_SOB  + 1 * MiB;
constexpr size_t WS_SX1B = WS_SMIX + 1 * MiB;
constexpr size_t WS_SH   = WS_SX1B + 1 * MiB;
constexpr size_t WS_DUMMY= WS_SH   + 3 * MiB;
constexpr size_t WS_END  = WS_DUMMY+ 72 * MiB;

constexpr int CW_TMO = 0, CW_CODE = 1;
constexpr int CW_BAR = 4096;
constexpr int CW_Q5 = 8192;
constexpr int CW_FLAG = 16384;
constexpr int CW_TICK = 65536;
static_assert((CW_TICK + 64 * 64) * 4 <= (int)CTL_ZERO_BYTES && (CW_BAR + 16 * 3456) * 4 <= (int)CTL_ZERO_BYTES, "CTL words inside the memset region");

constexpr int RING_OFF = 0, RING_BYTES = 131072;
constexpr int LDSCTL_OFF = RING_BYTES, MISC_OFF = LDSCTL_OFF + 320;
constexpr int LDS_BYTES = 147456;
static_assert(MISC_OFF + 128 <= LDS_BYTES, "LDS map");

__constant__ unsigned char kBkt[128] = {0, 1, 2, 3, 4, 5, 6, 7, 8, 9, 10, 11, 12, 13, 14, 15, 16, 16, 16, 17, 17, 18, 18, 18, 19, 19, 19, 20, 20, 20, 20, 21, 21, 21, 21, 22, 22, 22, 22, 22, 23, 23, 23, 23, 23, 23, 24, 24, 24, 24, 24, 24, 25, 25, 25, 25, 25, 25, 25, 26, 26, 26, 26, 26, 26, 26, 26, 27, 27, 27, 27, 27, 27, 27, 27, 27, 27, 28, 28, 28, 28, 28, 28, 28, 28, 28, 28, 29, 29, 29, 29, 29, 29, 29, 29, 29, 29, 29, 29, 30, 30, 30, 30, 30, 30, 30, 30, 30, 30, 30, 30, 30, 30, 31, 31, 31, 31, 31, 31, 31, 31, 31, 31, 31, 31, 31, 31, 31};

__host__ __device__ __forceinline__ size_t tm_idx(int row, int col, int nkt) { return ((size_t)((row >> 8) * nkt + (col >> 6)) * 256 + (row & 255)) * 64 + (col & 63); }

typedef unsigned v2u __attribute__((ext_vector_type(2)));
struct Ctx {
    const float* const* in; float* out; unsigned char* ws;
    LAS unsigned char* lds;
    int tid, lane, wave, vcu, G;
};
__device__ __forceinline__ int lane_now() { int l_; asm volatile("v_mbcnt_lo_u32_b32 %0, -1, 0\n\tv_mbcnt_hi_u32_b32 %0, -1, %0" : "=&v"(l_) : : "memory"); return l_; }
__device__ __forceinline__ Ctx fresh(const Ctx& C) { Ctx L = C; const int l_ = lane_now(); L.lane = l_; L.tid = C.wave * 64 + l_; return L; }
#define IN_XP 0
#define IN_XS 1
#define IN_CCMP 2
#define IN_CSEL 3
#define IN_WINB 4
#define IN_PT 5
#define IN_RELB 6
#define IN_GMIX 7
#define IN_WIN 8
#define IN_GSGU 9
#define IN_WSGU 10
#define IN_BSGU 11
#define IN_GQ 12
#define IN_GK 13
#define IN_POSK 14
#define IN_WCK 15
#define IN_POSV 16
#define IN_WCV 17
#define IN_WPG 18
#define IN_WPN 19
#define IN_WOUT 20
#define IN_GMLP 21
#define IN_WUP 22
#define IN_WDN 23

__device__ __forceinline__ float bf2f(unsigned short b) { return __uint_as_float((unsigned)b << 16); }
__device__ __forceinline__ float bflo(unsigned w) { return __uint_as_float(w << 16); }
__device__ __forceinline__ float bfhi(unsigned w) { return __uint_as_float(w & 0xffff0000u); }
__device__ __forceinline__ void unpack8(v4u w, float (&f)[8]) {
    f[0] = bflo(w.x); f[1] = bfhi(w.x); f[2] = bflo(w.y); f[3] = bfhi(w.y); f[4] = bflo(w.z); f[5] = bfhi(w.z); f[6] = bflo(w.w); f[7] = bfhi(w.w);
}
__device__ __forceinline__ v4u pack8f(const float (&f)[8]) { v4u w; w.x = pk2(f[0], f[1]); w.y = pk2(f[2], f[3]); w.z = pk2(f[4], f[5]); w.w = pk2(f[6], f[7]); return w; }
__device__ __forceinline__ float wave_sum(float v) {
#pragma unroll
    for (int o = 1; o < 64; o <<= 1) v += __shfl_xor(v, o);
    return v;
}
__device__ __forceinline__ float wave_max(float v) {
#pragma unroll
    for (int o = 1; o < 64; o <<= 1) v = fmaxf(v, __shfl_xor(v, o));
    return v;
}
__device__ __forceinline__ float sigmoidf_(float x) { return 1.0f / (1.0f + __expf(-x)); }
__device__ __forceinline__ float gelu_tanh(float x) {
    const float u = 0.7978845608028654f * (x + 0.044715f * x * x * x);
    return x / (1.0f + __expf(-2.0f * u));
}

__device__ __forceinline__ void tr_item(const float* W, int ldw, int srccol0, int nvalid, const float* kscale, bf16* WT, int nkt, int dst_row0, int k0, LAS float* scr, int lane) {
    const int n = lane & 31;
    float vv[32];
#pragma unroll
    for (int i = 0; i < 32; ++i) { const int kk = 2 * i + (lane >> 5); vv[i] = (n < nvalid) ? __builtin_nontemporal_load(W + (size_t)(k0 + kk) * ldw + srccol0 + n) : 0.f; }
    if (kscale) {
#pragma unroll
        for (int i = 0; i < 32; ++i) vv[i] *= kscale[k0 + 2 * i + (lane >> 5)]; }
#pragma unroll
    for (int i = 0; i < 32; ++i) scr[(2 * i + (lane >> 5)) * 33 + n] = vv[i];
    LDS_WAIT(); asm volatile("" ::: "memory");
    const int c = lane & 7;
#pragma unroll
    for (int j = 0; j < 4; ++j) { const int nn = (lane >> 3) + 8 * j; const LAS float* s = scr + (8 * c) * 33 + nn;
        v4u o; o.x = pk2(s[0 * 33], s[1 * 33]); o.y = pk2(s[2 * 33], s[3 * 33]); o.z = pk2(s[4 * 33], s[5 * 33]); o.w = pk2(s[6 * 33], s[7 * 33]);
        { const int n_ = dst_row0 + nn; *(GAS v4u*)(WT + ((size_t)((n_ >> 8) * nkt + (k0 >> 6)) * 256 + (n_ & 255)) * 64 + 8 * c) = o; } }
    LDS_WAIT(); asm volatile("" ::: "memory");
}

constexpr int I_IN = 32 * 280, I_PG = 16 * 64, I_PN = 16 * 64, I_OUT = 32 * 64, I_UP = 32 * 256, I_DN = 128 * 64, I_C = 4 * 128;
constexpr int I_LATE = I_PG + I_PN + I_OUT + I_UP + I_DN;
__device__ __forceinline__ void w_item_in(const Ctx& C, int r, LAS float* scr) {
    const int kb = r / 280, nb = r % 280, n0 = nb * 32;
    const int src = n0 < 4608 ? n0 : (n0 < 8704 ? n0 + 24 : n0 - 8704 + 4608);
    const int nv = n0 < 8704 ? 32 : (n0 == 8704 ? 24 : 0);
    tr_item(C.in[IN_WIN], NIN, src, nv, C.in[IN_GMIX], (bf16*)(C.ws + WS_WIN), DM / 64, n0, kb * 64, scr, C.lane);
}
__device__ __forceinline__ void w_item_cmp(const Ctx& C, int r, LAS float* scr) {
    const int sub = r / 128, rr = r % 128, kv = sub >> 1, hf = sub & 1, kb = rr / 4, nb = rr % 4;
    const float* W = (kv ? C.in[IN_WCV] : C.in[IN_WCK]) + (size_t)hf * 2048 * 128;
    tr_item(W, 128, nb * 32, 32, nullptr, (bf16*)(C.ws + WS_WC), 2048 / 64, kv * 256 + hf * 128 + nb * 32, kb * 64, scr, C.lane);
}
__device__ __forceinline__ void w_item_late(const Ctx& C, int r, LAS float* scr) {
    unsigned char* ws = C.ws; const int lane = C.lane;
    if (r < I_PG) { const int kb = r / 64, nb = r % 64; tr_item(C.in[IN_WPG], DM, nb * 32, 32, nullptr, (bf16*)(ws + WS_WG), DG / 64, nb * 32, kb * 64, scr, lane); return; } r -= I_PG;
    if (r < I_PN) { const int kb = r / 64, nb = r % 64; tr_item(C.in[IN_WPN], DM, nb * 32, 32, nullptr, (bf16*)(ws + WS_WN), DQ / 64, nb * 32, kb * 64, scr, lane); return; } r -= I_PN;
    if (r < I_OUT) { const int kb = r / 64, nb = r % 64; tr_item(C.in[IN_WOUT], DM, nb * 32, 32, nullptr, (bf16*)(ws + WS_WO), DM / 64, nb * 32, kb * 64, scr, lane); return; } r -= I_OUT;
    if (r < I_UP) { const int kb = r / 256, nb = r % 256; tr_item(C.in[IN_WUP], DFF, nb * 32, 32, C.in[IN_GMLP], (bf16*)(ws + WS_WUP), DM / 64, nb * 32, kb * 64, scr, lane); return; } r -= I_UP;
    { const int kb = r / 64, nb = r % 64; tr_item(C.in[IN_WDN], DM, nb * 32, 32, nullptr, (bf16*)(ws + WS_WDN), DFF / 64, nb * 32, kb * 64, scr, lane); }
}
__device__ __forceinline__ void gather_item(const Ctx& C, int it) {
    const int lane = C.lane, kvg = lane >> 4, d = (lane & 15) * 8;
    const int b = it >> 7, p = (it >> 3) & 15, sg = it & 7, page = ((const int*)C.in[IN_PT])[b * 16 + p], j = p * 8 + sg;
    const float* src = C.in[IN_CCMP] + ((size_t)page * 128 + sg * 16) * 512 + lane * 8;
    bf16* dst = (bf16*)(C.ws + WS_ACS) + (size_t)((b * 4 + kvg) * 128 + j) * LD2 + d;
#pragma unroll
    for (int h = 0; h < 2; ++h) { f32x4 a[8], c2[8];
#pragma unroll
        for (int s = 0; s < 8; ++s) { a[s] = __builtin_nontemporal_load((const GAS f32x4*)(src + (h * 8 + s) * 512)); c2[s] = __builtin_nontemporal_load((const GAS f32x4*)(src + (h * 8 + s) * 512 + 4)); }
#pragma unroll
        for (int s = 0; s < 8; ++s) { v4u o; o.x = pk2(a[s].x, a[s].y); o.y = pk2(a[s].z, a[s].w); o.z = pk2(c2[s].x, c2[s].y); o.w = pk2(c2[s].z, c2[s].w);
            *(GAS v4u*)(dst + (h * 8 + s) * 128) = o; } }
}
constexpr int WINCOPY_F4 = 128 * 65408, WINCOPY_CHUNK = 16384, WINCOPY_ITEMS = (WINCOPY_F4 + WINCOPY_CHUNK - 1) / WINCOPY_CHUNK;
__device__ __forceinline__ void wincopy_item(const Ctx& C, int chunk) {
    const GAS f32x4* src = (const GAS f32x4*)C.in[IN_WINB]; GAS f32x4* dst = (GAS f32x4*)(C.out + O_SWIN);
    const int base = chunk * WINCOPY_CHUNK + C.tid;
#pragma unroll
    for (int h = 0; h < 2; ++h) { f32x4 v[16];
#pragma unroll
        for (int k = 0; k < 16; ++k) { const int i = base + (h * 16 + k) * NWAVES * 64; if (i < WINCOPY_F4) { const int b = i / 65408, r = i - b * 65408; v[k] = __builtin_nontemporal_load(src + b * 65536 + 128 + r); } }
#pragma unroll
        for (int k = 0; k < 16; ++k) { const int i = base + (h * 16 + k) * NWAVES * 64; if (i < WINCOPY_F4) { const int b = i / 65408, r = i - b * 65408; __builtin_nontemporal_store(v[k], dst + b * 65536 + r); } } }
}

__device__ __forceinline__ void p0_prologue(const Ctx& C) {
    unsigned char* ws = C.ws;
    LAS float* scr = (LAS float*)(C.lds + RING_OFF + C.wave * 16384);
    const int gw = C.vcu * NWAVES + C.wave, NGW = C.G * NWAVES, lane = C.lane;
    for (int rep = 0; rep < (((PROBE_MASK >> 10) & 1) ? 2 : 1); ++rep)
    for (int it = gw; it < I_IN + I_C; it += NGW) { if (it < I_IN) w_item_in(C, it, scr); else w_item_cmp(C, it - I_IN, scr); }
    {
        bf16* XB = (bf16*)(ws + WS_XB); float* RS = (float*)(ws + WS_RSTD1);
        for (int rep = 0; rep < (((PROBE_MASK >> 12) & 1) ? 2 : 1); ++rep)
        for (int m = gw; m < MREAL; m += NGW) {
            const bool pr_ = m < MPROMPT;
            GAS v2u* o8 = pr_ ? (GAS v2u*)(XB + tm_idx(m, 4 * (lane & 15), DM / 64)) + 0 : (GAS v2u*)((bf16*)(ws + WS_SXB) + (size_t)(m - MPROMPT) * LDS_X) + lane;
            const float* xr = m < MPROMPT ? C.in[IN_XP] + (size_t)m * DM : C.in[IN_XS] + (size_t)(m - MPROMPT) * DM;
            const GAS f32x4* x4 = (const GAS f32x4*)xr + lane; f32x4 v[8]; float s = 0.f;
#pragma unroll
            for (int j = 0; j < 8; ++j) { v[j] = x4[64 * j]; s += (v[j].x * v[j].x + v[j].y * v[j].y) + (v[j].z * v[j].z + v[j].w * v[j].w); }
            s = wave_sum(s);
#pragma unroll
            for (int j = 0; j < 8; ++j) o8[pr_ ? (size_t)((lane >> 4) + 4 * j) * 4096 : (size_t)64 * j] = (v2u){pk2(v[j].x, v[j].y), pk2(v[j].z, v[j].w)};
            if (lane == 0) RS[m] = rsqrtf(s * (1.0f / DM) + EPS);
        }
    }
    {
        float* CBP = (float*)(ws + WS_CBP);
        for (int it = gw; it < 64; it += NGW) { const int kv = it >> 5, eb = (it >> 4) & 1, kc = it & 15, e = eb * 64 + lane;
            const float* pos = kv ? C.in[IN_POSV] : C.in[IN_POSK]; const float* W = kv ? C.in[IN_WCV] : C.in[IN_WCK]; float a = 0.f;
#pragma unroll 8
            for (int k = kc * 256; k < kc * 256 + 256; ++k) a += pos[k] * W[(size_t)k * 128 + e];
            CBP[(kv * 16 + kc) * 128 + e] = a; }
    }
    {
        const float* w = C.in[IN_WSGU]; bf16* WMB = (bf16*)(ws + WS_WMB);
        for (int i = gw * 64 + lane; i < 8 * 128 * 128 / 8; i += NGW * 64) { const int e0 = i * 8, t = (e0 >> 7) & 127, s0 = e0 & 127; float f[8];
#pragma unroll
            for (int k = 0; k < 8; ++k) f[k] = (s0 + k <= t) ? w[e0 + k] : 0.f;
            *(GAS v4u*)(WMB + e0) = pack8f(f); }
        float* BL = (float*)(ws + WS_BLUT); const float* rb = C.in[IN_RELB];
        for (int i = gw * 64 + lane; i < 8 * 132; i += NGW * 64) { const int h = i / 132, rel = i % 132; const int bk = rel < 128 ? kBkt[rel] : 31; BL[i] = rb[bk * 8 + h] * LOG2E; }
    }
}

namespace epi {
using pg8::f32x4; using pg8::Unit; using pg8::cvt_pk_bf16;
typedef unsigned u32x4 __attribute__((ext_vector_type(4)));
__device__ __forceinline__ u32x4 pack8v(f32x4 a, f32x4 b) { u32x4 w; w.x = cvt_pk_bf16(a[0], a[1]); w.y = cvt_pk_bf16(a[2], a[3]); w.z = cvt_pk_bf16(b[0], b[1]); w.w = cvt_pk_bf16(b[2], b[3]); return w; }

struct EpiIn {
    static constexpr bool PERM = true, AFTER_DRAIN = false;
    const float* rstd; bf16* U; bf16* VG; float* VSS; float* QRAW; float* KVWR; bf16* GA; bf16* GB; float* GN; float* out; bf16* ACP;
    __device__ __forceinline__ void operator()(const f32x4 (&acc)[2][2][4][2], const Unit& u, int wr, int wc, int fr, int fq) const {
        const int row0 = u.pm * 256 + wr * 64 + fr, cl = wc * 32 + 8 * fq, pn = u.pn;
#pragma unroll
        for (int ai = 0; ai < 2; ++ai)
#pragma unroll
            for (int m = 0; m < 4; ++m) { const int row = row0 + ai * 128 + m * 16; const float rs = rstd[row];
#pragma unroll
                for (int bj = 0; bj < 2; ++bj) { f32x4 v0 = acc[ai][bj][m][0] * rs, v1 = acc[ai][bj][m][1] * rs; const int c = cl + bj * 128;
                    if (pn < 8) {
#pragma unroll
                        for (int k = 0; k < 4; ++k) { v0[k] = gelu_tanh(v0[k]); v1[k] = gelu_tanh(v1[k]); }
                        if (pn < 4) *(u32x4*)(U + (size_t)row * DG + pn * 256 + c) = pack8v(v0, v1);
                        else { *(u32x4*)(VG + (size_t)row * DG + (pn - 4) * 256 + c) = pack8v(v0, v1);
                            float ss = (v0[0] * v0[0] + v0[1] * v0[1]) + (v0[2] * v0[2] + v0[3] * v0[3]) + (v1[0] * v1[0] + v1[1] * v1[1]) + (v1[2] * v1[2] + v1[3] * v1[3]);
                            ss += __shfl_xor(ss, 16); ss += __shfl_xor(ss, 32);
                            if (fq == 0) VSS[(size_t)row * 32 + (pn - 4) * 8 + bj * 4 + wc] = ss; }
                    } else if (pn < 12) { float* q = QRAW + (size_t)row * DQ + (pn - 8) * 256 + c; *(f32x4*)q = v0; *(f32x4*)(q + 4) = v1;
                    } else if (pn < 16) {
                        const int cc = ((pn - 12) & 1) * 256 + c; float* o = nullptr;
                        if (row < MPROMPT) o = out + (pn < 14 ? O_PCMP : O_PSEL) + (size_t)row * 512 + cc;
                        else if (row < MREAL) o = out + (pn < 14 ? O_SCMP : O_SSEL) + (size_t)(row - MPROMPT) * 512 + cc;
                        if (o) { *(f32x4*)o = v0; *(f32x4*)(o + 4) = v1; }
                        if (pn < 14 && row < MPROMPT) {
                            const int b_ = row >> 12, t_ = row & 4095;
                            *(u32x4*)(ACP + tm_idx(((b_ * 2 + (cc >> 8)) * 2 + ((cc >> 7) & 1)) * 256 + (t_ >> 4), (t_ & 15) * 128 + (cc & 127), 2048 / 64)) = pack8v(v0, v1); }
                    } else if (pn < 18) { float* o = KVWR + (size_t)row * 512 + (pn - 16) * 256 + c; *(f32x4*)o = v0; *(f32x4*)(o + 4) = v1;
                    } else if (pn < 34) {
#pragma unroll
                        for (int k = 0; k < 4; ++k) { v0[k] = sigmoidf_(v0[k]); v1[k] = sigmoidf_(v1[k]); }
                        bf16* g = (pn < 26 ? GA + (size_t)row * DM + (pn - 18) * 256 : GB + (size_t)row * DM + (pn - 26) * 256) + c; *(u32x4*)g = pack8v(v0, v1);
                    } else { if (c < 24) {
#pragma unroll
                        for (int k = 0; k < 4; ++k) { v0[k] = sigmoidf_(v0[k]); v1[k] = sigmoidf_(v1[k]); }
                        float* o = GN + (size_t)row * 32 + c; *(f32x4*)o = v0; *(f32x4*)(o + 4) = v1; } }
                } }
    }
};
struct EpiCmp {
    static constexpr bool PERM = false, AFTER_DRAIN = false;
    float* YC; int segmask;
    __device__ __forceinline__ void operator()(const f32x4 (&acc)[2][2][4][2], const Unit& u, int wr, int wc, int fr, int fq) const {
        const int row0 = u.pm * 256 + wr * 64 + fr, cl = wc * 32 + 4 * fq;
#pragma unroll
        for (int ai = 0; ai < 2; ++ai)
#pragma unroll
            for (int m = 0; m < 4; ++m) { const int row = row0 + ai * 128 + m * 16;
#pragma unroll
                for (int n = 0; n < 2; ++n) { *(f32x4*)(YC + (size_t)row * 256 + cl + n * 16) = acc[ai][0][m][n];
                    if ((row & segmask) != 0) *(f32x4*)(YC + (size_t)(row - 1) * 256 + 128 + cl + n * 16) = acc[ai][1][m][n]; } }
    }
};
struct EpiMixA {
    static constexpr bool PERM = true, AFTER_DRAIN = false;
    const bf16* GA; bf16* MIXA;
    __device__ __forceinline__ void operator()(const f32x4 (&acc)[2][2][4][2], const Unit& u, int wr, int wc, int fr, int fq) const {
        const int row0 = u.pm * 256 + wr * 64 + fr, c0 = u.pn * 256 + wc * 32 + 8 * fq;
#pragma unroll
        for (int ai = 0; ai < 2; ++ai) { v4u gv[4][2];
#pragma unroll
            for (int m = 0; m < 4; ++m)
#pragma unroll
                for (int bj = 0; bj < 2; ++bj) gv[m][bj] = *(const v4u*)(GA + (size_t)(row0 + ai * 128 + m * 16) * DM + c0 + bj * 128);
#pragma unroll
            for (int m = 0; m < 4; ++m) { const size_t ro = (size_t)(row0 + ai * 128 + m * 16) * DM;
#pragma unroll
                for (int bj = 0; bj < 2; ++bj) { const size_t o = ro + c0 + bj * 128; float g[8]; unpack8(gv[m][bj], g);
                    f32x4 v0 = acc[ai][bj][m][0], v1 = acc[ai][bj][m][1];
                    v0[0] *= g[0]; v0[1] *= g[1]; v0[2] *= g[2]; v0[3] *= g[3]; v1[0] *= g[4]; v1[1] *= g[5]; v1[2] *= g[6]; v1[3] *= g[7];
                    *(u32x4*)(MIXA + o) = pack8v(v0, v1); } } }
    }
};
struct EpiMixB {
    static constexpr bool PERM = true, AFTER_DRAIN = false;
    const bf16* GB; const bf16* MIXA; bf16* MIX;
    __device__ __forceinline__ void operator()(const f32x4 (&acc)[2][2][4][2], const Unit& u, int wr, int wc, int fr, int fq) const {
        const int row0 = u.pm * 256 + wr * 64 + fr, c0 = u.pn * 256 + wc * 32 + 8 * fq;
#pragma unroll
        for (int ai = 0; ai < 2; ++ai) { v4u gv[4][2], av[4][2];
#pragma unroll
            for (int m = 0; m < 4; ++m)
#pragma unroll
                for (int bj = 0; bj < 2; ++bj) { const size_t o = (size_t)(row0 + ai * 128 + m * 16) * DM + c0 + bj * 128; gv[m][bj] = *(const v4u*)(GB + o); av[m][bj] = *(const v4u*)(MIXA + o); }
#pragma unroll
            for (int m = 0; m < 4; ++m)
#pragma unroll
                for (int bj = 0; bj < 2; ++bj) { float g[8], a[8]; unpack8(gv[m][bj], g); unpack8(av[m][bj], a);
                    f32x4 v0 = acc[ai][bj][m][0], v1 = acc[ai][bj][m][1];
                    v0[0] = a[0] + v0[0] * g[0]; v0[1] = a[1] + v0[1] * g[1]; v0[2] = a[2] + v0[2] * g[2]; v0[3] = a[3] + v0[3] * g[3];
                    v1[0] = a[4] + v1[0] * g[4]; v1[1] = a[5] + v1[1] * g[5]; v1[2] = a[6] + v1[2] * g[6]; v1[3] = a[7] + v1[3] * g[7];
                    *(u32x4*)(MIX + tm_idx(row0 + ai * 128 + m * 16, c0 + bj * 128, DM / 64)) = pack8v(v0, v1); } }
    }
};
struct EpiOut {
    static constexpr bool PERM = true, AFTER_DRAIN = false;
    const float* xp; const float* xs; float* out; bf16* X1B; float* SS;
    __device__ __forceinline__ void operator()(const f32x4 (&acc)[2][2][4][2], const Unit& u, int wr, int wc, int fr, int fq) const {
        const int row0 = u.pm * 256 + wr * 64 + fr, c0 = u.pn * 256 + wc * 32 + 8 * fq;
#pragma unroll
        for (int ai = 0; ai < 2; ++ai) { f32x4 xv[4][2][2];
#pragma unroll
            for (int m = 0; m < 4; ++m)
#pragma unroll
                for (int bj = 0; bj < 2; ++bj) { const float* xr = xp + (size_t)(row0 + ai * 128 + m * 16) * DM + c0 + bj * 128; xv[m][bj][0] = *(const f32x4*)xr; xv[m][bj][1] = *(const f32x4*)(xr + 4); }
#pragma unroll
            for (int m = 0; m < 4; ++m) { const int row = row0 + ai * 128 + m * 16; float ss = 0.f;
#pragma unroll
                for (int bj = 0; bj < 2; ++bj) { const int c = c0 + bj * 128; const f32x4 v0 = acc[ai][bj][m][0] + xv[m][bj][0], v1 = acc[ai][bj][m][1] + xv[m][bj][1];
                    *(u32x4*)(X1B + tm_idx(row, c, DM / 64)) = pack8v(v0, v1);
                    ss += (v0[0] * v0[0] + v0[1] * v0[1]) + (v0[2] * v0[2] + v0[3] * v0[3]) + (v1[0] * v1[0] + v1[1] * v1[1]) + (v1[2] * v1[2] + v1[3] * v1[3]); }
                ss += __shfl_xor(ss, 16); ss += __shfl_xor(ss, 32);
                if (fq == 0) SS[(size_t)row * 32 + u.pn * 4 + wc] = ss; } }
    }
};
struct EpiUp {
    static constexpr bool PERM = true, AFTER_DRAIN = false;
    const float* SS; bf16* H;
    __device__ __forceinline__ void operator()(const f32x4 (&acc)[2][2][4][2], const Unit& u, int wr, int wc, int fr, int fq) const {
        const int row0 = u.pm * 256 + wr * 64 + fr, c0 = u.pn * 256 + wc * 32 + 8 * fq;
#pragma unroll
        for (int ai = 0; ai < 2; ++ai)
#pragma unroll
            for (int m = 0; m < 4; ++m) { const int row = row0 + ai * 128 + m * 16; const f32x4* sp = (const f32x4*)(SS + (size_t)row * 32) + 2 * fq;
                const f32x4 s4 = sp[0] + sp[1]; float st = (s4[0] + s4[1]) + (s4[2] + s4[3]); st += __shfl_xor(st, 16); st += __shfl_xor(st, 32);
                const float rs = rsqrtf(st * (1.0f / DM) + EPS);
#pragma unroll
                for (int bj = 0; bj < 2; ++bj) { f32x4 v0 = acc[ai][bj][m][0] * rs, v1 = acc[ai][bj][m][1] * rs;
#pragma unroll
                    for (int k = 0; k < 4; ++k) { const float a = fmaxf(v0[k], 0.f), b = fmaxf(v1[k], 0.f); v0[k] = a * a; v1[k] = b * b; }
                    { const int col = c0 + bj * 128; *(u32x4*)(H + ((size_t)((row >> 8) * (DFF / 64) + (col >> 6)) * 256 + (row & 255)) * 64 + (col & 63)) = pack8v(v0, v1); } } }
    }
};
struct EpiDown {
    static constexpr bool PERM = true, AFTER_DRAIN = false;
    float* out; const bf16* X1B;
    __device__ __forceinline__ void operator()(const f32x4 (&acc)[2][2][4][2], const Unit& u, int wr, int wc, int fr, int fq) const {
        const int row0 = u.pm * 256 + wr * 64 + fr, c0 = u.pn * 256 + wc * 32 + 8 * fq;
#pragma unroll
        for (int ai = 0; ai < 2; ++ai) { u32x4 xv[4][2];
#pragma unroll
            for (int m = 0; m < 4; ++m)
#pragma unroll
                for (int bj = 0; bj < 2; ++bj) xv[m][bj] = *(const u32x4*)(X1B + tm_idx(row0 + ai * 128 + m * 16, c0 + bj * 128, DM / 64));
#pragma unroll
            for (int m = 0; m < 4; ++m)
#pragma unroll
                for (int bj = 0; bj < 2; ++bj) { float* p = out + O_YP + (size_t)(row0 + ai * 128 + m * 16) * DM + c0 + bj * 128; const u32x4 w = xv[m][bj];
                    const f32x4 x0 = {__uint_as_float(w.x << 16), __uint_as_float(w.x & 0xffff0000u), __uint_as_float(w.y << 16), __uint_as_float(w.y & 0xffff0000u)};
                    const f32x4 x1 = {__uint_as_float(w.z << 16), __uint_as_float(w.z & 0xffff0000u), __uint_as_float(w.w << 16), __uint_as_float(w.w & 0xffff0000u)};
                    *(f32x4*)p = x0 + acc[ai][bj][m][0]; *(f32x4*)(p + 4) = x1 + acc[ai][bj][m][1]; } }
    }
};
struct CmpOrder {
    int n, G, c, shift;
    __device__ __forceinline__ bool next(int i, Unit& u) const { const int L = i * G + c; if (L >= n) return false; u.pm = L; u.pn = (L >> shift) & 1; return true; }
    __device__ __forceinline__ void a_ready(const Unit&) const {}
    __device__ __forceinline__ void done(const Unit&) const {}
};
}

__device__ __forceinline__ float grp_sum8(float v) { v += __shfl_xor(v, 1); v += __shfl_xor(v, 2); v += __shfl_xor(v, 4); return v; }
__device__ __forceinline__ float grp_sum16(float v) { v = grp_sum8(v); v += __shfl_xor(v, 8); return v; }
__device__ __forceinline__ float grp_sum32(float v) { v = grp_sum16(v); v += __shfl_xor(v, 16); return v; }

__device__ __forceinline__ void p2_post(const Ctx& C, int idx, int nblk) {
    unsigned char* ws = C.ws; const int gw = idx * NWAVES + C.wave, NGW = nblk * NWAVES, lane = C.lane;
    const float* QRAW = (const float*)(ws + WS_QRAW); bf16* QN = (bf16*)(ws + WS_QN); const float* KVWR = (const float*)(ws + WS_KVWR);
    const float* gq = C.in[IN_GQ]; const float* gk = C.in[IN_GK];
    const int kv = lane >> 5, g = (lane >> 4) & 1, d = (lane & 15) * 8;
    for (int row = gw; row < MREAL; row += NGW) {
        const bool pr = row < MPROMPT; const int b = row >> 12, t = row & 4095, bs = row - MPROMPT;
        const GAS f32x4* q4 = (const GAS f32x4*)(QRAW + (size_t)row * DQ + lane * 16); f32x4 v[4];
#pragma unroll
        for (int j2 = 0; j2 < 4; ++j2) v[j2] = q4[j2];
        const float* wsrc = KVWR + (size_t)row * 512 + lane * 8; const f32x4 wa = *(const GAS f32x4*)wsrc, wc2 = *(const GAS f32x4*)(wsrc + 4);
        f32x4 sa = {0.f, 0.f, 0.f, 0.f}, sc2 = sa;
        if (pr) { const float* ssrc = C.out + O_PSEL + (size_t)row * 512 + lane * 8; sa = *(const GAS f32x4*)ssrc; sc2 = *(const GAS f32x4*)(ssrc + 4);
 }
        float vs = lane < 32 ? ((const float*)(ws + WS_VSS))[(size_t)row * 32 + lane] : 0.f;
        { float ss = 0.f;
#pragma unroll
          for (int j2 = 0; j2 < 4; ++j2) ss += (v[j2].x * v[j2].x + v[j2].y * v[j2].y) + (v[j2].z * v[j2].z + v[j2].w * v[j2].w);
          ss = grp_sum8(ss); const float rs = rsqrtf(ss * (1.0f / 128) + EPS) * QSCALE; const float* gg = gq + (lane & 7) * 16; float f[16];
#pragma unroll
          for (int j2 = 0; j2 < 4; ++j2) { f[4 * j2] = v[j2].x * rs * gg[4 * j2]; f[4 * j2 + 1] = v[j2].y * rs * gg[4 * j2 + 1]; f[4 * j2 + 2] = v[j2].z * rs * gg[4 * j2 + 2]; f[4 * j2 + 3] = v[j2].w * rs * gg[4 * j2 + 3]; }
          GAS v4u* o = (GAS v4u*)(QN + (size_t)row * DQ + lane * 16);
          o[0] = (v4u){pk2(f[0], f[1]), pk2(f[2], f[3]), pk2(f[4], f[5]), pk2(f[6], f[7])}; o[1] = (v4u){pk2(f[8], f[9]), pk2(f[10], f[11]), pk2(f[12], f[13]), pk2(f[14], f[15])}; }
        if (pr) { float ss = (sa.x * sa.x + sa.y * sa.y) + (sa.z * sa.z + sa.w * sa.w) + (sc2.x * sc2.x + sc2.y * sc2.y) + (sc2.z * sc2.z + sc2.w * sc2.w); ss = grp_sum16(ss);
            const float rs = kv == 0 ? rsqrtf(ss * (1.0f / 128) + EPS) : 1.f; const float* gg = gk + 128 + d; float f[8] = {sa.x, sa.y, sa.z, sa.w, sc2.x, sc2.y, sc2.z, sc2.w};
#pragma unroll
            for (int k = 0; k < 8; ++k) f[k] = kv == 0 ? f[k] * rs * gg[k] : f[k];
            bf16* dst = (bf16*)(ws + (kv == 0 ? WS_KS : WS_VS)) + ((size_t)(b * 2 + g) * T + t) * 128 + d; *(GAS v4u*)dst = pack8f(f); }
        if (pr) { float ss = (wa.x * wa.x + wa.y * wa.y) + (wa.z * wa.z + wa.w * wa.w) + (wc2.x * wc2.x + wc2.y * wc2.y) + (wc2.z * wc2.z + wc2.w * wc2.w); ss = grp_sum16(ss);
            const float rs = kv == 0 ? rsqrtf(ss * (1.0f / 128) + EPS) : 1.f; const float* gg = gk + 256 + d; float f[8] = {wa.x, wa.y, wa.z, wa.w, wc2.x, wc2.y, wc2.z, wc2.w};
#pragma unroll
            for (int k = 0; k < 8; ++k) f[k] = kv == 0 ? f[k] * rs * gg[k] : f[k];
            bf16* dst = (bf16*)(ws + (kv == 0 ? WS_KW : WS_VW)) + ((size_t)(b * 2 + g) * T + t) * 128 + d; *(GAS v4u*)dst = pack8f(f);
            if (t >= T - 512) { float* o = C.out + O_PWIN + ((size_t)b * 512 + (t - (T - 512))) * 512 + lane * 8; *(GAS f32x4*)o = wa; *(GAS f32x4*)(o + 4) = wc2; }
        } else { float* o = C.out + O_SWIN + ((size_t)bs * 512 + 511) * 512 + lane * 8; *(GAS f32x4*)o = wa; *(GAS f32x4*)(o + 4) = wc2; }
        { vs = wave_sum(vs); if (lane == 0) ((float*)(ws + WS_RSTDV))[row] = rsqrtf(vs * (1.0f / DG) + EPS); }
    }
}

__device__ __forceinline__ float shx(float v, int mask, int lane) { return __int_as_float(__builtin_amdgcn_ds_bpermute((lane ^ mask) << 2, __float_as_int(v))); }
template <bool WT = false>
__device__ __forceinline__ void cmp_combine_rows(const Ctx& C, bool pr, int row0, int nrows) {
    unsigned char* ws = C.ws; const int hw = C.wave * 2 + (C.lane >> 5), l32 = C.lane & 31, e = l32 * 4;
    const float* CBP = (const float*)(ws + WS_CBP); const float* gk0 = C.in[IN_GK];
    f32x4 cb0 = {0.f, 0.f, 0.f, 0.f}, cb1 = {0.f, 0.f, 0.f, 0.f};
#pragma unroll
    for (int kc = 0; kc < 16; ++kc) { cb0 += *(const GAS f32x4*)(CBP + kc * 128 + e); cb1 += *(const GAS f32x4*)(CBP + (16 + kc) * 128 + e); }
    const f32x4 g4 = *(const GAS f32x4*)(gk0 + e);
    const int segs = pr ? 256 : 128;
    for (int rr = row0 + hw; rr < row0 + nrows; rr += 16) {
        const int j = rr & (segs - 1), grp = rr / segs, g = grp & 1, kv = (grp >> 1) & 1, b = grp >> 2;
        const float* Y = (const float*)(ws + (pr ? WS_YCP : WS_YCS)) + (size_t)rr * 256;
        f32x4 v = {0.f, 0.f, 0.f, 0.f};
        if (j < segs - 1) { v = *(const GAS f32x4*)(Y + e) + *(const GAS f32x4*)(Y + 128 + e) + (kv ? cb1 : cb0); }
        float ss = (v.x * v.x + v.y * v.y) + (v.z * v.z + v.w * v.w);
#pragma unroll
        for (int o = 1; o < 32; o <<= 1) ss += shx(ss, o, C.lane);
        if (kv == 0) { const float rs = rsqrtf(ss * (1.0f / 128) + EPS); v = v * rs * g4; }
        bf16* dst = (bf16*)(ws + (pr ? (kv ? WS_VCP : WS_KCP) : (kv ? WS_VCS : WS_KCS))) + ((size_t)(b * 2 + g) * segs + j) * 128 + e;
        if (WT) __hip_atomic_store((gu64*)dst, ((unsigned long long)pk2(v.z, v.w) << 32) | pk2(v.x, v.y), RLX_AGENT); else *(GAS v2u*)dst = (v2u){pk2(v.x, v.y), pk2(v.z, v.w)};
    }
}

typedef short s16x4 __attribute__((ext_vector_type(4)));
typedef float f32x16 __attribute__((ext_vector_type(16)));
__device__ __forceinline__ int v_st(int k, int c) { const int kk = (k & ~0xC) | ((k & 4) << 1) | ((k & 8) >> 1); return ((kk >> 3) * 4 + (c >> 5)) * 512 + ((kk & 7) * 32 + (c & 31)) * 2; }
__device__ __forceinline__ int v_rd_base(int lane) { return ((lane & 3) << 3) | (((lane >> 2) & 3) << 6) | (((lane >> 4) & 1) << 5) | (((lane >> 5) & 1) << 8); }
constexpr int v_rd_off(int d0, int ks, int half) { return d0 * 512 + ks * 4096 + half * 2048; }
__device__ __forceinline__ int crow(int r, int hi) { return (r & 3) + 8 * (r >> 2) + 4 * hi; }
#define SBAR() __builtin_amdgcn_sched_barrier(0)
__device__ __forceinline__ void pv_tile(f32x16* o, int vb0, bf16x8 pa0, bf16x8 pa1, bf16x8 pa2, bf16x8 pa3) {
#define TRRD(dst, off) asm volatile("ds_read_b64_tr_b16 %0, %1 offset:%2" : "=&v"(dst) : "v"(vb0), "i"(off) : "memory")
#define PV_D0(d0) do { s16x4 l0, l1, l2, l3, h0, h1, h2, h3; constexpr int b_ = v_rd_off(d0, 0, 0); \
        TRRD(l0, b_); TRRD(h0, b_ + 2048); TRRD(l1, b_ + 4096); TRRD(h1, b_ + 6144); TRRD(l2, b_ + 8192); TRRD(h2, b_ + 10240); TRRD(l3, b_ + 12288); TRRD(h3, b_ + 14336); \
        asm volatile("s_waitcnt lgkmcnt(0)" ::: "memory"); SBAR(); \
        o[d0] = __builtin_amdgcn_mfma_f32_32x32x16_bf16(pa0, (bf16x8){l0[0], l0[1], l0[2], l0[3], h0[0], h0[1], h0[2], h0[3]}, o[d0], 0, 0, 0); \
        o[d0] = __builtin_amdgcn_mfma_f32_32x32x16_bf16(pa1, (bf16x8){l1[0], l1[1], l1[2], l1[3], h1[0], h1[1], h1[2], h1[3]}, o[d0], 0, 0, 0); \
        o[d0] = __builtin_amdgcn_mfma_f32_32x32x16_bf16(pa2, (bf16x8){l2[0], l2[1], l2[2], l2[3], h2[0], h2[1], h2[2], h2[3]}, o[d0], 0, 0, 0); \
        o[d0] = __builtin_amdgcn_mfma_f32_32x32x16_bf16(pa3, (bf16x8){l3[0], l3[1], l3[2], l3[3], h3[0], h3[1], h3[2], h3[3]}, o[d0], 0, 0, 0); } while (0)
    PV_D0(0); PV_D0(1); PV_D0(2); PV_D0(3);
#undef PV_D0
#undef TRRD
}

__device__ __forceinline__ float rstd_v(const float* VSS, int row) { const GAS f32x4* p = (const GAS f32x4*)(VSS + (size_t)row * 32); f32x4 s = p[0];
#pragma unroll
    for (int k = 1; k < 8; ++k) s += p[k];
    return rsqrtf(((s.x + s.y) + (s.z + s.w)) * (1.0f / DG) + EPS); }
__device__ __forceinline__ void p4_sgu(const Ctx& C, int idx, int nblk) {
    unsigned char* ws = C.ws; const int tid = C.tid, lane = C.lane, wave = C.wave, r32 = lane & 31, hi = lane >> 5;
    const bf16* U = (const bf16*)(ws + WS_U); const bf16* VG = (const bf16*)(ws + WS_VG); const float* VSS = (const float*)(ws + WS_VSS);
    const bf16* WMB = (const bf16*)(ws + WS_WMB); bf16* OA = (bf16*)(ws + WS_OA);
    const float* gs = C.in[IN_GSGU]; const float* bs = C.in[IN_BSGU];
    LAS unsigned char* Vl = C.lds + RING_OFF;
    for (int unit = idx; unit < 256; unit += nblk) {
        const int n = unit >> 2, gp = unit & 3, rowbase = n * 128; const bool last = (n & 31) == 31; const int bb = n >> 5;
        __syncthreads();
        { const int sr = tid >> 4, sc = (tid & 15) * 8;
#pragma unroll
          for (int gl = 0; gl < 2; ++gl) { const int g = gp * 2 + gl; float gg[8];
#pragma unroll
              for (int k = 0; k < 8; ++k) gg[k] = gs[g * 128 + sc + k];
#pragma unroll
              for (int q = 0; q < 4; ++q) { const int s = q * 32 + sr, st = s >> 6, row = rowbase + s; float f[8];
                  unpack8(*(const GAS v4u*)(VG + (size_t)row * DG + g * 128 + sc), f); const float rs = rstd_v(VSS, row);
#pragma unroll
                  for (int k = 0; k < 8; ++k) f[k] = f[k] * rs * gg[k];
                  *(LAS v4u*)(Vl + (gl * 2 + st) * 16384 + v_st(s & 63, sc)) = pack8f(f);
                  if (last) { float* o = C.out + O_PSGU + ((size_t)bb * 128 + s) * DG + g * 128 + sc; *(GAS f32x4*)o = (f32x4){f[0], f[1], f[2], f[3]}; *(GAS f32x4*)(o + 4) = (f32x4){f[4], f[5], f[6], f[7]}; } } } }
        __syncthreads();
        const int tb = wave & 3, gl = wave >> 2, g = gp * 2 + gl;
        f32x16 o[4];
#pragma unroll
        for (int d0 = 0; d0 < 4; ++d0)
#pragma unroll
            for (int r = 0; r < 16; ++r) o[d0][r] = 0.f;
#pragma unroll
        for (int st = 0; st < 2; ++st) if (64 * st <= 32 * tb + 31) {
            const bf16* wp = WMB + ((size_t)g * 128 + tb * 32 + r32) * 128 + st * 64 + hi * 8;
            const bf16x8 pa0 = *(const GAS bf16x8*)(wp), pa1 = *(const GAS bf16x8*)(wp + 16), pa2 = *(const GAS bf16x8*)(wp + 32), pa3 = *(const GAS bf16x8*)(wp + 48);
            const int vb0 = (int)(unsigned)(uintptr_t)(Vl + (gl * 2 + st) * 16384) + v_rd_base(lane);
            pv_tile(o, vb0, pa0, pa1, pa2, pa3);
        }
#pragma unroll
        for (int r = 0; r < 16; ++r) { const int trow = tb * 32 + crow(r, hi); const float bv = bs[g * 128 + trow]; const size_t ro = (size_t)(rowbase + trow) * DG + g * 128, roa = (size_t)(rowbase + trow) * LD1 + g * 128;
#pragma unroll
            for (int d0 = 0; d0 < 4; ++d0) { const int c = d0 * 32 + r32; const float v = (o[d0][r] + bv) * bf2f(U[ro + c]); const float vn = __shfl_xor(v, 1);
                if ((r32 & 1) == 0) *(GAS unsigned*)(OA + tm_idx(rowbase + trow, g * 128 + c, DG / 64)) = pk2(v, vn); } }
    }
    { const int gt = idx * 512 + tid, NT = nblk * 512; const float* w = C.in[IN_WSGU];
      for (int i = gt; i < MSAMP * DG / 8; i += NT) { const int r = i >> 7, c = (i & 127) * 8, row = MPROMPT + r, g = c >> 7; float f[8], uu[8];
          unpack8(*(const GAS v4u*)(VG + (size_t)row * DG + c), f); unpack8(*(const GAS v4u*)(U + (size_t)row * DG + c), uu); const float rs = rstd_v(VSS, row), w00 = w[g * 16384], b0 = bs[g * 128];
#pragma unroll
          for (int k = 0; k < 8; ++k) { f[k] = f[k] * rs * gs[c + k]; uu[k] = uu[k] * (w00 * f[k] + b0); }
          float* o = C.out + O_SSGU + (size_t)r * DG + c; *(GAS f32x4*)o = (f32x4){f[0], f[1], f[2], f[3]}; *(GAS f32x4*)(o + 4) = (f32x4){f[4], f[5], f[6], f[7]};
          *(GAS v4u*)((bf16*)(ws + WS_SOA) + (size_t)r * LDS_G + c) = pack8f(uu); } }
}

struct AttItem { const bf16* q; int t; int ncmp; const bf16* kc; const bf16* vc; int nblk; const float* gates; bf16* out; const float* blut; };

__device__ __forceinline__ void ld8f(const float* p, float (&f)[8]) { const f32x4 a = *(const GAS f32x4*)p, b = *(const GAS f32x4*)(p + 4); f[0] = a.x; f[1] = a.y; f[2] = a.z; f[3] = a.w; f[4] = b.x; f[5] = b.y; f[6] = b.z; f[7] = b.w; }
struct PromptKV {
    const bf16 *ks, *vs, *kw, *vw;
    static constexpr bool NORM = false;
    __device__ __forceinline__ void selK(int pos, int d8, float (&k)[8]) const { unpack8(*(const GAS v4u*)(ks + (size_t)pos * 128 + d8), k); }
    __device__ __forceinline__ void selV(int pos, int d8, float (&k)[8]) const { unpack8(*(const GAS v4u*)(vs + (size_t)pos * 128 + d8), k); }
    __device__ __forceinline__ void winK(int pos, int d8, float (&k)[8]) const { unpack8(*(const GAS v4u*)(kw + (size_t)pos * 128 + d8), k); }
    __device__ __forceinline__ void winV(int pos, int d8, float (&k)[8]) const { unpack8(*(const GAS v4u*)(vw + (size_t)pos * 128 + d8), k); }
};
struct SampleKV {
    const float* csel; const int* pt; const float* nsel; const float* win; const float* nwin;
    static constexpr bool NORM = true;
    __device__ __forceinline__ const float* selp(int pos) const { return pos < PASTLEN ? csel + ((size_t)pt[pos >> 7] * 128 + (pos & 127)) * 512 : nsel; }
    __device__ __forceinline__ const float* winp(int pos) const { return pos < PASTLEN ? win + (size_t)(pos - (PASTLEN - 512)) * 512 : nwin; }
    __device__ __forceinline__ void selK(int pos, int d8, float (&k)[8]) const { ld8f(selp(pos) + d8, k); }
    __device__ __forceinline__ void selV(int pos, int d8, float (&k)[8]) const { ld8f(selp(pos) + 256 + d8, k); }
    __device__ __forceinline__ void winK(int pos, int d8, float (&k)[8]) const { ld8f(winp(pos) + d8, k); }
    __device__ __forceinline__ void winV(int pos, int d8, float (&k)[8]) const { ld8f(winp(pos) + 256 + d8, k); }
};
#define DPP_ADD(x, ctrl) ((x) + __int_as_float(__builtin_amdgcn_update_dpp(0, __float_as_int(x), (ctrl), 0xF, 0xF, true)))
__device__ __forceinline__ float row_sum16(float x) { x = DPP_ADD(x, 0xB1); x = DPP_ADD(x, 0x4E); x = DPP_ADD(x, 0x141); x = DPP_ADD(x, 0x140); return x; }
template <bool NORM>
__device__ __forceinline__ void score4(const float (&k)[8], const float (&gkv)[8], const float (&q)[4][8], float (&s)[4]) {
    float kk[8]; float ss = 0.f;
#pragma unroll
    for (int i = 0; i < 8; ++i) { if (NORM) { ss += k[i] * k[i]; kk[i] = k[i] * gkv[i]; } else kk[i] = k[i]; }
#pragma unroll
    for (int h = 0; h < 4; ++h) { float a = 0.f;
#pragma unroll
        for (int i = 0; i < 8; ++i) a += q[h][i] * kk[i];
        s[h] = row_sum16(a); }
    if (NORM) { ss = row_sum16(ss); const float rs = rsqrtf(ss * (1.0f / 128) + EPS);
#pragma unroll
        for (int h = 0; h < 4; ++h) s[h] *= rs; }
}
__device__ __forceinline__ void online4(const float (&s)[4], bool valid, float (&m)[4], float (&l)[4], float (&o)[4][8], const float (&v)[8]) {
#pragma unroll
    for (int h = 0; h < 4; ++h) { const float sv = valid ? s[h] : -__builtin_inff(); const float mn = fmaxf(m[h], sv);
        const float al = __builtin_amdgcn_exp2f(m[h] - mn), p = __builtin_amdgcn_exp2f(sv - mn); m[h] = mn; l[h] = l[h] * al + p;
#pragma unroll
        for (int i = 0; i < 8; ++i) o[h][i] = o[h][i] * al + p * v[i]; }
}
__device__ __forceinline__ void merge_store(float (&m)[4], float (&l)[4], float (&o)[4][8], LAS float* Cmb, int wave, int lane) {
#pragma unroll
    for (int h = 0; h < 4; ++h) { float M = fmaxf(m[h], __shfl_xor(m[h], 16)); M = fmaxf(M, __shfl_xor(M, 32));
        const float sc = __builtin_amdgcn_exp2f(m[h] - M); float ll = l[h] * sc; ll += __shfl_xor(ll, 16); ll += __shfl_xor(ll, 32);
        LAS float* dst = Cmb + (wave * 4 + h) * 132;
#pragma unroll
        for (int i = 0; i < 8; ++i) { float x = o[h][i] * sc; x += __shfl_xor(x, 16); x += __shfl_xor(x, 32); if (lane < 16) dst[lane * 8 + i] = x; }
        if (lane == 0) { dst[128] = M; dst[129] = ll; } }
}
__device__ __forceinline__ float combine8(const LAS float* Cmb, int hh, int dd) {
    float M = -1e30f;
#pragma unroll
    for (int w = 0; w < 8; ++w) M = fmaxf(M, Cmb[(w * 4 + hh) * 132 + 128]);
    float L = 0.f, O = 0.f;
#pragma unroll
    for (int w = 0; w < 8; ++w) { const LAS float* p = Cmb + (w * 4 + hh) * 132; const float sc = __builtin_amdgcn_exp2f(p[128] - M); L += p[129] * sc; O += p[dd] * sc; }
    return L > 0.f ? O / L : 0.f;
}

template <class KV, bool WIN>
__device__ __forceinline__ void nsa_stream(const KV& kv, int total, int wave, int grp, int d8, int t, int wlo, const LAS int* sl, const float (&gkv)[8], const float (&q)[4][8],
                                           const float* blut, float (&m)[4], float (&l)[4], float (&o)[4][8]) {
    const int nper = total > wave ? (total - wave + 7) >> 3 : 0;
    float kA[2][8], vA[2][8], kB[2][8], vB[2][8]; int ppA[2], ppB[2]; bool okA[2], okB[2];
#define NS_LOAD(K_, V_, PP_, OK_, i0_) do { _Pragma("unroll") for (int u = 0; u < 2; ++u) { const int ch = wave + 8 * ((i0_) + u); const bool in = (i0_) + u < nper; \
            int pos; if (WIN) pos = wlo + ch * 4 + grp; else pos = sl[in ? (ch >> 4) : 0] * 64 + (ch & 15) * 4 + grp; \
            OK_[u] = in && pos <= t; PP_[u] = OK_[u] ? pos : t; \
            if (WIN) { kv.winK(PP_[u], d8, K_[u]); kv.winV(PP_[u], d8, V_[u]); } else { kv.selK(PP_[u], d8, K_[u]); kv.selV(PP_[u], d8, V_[u]); } } } while (0)
#define NS_COMP(K_, V_, PP_, OK_, i0_) do { _Pragma("unroll") for (int u = 0; u < 2; ++u) if ((i0_) + u < nper) { float sc[4]; score4<KV::NORM>(K_[u], gkv, q, sc); \
            const int rel = t - PP_[u]; const int ri = rel > 128 ? 128 : rel; \
            _Pragma("unroll") for (int h = 0; h < 4; ++h) sc[h] += blut[h * 132 + ri]; \
            online4(sc, OK_[u], m, l, o, V_[u]); } } while (0)
    if (nper > 0) NS_LOAD(kA, vA, ppA, okA, 0);
    for (int i0 = 0; i0 < nper; i0 += 4) {
        if (i0 + 2 < nper) NS_LOAD(kB, vB, ppB, okB, i0 + 2);
        NS_COMP(kA, vA, ppA, okA, i0);
        if (i0 + 4 < nper) NS_LOAD(kA, vA, ppA, okA, i0 + 4);
        if (i0 + 2 < nper) NS_COMP(kB, vB, ppB, okB, i0 + 2);
    }
#undef NS_LOAD
#undef NS_COMP
}

template <class KV>
__device__ __forceinline__ void nsa_item(const Ctx& C, const AttItem& it, const KV& kv, const float* gk1, const float* gk2) {
    const int tid = C.tid, lane = C.lane, wave = C.wave, grp = lane >> 4, d8 = (lane & 15) * 8, t = it.t;
    LAS float* Sc = (LAS float*)(C.lds + RING_OFF);
    LAS float* Cmb = (LAS float*)(C.lds + RING_OFF + 4096);
    LAS int* sl = (LAS int*)(C.lds + RING_OFF + 4096 + 16896);
    const float NEG = -__builtin_inff();
    float q[4][8];
#pragma unroll
    for (int h = 0; h < 4; ++h) unpack8(*(const GAS v4u*)(it.q + h * 128 + d8), q[h]);
    const int hh = tid >> 7, dd = tid & 127;
    const float g0 = it.gates[hh * 3 + 0], g1 = it.gates[hh * 3 + 1], g2 = it.gates[hh * 3 + 2];
    float res = 0.f;
    float m[4], l[4], o[4][8], gkv[8];
#pragma unroll
    for (int i = 0; i < 8; ++i) gkv[i] = 1.f;

    int nvis = t >= 31 ? (t - 31) / 16 + 1 : 0; if (nvis > it.ncmp) nvis = it.ncmp;
    const int nch = (nvis + 3) >> 2;
    for (int ch = wave; ch < 64; ch += 8) {
        const int c = ch * 4 + grp; float s[4] = {NEG, NEG, NEG, NEG};
        if (ch < nch) {
            const bool valid = c < nvis; const int cc = valid ? c : 0; float k[8]; unpack8(*(const GAS v4u*)(it.kc + (size_t)cc * 128 + d8), k);
            float sc[4]; score4<false>(k, gkv, q, sc);
            const int rel = t - (16 * c + 31); const int ri = rel < 0 ? 0 : (rel > 128 ? 128 : rel);
#pragma unroll
            for (int h = 0; h < 4; ++h) s[h] = valid ? sc[h] + it.blut[h * 132 + ri] : NEG;
        }
        if ((lane & 15) == 0) {
#pragma unroll
            for (int h = 0; h < 4; ++h) Sc[h * 256 + c] = s[h]; }
    }
    __syncthreads();
    float mh[4], il[4];
#pragma unroll
    for (int h = 0; h < 4; ++h) { const f32x4 v = *(const LAS f32x4*)(Sc + h * 256 + lane * 4); float mx = fmaxf(fmaxf(v.x, v.y), fmaxf(v.z, v.w)); mx = fmaxf(wave_max(mx), -1e30f);
        float e = (__builtin_amdgcn_exp2f(v.x - mx) + __builtin_amdgcn_exp2f(v.y - mx)) + (__builtin_amdgcn_exp2f(v.z - mx) + __builtin_amdgcn_exp2f(v.w - mx)); e = wave_sum(e);
        mh[h] = mx; il[h] = e > 0.f ? 1.0f / e : 0.f; }
    float imp = 0.f;
#pragma unroll
    for (int h = 0; h < 4; ++h) { float a = 0.f;
#pragma unroll
        for (int k = 0; k < 5; ++k) { const int c = 4 * lane - 1 + k; if (c >= 0) a += __builtin_amdgcn_exp2f(Sc[h * 256 + c] - mh[h]); }
        imp += a * il[h]; }
    unsigned long long mask;
    { const int j = lane, cur = t >> 6; const bool forced = (j == 0) || (j == cur) || (j == cur - 1), elig = 64 * j <= t, exists = j < it.nblk;
      const float val = exists ? (forced ? 1e6f : (elig ? imp : -1.f)) : -2.f; int rank = 0;
      const int key = (int)((__float_as_uint(val) & ~63u) | (unsigned)(63 - j));
#pragma unroll
      for (int jp = 0; jp < 64; ++jp) rank += (__builtin_amdgcn_readlane(key, jp) > key) ? 1 : 0;
      const bool sel_ = rank < 16 && elig && exists; mask = __ballot(sel_);
      if (wave == 0 && sel_) sl[__builtin_popcountll(mask & ((1ull << j) - 1ull))] = j; }
#pragma unroll
    for (int h = 0; h < 4; ++h) { m[h] = mh[h]; l[h] = 0.f;
#pragma unroll
        for (int i = 0; i < 8; ++i) o[h][i] = 0.f; }
    for (int ch = wave; ch < nch; ch += 8) {
        const int c = ch * 4 + grp; const bool valid = c < nvis; const int cc = valid ? c : 0; float v[8]; unpack8(*(const GAS v4u*)(it.vc + (size_t)cc * 128 + d8), v);
#pragma unroll
        for (int h = 0; h < 4; ++h) { const float p = valid ? __builtin_amdgcn_exp2f(Sc[h * 256 + cc] - mh[h]) : 0.f; l[h] += p;
#pragma unroll
            for (int i = 0; i < 8; ++i) o[h][i] += p * v[i]; }
    }
    merge_store(m, l, o, Cmb, wave, lane);
    __syncthreads();
    res += g0 * combine8(Cmb, hh, dd);
    __syncthreads();

#pragma unroll
    for (int h = 0; h < 4; ++h) { m[h] = -1e30f; l[h] = 0.f;
#pragma unroll
        for (int i = 0; i < 8; ++i) o[h][i] = 0.f; }
    if (KV::NORM) {
#pragma unroll
        for (int i = 0; i < 8; ++i) gkv[i] = gk1[d8 + i]; }
    nsa_stream<KV, false>(kv, __builtin_popcountll(mask) * 16, wave, grp, d8, t, 0, sl, gkv, q, it.blut, m, l, o);
    merge_store(m, l, o, Cmb, wave, lane);
    __syncthreads();
    res += g1 * combine8(Cmb, hh, dd);
    __syncthreads();

#pragma unroll
    for (int h = 0; h < 4; ++h) { m[h] = -1e30f; l[h] = 0.f;
#pragma unroll
        for (int i = 0; i < 8; ++i) o[h][i] = 0.f; }
    if (KV::NORM) {
#pragma unroll
        for (int i = 0; i < 8; ++i) gkv[i] = gk2[d8 + i]; }
    const int wlo = t - 511 < 0 ? 0 : t - 511, nchw = (t - wlo + 4) >> 2;
    nsa_stream<KV, true>(kv, nchw, wave, grp, d8, t, wlo, sl, gkv, q, it.blut, m, l, o);
    merge_store(m, l, o, Cmb, wave, lane);
    __syncthreads();
    res += g2 * combine8(Cmb, hh, dd);
    it.out[hh * 128 + dd] = (bf16)f2bf(res);
    __syncthreads();
}


#define KSWZ(row, colB) ((row) * 256 + ((colB) ^ (((row) & 7) << 4)))
constexpr int AT_V = 0, AT_K = 32768, AT_PC = 65536, AT_X = 131584, AT_BLUT = AT_X, AT_SELM = AT_X + 2176, AT_WS = AT_SELM + 512;
static_assert(AT_WS + 8 * 256 + 64 <= LDS_BYTES && AT_X >= MISC_OFF + 128 && AT_PC + 64 * 256 * 4 <= LDSCTL_OFF, "attention LDS map");

__device__ __forceinline__ unsigned cvtpk(float lo, float hi) { unsigned r; asm volatile("v_cvt_pk_bf16_f32 %0, %1, %2" : "=v"(r) : "v"(lo), "v"(hi)); return r; }
__device__ __forceinline__ float swap_max(float x) { auto rr = __builtin_amdgcn_permlane32_swap(__float_as_uint(x), __float_as_uint(x), false, false); return fmaxf(__uint_as_float(rr[0]), __uint_as_float(rr[1])); }
__device__ __forceinline__ float swap_add(float x) { auto rr = __builtin_amdgcn_permlane32_swap(__float_as_uint(x), __float_as_uint(x), false, false); return __uint_as_float(rr[0]) + __uint_as_float(rr[1]); }
__device__ __forceinline__ float quad_sum(float x) {
    x += __int_as_float(__builtin_amdgcn_update_dpp(0, __float_as_int(x), 0xB1, 0xF, 0xF, true));
    x += __int_as_float(__builtin_amdgcn_update_dpp(0, __float_as_int(x), 0x4E, 0xF, 0xF, true));
    return x;
}
__device__ __forceinline__ void qkt_tile(f32x16& p0, f32x16& p1, const LAS unsigned char* Kt, int r32, int hi, const bf16x8 (&qr)[8]) {
#pragma unroll
    for (int r = 0; r < 16; ++r) { p0[r] = 0.f; p1[r] = 0.f; }
    const LAS unsigned char* kb[4];
#pragma unroll
    for (int dd = 0; dd < 4; ++dd) kb[dd] = Kt + KSWZ(r32, (dd * 16 + hi * 8) * 2);
#pragma unroll
    for (int d0 = 0; d0 < 8; ++d0) { const LAS unsigned char* a = kb[d0 & 3] + (d0 >> 2) * 128;
        const bf16x8 b0 = *(const LAS bf16x8*)a, b1 = *(const LAS bf16x8*)(a + 32 * 256);
        p0 = __builtin_amdgcn_mfma_f32_32x32x16_bf16(b0, qr[d0], p0, 0, 0, 0);
        p1 = __builtin_amdgcn_mfma_f32_32x32x16_bf16(b1, qr[d0], p1, 0, 0, 0); }
}
template <int MODE>
__device__ __forceinline__ void fix_tile(f32x16& p0, f32x16& p1, int tile, int tq, int tmin, int head, int hi, bool bit, const LAS float* lut) {
    const float NEG = -__builtin_inff(); const float c31 = lut[head * 132 + 128];
    bool fast;
    if (MODE == 0) fast = tmin - 16 * (64 * tile + 63) - 31 >= 128;
    else if (MODE == 2) fast = tmin - (64 * tile + 63) >= 128;
    else fast = (tmin - (64 * tile + 63) >= 128) && (tmin + 7 - 64 * tile < 512);
    if (fast) {
        if (MODE == 2) {
#pragma unroll
            for (int r = 0; r < 16; ++r) { p0[r] = bit ? p0[r] + c31 : NEG; p1[r] = bit ? p1[r] + c31 : NEG; }
        } else {
#pragma unroll
            for (int r = 0; r < 16; ++r) { p0[r] += c31; p1[r] += c31; }
        }
        return;
    }
    const LAS float* lh = lut + head * 132;
#pragma unroll
    for (int hf = 0; hf < 2; ++hf)
#pragma unroll
        for (int r = 0; r < 16; ++r) { const int cr = (r & 3) + 8 * (r >> 2); int rel;
            if (MODE == 0) rel = tq - 31 - 16 * (64 * tile + 32 * hf + 4 * hi + cr); else rel = tq - (64 * tile + 32 * hf + 4 * hi + cr);
            bool valid;
            if (MODE == 0) valid = rel >= 0; else if (MODE == 2) valid = rel >= 0 && bit; else valid = (unsigned)rel < 512u;
            const int ri = rel < 0 ? 0 : (rel > 128 ? 128 : rel); const float bv = lh[ri];
            if (hf == 0) p0[r] = valid ? p0[r] + bv : NEG; else p1[r] = valid ? p1[r] + bv : NEG; }
}
__device__ __forceinline__ void softmax_tile(f32x16& p0, f32x16& p1, float& m_reg, float& l_reg, float& alpha, bf16x8& pa0, bf16x8& pa1, bf16x8& pa2, bf16x8& pa3) {
    float pmax = p0[0];
#pragma unroll
    for (int r = 1; r < 16; ++r) pmax = fmaxf(pmax, p0[r]);
#pragma unroll
    for (int r = 0; r < 16; ++r) pmax = fmaxf(pmax, p1[r]);
    pmax = swap_max(pmax);
    const float mn = fmaxf(m_reg, pmax); alpha = __builtin_amdgcn_exp2f(m_reg - mn); m_reg = mn;
    float ps = 0.f;
#pragma unroll
    for (int r = 0; r < 16; ++r) { p0[r] = __builtin_amdgcn_exp2f(p0[r] - mn); p1[r] = __builtin_amdgcn_exp2f(p1[r] - mn); ps += p0[r] + p1[r]; }
    ps = swap_add(ps); l_reg = l_reg * alpha + ps;
#define PK4(P, B_, OUT) do { unsigned a0 = cvtpk(P[B_+0], P[B_+1]), a1 = cvtpk(P[B_+2], P[B_+3]); unsigned b0 = cvtpk(P[B_+4], P[B_+5]), b1 = cvtpk(P[B_+6], P[B_+7]); \
        auto r0 = __builtin_amdgcn_permlane32_swap(a0, b0, false, false); auto r1 = __builtin_amdgcn_permlane32_swap(a1, b1, false, false); \
        v4u w = {r0[0], r1[0], r0[1], r1[1]}; OUT = __builtin_bit_cast(bf16x8, w); } while (0)
    PK4(p0, 0, pa0); PK4(p0, 8, pa1); PK4(p1, 0, pa2); PK4(p1, 8, pa3);
#undef PK4
}

struct FlashSt {
    bf16x8 qr[8];
    int tq, tmin, head;
};
template <int MODE, bool PASS2, int ACC>
__device__ __forceinline__ void flash_branch(const Ctx& C, FlashSt& S, const bf16* Kb, const bf16* Vb, int j_lo, int j_hi, float gate, unsigned long long mymask, unsigned long long wor,
                                             float& m_reg, float& l_reg, float* OT, bf16* OBrow) {
    const int tid = C.tid, lane = C.lane, wave = C.wave, r32 = lane & 31, hi = lane >> 5;
    LAS unsigned char* Vl = C.lds + AT_V; LAS unsigned char* Kl = C.lds + AT_K; LAS float* Pc = (LAS float*)(C.lds + AT_PC);
    const LAS float* lut = (const LAS float*)(C.lds + AT_BLUT); LAS float* wsl = (LAS float*)(C.lds + AT_WS) + wave * 64;
    const int vb0 = (int)(unsigned)(uintptr_t)Vl + v_rd_base(lane);
    f32x16 o[4];
    if (!PASS2) {
#pragma unroll
        for (int d0 = 0; d0 < 4; ++d0)
#pragma unroll
            for (int r = 0; r < 16; ++r) o[d0][r] = 0.f;
        m_reg = -1e30f; l_reg = 0.f; }
    const float inv_l = PASS2 ? (l_reg > 0.f ? 1.0f / l_reg : 0.f) : 0.f;
    const int n = j_hi - j_lo;
    const int lrow = wave * 4 + (lane >> 4);
    const unsigned ksrc = (unsigned)(lrow * 256 + ((((lane & 15) << 4)) ^ ((lrow & 7) << 4)));
    const int vkk = (((wave * 2 + (lane >> 5)) >> 2) << 3) + ((lane & 31) >> 2);
    const int vk = (vkk & ~0xC) | ((vkk & 4) << 1) | ((vkk & 8) >> 1);
    const unsigned vsrc = (unsigned)(vk * 256 + ((((wave * 2 + (lane >> 5)) & 3) * 32 + (lane & 3) * 8) * 2));
#define ST_DMA(tile, bf) do { const char* kp = (const char*)(Kb + (size_t)(tile) * 64 * 128) + ksrc; \
        __builtin_amdgcn_global_load_lds((const unsigned*)kp, (LAS unsigned*)(Kl + (bf) * 16384 + wave * 1024), 16, 0, 0); \
        __builtin_amdgcn_global_load_lds((const unsigned*)(kp + 8192), (LAS unsigned*)(Kl + (bf) * 16384 + 8192 + wave * 1024), 16, 0, 0); \
        if (!PASS2) { const char* vp = (const char*)(Vb + (size_t)(tile) * 64 * 128) + vsrc; \
            __builtin_amdgcn_global_load_lds((const unsigned*)vp, (LAS unsigned*)(Vl + (bf) * 16384 + wave * 1024), 16, 0, 0); \
            __builtin_amdgcn_global_load_lds((const unsigned*)(vp + 8192), (LAS unsigned*)(Vl + (bf) * 16384 + 8192 + wave * 1024), 16, 0, 0); } } while (0)
    if (n > 0) ST_DMA(j_lo, 0);
    asm volatile("s_waitcnt vmcnt(0)" ::: "memory");
    __syncthreads();
    for (int i = 0; i < n; ++i) {
        const int tile = j_lo + i, buf = i & 1;
        if (i + 1 < n) ST_DMA(tile + 1, buf ^ 1);
        bool act;
        if (PASS2) act = true; else if (MODE == 0) act = 16 * (64 * tile) + 31 <= S.tmin + 7; else if (MODE == 2) act = (wor >> tile) & 1ull; else act = true;
        if (act) {
            f32x16 p0, p1; qkt_tile(p0, p1, Kl + buf * 16384, r32, hi, S.qr);
            const bool bit = MODE == 2 ? ((mymask >> tile) & 1ull) != 0ull : true;
            fix_tile<MODE>(p0, p1, tile, S.tq, S.tmin, S.head, hi, bit, lut);
            if (PASS2) {
#pragma unroll
                for (int r = 0; r < 16; ++r) { p0[r] = quad_sum(__builtin_amdgcn_exp2f(p0[r] - m_reg) * inv_l); p1[r] = quad_sum(__builtin_amdgcn_exp2f(p1[r] - m_reg) * inv_l); }
                if ((r32 & 3) == 0) { LAS float* pr = Pc + (wave * 8 + (r32 >> 2)) * 256 + tile * 64 + 4 * hi;
#pragma unroll
                    for (int r = 0; r < 16; ++r) { const int cr = (r & 3) + 8 * (r >> 2); pr[cr] = p0[r]; pr[32 + cr] = p1[r]; } }
            } else {
                float alpha; bf16x8 pa0, pa1, pa2, pa3;
                softmax_tile(p0, p1, m_reg, l_reg, alpha, pa0, pa1, pa2, pa3);
                if (__any(alpha < 1.f)) { if (hi == 0) wsl[r32] = alpha; asm volatile("s_waitcnt lgkmcnt(0)" ::: "memory"); const LAS float* wh = wsl + 4 * hi;
#pragma unroll
                    for (int r = 0; r < 16; ++r) { const float a = wh[(r & 3) + 8 * (r >> 2)];
#pragma unroll
                        for (int d0 = 0; d0 < 4; ++d0) o[d0][r] *= a; }
                    asm volatile("s_waitcnt lgkmcnt(0)" ::: "memory"); }
                pv_tile(o, vb0 + buf * 16384, pa0, pa1, pa2, pa3);
            }
        }
        asm volatile("s_waitcnt vmcnt(0)" ::: "memory");
        __syncthreads();
    }
#undef ST_DMA
    if (!PASS2) {
        const float scl = l_reg > 0.f ? gate / l_reg : 0.f;
        if (hi == 0) wsl[32 + r32] = scl; asm volatile("s_waitcnt lgkmcnt(0)" ::: "memory");
        const LAS float* wh = wsl + 32 + 4 * hi; GAS float* otl = (GAS float*)OT + (size_t)(4 * hi) * 128 + r32; GAS bf16* obl = (GAS bf16*)OBrow + (size_t)hi * 64 + r32;
        asm volatile("" : "+v"(otl), "+v"(obl));
#pragma unroll
        for (int r = 0; r < 16; ++r) { const int cr = (r & 3) + 8 * (r >> 2); const float a = wh[cr];
#pragma unroll
            for (int d0 = 0; d0 < 4; ++d0) { float v = o[d0][r] * a; if (ACC > 0) v += otl[cr * 128 + d0 * 32];
                if (ACC < 2) otl[cr * 128 + d0 * 32] = v;
                else { const float vn = __shfl_xor(v, 1); if ((r32 & 1) == 0) *(GAS unsigned*)(obl + ((r & 3) * 2 + (d0 >> 1)) * 16384 + (2 * (r >> 2)) * 64 + (d0 & 1) * 32) = cvtpk(v, vn); } } }
        asm volatile("s_waitcnt lgkmcnt(0)" ::: "memory");
    }
}

__device__ __forceinline__ void flash_unit(const Ctx& C, int b, int g, int qb) {
    unsigned char* ws = C.ws; const int tid = C.tid, lane = C.lane, wave = C.wave, r32 = lane & 31, hi = lane >> 5, t0 = qb * 64;
    LAS float* lut = (LAS float*)(C.lds + AT_BLUT); LAS float* Pc = (LAS float*)(C.lds + AT_PC); LAS unsigned long long* selm = (LAS unsigned long long*)(C.lds + AT_SELM);
    const float* BL = (const float*)(ws + WS_BLUT) + g * 4 * 132;
    for (int i = tid; i < 4 * 132; i += NWAVES * 64) lut[i] = BL[i];
    FlashSt S; S.tmin = t0 + wave * 8; S.tq = S.tmin + (r32 >> 2); S.head = r32 & 3;
    const int row = b * T + S.tq;
    { const bf16* qp = (const bf16*)(ws + WS_QN) + (size_t)row * DQ + (g * 4 + S.head) * 128 + hi * 8;
#pragma unroll
      for (int d0 = 0; d0 < 8; ++d0) S.qr[d0] = *(const GAS bf16x8*)(qp + d0 * 16); }
    const float* gn = (const float*)(ws + WS_GN) + (size_t)row * 32 + (g * 4 + S.head) * 3; const float gc = gn[0], gsel = gn[1], gw = gn[2];
    const size_t kvb = (size_t)(b * 2 + g) * T * 128, cb = (size_t)(b * 2 + g) * 256 * 128;
    const int cmax = (t0 + 63 - 31) >> 4;
    const int nct = (cmax >> 6) + 1;
    float m_c, l_c;
    float* OT = (float*)(ws + WS_OT) + ((size_t)blockIdx.x * 8 + wave) * 32 * 128;
    bf16* OBrow = (bf16*)(ws + WS_OB) + tm_idx(b * T + S.tmin, g * 512, DQ / 64);
    flash_branch<0, false, 0>(C, S, (const bf16*)(ws + WS_KCP) + cb, (const bf16*)(ws + WS_VCP) + cb, 0, nct, gc, 0ull, 0ull, m_c, l_c, OT, OBrow);
    flash_branch<0, true, 0>(C, S, (const bf16*)(ws + WS_KCP) + cb, nullptr, 0, nct, 0.f, 0ull, 0ull, m_c, l_c, OT, OBrow);
    unsigned long long wor = 0ull;
    { asm volatile("s_waitcnt lgkmcnt(0)" ::: "memory");
      const int ncomp = nct * 64;
#pragma unroll 1
      for (int qi = 0; qi < 8; ++qi) { const int ql = wave * 8 + qi, t = t0 + ql; const LAS float* pr = Pc + ql * 256; float imp = 0.f;
#pragma unroll
          for (int k = 0; k < 5; ++k) { const int c = 4 * lane - 1 + k; if (c >= 0 && c < ncomp) imp += pr[c]; }
          const int j = lane, cur = t >> 6; const bool forced = (j == 0) || (j == cur) || (j == cur - 1), elig = 64 * j <= t;
          const float val = forced ? 1e6f : (elig ? imp : -1.f); int rank = 0;
          const int key = (int)((__float_as_uint(val) & ~63u) | (unsigned)(63 - j));
#pragma unroll
          for (int jp = 0; jp < 64; ++jp) rank += (__builtin_amdgcn_readlane(key, jp) > key) ? 1 : 0;
          const unsigned long long mk = __ballot(rank < 16 && elig); wor |= mk;
          if (lane == 0) selm[ql] = mk; }
      asm volatile("s_waitcnt lgkmcnt(0)" ::: "memory"); }
    const unsigned long long mymask = selm[wave * 8 + (r32 >> 2)];
    float m_s, l_s;
    flash_branch<2, false, 1>(C, S, (const bf16*)(ws + WS_KS) + kvb, (const bf16*)(ws + WS_VS) + kvb, 0, qb + 1, gsel, mymask, wor, m_s, l_s, OT, OBrow);
    flash_branch<3, false, 2>(C, S, (const bf16*)(ws + WS_KW) + kvb, (const bf16*)(ws + WS_VW) + kvb, qb >= 8 ? qb - 8 : 0, qb + 1, gw, 0ull, 0ull, m_s, l_s, OT, OBrow);
    __syncthreads();
}


template <bool SPLIT = false>
__device__ __forceinline__ void skinny_core(const Ctx& C, const bf16* A, int lda, const bf16* Bs, int kbeg, int Kw, float (&out)[8], float* out2 = nullptr) {
    const int lane = C.lane, wave = C.wave, r32 = lane & 31, hi = lane >> 5, tid = C.tid;
    f32x16 acc[4];
#pragma unroll
    for (int rb = 0; rb < 4; ++rb)
#pragma unroll
        for (int r = 0; r < 16; ++r) acc[rb][r] = 0.f;
    const GAS bf16* ap0 = (const GAS bf16*)A + (size_t)r32 * lda + kbeg + hi * 32;
    const GAS bf16* bp = (const GAS bf16*)Bs + (size_t)r32 * 64 + (size_t)(kbeg >> 6) * 16384 + hi * 32;
    const GAS bf16* ap1 = ap0 + (size_t)32 * lda; const GAS bf16* ap2 = ap0 + (size_t)64 * lda; const GAS bf16* ap3 = ap0 + (size_t)96 * lda;
    asm volatile("" : "+v"(ap0), "+v"(ap1), "+v"(ap2), "+v"(ap3), "+v"(bp));
    bf16x8 a0[4][2], b0[2], a1[4][2], b1[2], a2[4][2], b2[2], a3[4][2], b3[2];
#define SK_OFF(st) ((((st) >> 1) << 6) + (((st) & 1) << 4))
#define SK_LOAD(a, b, st) do { const int k_ = SK_OFF(st), kb_ = (((st) >> 1) << 14) + (((st) & 1) << 4); _Pragma("unroll") for (int j = 0; j < 2; ++j) b[j] = *(const GAS bf16x8*)(bp + kb_ + 8 * j); \
        _Pragma("unroll") for (int j = 0; j < 2; ++j) { a[0][j] = *(const GAS bf16x8*)(ap0 + k_ + 8 * j); a[1][j] = *(const GAS bf16x8*)(ap1 + k_ + 8 * j); a[2][j] = *(const GAS bf16x8*)(ap2 + k_ + 8 * j); a[3][j] = *(const GAS bf16x8*)(ap3 + k_ + 8 * j); } } while (0)
#define SK_MMA(a, b) do { _Pragma("unroll") for (int j = 0; j < 2; ++j) _Pragma("unroll") for (int rb = 0; rb < 4; ++rb) acc[rb] = __builtin_amdgcn_mfma_f32_32x32x16_bf16(a[rb][j], b[j], acc[rb], 0, 0, 0); } while (0)
    const int ns = Kw >> 5;
    SK_LOAD(a0, b0, 0); if (ns > 1) SK_LOAD(a1, b1, 1); if (ns > 2) SK_LOAD(a2, b2, 2); if (ns > 3) SK_LOAD(a3, b3, 3);
    for (int st = 0; st < ns; st += 4) {
        SK_MMA(a0, b0); if (st + 4 < ns) SK_LOAD(a0, b0, st + 4);
        if (st + 1 < ns) { SK_MMA(a1, b1); if (st + 5 < ns) SK_LOAD(a1, b1, st + 5); }
        if (st + 2 < ns) { SK_MMA(a2, b2); if (st + 6 < ns) SK_LOAD(a2, b2, st + 6); }
        if (st + 3 < ns) { SK_MMA(a3, b3); if (st + 7 < ns) SK_LOAD(a3, b3, st + 7); }
    }
#undef SK_OFF
#undef SK_LOAD
#undef SK_MMA
    LAS float* Red = (LAS float*)(C.lds + RING_OFF);
    LAS float* wr_ = Red + (wave * 128 + 4 * hi) * 32 + r32;
#pragma unroll
    for (int rb = 0; rb < 4; ++rb)
#pragma unroll
        for (int r = 0; r < 16; ++r) wr_[(32 * rb + (r & 3) + 8 * (r >> 2)) * 32] = acc[rb][r];
    __syncthreads();
    const LAS float* rd = Red + (tid >> 2) * 32 + (tid & 3) * 8;
    f32x4 s0 = *(const LAS f32x4*)rd, s1 = *(const LAS f32x4*)(rd + 4);
#pragma unroll
    for (int w = 1; w < (SPLIT ? 4 : 8); ++w) { s0 += *(const LAS f32x4*)(rd + w * 4096); s1 += *(const LAS f32x4*)(rd + w * 4096 + 4); }
    out[0] = s0.x; out[1] = s0.y; out[2] = s0.z; out[3] = s0.w; out[4] = s1.x; out[5] = s1.y; out[6] = s1.z; out[7] = s1.w;
    if (SPLIT) { f32x4 t0 = *(const LAS f32x4*)(rd + 4 * 4096), t1 = *(const LAS f32x4*)(rd + 4 * 4096 + 4);
#pragma unroll
        for (int w = 5; w < 8; ++w) { t0 += *(const LAS f32x4*)(rd + w * 4096); t1 += *(const LAS f32x4*)(rd + w * 4096 + 4); }
        out2[0] = t0.x; out2[1] = t0.y; out2[2] = t0.z; out2[3] = t0.w; out2[4] = t1.x; out2[5] = t1.y; out2[6] = t1.z; out2[7] = t1.w; }
    __syncthreads();
}
__device__ __forceinline__ void st8f(float* p, const float (&v)[8]) { *(GAS f32x4*)p = (f32x4){v[0], v[1], v[2], v[3]}; *(GAS f32x4*)(p + 4) = (f32x4){v[4], v[5], v[6], v[7]}; }

__device__ __forceinline__ void s_in(const Ctx& C, int idx, int nblk) {
    unsigned char* ws = C.ws; const int tid = C.tid, row = tid >> 2, c8 = (tid & 3) * 8, rg = MPROMPT + row;
    const float rs = ((const float*)(ws + WS_RSTD1))[rg];
    for (int u = idx; u < 273; u += nblk) {
        float v[8]; skinny_core(C, (const bf16*)(ws + WS_SXB), LDS_X, (const bf16*)(ws + WS_WIN) + ((size_t)(u >> 3) * (DM / 64) * 256 + (u & 7) * 32) * 64, C.wave * 256, 256, v);
        const int n = u * 32 + c8;
#pragma unroll
        for (int k = 0; k < 8; ++k) v[k] *= rs;
        if (n < 2048) {
#pragma unroll
            for (int k = 0; k < 8; ++k) v[k] = gelu_tanh(v[k]);
            if (n < 1024) *(GAS v4u*)((bf16*)(ws + WS_U) + (size_t)rg * DG + n) = pack8f(v);
            else { *(GAS v4u*)((bf16*)(ws + WS_VG) + (size_t)rg * DG + n - 1024) = pack8f(v); float ss = 0.f;
#pragma unroll
                for (int k = 0; k < 8; ++k) ss += v[k] * v[k];
                ss += __shfl_xor(ss, 1); ss += __shfl_xor(ss, 2);
                if ((tid & 3) == 0) ((float*)(ws + WS_VSS))[(size_t)rg * 32 + (n - 1024) / 32] = ss; }
        } else if (n < 3072) st8f((float*)(ws + WS_QRAW) + (size_t)rg * DQ + n - 2048, v);
        else if (n < 3584) st8f(C.out + O_SCMP + (size_t)row * 512 + n - 3072, v);
        else if (n < 4096) st8f(C.out + O_SSEL + (size_t)row * 512 + n - 3584, v);
        else if (n < 4608) st8f((float*)(ws + WS_KVWR) + (size_t)rg * 512 + n - 4096, v);
        else if (n < 8704) {
#pragma unroll
            for (int k = 0; k < 8; ++k) v[k] = sigmoidf_(v[k]);
            if (n < 6656) *(GAS v4u*)((bf16*)(ws + WS_GA) + (size_t)rg * DM + n - 4608) = pack8f(v); else *(GAS v4u*)((bf16*)(ws + WS_GB) + (size_t)rg * DM + n - 6656) = pack8f(v);
        } else if (n < 8728) {
#pragma unroll
            for (int k = 0; k < 8; ++k) v[k] = sigmoidf_(v[k]);
            st8f((float*)(ws + WS_GN) + (size_t)rg * 32 + n - 8704, v); }
    }
}
__device__ __forceinline__ void s_proj(const Ctx& C) {
    unsigned char* ws = C.ws; const int tid = C.tid, row = tid >> 2, c8 = (tid & 3) * 8, rg = MPROMPT + row;
    for (int u = blockIdx.x; u < 64; u += C.G) {
        float a[8], b[8], ga[8], gb[8]; const int n = u * 32 + c8;
        { const bool pb = C.wave >= 4;
          skinny_core<true>(C, (const bf16*)(ws + (pb ? WS_SOB : WS_SOA)), LDS_G, (const bf16*)(ws + (pb ? WS_WN : WS_WG)) + ((size_t)(u >> 3) * (DG / 64) * 256 + (u & 7) * 32) * 64, (C.wave & 3) * 256, 256, a, b); }
        unpack8(*(const GAS v4u*)((const bf16*)(ws + WS_GA) + (size_t)rg * DM + n), ga); unpack8(*(const GAS v4u*)((const bf16*)(ws + WS_GB) + (size_t)rg * DM + n), gb);
#pragma unroll
        for (int k = 0; k < 8; ++k) a[k] = ga[k] * a[k] + gb[k] * b[k];
        *(GAS v4u*)((bf16*)(ws + WS_SMIX) + (size_t)row * LDS_X + n) = pack8f(a);
    }
}
__device__ __forceinline__ void s_out(const Ctx& C) {
    unsigned char* ws = C.ws; const int tid = C.tid, row = tid >> 2, c8 = (tid & 3) * 8, rg = MPROMPT + row;
    for (int u = blockIdx.x; u < 64; u += C.G) {
        float v[8], x[8]; const int n = u * 32 + c8;
        skinny_core(C, (const bf16*)(ws + WS_SMIX), LDS_X, (const bf16*)(ws + WS_WO) + ((size_t)(u >> 3) * (DM / 64) * 256 + (u & 7) * 32) * 64, C.wave * 256, 256, v);
        ld8f(C.in[IN_XS] + (size_t)row * DM + n, x); float ss = 0.f;
#pragma unroll
        for (int k = 0; k < 8; ++k) { v[k] += x[k]; ss += v[k] * v[k]; }
        st8f(C.out + O_YS + (size_t)row * DM + n, v); *(GAS v4u*)((bf16*)(ws + WS_SX1B) + (size_t)row * LDS_X + n) = pack8f(v);
        ss += __shfl_xor(ss, 1); ss += __shfl_xor(ss, 2);
        if ((tid & 3) == 0) ((float*)(ws + WS_X1SS))[(size_t)MPROMPT * 32 + row * 64 + u] = ss;
    }
}
__device__ __forceinline__ void s_up(const Ctx& C) {
    unsigned char* ws = C.ws; const int tid = C.tid, row = tid >> 2, c8 = (tid & 3) * 8, rg = MPROMPT + row;
    float rs; { const GAS f32x4* sp = (const GAS f32x4*)((const float*)(ws + WS_X1SS) + (size_t)MPROMPT * 32 + row * 64); f32x4 s4 = sp[0];
#pragma unroll
        for (int k = 1; k < 16; ++k) s4 += sp[k];
        rs = rsqrtf(((s4.x + s4.y) + (s4.z + s4.w)) * (1.0f / DM) + EPS); }
    for (int u = blockIdx.x; u < 256; u += C.G) {
        float v[8]; skinny_core(C, (const bf16*)(ws + WS_SX1B), LDS_X, (const bf16*)(ws + WS_WUP) + ((size_t)(u >> 3) * (DM / 64) * 256 + (u & 7) * 32) * 64, C.wave * 256, 256, v);
#pragma unroll
        for (int k = 0; k < 8; ++k) { const float a = fmaxf(v[k] * rs, 0.f); v[k] = a * a; }
        *(GAS v4u*)((bf16*)(ws + WS_SH) + (size_t)row * LDS_H + u * 32 + c8) = pack8f(v);
    }
}
__device__ __forceinline__ void s_down(const Ctx& C) {
    unsigned char* ws = C.ws; const int tid = C.tid, row = tid >> 2, c8 = (tid & 3) * 8, rg = MPROMPT + row;
    float* PART = (float*)(ws + WS_SPART); gu32* tick = (gu32*)(ws + WS_CTL) + CW_TICK; LAS unsigned* flag = (LAS unsigned*)(C.lds + AT_X);
    for (int u = blockIdx.x; u < 256; u += C.G) { const int strip = u >> 2, kq = u & 3;
        float v[8]; skinny_core(C, (const bf16*)(ws + WS_SH), LDS_H, (const bf16*)(ws + WS_WDN) + ((size_t)(strip >> 3) * (DFF / 64) * 256 + (strip & 7) * 32) * 64, kq * 2048 + C.wave * 256, 256, v);
        { gu64* pp = (gu64*)(PART + ((size_t)(strip * 4 + kq) * 128 + row) * 32 + c8);
#pragma unroll
          for (int q = 0; q < 4; ++q) __hip_atomic_store(pp + q, ((unsigned long long)__float_as_uint(v[2 * q + 1]) << 32) | __float_as_uint(v[2 * q]), RLX_AGENT); }
        asm volatile("s_waitcnt vmcnt(0)" ::: "memory"); __syncthreads();
        if (tid == 0) { const unsigned old = __hip_atomic_fetch_add(tick + strip * 64, 1u, __ATOMIC_RELAXED, __HIP_MEMORY_SCOPE_AGENT); flag[0] = old; }
        __syncthreads();
        const bool last = flag[0] == 3u;
        __syncthreads();
        if (last) { __builtin_amdgcn_fence(__ATOMIC_ACQUIRE, "agent"); asm volatile("s_waitcnt vmcnt(0)" ::: "memory");
            float* y = C.out + O_YS + (size_t)row * DM + strip * 32 + c8; float acc[8]; ld8f(y, acc);
#pragma unroll
            for (int q = 0; q < 4; ++q) { const gu64* pp = (const gu64*)(PART + ((size_t)(strip * 4 + q) * 128 + row) * 32 + c8);
#pragma unroll
                for (int k = 0; k < 4; ++k) { const unsigned long long w = __hip_atomic_load(pp + k, RLX_AGENT); acc[2 * k] += __uint_as_float((unsigned)w); acc[2 * k + 1] += __uint_as_float((unsigned)(w >> 32)); } }
            st8f(y, acc); }
    }
}

__device__ __forceinline__ void fused_cmp_unit(const Ctx& C, int L, const epi::EpiCmp& E) {
    using pg8::bf16x8; using pg8::f32x4; using pg8::HTB;
    LAS unsigned char* lds = C.lds + RING_OFF;
    const Ctx Lf = fresh(C);
    const int tid = Lf.tid, wid = C.wave, lane = Lf.lane, wr = wid >> 2, wc = wid & 3, fr = lane & 15, fq = lane >> 4;
    const int b = L >> 1, kv = L & 1;
    const int* pt = (const int*)C.in[IN_PT] + b * 16;
    unsigned aofg[2][2], voffB[2];
#pragma unroll
    for (int i = 0; i < 2; ++i) { int R, Cx; pg8::stage_rc(tid * 16 + i * 8192, R, Cx);
        const unsigned page = (unsigned)pt[R >> 3];
#pragma unroll
        for (int h = 0; h < 2; ++h) aofg[h][i] = (((page * 128u + (unsigned)(R & 7) * 16u) * 512u) + (unsigned)((kv * 2 + h) * 128 + Cx)) * 4u;
        voffB[i] = (unsigned)(R * 64 + Cx) * 2u; }
    const char* cA = (const char*)C.in[IN_CCMP];
    const char* cB = (const char*)(C.ws + WS_WC) + (size_t)kv * 32 * 32768;
    const size_t hstepB = 16384;
    const int aoff = pg8::lds_byte(wr * 64 + fr, fq * 8), boff = pg8::lds_byte(wc * 32 + fr, fq * 8);
#define FC_SA(bf, h) (((bf) * 2 + (h)) * HTB)
#define FC_SB(bf, h) ((4 + (bf) * 2 + (h)) * HTB)
#define FC_LOADA(kt) do { const unsigned ko_ = (unsigned)((kt) >> 1) * 2048u + (unsigned)((kt) & 1) * 256u; \
        _Pragma("unroll") for (int h = 0; h < 2; ++h) _Pragma("unroll") for (int i = 0; i < 2; ++i) { const char* p_ = cA + aofg[h][i] + ko_; \
            ar[h][i][0] = *(const GAS f32x4*)p_; ar[h][i][1] = *(const GAS f32x4*)(p_ + 16); } } while (0)
#define FC_WRITEA(bf) do { _Pragma("unroll") for (int h = 0; h < 2; ++h) _Pragma("unroll") for (int i = 0; i < 2; ++i) { v4u w_; \
            w_.x = pk2(ar[h][i][0].x, ar[h][i][0].y); w_.y = pk2(ar[h][i][0].z, ar[h][i][0].w); w_.z = pk2(ar[h][i][1].x, ar[h][i][1].y); w_.w = pk2(ar[h][i][1].z, ar[h][i][1].w); \
            *(LAS v4u*)(lds + FC_SA(bf, h) + tid * 16 + i * 8192) = w_; } } while (0)
#define FC_DMAB(kt, bf) do { _Pragma("unroll") for (int h = 0; h < 2; ++h) _Pragma("unroll") for (int i = 0; i < 2; ++i) \
            __builtin_amdgcn_global_load_lds((const unsigned*)(cB + h * hstepB + (size_t)(kt) * 32768 + voffB[i]), (LAS unsigned*)(lds + FC_SB(bf, h) + wid * 1024 + i * 8192), 16, 0, 0); } while (0)
#define FC_LDA(dst, bf, h) do { _Pragma("unroll") for (int m = 0; m < 4; ++m) _Pragma("unroll") for (int k = 0; k < 2; ++k) dst[m][k] = *(const LAS bf16x8*)(lds + FC_SA(bf, h) + aoff + m * 2048 + k * 1024); } while (0)
#define FC_LDB(dst, bf, h) do { _Pragma("unroll") for (int n = 0; n < 2; ++n) _Pragma("unroll") for (int k = 0; k < 2; ++k) dst[n][k] = *(const LAS bf16x8*)(lds + FC_SB(bf, h) + boff + n * 2048 + k * 1024); } while (0)
#define FC_MMA(ai, bj, At_, Bt_) do { _Pragma("unroll") for (int m = 0; m < 4; ++m) _Pragma("unroll") for (int n = 0; n < 2; ++n) _Pragma("unroll") for (int k = 0; k < 2; ++k) \
        acc[ai][bj][m][n] = __builtin_amdgcn_mfma_f32_16x16x32_bf16(Bt_[n][k], At_[m][k], acc[ai][bj][m][n], 0, 0, 0); } while (0)
    f32x4 acc[2][2][4][2];
#pragma unroll
    for (int a = 0; a < 2; ++a)
#pragma unroll
        for (int bb = 0; bb < 2; ++bb)
#pragma unroll
            for (int m = 0; m < 4; ++m)
#pragma unroll
                for (int n = 0; n < 2; ++n) acc[a][bb][m][n] = (f32x4){0.f, 0.f, 0.f, 0.f};
    f32x4 ar[2][2][2];
    bf16x8 At[4][2], B0[2][2];
    __syncthreads();
    FC_LOADA(0); FC_DMAB(0, 0); FC_WRITEA(0);
    asm volatile("s_waitcnt vmcnt(0) lgkmcnt(0)" ::: "memory"); __syncthreads();
#pragma unroll 1
    for (int kt = 0; kt < 32; ++kt) { const int bf = kt & 1;
        if (kt + 1 < 32) { FC_LOADA(kt + 1); FC_DMAB(kt + 1, bf ^ 1); }
        FC_LDB(B0, bf, 0); FC_LDA(At, bf, 0); FC_MMA(0, 0, At, B0);
        FC_LDA(At, bf, 1); FC_MMA(1, 0, At, B0);
        FC_LDB(B0, bf, 1); FC_MMA(1, 1, At, B0);
        FC_LDA(At, bf, 0); FC_MMA(0, 1, At, B0);
        if (kt + 1 < 32) FC_WRITEA(bf ^ 1);
        asm volatile("s_waitcnt vmcnt(0) lgkmcnt(0)" ::: "memory"); __syncthreads();
    }
    const pg8::Unit u{L, kv};
    { const Ctx Le = fresh(C); E(acc, u, wr, wc, Le.lane & 15, Le.lane >> 4); }
#undef FC_SA
#undef FC_SB
#undef FC_LOADA
#undef FC_WRITEA
#undef FC_DMAB
#undef FC_LDA
#undef FC_LDB
#undef FC_MMA
}

constexpr int LATE_P1 = 4096;
constexpr int WINCOPY_P2 = 0;
constexpr int LATE_P2 = I_LATE - LATE_P1;
constexpr int LATE_P12 = LATE_P1 + LATE_P2;
constexpr int NLATE_W = (I_LATE - LATE_P12 + 31) / 32, P5_HEAVY = 160, P5_SAMP0 = P5_HEAVY, P5_LIGHT0 = P5_SAMP0 + 256, P5_STREAM0 = P5_LIGHT0 + (256 - P5_HEAVY),
              P5_ITEMS = P5_STREAM0 + NLATE_W + WINCOPY_ITEMS - WINCOPY_P2;
__device__ __forceinline__ void p5_attn_flash(const Ctx& C, const int it_lo = 0, const int it_hi = P5_ITEMS) {
    unsigned char* ws = C.ws; gu32* ctl = (gu32*)(ws + WS_CTL); gu32* qa = ctl + CW_Q5;
    LAS float* scr = (LAS float*)(C.lds + RING_OFF + C.wave * 16384);
    for (;;) {
        gu32* qa_ = qa; unsigned qo_ = AT_WS + 2048; asm volatile("" : "+s"(qa_), "+s"(qo_));
        LAS unsigned* qf_ = (LAS unsigned*)(C.lds + qo_);
        __syncthreads();
        if (C.wave == 0 && lane_now() == 0) qf_[0] = __hip_atomic_fetch_add(qa_, 1u, __ATOMIC_RELAXED, __HIP_MEMORY_SCOPE_AGENT);
        __syncthreads();
        const int it = __builtin_amdgcn_readfirstlane((int)qf_[0]) + it_lo;
        if (it >= it_hi) break;
        const Ctx L = fresh(C);
        if (it < P5_HEAVY || (it >= P5_LIGHT0 && it < P5_STREAM0)) { const int un = it < P5_HEAVY ? it : it - P5_LIGHT0 + P5_HEAVY;
            const int qb_ = 63 - (un >> 2), bg = un & 3; flash_unit(L, bg >> 1, bg & 1, qb_); }
        else if (it < P5_LIGHT0) { const int si = it - P5_SAMP0, b = si >> 1, g = si & 1, row = MPROMPT + b;
            AttItem ai{(const bf16*)(ws + WS_QN) + (size_t)row * DQ + g * 512, PASTLEN, 127, (const bf16*)(ws + WS_KCS) + (size_t)(b * 2 + g) * 128 * 128, (const bf16*)(ws + WS_VCS) + (size_t)(b * 2 + g) * 128 * 128, 33,
                       (const float*)(ws + WS_GN) + (size_t)row * 32 + g * 12, (bf16*)(ws + WS_SOB) + (size_t)b * LDS_G + g * 512, (const float*)(ws + WS_BLUT) + g * 4 * 132};
            SampleKV kv{C.in[IN_CSEL] + g * 128, (const int*)C.in[IN_PT] + b * 16, C.out + O_SSEL + (size_t)b * 512 + g * 128, C.in[IN_WINB] + (size_t)b * 512 * 512 + g * 128,
                        (const float*)(ws + WS_KVWR) + (size_t)row * 512 + g * 128};
            nsa_item<SampleKV>(L, ai, kv, C.in[IN_GK] + 128, C.in[IN_GK] + 256); }
        else if (it < P5_STREAM0 + NLATE_W) { const int base = LATE_P12 + (it - P5_STREAM0) * 32;
#pragma unroll 1
            for (int k = 0; k < 4; ++k) { const int r = base + k * 8 + C.wave; if (r < I_LATE) w_item_late(L, r, scr); } }
        else wincopy_item(L, WINCOPY_P2 + it - P5_STREAM0 - NLATE_W);
    }
}

#ifndef MK_N_LAUNCHES
#define MK_N_LAUNCHES 1
#endif
constexpr int NPHASES = 10;

__device__ __forceinline__ void ph1(const Ctx& C, LAS unsigned char* ring) { unsigned char* ws = C.ws;
    pg8::Gemm g{(const bf16*)(ws + WS_XB), (const bf16*)(ws + WS_WIN), MPROMPT, NINP, DM, LD2, LD2, 1, 1}; pg8::StaticOrder S; S.init(MPROMPT, NINP, C.G, (int)blockIdx.x);
    epi::EpiIn E{(const float*)(ws + WS_RSTD1), (bf16*)(ws + WS_U), (bf16*)(ws + WS_VG), (float*)(ws + WS_VSS), (float*)(ws + WS_QRAW), (float*)(ws + WS_KVWR),
                 (bf16*)(ws + WS_GA), (bf16*)(ws + WS_GB), (float*)(ws + WS_GN), C.out, (bf16*)(ws + WS_ACP)};
    pg8::gemm_phase<epi::EpiIn, pg8::StaticOrder, true, true>(ring, g, S, E, C.tid);
    { const int nu = (MPROMPT / 256) * (NINP / 256), full = nu % C.G, nlight = full ? C.G - full : C.G, idx = full ? (int)blockIdx.x - full : (int)blockIdx.x;
      if (idx >= 0) { s_in(C, idx, nlight);
          const Ctx L = fresh(C); LAS float* scr = (LAS float*)(C.lds + RING_OFF + C.wave * 16384); __syncthreads();
          for (int r = idx * NWAVES + C.wave; r < LATE_P1; r += nlight * NWAVES) w_item_late(L, r, scr); } } }
__device__ __forceinline__ void ph2(const Ctx& C, LAS unsigned char* ring) { unsigned char* ws = C.ws;
    { const int skip = C.G > 32 ? 16 : 0; if ((int)blockIdx.x >= skip) p2_post(C, (int)blockIdx.x - skip, C.G - skip); }
    { epi::EpiCmp E{(float*)(ws + WS_YCS), 127};
      for (int Lu = (int)blockIdx.x; Lu < 256; Lu += C.G) { fused_cmp_unit(C, Lu, E);
          asm volatile("s_waitcnt vmcnt(0)" ::: "memory"); __syncthreads();
          const Ctx Lc = fresh(C);
          cmp_combine_rows(Lc, false, Lu * 256, 256); } }
    __syncthreads();
    const int ngb = C.G > 16 ? 8 : 0;
    if (ngb == 0 || (int)blockIdx.x < ngb) {
        { pg8::Gemm g{(const bf16*)(ws + WS_ACP), (const bf16*)(ws + WS_WC), 2048, 512, 2048, LD2, LD2, 1, 1}; epi::CmpOrder S{8, C.G, (int)blockIdx.x, 1};
          epi::EpiCmp E{(float*)(ws + WS_YCP), 255};
          const Ctx Lg = fresh(C); pg8::gemm_phase<epi::EpiCmp, epi::CmpOrder, true, true>(ring, g, S, E, Lg.tid); }
        asm volatile("s_waitcnt vmcnt(0)" ::: "memory"); __syncthreads();
        const Ctx Lc = fresh(C);
        for (int L = (int)blockIdx.x; L < 8; L += C.G) cmp_combine_rows(Lc, true, L * 256, 256); }
    { const Ctx Ls = fresh(C);
      if (ngb == 0) p4_sgu(Ls, (int)blockIdx.x, C.G); else if ((int)blockIdx.x >= ngb) p4_sgu(Ls, (int)blockIdx.x - ngb, C.G - ngb); }
    { const int skip = C.G > 32 ? 16 : 0;
      if ((int)blockIdx.x >= skip) { const Ctx L = fresh(C); LAS float* scr = (LAS float*)(C.lds + RING_OFF + C.wave * 16384); __syncthreads();
          for (int r = LATE_P1 + ((int)blockIdx.x - skip) * NWAVES + C.wave; r < LATE_P12; r += (C.G - skip) * NWAVES) w_item_late(L, r, scr);
          for (int c = (int)blockIdx.x - skip; c < WINCOPY_P2; c += C.G - skip) wincopy_item(L, c); } } }
__device__ __forceinline__ void ph6(const Ctx& C, LAS unsigned char* ring) { unsigned char* ws = C.ws;
    { pg8::Gemm g{(const bf16*)(ws + WS_OA), (const bf16*)(ws + WS_WG), MPROMPT, DM, DG, LD1, LD1, 1, 1}; pg8::StaticOrder S; S.init(MPROMPT, DM, C.G, (int)blockIdx.x);
      epi::EpiMixA E{(const bf16*)(ws + WS_GA), (bf16*)(ws + WS_MIXA)};
      pg8::gemm_phase<epi::EpiMixA, pg8::StaticOrder, true, true>(ring, g, S, E, C.tid); }
    { pg8::Gemm g{(const bf16*)(ws + WS_OB), (const bf16*)(ws + WS_WN), MPROMPT, DM, DQ, LD1, LD1, 1, 1}; pg8::StaticOrder S; S.init(MPROMPT, DM, C.G, (int)blockIdx.x);
      epi::EpiMixB E{(const bf16*)(ws + WS_GB), (const bf16*)(ws + WS_MIXA), (bf16*)(ws + WS_MIX)};
      pg8::gemm_phase<epi::EpiMixB, pg8::StaticOrder, true, true>(ring, g, S, E, C.tid); }
    s_proj(C); }
__device__ __forceinline__ void ph7(const Ctx& C, LAS unsigned char* ring) { unsigned char* ws = C.ws;
    pg8::Gemm g{(const bf16*)(ws + WS_MIX), (const bf16*)(ws + WS_WO), MPROMPT, DM, DM, LD2, LD2, 1, 1}; pg8::StaticOrder S; S.init(MPROMPT, DM, C.G, (int)blockIdx.x);
    epi::EpiOut E{C.in[IN_XP], C.in[IN_XS], C.out, (bf16*)(ws + WS_X1B), (float*)(ws + WS_X1SS)};
    pg8::gemm_phase<epi::EpiOut, pg8::StaticOrder, true, true>(ring, g, S, E, C.tid);
    s_out(C); }
__device__ __forceinline__ void ph8(const Ctx& C, LAS unsigned char* ring) { unsigned char* ws = C.ws;
    pg8::Gemm g{(const bf16*)(ws + WS_X1B), (const bf16*)(ws + WS_WUP), MPROMPT, DFF, DM, LD2, LD2, 1, 1}; pg8::StaticOrder S; S.init(MPROMPT, DFF, C.G, (int)blockIdx.x);
    epi::EpiUp E{(const float*)(ws + WS_X1SS), (bf16*)(ws + WS_H)};
    pg8::gemm_phase<epi::EpiUp, pg8::StaticOrder, true, true>(ring, g, S, E, C.tid);
    s_up(C); }
template <bool DUMMY>
__device__ __forceinline__ void ph9(const Ctx& C, LAS unsigned char* ring) { unsigned char* ws = C.ws;
    pg8::Gemm g{(const bf16*)(ws + WS_H), (const bf16*)(ws + WS_WDN), MPROMPT, DM, DFF, LD8, LD8, 1, 1}; pg8::StaticOrder S; S.init(MPROMPT, DM, C.G, (int)blockIdx.x);
    epi::EpiDown E{DUMMY ? (float*)(ws + WS_DUMMY) : C.out, (const bf16*)(ws + WS_X1B)};
    pg8::gemm_phase<epi::EpiDown, pg8::StaticOrder, true, true>(ring, g, S, E, C.tid);
    if (!DUMMY) s_down(C); }

struct Args { const float* in[24]; float* out; unsigned char* ws; int ph_lo, ph_hi; };
static_assert(sizeof(Args) == 24 * 8 + 8 + 8 + 8, "no padding bytes in the kernel argument struct");

__global__ void __launch_bounds__(NWAVES * 64, 2) nsa_fwd(Args args) {
    extern __shared__ __attribute__((aligned(16))) unsigned char lds_raw[];
    Ctx C;
    C.in = args.in;
    C.out = args.out; C.ws = args.ws; C.lds = (LAS unsigned char*)lds_raw;
    C.tid = threadIdx.x; C.lane = C.tid & 63; C.wave = __builtin_amdgcn_readfirstlane(C.tid >> 6);
    C.G = gridDim.x; { const int bx = blockIdx.x; C.vcu = (C.G % 8 == 0) ? (bx % 8) * (C.G / 8) + bx / 8 : bx; }
    volatile LAS unsigned* MISC = (volatile LAS unsigned*)(C.lds + MISC_OFF);
    gu32* ctl = (gu32*)(args.ws + WS_CTL);
    for (int u = C.tid; u < (LDS_BYTES - LDSCTL_OFF) / 4; u += NWAVES * 64) ((LAS unsigned*)(C.lds + LDSCTL_OFF))[u] = 0u;
    __syncthreads();
    const int lo = args.ph_lo, hi = args.ph_hi;
    XcdBarrier bar; bar.bar = (unsigned*)(ctl + CW_BAR); bar.x = 0; bar.w = 0; bar.st = nullptr;
    if (hi - lo > 1) bar = xcd_barrier_post((unsigned*)(ctl + CW_BAR), MISC + 8);
#ifndef ONLY_PHASES
#define ONLY_PHASES 0x3ff
#endif
#define IN(k) (((ONLY_PHASES >> (k)) & 1) && lo <= (k) && (k) < hi)
#ifndef PROBE_SLACK
#define PROBE_SLACK -1
#endif
#ifndef PROBE_SLACK_PH
#define PROBE_SLACK_PH 2
#endif
#if PROBE_SLACK >= 0
    unsigned long long ps0_ = 0;
#define SEAM2(k, n) do { if (IN(k) && IN(n)) { if ((k) == PROBE_SLACK_PH) { __syncthreads(); ps0_ = __builtin_amdgcn_s_memrealtime(); } xcd_barrier(bar); \
        if ((k) == PROBE_SLACK_PH) { if ((int)blockIdx.x == PROBE_SLACK && C.wave == 0) { const unsigned long long d_ = __builtin_amdgcn_s_memrealtime() - ps0_, t0_ = __builtin_amdgcn_s_memrealtime(); \
                while (__builtin_amdgcn_s_memrealtime() - t0_ < d_ * 10ull) __builtin_amdgcn_s_sleep(16); } \
            xcd_barrier(bar); } } } while (0)
#else
#define SEAM2(k, n) do { if (IN(k) && IN(n)) xcd_barrier(bar); } while (0)
#endif
#define SEAM(k) SEAM2(k, (k) + 1)
    LAS unsigned char* ring = C.lds + RING_OFF;

#define PROBE2(k, call) do { if ((PROBE_MASK >> (k)) & 1) { xcd_barrier(bar); call; } } while (0)
    if (IN(0)) { p0_prologue(fresh(C)); PROBE2(0, p0_prologue(fresh(C))); } SEAM(0);
    if (IN(1)) { ph1(fresh(C), ring); PROBE2(1, ph1(fresh(C), ring)); } SEAM(1);
    if (IN(2)) { ph2(fresh(C), ring); PROBE2(2, ph2(fresh(C), ring)); } SEAM2(2, 5);
    if (IN(5)) { p5_attn_flash(fresh(C));
#define P5_RERUN(lo_, hi_) do { xcd_barrier(bar); if (blockIdx.x == 0 && C.wave == 0 && lane_now() == 0) __hip_atomic_store(ctl + CW_Q5, 0u, RLX_AGENT); xcd_barrier(bar); p5_attn_flash(fresh(C), lo_, hi_); } while (0)
        if ((PROBE_MASK >> 5) & 1) P5_RERUN(0, P5_ITEMS);
        if ((PROBE_MASK >> 13) & 1) { P5_RERUN(0, P5_HEAVY); }
        if ((PROBE_MASK >> 14) & 1) { P5_RERUN(P5_SAMP0, P5_LIGHT0); }
        if ((PROBE_MASK >> 15) & 1) { P5_RERUN(P5_STREAM0, P5_ITEMS); }
} SEAM(5);
    if (IN(6)) { ph6(fresh(C), ring); PROBE2(6, ph6(fresh(C), ring)); } SEAM(6);
    if (IN(7)) { ph7(fresh(C), ring); PROBE2(7, ph7(fresh(C), ring)); } SEAM(7);
#if (PROBE_MASK >> 20) & 1
    long long pc0_ = 0; unsigned long long pr0_ = 0; if (IN(8)) { pc0_ = clock64(); pr0_ = __builtin_amdgcn_s_memrealtime(); }
#endif
    if (IN(8)) { ph8(fresh(C), ring); PROBE2(8, ph8(fresh(C), ring)); }
#if (PROBE_MASK >> 20) & 1
    if (IN(8) && blockIdx.x == 0 && C.wave == 0) { const long long dc_ = clock64() - pc0_; const unsigned long long dr_ = __builtin_amdgcn_s_memrealtime() - pr0_;
        const unsigned long long mhz_ = (unsigned long long)dc_ * 100ull / (dr_ ? dr_ : 1ull); const unsigned long long t0_ = __builtin_amdgcn_s_memrealtime();
        while (__builtin_amdgcn_s_memrealtime() - t0_ < mhz_ * 100ull) __builtin_amdgcn_s_sleep(16); }
#endif
    SEAM(8);
    if (IN(9)) { PROBE2(9, ph9<true>(fresh(C), ring)); if ((PROBE_MASK >> 9) & 1) xcd_barrier(bar); ph9<false>(fresh(C), ring); }
#undef PROBE2
#undef IN
#undef SEAM
#undef SEAM2
}

extern "C" void kernel_launch(void* const* d_in, const int* in_sizes, int n_in, void* d_out, int out_size, void* d_ws, size_t ws_size, hipStream_t stream) {
    static int grid = 0;
    if (grid == 0) {
        if (n_in != 24 || out_size != (int)O_END || ws_size < WS_END) {
            fprintf(stderr, "kernel_launch: built for 24 inputs, %zu outputs, >= %zu bytes of workspace; got n_in %d out %d ws %zu; nothing launched\n", (size_t)O_END, (size_t)WS_END, n_in, out_size, ws_size);
            grid = -1; return; }
        int dev = 0, cus = 0, per_cu = 0;
        if (hipGetDevice(&dev) != hipSuccess || hipDeviceGetAttribute(&cus, hipDeviceAttributeMultiprocessorCount, dev) != hipSuccess) { fprintf(stderr, "kernel_launch: device query failed\n"); grid = -1; return; }
        if (hipFuncSetAttribute((const void*)nsa_fwd, hipFuncAttributeMaxDynamicSharedMemorySize, LDS_BYTES) != hipSuccess) { fprintf(stderr, "kernel_launch: hipFuncSetAttribute failed\n"); grid = -1; return; }
        if (hipOccupancyMaxActiveBlocksPerMultiprocessor(&per_cu, (const void*)nsa_fwd, NWAVES * 64, LDS_BYTES) != hipSuccess || per_cu < 1)
            fprintf(stderr, "kernel_launch: note: occupancy query reports %d workgroups per CU\n", per_cu);
        (void)hipGetLastError();
        grid = cus;
    }
    if (grid < 0) return;
    if (hipMemsetAsync((char*)d_ws + WS_CTL, 0, CTL_ZERO_BYTES, stream) != hipSuccess) { fprintf(stderr, "kernel_launch: memset failed\n"); return; }
    Args a{};
    for (int i = 0; i < 24; ++i) a.in[i] = (const float*)d_in[i];
    a.out = (float*)d_out; a.ws = (unsigned char*)d_ws;
    const int nl = MK_N_LAUNCHES;
    for (int li = 0; li < nl; ++li) {
        a.ph_lo = nl == 1 ? 0 : li; a.ph_hi = nl == 1 ? NPHASES : li + 1;
        hipLaunchKernelGGL(nsa_fwd, dim3(grid), dim3(NWAVES * 64), LDS_BYTES, stream, a);
        const hipError_t le = hipPeekAtLastError();
        if (le != hipSuccess) { fprintf(stderr, "kernel_launch: launch %d failed: %s\n", li, hipGetErrorName(le)); break; }
    }
}
```

```cpp
#include <hip/hip_runtime.h>
#include <cstdio>
#include <cstdint>
namespace pg8 {
#define PG8_LAS __attribute__((address_space(3)))
typedef unsigned short bf16_t;
typedef short bf16x8 __attribute__((ext_vector_type(8)));
typedef float f32x4 __attribute__((ext_vector_type(4)));
typedef unsigned u32x4 __attribute__((ext_vector_type(4)));
constexpr int BM = 256, BK = 64, HALF = 128, HTB = HALF * BK * 2  , STAGE_BYTES = 8 * HTB, NXCD = 8, WGM = 8;

__host__ __device__ __forceinline__ int lds_byte(int r, int c) { const int st = (r >> 4) * 2 + (c >> 5), rr = r & 15, cc = c & 31, ob = rr * 64 + cc * 2; return st * 1024 + (ob ^ (((ob >> 9) & 1) << 5)); }
__host__ __device__ __forceinline__ void stage_rc(int b, int& R, int& C) { const int st = b / 1024, sb = b % 1024, swz = sb ^ (((sb >> 9) & 1) << 5); R = (st >> 1) * 16 + swz / 64; C = (st & 1) * 32 + (swz % 64) / 2; }
__host__ __device__ __forceinline__ int perm32(int rho) { const int n = rho >> 4, i = rho & 15; return 8 * (i >> 2) + 4 * n + (i & 3); }

struct Unit { int pm, pn; };
struct Gemm { const bf16_t* A; const bf16_t* Bt; int M, N, K, lda, ldb; int tileA = 0, tileB = 0; };

struct StaticOrder {
    int nM, nN, nwg, G, c;
    __host__ __device__ void init(int M, int N, int G_, int c_) { nM = M / BM; nN = N / BM; nwg = nM * nN; G = G_; c = c_; }
    __host__ __device__ bool next(int i, Unit& u) const {
        const long L = (long)i * G + c; if (L >= nwg) return false;
        int wgid = (int)L; { const int q = nwg / NXCD, r = nwg % NXCD, xcd = wgid % NXCD, off = wgid / NXCD; wgid = (xcd < r ? xcd * (q + 1) : r * (q + 1) + (xcd - r) * q) + off; }
        const int nig = WGM * nN, gid = wgid / nig, fm = gid * WGM, gsz = (nM - fm) < WGM ? (nM - fm) : WGM;
        u.pm = fm + ((wgid % nig) % gsz); u.pn = (wgid % nig) / gsz; return true;
    }
    __device__ __forceinline__ void a_ready(const Unit&) const {}
    __device__ __forceinline__ void done(const Unit&) const {}
};

__device__ __forceinline__ unsigned cvt_pk_bf16(float lo, float hi) { unsigned r; asm volatile("v_cvt_pk_bf16_f32 %0, %1, %2" : "=v"(r) : "v"(lo), "v"(hi)); return r; }
typedef float f32x2 __attribute__((ext_vector_type(2)));
template <class Epi, class Sched, bool ALIGN_EPI = false, bool SP2 = false>
__device__ __forceinline__ void gemm_phase(PG8_LAS unsigned char* lds, const Gemm g, const Sched& S, const Epi& E, const int tid) {
    const int wid = __builtin_amdgcn_readfirstlane(tid >> 6), lane = tid & 63, wr = wid >> 2, wc = wid & 3, fr = lane & 15, fq = lane >> 4;
    const int K = g.K, nt = K / BK;
    unsigned voffA[2], voffB[2];
#pragma unroll
    for (int i = 0; i < 2; ++i) { int R, C; stage_rc(tid * 16 + i * 8192, R, C); const int Rb = Epi::PERM ? ((R & ~31) + perm32(R & 31)) : R;
        voffA[i] = (unsigned)(R * (g.tileA ? 64 : g.lda) + C) * 2u; voffB[i] = (unsigned)(Rb * (g.tileB ? 64 : g.ldb) + C) * 2u; }
    const size_t kstepA = g.tileA ? (size_t)32768 : (size_t)(BK * 2), kstepB = g.tileB ? (size_t)32768 : (size_t)(BK * 2);
    const size_t hstepA = g.tileA ? (size_t)16384 : (size_t)HALF * g.lda * 2, hstepB = g.tileB ? (size_t)16384 : (size_t)HALF * g.ldb * 2;
    const size_t tstepA = g.tileA ? (size_t)(g.K / BK) * 32768 : 2 * hstepA, tstepB = g.tileB ? (size_t)(g.K / BK) * 32768 : 2 * hstepB;
    const unsigned ldsw = (unsigned)wid * 1024u;
    const int aoff = lds_byte(wr * 64 + fr, fq * 8), boff = lds_byte(wc * 32 + fr, fq * 8);
#define PG8_SA(b, h) (((b) * 2 + (h)) * HTB)
#define PG8_SB(b, h) ((4 + (b) * 2 + (h)) * HTB)
#define PG8_STAGE(bufoff, gbase, voff) do { _Pragma("unroll") for (int _i = 0; _i < 2; ++_i) \
        __builtin_amdgcn_global_load_lds((const unsigned*)((const char*)(gbase) + (voff)[_i]), (PG8_LAS unsigned*)(lds + (bufoff) + ldsw + _i * 8192), 16, 0, 0); } while (0)
#define PG8_LDA(dst, b, h) do { _Pragma("unroll") for (int m = 0; m < 4; ++m) _Pragma("unroll") for (int k = 0; k < 2; ++k) dst[m][k] = *(const PG8_LAS bf16x8*)(lds + PG8_SA(b, h) + aoff + m * 2048 + k * 1024); } while (0)
#define PG8_LDB(dst, b, h) do { _Pragma("unroll") for (int n = 0; n < 2; ++n) _Pragma("unroll") for (int k = 0; k < 2; ++k) dst[n][k] = *(const PG8_LAS bf16x8*)(lds + PG8_SB(b, h) + boff + n * 2048 + k * 1024); } while (0)
#define PG8_MMA(ai, bj, At, Bt) do { __builtin_amdgcn_s_setprio(1); _Pragma("unroll") for (int m = 0; m < 4; ++m) _Pragma("unroll") for (int n = 0; n < 2; ++n) _Pragma("unroll") for (int k = 0; k < 2; ++k) \
        acc[ai][bj][m][n] = __builtin_amdgcn_mfma_f32_16x16x32_bf16(Bt[n][k], At[m][k], acc[ai][bj][m][n], 0, 0, 0); __builtin_amdgcn_s_setprio(0); } while (0)
#define PG8_WAIT_V(n) asm volatile("s_waitcnt vmcnt(" #n ")" ::: "memory")
#define PG8_WAIT_L(n) asm volatile("s_waitcnt lgkmcnt(" #n ")" ::: "memory")
#define PG8_BAR __builtin_amdgcn_s_barrier()
#define PG8_SCHED __builtin_amdgcn_sched_barrier(0)
    Unit cur, nxt; int ui = 0;
    if (!S.next(0, cur)) return;
    f32x4 acc[2][2][4][2];
#pragma unroll
    for (int a = 0; a < 2; ++a)
#pragma unroll
        for (int b = 0; b < 2; ++b)
#pragma unroll
            for (int m = 0; m < 4; ++m)
#pragma unroll
                for (int n = 0; n < 2; ++n) acc[a][b][m][n] = (f32x4){0.f, 0.f, 0.f, 0.f};
    bf16x8 At[4][2], B0[2][2], B1[2][2];
    const char* cA = (const char*)g.A + (size_t)cur.pm * tstepA; const char* cB = (const char*)g.Bt + (size_t)cur.pn * tstepB;
    S.a_ready(cur);
    if constexpr (SP2) {
        PG8_STAGE(PG8_SB(0, 0), cB, voffB); PG8_STAGE(PG8_SB(0, 1), cB + hstepB, voffB); PG8_STAGE(PG8_SA(0, 0), cA, voffA); PG8_STAGE(PG8_SA(0, 1), cA + hstepA, voffA);
        if (wr == 1) PG8_BAR;
        PG8_WAIT_V(2); PG8_BAR;
        PG8_STAGE(PG8_SB(1, 0), cB + kstepB, voffB); PG8_STAGE(PG8_SA(1, 0), cA + kstepA, voffA); PG8_STAGE(PG8_SB(1, 1), cB + hstepB + kstepB, voffB);
        PG8_WAIT_V(6); PG8_BAR;
    } else {
        PG8_STAGE(PG8_SB(0, 0), cB, voffB); PG8_STAGE(PG8_SA(0, 0), cA, voffA); PG8_STAGE(PG8_SB(0, 1), cB + hstepB, voffB); PG8_STAGE(PG8_SA(0, 1), cA + hstepA, voffA);
        if (wr == 1) PG8_BAR;
        PG8_WAIT_V(4); PG8_BAR;
        PG8_STAGE(PG8_SB(1, 0), cB + kstepB, voffB); PG8_STAGE(PG8_SA(1, 0), cA + kstepA, voffA); PG8_STAGE(PG8_SB(1, 1), cB + hstepB + kstepB, voffB);
        PG8_WAIT_V(6); PG8_BAR;
    }
    for (;;) {
        const bool has_next = S.next(ui + 1, nxt);
        const char* nA = has_next ? (const char*)g.A + (size_t)nxt.pm * tstepA : cA; const char* nB = has_next ? (const char*)g.Bt + (size_t)nxt.pn * tstepB : cB;
        for (int t = 0; t < nt; t += 2) {
            const bool last = (t == nt - 2);
            const char* a1 = cA + (size_t)(t + 1) * kstepA;
            const char* a2 = last ? nA : cA + (size_t)(t + 2) * kstepA; const char* b2 = last ? nB : cB + (size_t)(t + 2) * kstepB;
            const char* a3 = a2 + kstepA; const char* b3 = b2 + kstepB;
            if (last && has_next) S.a_ready(nxt);
            if constexpr (SP2) {
            PG8_LDB(B0, 0, 0); PG8_LDB(B1, 0, 1); PG8_SCHED; PG8_LDA(At, 0, 0); PG8_STAGE(PG8_SA(1, 1), a1 + hstepA, voffA);
            PG8_WAIT_V(8); PG8_WAIT_L(0); PG8_BAR; PG8_MMA(0, 0, At, B0); PG8_MMA(0, 1, At, B1); PG8_BAR; PG8_SCHED;
            PG8_LDA(At, 0, 1); PG8_STAGE(PG8_SB(0, 0), b2, voffB); PG8_STAGE(PG8_SB(0, 1), b2 + hstepB, voffB); PG8_STAGE(PG8_SA(0, 0), a2, voffA);
            PG8_WAIT_V(8); PG8_WAIT_L(0); PG8_BAR; PG8_MMA(1, 0, At, B0); PG8_MMA(1, 1, At, B1); PG8_BAR; PG8_SCHED;
            PG8_LDB(B0, 1, 0); PG8_LDB(B1, 1, 1); PG8_SCHED; PG8_LDA(At, 1, 0); PG8_STAGE(PG8_SA(0, 1), a2 + hstepA, voffA);
            PG8_WAIT_V(8); PG8_WAIT_L(0); PG8_BAR; PG8_MMA(0, 0, At, B0); PG8_MMA(0, 1, At, B1); PG8_BAR; PG8_SCHED;
            PG8_LDA(At, 1, 1); PG8_STAGE(PG8_SB(1, 0), b3, voffB); PG8_STAGE(PG8_SB(1, 1), b3 + hstepB, voffB); PG8_STAGE(PG8_SA(1, 0), a3, voffA);
            PG8_WAIT_V(8); PG8_WAIT_L(0); PG8_BAR; PG8_MMA(1, 0, At, B0); PG8_MMA(1, 1, At, B1); PG8_BAR; PG8_SCHED;
            } else {
            PG8_LDB(B0, 0, 0); PG8_SCHED; PG8_LDA(At, 0, 0); PG8_STAGE(PG8_SA(1, 1), a1 + hstepA, voffA);
            PG8_WAIT_L(8); PG8_BAR; PG8_WAIT_L(0); PG8_MMA(0, 0, At, B0); PG8_BAR; PG8_SCHED;
            PG8_LDB(B1, 0, 1); PG8_STAGE(PG8_SB(0, 0), b2, voffB);
            PG8_BAR; PG8_WAIT_L(0); PG8_MMA(0, 1, At, B1); PG8_BAR;
            PG8_LDA(At, 0, 1); PG8_STAGE(PG8_SA(0, 0), a2, voffA);
            PG8_BAR; PG8_WAIT_L(0); PG8_MMA(1, 0, At, B0); PG8_BAR; PG8_SCHED;
            PG8_STAGE(PG8_SB(0, 1), b2 + hstepB, voffB);
            PG8_WAIT_V(6); PG8_BAR; PG8_MMA(1, 1, At, B1); PG8_BAR;
            PG8_LDB(B0, 1, 0); PG8_SCHED; PG8_LDA(At, 1, 0); PG8_STAGE(PG8_SA(0, 1), a2 + hstepA, voffA);
            PG8_WAIT_L(8); PG8_BAR; PG8_WAIT_L(0); PG8_MMA(0, 0, At, B0); PG8_BAR; PG8_SCHED;
            PG8_LDB(B1, 1, 1); PG8_STAGE(PG8_SB(1, 0), b3, voffB);
            PG8_BAR; PG8_WAIT_L(0); PG8_MMA(0, 1, At, B1); PG8_BAR;
            PG8_LDA(At, 1, 1); PG8_STAGE(PG8_SA(1, 0), a3, voffA);
            PG8_BAR; PG8_WAIT_L(0); PG8_MMA(1, 0, At, B0); PG8_BAR; PG8_SCHED;
            PG8_STAGE(PG8_SB(1, 1), b3 + hstepB, voffB);
            PG8_WAIT_V(6); PG8_BAR; PG8_MMA(1, 1, At, B1); PG8_BAR;
            }
        }
        if constexpr (ALIGN_EPI) { if (wr == 0) PG8_BAR; }
        if constexpr (!Epi::AFTER_DRAIN) { E(acc, cur, wr, wc, fr, fq); S.done(cur); }
        if (!has_next) break;
#pragma unroll
        for (int a = 0; a < 2; ++a)
#pragma unroll
            for (int b = 0; b < 2; ++b)
#pragma unroll
                for (int m = 0; m < 4; ++m)
#pragma unroll
                    for (int n = 0; n < 2; ++n) acc[a][b][m][n] = (f32x4){0.f, 0.f, 0.f, 0.f};
        cur = nxt; cA = nA; cB = nB; ++ui;
        if constexpr (ALIGN_EPI) { if (wr == 1) PG8_BAR; }
    }
    PG8_WAIT_V(0);
    if constexpr (!ALIGN_EPI) { if (wr == 0) PG8_BAR; }
    PG8_BAR;
    if constexpr (Epi::AFTER_DRAIN) { E.fused(acc, cur, wr, wc, fr, fq, lds, wid, lane); S.done(cur); }
#undef PG8_SA
#undef PG8_SB
#undef PG8_STAGE
#undef PG8_LDA
#undef PG8_LDB
#undef PG8_MMA
#undef PG8_WAIT_V
#undef PG8_WAIT_L
#undef PG8_BAR
#undef PG8_SCHED
}
}
#define GAS __attribute__((address_space(1)))
#define LAS __attribute__((address_space(3)))
typedef unsigned short bf16;
typedef unsigned v4u __attribute__((ext_vector_type(4)));
typedef float f32x4 __attribute__((ext_vector_type(4)));
typedef short bf16x8 __attribute__((ext_vector_type(8)));
typedef GAS unsigned gu32;
typedef GAS unsigned long long gu64;
#define RLX_AGENT __ATOMIC_RELAXED, __HIP_MEMORY_SCOPE_AGENT
#define LDS_WAIT() asm volatile("s_waitcnt lgkmcnt(0)" ::: "memory")
#define VM_WAIT() asm volatile("s_waitcnt vmcnt(0)" ::: "memory")
__device__ __forceinline__ unsigned long long rt() { return __builtin_amdgcn_s_memrealtime(); }
__device__ __forceinline__ unsigned f2bf(float f) { unsigned u = __builtin_bit_cast(unsigned, f); return (u + 0x7fffu + ((u >> 16) & 1u)) >> 16; }
__device__ __forceinline__ unsigned pk2(float lo, float hi) { return f2bf(lo) | (f2bf(hi) << 16); }

#define XB_TMO      128
#define XB_XCNT(j)  (256  + 64 * (j))
#define XB_XSUB(j)  (1280 + 64 * (j))
#define XB_XGEN(j)  (2304 + 64 * (j))
#define XB_TOP      3328
#define XB_TOPGEN   3392
#define XCD_BAR_WORDS 3456
#define XB_SPIN_CAP (1u << 24)

__device__ __forceinline__ unsigned xb_ld(unsigned* p)              { return __hip_atomic_load(p, __ATOMIC_RELAXED, __HIP_MEMORY_SCOPE_AGENT); }
__device__ __forceinline__ unsigned xb_add(unsigned* p, unsigned v) { return __hip_atomic_fetch_add(p, v, __ATOMIC_RELAXED, __HIP_MEMORY_SCOPE_AGENT); }
__device__ __forceinline__ unsigned xb_xcc_id() { return (unsigned)__builtin_amdgcn_s_getreg((3 << 11) | 20) & 0xFu; }
#define XB_SPIN(cond, bar) do { unsigned _sp = 0; while (cond) { __builtin_amdgcn_s_sleep(1); \
    if ((++_sp & 255u) == 0u) { if (xb_ld(&(bar)[XB_TMO])) break; if (_sp > XB_SPIN_CAP) { atomicAdd(&(bar)[XB_TMO], 1u); break; } } } } while (0)

__device__ __forceinline__ unsigned xb_lane() { unsigned l_; asm volatile("v_mbcnt_lo_u32_b32 %0, -1, 0\n\tv_mbcnt_hi_u32_b32 %0, -1, %0" : "=&v"(l_)); return l_; }
struct XcdBarrier {
    unsigned* bar; unsigned x; unsigned w;
    volatile LAS unsigned* st;
};

__device__ __forceinline__ XcdBarrier xcd_barrier_post(unsigned* bar, volatile LAS unsigned* st) {
    XcdBarrier b; b.bar = bar; b.x = xb_xcc_id(); b.st = st; b.w = (unsigned)__builtin_amdgcn_readfirstlane(threadIdx.x >> 6);
    if (threadIdx.x == 0) (void)xb_add(&bar[XB_XCNT(b.x)], 1u);
    return b;
}
__device__ __forceinline__ void xcd_barrier_complete(unsigned* bar, unsigned x, unsigned& nloc, unsigned& nx) {
    const unsigned G = gridDim.x * gridDim.y * gridDim.z;
    unsigned sum, cnt, mine, sp = 0u;
    for (;;) {
        sum = 0u; cnt = 0u; mine = 0u;
#pragma unroll
        for (unsigned j = 0; j < 16; ++j) { const unsigned c = xb_ld(&bar[XB_XCNT(j)]); sum += c; cnt += (c > 0u) ? 1u : 0u; mine = (j == x) ? c : mine; }
        if (sum == G) break;
        __builtin_amdgcn_s_sleep(1);
        if ((++sp & 255u) == 0u) { if (xb_ld(&bar[XB_TMO])) break; if (sp > XB_SPIN_CAP) { atomicAdd(&bar[XB_TMO], 1u); break; } }
    }
    nloc = mine > 0u ? mine : 1u; nx = cnt > 0u ? cnt : 1u;
}

__device__ __forceinline__ void xcd_barrier(const XcdBarrier& b) {
    asm volatile("s_waitcnt vmcnt(0)" ::: "memory");
    __syncthreads();
    if (b.w == 0u && xb_lane() == 0u) {
        unsigned* bar = b.bar;
        __builtin_amdgcn_s_waitcnt(0);
        unsigned nloc = b.st[0], nx = b.st[1];
        if (nloc == 0u) { xcd_barrier_complete(bar, b.x, nloc, nx); b.st[0] = nloc; b.st[1] = nx; }
        const unsigned old = xb_add(&bar[XB_XSUB(b.x)], 1u);
        const unsigned gen = old / nloc;
        if (old + 1u == (gen + 1u) * nloc) {
            __builtin_amdgcn_fence(__ATOMIC_RELEASE, "agent");
            asm volatile("s_waitcnt vmcnt(0)" ::: "memory");
            const unsigned og = xb_add(&bar[XB_TOP], 1u);
            const unsigned tg = og / nx;
            if (og + 1u == (tg + 1u) * nx) xb_add(&bar[XB_TOPGEN], 1u);
            else XB_SPIN(xb_ld(&bar[XB_TOPGEN]) == tg, bar);
            __builtin_amdgcn_fence(__ATOMIC_ACQUIRE, "agent");
            xb_add(&bar[XB_XGEN(b.x)], 1u);
            asm volatile("s_waitcnt vmcnt(0)" ::: "memory");
        } else {
            XB_SPIN(xb_ld(&bar[XB_XGEN(b.x)]) == gen, bar);
            __builtin_amdgcn_fence(__ATOMIC_ACQUIRE, "agent");
            asm volatile("s_waitcnt vmcnt(0)" ::: "memory");
        }
    }
    __syncthreads();
}
#ifndef PROBE_MASK
#define PROBE_MASK 0
#endif

constexpr int T = 4096, NBATCH = 2, MPROMPT = 8192, MSAMP = 128, MREAL = 8320, MPAD = 8448;
constexpr int DM = 2048, DG = 1024, DQ = 1024, DFF = 8192, NIN = 8728, NINP = 8960;
constexpr int PASTLEN = 2048;
constexpr float EPS = 1e-6f;
constexpr float LOG2E = 1.4426950408889634f;
constexpr float QSCALE = 0.08838834764831845f * 1.4426950408889634f;
constexpr int NWAVES = 8;
constexpr int LD2 = DM + 64, LD1 = DG + 64, LD8 = DFF + 64;

constexpr size_t O_YP = 0, O_YS = 16777216, O_PCMP = O_YS + 262144, O_PSEL = O_PCMP + 4194304, O_PWIN = O_PSEL + 4194304,
                 O_PSGU = O_PWIN + 524288, O_SCMP = O_PSGU + 262144, O_SSEL = O_SCMP + 65536, O_SWIN = O_SSEL + 65536,
                 O_SSGU = O_SWIN + 33554432, O_END = O_SSGU + 131072;
static_assert(O_END == 60030976, "output size");

constexpr size_t MiB = 1ull << 20;
constexpr size_t al(size_t x) { return (x + MiB - 1) / MiB * MiB; }
constexpr size_t WS_CTL = 0, CTL_ZERO_BYTES = 1 * MiB;
constexpr size_t WS_WIN  = 1 * MiB;
constexpr size_t WS_WG   = WS_WIN  + al((size_t)NINP * LD2 * 2);
constexpr size_t WS_WN   = WS_WG   + al((size_t)DM * LD1 * 2);
constexpr size_t WS_WO   = WS_WN   + al((size_t)DM * LD1 * 2);
constexpr size_t WS_WUP  = WS_WO   + al((size_t)DM * LD2 * 2);
constexpr size_t WS_WDN  = WS_WUP  + al((size_t)DFF * LD2 * 2);
constexpr size_t WS_WC   = WS_WDN  + al((size_t)DM * LD8 * 2);
constexpr size_t WS_XB   = WS_WC   + al((size_t)512 * LD2 * 2);
constexpr size_t WS_RSTD1= WS_XB   + al((size_t)MPAD * LD2 * 2);
constexpr size_t WS_U    = WS_RSTD1+ al((size_t)MPAD * 4);
constexpr size_t WS_VG   = WS_U    + al((size_t)MPAD * DG * 2);
constexpr size_t WS_VSS  = WS_VG   + al((size_t)MPAD * DG * 2);
constexpr size_t WS_RSTDV= WS_VSS  + al((size_t)MPAD * 32 * 4);
constexpr size_t WS_QRAW = WS_RSTDV+ al((size_t)MPAD * 4);
constexpr size_t WS_KVWR = WS_QRAW + al((size_t)MPAD * DQ * 4);
constexpr size_t WS_GA   = WS_KVWR + al((size_t)MPAD * 512 * 4);
constexpr size_t WS_GB   = WS_GA   + al((size_t)MPAD * DM * 2);
constexpr size_t WS_GN   = WS_GB   + al((size_t)MPAD * DM * 2);
constexpr size_t WS_QN   = WS_GN   + al((size_t)MPAD * 32 * 4);
constexpr size_t WS_KS   = WS_QN   + al((size_t)MPAD * DQ * 2);
constexpr size_t WS_VS   = WS_KS   + 4 * MiB;
constexpr size_t WS_KW   = WS_VS   + 4 * MiB;
constexpr size_t WS_VW   = WS_KW   + 4 * MiB;
constexpr size_t WS_ACP  = WS_VW   + 4 * MiB;
constexpr size_t WS_ACS  = WS_ACP  + al((size_t)2048 * LD2 * 2);
constexpr size_t WS_YCP  = WS_ACS  + al((size_t)65536 * LD2 * 2);
constexpr size_t WS_YCS  = WS_YCP  + 2 * MiB;
constexpr size_t WS_KCP  = WS_YCS  + 64 * MiB;
constexpr size_t WS_VCP  = WS_KCP  + 1 * MiB;
constexpr size_t WS_KCS  = WS_VCP  + 1 * MiB;
constexpr size_t WS_VCS  = WS_KCS  + 8 * MiB;
constexpr size_t WS_CBP  = WS_VCS  + 8 * MiB;
constexpr size_t WS_WMB  = WS_CBP  + 1 * MiB;
constexpr size_t WS_BLUT = WS_WMB  + 1 * MiB;
constexpr size_t WS_OA   = WS_BLUT + 1 * MiB;
constexpr size_t WS_OB   = WS_OA   + al((size_t)MPAD * LD1 * 2);
constexpr size_t WS_MIXA = WS_OB   + al((size_t)MPAD * LD1 * 2);
constexpr size_t WS_MIX  = WS_MIXA + al((size_t)MPAD * DM * 2);
constexpr size_t WS_X1B  = WS_MIX  + al((size_t)MPAD * LD2 * 2);
constexpr size_t WS_X1F  = WS_X1B  + al((size_t)MPAD * LD2 * 2);
constexpr size_t WS_X1SS = WS_X1F  + al((size_t)128 * DM * 4);
constexpr size_t WS_H    = WS_X1SS + al((size_t)MPAD * 32 * 4);
constexpr size_t WS_OT   = WS_H    + al((size_t)MPAD * LD8 * 2);
constexpr size_t WS_SPART= WS_OT   + 32 * MiB;
constexpr int LDS_X = DM + 64, LDS_G = DG + 64, LDS_H = DFF + 64;
constexpr size_t WS_SXB  = WS_SPART+ 4 * MiB;
constexpr size_t WS_SOA  = WS_SXB  + 1 * MiB;
constexpr size_t WS_SOB  = WS_SOA  + 1 * MiB;
constexpr size_t WS_SMIX = WS_SOB  + 1 * MiB;
constexpr size_t WS_SX1B = WS_SMIX + 1 * MiB;
constexpr size_t WS_SH   = WS_SX1B + 1 * MiB;
constexpr size_t WS_DUMMY= WS_SH   + 3 * MiB;
constexpr size_t WS_END  = WS_DUMMY+ 72 * MiB;

constexpr int CW_TMO = 0, CW_CODE = 1;
constexpr int CW_BAR = 4096;
constexpr int CW_Q5 = 8192;
constexpr int CW_FLAG = 16384;
constexpr int CW_TICK = 65536;
static_assert((CW_TICK + 64 * 64) * 4 <= (int)CTL_ZERO_BYTES && (CW_BAR + 16 * 3456) * 4 <= (int)CTL_ZERO_BYTES, "CTL words inside the memset region");

constexpr int RING_OFF = 0, RING_BYTES = 131072;
constexpr int LDSCTL_OFF = RING_BYTES, MISC_OFF = LDSCTL_OFF + 320;
constexpr int LDS_BYTES = 147456;
static_assert(MISC_OFF + 128 <= LDS_BYTES, "LDS map");

__constant__ unsigned char kBkt[128] = {0, 1, 2, 3, 4, 5, 6, 7, 8, 9, 10, 11, 12, 13, 14, 15, 16, 16, 16, 17, 17, 18, 18, 18, 19, 19, 19, 20, 20, 20, 20, 21, 21, 21, 21, 22, 22, 22, 22, 22, 23, 23, 23, 23, 23, 23, 24, 24, 24, 24, 24, 24, 25, 25, 25, 25, 25, 25, 25, 26, 26, 26, 26, 26, 26, 26, 26, 27, 27, 27, 27, 27, 27, 27, 27, 27, 27, 28, 28, 28, 28, 28, 28, 28, 28, 28, 28, 29, 29, 29, 29, 29, 29, 29, 29, 29, 29, 29, 29, 30, 30, 30, 30, 30, 30, 30, 30, 30, 30, 30, 30, 30, 30, 31, 31, 31, 31, 31, 31, 31, 31, 31, 31, 31, 31, 31, 31, 31};

__host__ __device__ __forceinline__ size_t tm_idx(int row, int col, int nkt) { return ((size_t)((row >> 8) * nkt + (col >> 6)) * 256 + (row & 255)) * 64 + (col & 63); }

typedef unsigned v2u __attribute__((ext_vector_type(2)));
struct Ctx {
    const float* const* in; float* out; unsigned char* ws;
    LAS unsigned char* lds;
    int tid, lane, wave, vcu, G;
};
__device__ __forceinline__ int lane_now() { int l_; asm volatile("v_mbcnt_lo_u32_b32 %0, -1, 0\n\tv_mbcnt_hi_u32_b32 %0, -1, %0" : "=&v"(l_) : : "memory"); return l_; }
__device__ __forceinline__ Ctx fresh(const Ctx& C) { Ctx L = C; const int l_ = lane_now(); L.lane = l_; L.tid = C.wave * 64 + l_; return L; }
#define IN_XP 0
#define IN_XS 1
#define IN_CCMP 2
#define IN_CSEL 3
#define IN_WINB 4
#define IN_PT 5
#define IN_RELB 6
#define IN_GMIX 7
#define IN_WIN 8
#define IN_GSGU 9
#define IN_WSGU 10
#define IN_BSGU 11
#define IN_GQ 12
#define IN_GK 13
#define IN_POSK 14
#define IN_WCK 15
#define IN_POSV 16
#define IN_WCV 17
#define IN_WPG 18
#define IN_WPN 19
#define IN_WOUT 20
#define IN_GMLP 21
#define IN_WUP 22
#define IN_WDN 23

__device__ __forceinline__ float bf2f(unsigned short b) { return __uint_as_float((unsigned)b << 16); }
__device__ __forceinline__ float bflo(unsigned w) { return __uint_as_float(w << 16); }
__device__ __forceinline__ float bfhi(unsigned w) { return __uint_as_float(w & 0xffff0000u); }
__device__ __forceinline__ void unpack8(v4u w, float (&f)[8]) {
    f[0] = bflo(w.x); f[1] = bfhi(w.x); f[2] = bflo(w.y); f[3] = bfhi(w.y); f[4] = bflo(w.z); f[5] = bfhi(w.z); f[6] = bflo(w.w); f[7] = bfhi(w.w);
}
__device__ __forceinline__ v4u pack8f(const float (&f)[8]) { v4u w; w.x = pk2(f[0], f[1]); w.y = pk2(f[2], f[3]); w.z = pk2(f[4], f[5]); w.w = pk2(f[6], f[7]); return w; }
__device__ __forceinline__ float wave_sum(float v) {
#pragma unroll
    for (int o = 1; o < 64; o <<= 1) v += __shfl_xor(v, o);
    return v;
}
__device__ __forceinline__ float wave_max(float v) {
#pragma unroll
    for (int o = 1; o < 64; o <<= 1) v = fmaxf(v, __shfl_xor(v, o));
    return v;
}
__device__ __forceinline__ float sigmoidf_(float x) { return 1.0f / (1.0f + __expf(-x)); }
__device__ __forceinline__ float gelu_tanh(float x) {
    const float u = 0.7978845608028654f * (x + 0.044715f * x * x * x);
    return x / (1.0f + __expf(-2.0f * u));
}

__device__ __forceinline__ void tr_item(const float* W, int ldw, int srccol0, int nvalid, const float* kscale, bf16* WT, int nkt, int dst_row0, int k0, LAS float* scr, int lane) {
    const int n = lane & 31;
    float vv[32];
#pragma unroll
    for (int i = 0; i < 32; ++i) { const int kk = 2 * i + (lane >> 5); vv[i] = (n < nvalid) ? __builtin_nontemporal_load(W + (size_t)(k0 + kk) * ldw + srccol0 + n) : 0.f; }
    if (kscale) {
#pragma unroll
        for (int i = 0; i < 32; ++i) vv[i] *= kscale[k0 + 2 * i + (lane >> 5)]; }
#pragma unroll
    for (int i = 0; i < 32; ++i) scr[(2 * i + (lane >> 5)) * 33 + n] = vv[i];
    LDS_WAIT(); asm volatile("" ::: "memory");
    const int c = lane & 7;
#pragma unroll
    for (int j = 0; j < 4; ++j) { const int nn = (lane >> 3) + 8 * j; const LAS float* s = scr + (8 * c) * 33 + nn;
        v4u o; o.x = pk2(s[0 * 33], s[1 * 33]); o.y = pk2(s[2 * 33], s[3 * 33]); o.z = pk2(s[4 * 33], s[5 * 33]); o.w = pk2(s[6 * 33], s[7 * 33]);
        { const int n_ = dst_row0 + nn; *(GAS v4u*)(WT + ((size_t)((n_ >> 8) * nkt + (k0 >> 6)) * 256 + (n_ & 255)) * 64 + 8 * c) = o; } }
    LDS_WAIT(); asm volatile("" ::: "memory");
}

constexpr int I_IN = 32 * 280, I_PG = 16 * 64, I_PN = 16 * 64, I_OUT = 32 * 64, I_UP = 32 * 256, I_DN = 128 * 64, I_C = 4 * 128;
constexpr int I_LATE = I_PG + I_PN + I_OUT + I_UP + I_DN;
__device__ __forceinline__ void w_item_in(const Ctx& C, int r, LAS float* scr) {
    const int kb = r / 280, nb = r % 280, n0 = nb * 32;
    const int src = n0 < 4608 ? n0 : (n0 < 8704 ? n0 + 24 : n0 - 8704 + 4608);
    const int nv = n0 < 8704 ? 32 : (n0 == 8704 ? 24 : 0);
    tr_item(C.in[IN_WIN], NIN, src, nv, C.in[IN_GMIX], (bf16*)(C.ws + WS_WIN), DM / 64, n0, kb * 64, scr, C.lane);
}
__device__ __forceinline__ void w_item_cmp(const Ctx& C, int r, LAS float* scr) {
    const int sub = r / 128, rr = r % 128, kv = sub >> 1, hf = sub & 1, kb = rr / 4, nb = rr % 4;
    const float* W = (kv ? C.in[IN_WCV] : C.in[IN_WCK]) + (size_t)hf * 2048 * 128;
    tr_item(W, 128, nb * 32, 32, nullptr, (bf16*)(C.ws + WS_WC), 2048 / 64, kv * 256 + hf * 128 + nb * 32, kb * 64, scr, C.lane);
}
__device__ __forceinline__ void w_item_late(const Ctx& C, int r, LAS float* scr) {
    unsigned char* ws = C.ws; const int lane = C.lane;
    if (r < I_PG) { const int kb = r / 64, nb = r % 64; tr_item(C.in[IN_WPG], DM, nb * 32, 32, nullptr, (bf16*)(ws + WS_WG), DG / 64, nb * 32, kb * 64, scr, lane); return; } r -= I_PG;
    if (r < I_PN) { const int kb = r / 64, nb = r % 64; tr_item(C.in[IN_WPN], DM, nb * 32, 32, nullptr, (bf16*)(ws + WS_WN), DQ / 64, nb * 32, kb * 64, scr, lane); return; } r -= I_PN;
    if (r < I_OUT) { const int kb = r / 64, nb = r % 64; tr_item(C.in[IN_WOUT], DM, nb * 32, 32, nullptr, (bf16*)(ws + WS_WO), DM / 64, nb * 32, kb * 64, scr, lane); return; } r -= I_OUT;
    if (r < I_UP) { const int kb = r / 256, nb = r % 256; tr_item(C.in[IN_WUP], DFF, nb * 32, 32, C.in[IN_GMLP], (bf16*)(ws + WS_WUP), DM / 64, nb * 32, kb * 64, scr, lane); return; } r -= I_UP;
    { const int kb = r / 64, nb = r % 64; tr_item(C.in[IN_WDN], DM, nb * 32, 32, nullptr, (bf16*)(ws + WS_WDN), DFF / 64, nb * 32, kb * 64, scr, lane); }
}
__device__ __forceinline__ void gather_item(const Ctx& C, int it) {
    const int lane = C.lane, kvg = lane >> 4, d = (lane & 15) * 8;
    const int b = it >> 7, p = (it >> 3) & 15, sg = it & 7, page = ((const int*)C.in[IN_PT])[b * 16 + p], j = p * 8 + sg;
    const float* src = C.in[IN_CCMP] + ((size_t)page * 128 + sg * 16) * 512 + lane * 8;
    bf16* dst = (bf16*)(C.ws + WS_ACS) + (size_t)((b * 4 + kvg) * 128 + j) * LD2 + d;
#pragma unroll
    for (int h = 0; h < 2; ++h) { f32x4 a[8], c2[8];
#pragma unroll
        for (int s = 0; s < 8; ++s) { a[s] = __builtin_nontemporal_load((const GAS f32x4*)(src + (h * 8 + s) * 512)); c2[s] = __builtin_nontemporal_load((const GAS f32x4*)(src + (h * 8 + s) * 512 + 4)); }
#pragma unroll
        for (int s = 0; s < 8; ++s) { v4u o; o.x = pk2(a[s].x, a[s].y); o.y = pk2(a[s].z, a[s].w); o.z = pk2(c2[s].x, c2[s].y); o.w = pk2(c2[s].z, c2[s].w);
            *(GAS v4u*)(dst + (h * 8 + s) * 128) = o; } }
}
constexpr int WINCOPY_F4 = 128 * 65408, WINCOPY_CHUNK = 16384, WINCOPY_ITEMS = (WINCOPY_F4 + WINCOPY_CHUNK - 1) / WINCOPY_CHUNK;
__device__ __forceinline__ void wincopy_item(const Ctx& C, int chunk) {
    const GAS f32x4* src = (const GAS f32x4*)C.in[IN_WINB]; GAS f32x4* dst = (GAS f32x4*)(C.out + O_SWIN);
    const int base = chunk * WINCOPY_CHUNK + C.tid;
#pragma unroll
    for (int h = 0; h < 2; ++h) { f32x4 v[16];
#pragma unroll
        for (int k = 0; k < 16; ++k) { const int i = base + (h * 16 + k) * NWAVES * 64; if (i < WINCOPY_F4) { const int b = i / 65408, r = i - b * 65408; v[k] = __builtin_nontemporal_load(src + b * 65536 + 128 + r); } }
#pragma unroll
        for (int k = 0; k < 16; ++k) { const int i = base + (h * 16 + k) * NWAVES * 64; if (i < WINCOPY_F4) { const int b = i / 65408, r = i - b * 65408; __builtin_nontemporal_store(v[k], dst + b * 65536 + r); } } }
}

__device__ __forceinline__ void p0_prologue(const Ctx& C) {
    unsigned char* ws = C.ws;
    LAS float* scr = (LAS float*)(C.lds + RING_OFF + C.wave * 16384);
    const int gw = C.vcu * NWAVES + C.wave, NGW = C.G * NWAVES, lane = C.lane;
    for (int rep = 0; rep < (((PROBE_MASK >> 10) & 1) ? 2 : 1); ++rep)
    for (int it = gw; it < I_IN + I_C; it += NGW) { if (it < I_IN) w_item_in(C, it, scr); else w_item_cmp(C, it - I_IN, scr); }
    {
        bf16* XB = (bf16*)(ws + WS_XB); float* RS = (float*)(ws + WS_RSTD1);
        for (int rep = 0; rep < (((PROBE_MASK >> 12) & 1) ? 2 : 1); ++rep)
        for (int m = gw; m < MREAL; m += NGW) {
            const bool pr_ = m < MPROMPT;
            GAS v2u* o8 = pr_ ? (GAS v2u*)(XB + tm_idx(m, 4 * (lane & 15), DM / 64)) + 0 : (GAS v2u*)((bf16*)(ws + WS_SXB) + (size_t)(m - MPROMPT) * LDS_X) + lane;
            const float* xr = m < MPROMPT ? C.in[IN_XP] + (size_t)m * DM : C.in[IN_XS] + (size_t)(m - MPROMPT) * DM;
            const GAS f32x4* x4 = (const GAS f32x4*)xr + lane; f32x4 v[8]; float s = 0.f;
#pragma unroll
            for (int j = 0; j < 8; ++j) { v[j] = x4[64 * j]; s += (v[j].x * v[j].x + v[j].y * v[j].y) + (v[j].z * v[j].z + v[j].w * v[j].w); }
            s = wave_sum(s);
#pragma unroll
            for (int j = 0; j < 8; ++j) o8[pr_ ? (size_t)((lane >> 4) + 4 * j) * 4096 : (size_t)64 * j] = (v2u){pk2(v[j].x, v[j].y), pk2(v[j].z, v[j].w)};
            if (lane == 0) RS[m] = rsqrtf(s * (1.0f / DM) + EPS);
        }
    }
    {
        float* CBP = (float*)(ws + WS_CBP);
        for (int it = gw; it < 64; it += NGW) { const int kv = it >> 5, eb = (it >> 4) & 1, kc = it & 15, e = eb * 64 + lane;
            const float* pos = kv ? C.in[IN_POSV] : C.in[IN_POSK]; const float* W = kv ? C.in[IN_WCV] : C.in[IN_WCK]; float a = 0.f;
#pragma unroll 8
            for (int k = kc * 256; k < kc * 256 + 256; ++k) a += pos[k] * W[(size_t)k * 128 + e];
            CBP[(kv * 16 + kc) * 128 + e] = a; }
    }
    {
        const float* w = C.in[IN_WSGU]; bf16* WMB = (bf16*)(ws + WS_WMB);
        for (int i = gw * 64 + lane; i < 8 * 128 * 128 / 8; i += NGW * 64) { const int e0 = i * 8, t = (e0 >> 7) & 127, s0 = e0 & 127; float f[8];
#pragma unroll
            for (int k = 0; k < 8; ++k) f[k] = (s0 + k <= t) ? w[e0 + k] : 0.f;
            *(GAS v4u*)(WMB + e0) = pack8f(f); }
        float* BL = (float*)(ws + WS_BLUT); const float* rb = C.in[IN_RELB];
        for (int i = gw * 64 + lane; i < 8 * 132; i += NGW * 64) { const int h = i / 132, rel = i % 132; const int bk = rel < 128 ? kBkt[rel] : 31; BL[i] = rb[bk * 8 + h] * LOG2E; }
    }
}

namespace epi {
using pg8::f32x4; using pg8::Unit; using pg8::cvt_pk_bf16;
typedef unsigned u32x4 __attribute__((ext_vector_type(4)));
__device__ __forceinline__ u32x4 pack8v(f32x4 a, f32x4 b) { u32x4 w; w.x = cvt_pk_bf16(a[0], a[1]); w.y = cvt_pk_bf16(a[2], a[3]); w.z = cvt_pk_bf16(b[0], b[1]); w.w = cvt_pk_bf16(b[2], b[3]); return w; }

struct EpiIn {
    static constexpr bool PERM = true, AFTER_DRAIN = false;
    const float* rstd; bf16* U; bf16* VG; float* VSS; float* QRAW; float* KVWR; bf16* GA; bf16* GB; float* GN; float* out; bf16* ACP;
    __device__ __forceinline__ void operator()(const f32x4 (&acc)[2][2][4][2], const Unit& u, int wr, int wc, int fr, int fq) const {
        const int row0 = u.pm * 256 + wr * 64 + fr, cl = wc * 32 + 8 * fq, pn = u.pn;
#pragma unroll
        for (int ai = 0; ai < 2; ++ai)
#pragma unroll
            for (int m = 0; m < 4; ++m) { const int row = row0 + ai * 128 + m * 16; const float rs = rstd[row];
#pragma unroll
                for (int bj = 0; bj < 2; ++bj) { f32x4 v0 = acc[ai][bj][m][0] * rs, v1 = acc[ai][bj][m][1] * rs; const int c = cl + bj * 128;
                    if (pn < 8) {
#pragma unroll
                        for (int k = 0; k < 4; ++k) { v0[k] = gelu_tanh(v0[k]); v1[k] = gelu_tanh(v1[k]); }
                        if (pn < 4) *(u32x4*)(U + (size_t)row * DG + pn * 256 + c) = pack8v(v0, v1);
                        else { *(u32x4*)(VG + (size_t)row * DG + (pn - 4) * 256 + c) = pack8v(v0, v1);
                            float ss = (v0[0] * v0[0] + v0[1] * v0[1]) + (v0[2] * v0[2] + v0[3] * v0[3]) + (v1[0] * v1[0] + v1[1] * v1[1]) + (v1[2] * v1[2] + v1[3] * v1[3]);
                            ss += __shfl_xor(ss, 16); ss += __shfl_xor(ss, 32);
                            if (fq == 0) VSS[(size_t)row * 32 + (pn - 4) * 8 + bj * 4 + wc] = ss; }
                    } else if (pn < 12) { float* q = QRAW + (size_t)row * DQ + (pn - 8) * 256 + c; *(f32x4*)q = v0; *(f32x4*)(q + 4) = v1;
                    } else if (pn < 16) {
                        const int cc = ((pn - 12) & 1) * 256 + c; float* o = nullptr;
                        if (row < MPROMPT) o = out + (pn < 14 ? O_PCMP : O_PSEL) + (size_t)row * 512 + cc;
                        else if (row < MREAL) o = out + (pn < 14 ? O_SCMP : O_SSEL) + (size_t)(row - MPROMPT) * 512 + cc;
                        if (o) { *(f32x4*)o = v0; *(f32x4*)(o + 4) = v1; }
                        if (pn < 14 && row < MPROMPT) {
                            const int b_ = row >> 12, t_ = row & 4095;
                            *(u32x4*)(ACP + tm_idx(((b_ * 2 + (cc >> 8)) * 2 + ((cc >> 7) & 1)) * 256 + (t_ >> 4), (t_ & 15) * 128 + (cc & 127), 2048 / 64)) = pack8v(v0, v1); }
                    } else if (pn < 18) { float* o = KVWR + (size_t)row * 512 + (pn - 16) * 256 + c; *(f32x4*)o = v0; *(f32x4*)(o + 4) = v1;
                    } else if (pn < 34) {
#pragma unroll
                        for (int k = 0; k < 4; ++k) { v0[k] = sigmoidf_(v0[k]); v1[k] = sigmoidf_(v1[k]); }
                        bf16* g = (pn < 26 ? GA + (size_t)row * DM + (pn - 18) * 256 : GB + (size_t)row * DM + (pn - 26) * 256) + c; *(u32x4*)g = pack8v(v0, v1);
                    } else { if (c < 24) {
#pragma unroll
                        for (int k = 0; k < 4; ++k) { v0[k] = sigmoidf_(v0[k]); v1[k] = sigmoidf_(v1[k]); }
                        float* o = GN + (size_t)row * 32 + c; *(f32x4*)o = v0; *(f32x4*)(o + 4) = v1; } }
                } }
    }
};
struct EpiCmp {
    static constexpr bool PERM = false, AFTER_DRAIN = false;
    float* YC; int segmask;
    __device__ __forceinline__ void operator()(const f32x4 (&acc)[2][2][4][2], const Unit& u, int wr, int wc, int fr, int fq) const {
        const int row0 = u.pm * 256 + wr * 64 + fr, cl = wc * 32 + 4 * fq;
#pragma unroll
        for (int ai = 0; ai < 2; ++ai)
#pragma unroll
            for (int m = 0; m < 4; ++m) { const int row = row0 + ai * 128 + m * 16;
#pragma unroll
                for (int n = 0; n < 2; ++n) { *(f32x4*)(YC + (size_t)row * 256 + cl + n * 16) = acc[ai][0][m][n];
                    if ((row & segmask) != 0) *(f32x4*)(YC + (size_t)(row - 1) * 256 + 128 + cl + n * 16) = acc[ai][1][m][n]; } }
    }
};
struct EpiMixA {
    static constexpr bool PERM = true, AFTER_DRAIN = false;
    const bf16* GA; bf16* MIXA;
    __device__ __forceinline__ void operator()(const f32x4 (&acc)[2][2][4][2], const Unit& u, int wr, int wc, int fr, int fq) const {
        const int row0 = u.pm * 256 + wr * 64 + fr, c0 = u.pn * 256 + wc * 32 + 8 * fq;
#pragma unroll
        for (int ai = 0; ai < 2; ++ai) { v4u gv[4][2];
#pragma unroll
            for (int m = 0; m < 4; ++m)
#pragma unroll
                for (int bj = 0; bj < 2; ++bj) gv[m][bj] = *(const v4u*)(GA + (size_t)(row0 + ai * 128 + m * 16) * DM + c0 + bj * 128);
#pragma unroll
            for (int m = 0; m < 4; ++m) { const size_t ro = (size_t)(row0 + ai * 128 + m * 16) * DM;
#pragma unroll
                for (int bj = 0; bj < 2; ++bj) { const size_t o = ro + c0 + bj * 128; float g[8]; unpack8(gv[m][bj], g);
                    f32x4 v0 = acc[ai][bj][m][0], v1 = acc[ai][bj][m][1];
                    v0[0] *= g[0]; v0[1] *= g[1]; v0[2] *= g[2]; v0[3] *= g[3]; v1[0] *= g[4]; v1[1] *= g[5]; v1[2] *= g[6]; v1[3] *= g[7];
                    *(u32x4*)(MIXA + o) = pack8v(v0, v1); } } }
    }
};
struct EpiMixB {
    static constexpr bool PERM = true, AFTER_DRAIN = false;
    const bf16* GB; const bf16* MIXA; bf16* MIX;
    __device__ __forceinline__ void operator()(const f32x4 (&acc)[2][2][4][2], const Unit& u, int wr, int wc, int fr, int fq) const {
        const int row0 = u.pm * 256 + wr * 64 + fr, c0 = u.pn * 256 + wc * 32 + 8 * fq;
#pragma unroll
        for (int ai = 0; ai < 2; ++ai) { v4u gv[4][2], av[4][2];
#pragma unroll
            for (int m = 0; m < 4; ++m)
#pragma unroll
                for (int bj = 0; bj < 2; ++bj) { const size_t o = (size_t)(row0 + ai * 128 + m * 16) * DM + c0 + bj * 128; gv[m][bj] = *(const v4u*)(GB + o); av[m][bj] = *(const v4u*)(MIXA + o); }
#pragma unroll
            for (int m = 0; m < 4; ++m)
#pragma unroll
                for (int bj = 0; bj < 2; ++bj) { float g[8], a[8]; unpack8(gv[m][bj], g); unpack8(av[m][bj], a);
                    f32x4 v0 = acc[ai][bj][m][0], v1 = acc[ai][bj][m][1];
                    v0[0] = a[0] + v0[0] * g[0]; v0[1] = a[1] + v0[1] * g[1]; v0[2] = a[2] + v0[2] * g[2]; v0[3] = a[3] + v0[3] * g[3];
                    v1[0] = a[4] + v1[0] * g[4]; v1[1] = a[5] + v1[1] * g[5]; v1[2] = a[6] + v1[2] * g[6]; v1[3] = a[7] + v1[3] * g[7];
                    *(u32x4*)(MIX + tm_idx(row0 + ai * 128 + m * 16, c0 + bj * 128, DM / 64)) = pack8v(v0, v1); } }
    }
};
struct EpiOut {
    static constexpr bool PERM = true, AFTER_DRAIN = false;
    const float* xp; const float* xs; float* out; bf16* X1B; float* SS;
    __device__ __forceinline__ void operator()(const f32x4 (&acc)[2][2][4][2], const Unit& u, int wr, int wc, int fr, int fq) const {
        const int row0 = u.pm * 256 + wr * 64 + fr, c0 = u.pn * 256 + wc * 32 + 8 * fq;
#pragma unroll
        for (int ai = 0; ai < 2; ++ai) { f32x4 xv[4][2][2];
#pragma unroll
            for (int m = 0; m < 4; ++m)
#pragma unroll
                for (int bj = 0; bj < 2; ++bj) { const float* xr = xp + (size_t)(row0 + ai * 128 + m * 16) * DM + c0 + bj * 128; xv[m][bj][0] = *(const f32x4*)xr; xv[m][bj][1] = *(const f32x4*)(xr + 4); }
#pragma unroll
            for (int m = 0; m < 4; ++m) { const int row = row0 + ai * 128 + m * 16; float ss = 0.f;
#pragma unroll
                for (int bj = 0; bj < 2; ++bj) { const int c = c0 + bj * 128; const f32x4 v0 = acc[ai][bj][m][0] + xv[m][bj][0], v1 = acc[ai][bj][m][1] + xv[m][bj][1];
                    *(u32x4*)(X1B + tm_idx(row, c, DM / 64)) = pack8v(v0, v1);
                    ss += (v0[0] * v0[0] + v0[1] * v0[1]) + (v0[2] * v0[2] + v0[3] * v0[3]) + (v1[0] * v1[0] + v1[1] * v1[1]) + (v1[2] * v1[2] + v1[3] * v1[3]); }
                ss += __shfl_xor(ss, 16); ss += __shfl_xor(ss, 32);
                if (fq == 0) SS[(size_t)row * 32 + u.pn * 4 + wc] = ss; } }
    }
};
struct EpiUp {
    static constexpr bool PERM = true, AFTER_DRAIN = false;
    const float* SS; bf16* H;
    __device__ __forceinline__ void operator()(const f32x4 (&acc)[2][2][4][2], const Unit& u, int wr, int wc, int fr, int fq) const {
        const int row0 = u.pm * 256 + wr * 64 + fr, c0 = u.pn * 256 + wc * 32 + 8 * fq;
#pragma unroll
        for (int ai = 0; ai < 2; ++ai)
#pragma unroll
            for (int m = 0; m < 4; ++m) { const int row = row0 + ai * 128 + m * 16; const f32x4* sp = (const f32x4*)(SS + (size_t)row * 32) + 2 * fq;
                const f32x4 s4 = sp[0] + sp[1]; float st = (s4[0] + s4[1]) + (s4[2] + s4[3]); st += __shfl_xor(st, 16); st += __shfl_xor(st, 32);
                const float rs = rsqrtf(st * (1.0f / DM) + EPS);
#pragma unroll
                for (int bj = 0; bj < 2; ++bj) { f32x4 v0 = acc[ai][bj][m][0] * rs, v1 = acc[ai][bj][m][1] * rs;
#pragma unroll
                    for (int k = 0; k < 4; ++k) { const float a = fmaxf(v0[k], 0.f), b = fmaxf(v1[k], 0.f); v0[k] = a * a; v1[k] = b * b; }
                    { const int col = c0 + bj * 128; *(u32x4*)(H + ((size_t)((row >> 8) * (DFF / 64) + (col >> 6)) * 256 + (row & 255)) * 64 + (col & 63)) = pack8v(v0, v1); } } }
    }
};
struct EpiDown {
    static constexpr bool PERM = true, AFTER_DRAIN = false;
    float* out; const bf16* X1B;
    __device__ __forceinline__ void operator()(const f32x4 (&acc)[2][2][4][2], const Unit& u, int wr, int wc, int fr, int fq) const {
        const int row0 = u.pm * 256 + wr * 64 + fr, c0 = u.pn * 256 + wc * 32 + 8 * fq;
#pragma unroll
        for (int ai = 0; ai < 2; ++ai) { u32x4 xv[4][2];
#pragma unroll
            for (int m = 0; m < 4; ++m)
#pragma unroll
                for (int bj = 0; bj < 2; ++bj) xv[m][bj] = *(const u32x4*)(X1B + tm_idx(row0 + ai * 128 + m * 16, c0 + bj * 128, DM / 64));
#pragma unroll
            for (int m = 0; m < 4; ++m)
#pragma unroll
                for (int bj = 0; bj < 2; ++bj) { float* p = out + O_YP + (size_t)(row0 + ai * 128 + m * 16) * DM + c0 + bj * 128; const u32x4 w = xv[m][bj];
                    const f32x4 x0 = {__uint_as_float(w.x << 16), __uint_as_float(w.x & 0xffff0000u), __uint_as_float(w.y << 16), __uint_as_float(w.y & 0xffff0000u)};
                    const f32x4 x1 = {__uint_as_float(w.z << 16), __uint_as_float(w.z & 0xffff0000u), __uint_as_float(w.w << 16), __uint_as_float(w.w & 0xffff0000u)};
                    *(f32x4*)p = x0 + acc[ai][bj][m][0]; *(f32x4*)(p + 4) = x1 + acc[ai][bj][m][1]; } }
    }
};
struct CmpOrder {
    int n, G, c, shift;
    __device__ __forceinline__ bool next(int i, Unit& u) const { const int L = i * G + c; if (L >= n) return false; u.pm = L; u.pn = (L >> shift) & 1; return true; }
    __device__ __forceinline__ void a_ready(const Unit&) const {}
    __device__ __forceinline__ void done(const Unit&) const {}
};
}

__device__ __forceinline__ float grp_sum8(float v) { v += __shfl_xor(v, 1); v += __shfl_xor(v, 2); v += __shfl_xor(v, 4); return v; }
__device__ __forceinline__ float grp_sum16(float v) { v = grp_sum8(v); v += __shfl_xor(v, 8); return v; }
__device__ __forceinline__ float grp_sum32(float v) { v = grp_sum16(v); v += __shfl_xor(v, 16); return v; }

__device__ __forceinline__ void p2_post(const Ctx& C, int idx, int nblk) {
    unsigned char* ws = C.ws; const int gw = idx * NWAVES + C.wave, NGW = nblk * NWAVES, lane = C.lane;
    const float* QRAW = (const float*)(ws + WS_QRAW); bf16* QN = (bf16*)(ws + WS_QN); const float* KVWR = (const float*)(ws + WS_KVWR);
    const float* gq = C.in[IN_GQ]; const float* gk = C.in[IN_GK];
    const int kv = lane >> 5, g = (lane >> 4) & 1, d = (lane & 15) * 8;
    for (int row = gw; row < MREAL; row += NGW) {
        const bool pr = row < MPROMPT; const int b = row >> 12, t = row & 4095, bs = row - MPROMPT;
        const GAS f32x4* q4 = (const GAS f32x4*)(QRAW + (size_t)row * DQ + lane * 16); f32x4 v[4];
#pragma unroll
        for (int j2 = 0; j2 < 4; ++j2) v[j2] = q4[j2];
        const float* wsrc = KVWR + (size_t)row * 512 + lane * 8; const f32x4 wa = *(const GAS f32x4*)wsrc, wc2 = *(const GAS f32x4*)(wsrc + 4);
        f32x4 sa = {0.f, 0.f, 0.f, 0.f}, sc2 = sa;
        if (pr) { const float* ssrc = C.out + O_PSEL + (size_t)row * 512 + lane * 8; sa = *(const GAS f32x4*)ssrc; sc2 = *(const GAS f32x4*)(ssrc + 4);
 }
        float vs = lane < 32 ? ((const float*)(ws + WS_VSS))[(size_t)row * 32 + lane] : 0.f;
        { float ss = 0.f;
#pragma unroll
          for (int j2 = 0; j2 < 4; ++j2) ss += (v[j2].x * v[j2].x + v[j2].y * v[j2].y) + (v[j2].z * v[j2].z + v[j2].w * v[j2].w);
          ss = grp_sum8(ss); const float rs = rsqrtf(ss * (1.0f / 128) + EPS) * QSCALE; const float* gg = gq + (lane & 7) * 16; float f[16];
#pragma unroll
          for (int j2 = 0; j2 < 4; ++j2) { f[4 * j2] = v[j2].x * rs * gg[4 * j2]; f[4 * j2 + 1] = v[j2].y * rs * gg[4 * j2 + 1]; f[4 * j2 + 2] = v[j2].z * rs * gg[4 * j2 + 2]; f[4 * j2 + 3] = v[j2].w * rs * gg[4 * j2 + 3]; }
          GAS v4u* o = (GAS v4u*)(QN + (size_t)row * DQ + lane * 16);
          o[0] = (v4u){pk2(f[0], f[1]), pk2(f[2], f[3]), pk2(f[4], f[5]), pk2(f[6], f[7])}; o[1] = (v4u){pk2(f[8], f[9]), pk2(f[10], f[11]), pk2(f[12], f[13]), pk2(f[14], f[15])}; }
        if (pr) { float ss = (sa.x * sa.x + sa.y * sa.y) + (sa.z * sa.z + sa.w * sa.w) + (sc2.x * sc2.x + sc2.y * sc2.y) + (sc2.z * sc2.z + sc2.w * sc2.w); ss = grp_sum16(ss);
            const float rs = kv == 0 ? rsqrtf(ss * (1.0f / 128) + EPS) : 1.f; const float* gg = gk + 128 + d; float f[8] = {sa.x, sa.y, sa.z, sa.w, sc2.x, sc2.y, sc2.z, sc2.w};
#pragma unroll
            for (int k = 0; k < 8; ++k) f[k] = kv == 0 ? f[k] * rs * gg[k] : f[k];
            bf16* dst = (bf16*)(ws + (kv == 0 ? WS_KS : WS_VS)) + ((size_t)(b * 2 + g) * T + t) * 128 + d; *(GAS v4u*)dst = pack8f(f); }
        if (pr) { float ss = (wa.x * wa.x + wa.y * wa.y) + (wa.z * wa.z + wa.w * wa.w) + (wc2.x * wc2.x + wc2.y * wc2.y) + (wc2.z * wc2.z + wc2.w * wc2.w); ss = grp_sum16(ss);
            const float rs = kv == 0 ? rsqrtf(ss * (1.0f / 128) + EPS) : 1.f; const float* gg = gk + 256 + d; float f[8] = {wa.x, wa.y, wa.z, wa.w, wc2.x, wc2.y, wc2.z, wc2.w};
#pragma unroll
            for (int k = 0; k < 8; ++k) f[k] = kv == 0 ? f[k] * rs * gg[k] : f[k];
            bf16* dst = (bf16*)(ws + (kv == 0 ? WS_KW : WS_VW)) + ((size_t)(b * 2 + g) * T + t) * 128 + d; *(GAS v4u*)dst = pack8f(f);
            if (t >= T - 512) { float* o = C.out + O_PWIN + ((size_t)b * 512 + (t - (T - 512))) * 512 + lane * 8; *(GAS f32x4*)o = wa; *(GAS f32x4*)(o + 4) = wc2; }
        } else { float* o = C.out + O_SWIN + ((size_t)bs * 512 + 511) * 512 + lane * 8; *(GAS f32x4*)o = wa; *(GAS f32x4*)(o + 4) = wc2; }
        { vs = wave_sum(vs); if (lane == 0) ((float*)(ws + WS_RSTDV))[row] = rsqrtf(vs * (1.0f / DG) + EPS); }
    }
}

__device__ __forceinline__ float shx(float v, int mask, int lane) { return __int_as_float(__builtin_amdgcn_ds_bpermute((lane ^ mask) << 2, __float_as_int(v))); }
template <bool WT = false>
__device__ __forceinline__ void cmp_combine_rows(const Ctx& C, bool pr, int row0, int nrows) {
    unsigned char* ws = C.ws; const int hw = C.wave * 2 + (C.lane >> 5), l32 = C.lane & 31, e = l32 * 4;
    const float* CBP = (const float*)(ws + WS_CBP); const float* gk0 = C.in[IN_GK];
    f32x4 cb0 = {0.f, 0.f, 0.f, 0.f}, cb1 = {0.f, 0.f, 0.f, 0.f};
#pragma unroll
    for (int kc = 0; kc < 16; ++kc) { cb0 += *(const GAS f32x4*)(CBP + kc * 128 + e); cb1 += *(const GAS f32x4*)(CBP + (16 + kc) * 128 + e); }
    const f32x4 g4 = *(const GAS f32x4*)(gk0 + e);
    const int segs = pr ? 256 : 128;
    for (int rr = row0 + hw; rr < row0 + nrows; rr += 16) {
        const int j = rr & (segs - 1), grp = rr / segs, g = grp & 1, kv = (grp >> 1) & 1, b = grp >> 2;
        const float* Y = (const float*)(ws + (pr ? WS_YCP : WS_YCS)) + (size_t)rr * 256;
        f32x4 v = {0.f, 0.f, 0.f, 0.f};
        if (j < segs - 1) { v = *(const GAS f32x4*)(Y + e) + *(const GAS f32x4*)(Y + 128 + e) + (kv ? cb1 : cb0); }
        float ss = (v.x * v.x + v.y * v.y) + (v.z * v.z + v.w * v.w);
#pragma unroll
        for (int o = 1; o < 32; o <<= 1) ss += shx(ss, o, C.lane);
        if (kv == 0) { const float rs = rsqrtf(ss * (1.0f / 128) + EPS); v = v * rs * g4; }
        bf16* dst = (bf16*)(ws + (pr ? (kv ? WS_VCP : WS_KCP) : (kv ? WS_VCS : WS_KCS))) + ((size_t)(b * 2 + g) * segs + j) * 128 + e;
        if (WT) __hip_atomic_store((gu64*)dst, ((unsigned long long)pk2(v.z, v.w) << 32) | pk2(v.x, v.y), RLX_AGENT); else *(GAS v2u*)dst = (v2u){pk2(v.x, v.y), pk2(v.z, v.w)};
    }
}

typedef short s16x4 __attribute__((ext_vector_type(4)));
typedef float f32x16 __attribute__((ext_vector_type(16)));
__device__ __forceinline__ int v_st(int k, int c) { const int kk = (k & ~0xC) | ((k & 4) << 1) | ((k & 8) >> 1); return ((kk >> 3) * 4 + (c >> 5)) * 512 + ((kk & 7) * 32 + (c & 31)) * 2; }
__device__ __forceinline__ int v_rd_base(int lane) { return ((lane & 3) << 3) | (((lane >> 2) & 3) << 6) | (((lane >> 4) & 1) << 5) | (((lane >> 5) & 1) << 8); }
constexpr int v_rd_off(int d0, int ks, int half) { return d0 * 512 + ks * 4096 + half * 2048; }
__device__ __forceinline__ int crow(int r, int hi) { return (r & 3) + 8 * (r >> 2) + 4 * hi; }
#define SBAR() __builtin_amdgcn_sched_barrier(0)
__device__ __forceinline__ void pv_tile(f32x16* o, int vb0, bf16x8 pa0, bf16x8 pa1, bf16x8 pa2, bf16x8 pa3) {
#define TRRD(dst, off) asm volatile("ds_read_b64_tr_b16 %0, %1 offset:%2" : "=&v"(dst) : "v"(vb0), "i"(off) : "memory")
#define PV_D0(d0) do { s16x4 l0, l1, l2, l3, h0, h1, h2, h3; constexpr int b_ = v_rd_off(d0, 0, 0); \
        TRRD(l0, b_); TRRD(h0, b_ + 2048); TRRD(l1, b_ + 4096); TRRD(h1, b_ + 6144); TRRD(l2, b_ + 8192); TRRD(h2, b_ + 10240); TRRD(l3, b_ + 12288); TRRD(h3, b_ + 14336); \
        asm volatile("s_waitcnt lgkmcnt(0)" ::: "memory"); SBAR(); \
        o[d0] = __builtin_amdgcn_mfma_f32_32x32x16_bf16(pa0, (bf16x8){l0[0], l0[1], l0[2], l0[3], h0[0], h0[1], h0[2], h0[3]}, o[d0], 0, 0, 0); \
        o[d0] = __builtin_amdgcn_mfma_f32_32x32x16_bf16(pa1, (bf16x8){l1[0], l1[1], l1[2], l1[3], h1[0], h1[1], h1[2], h1[3]}, o[d0], 0, 0, 0); \
        o[d0] = __builtin_amdgcn_mfma_f32_32x32x16_bf16(pa2, (bf16x8){l2[0], l2[1], l2[2], l2[3], h2[0], h2[1], h2[2], h2[3]}, o[d0], 0, 0, 0); \
        o[d0] = __builtin_amdgcn_mfma_f32_32x32x16_bf16(pa3, (bf16x8){l3[0], l3[1], l3[2], l3[3], h3[0], h3[1], h3[2], h3[3]}, o[d0], 0, 0, 0); } while (0)
    PV_D0(0); PV_D0(1); PV_D0(2); PV_D0(3);
#undef PV_D0
#undef TRRD
}

__device__ __forceinline__ float rstd_v(const float* VSS, int row) { const GAS f32x4* p = (const GAS f32x4*)(VSS + (size_t)row * 32); f32x4 s = p[0];
#pragma unroll
    for (int k = 1; k < 8; ++k) s += p[k];
    return rsqrtf(((s.x + s.y) + (s.z + s.w)) * (1.0f / DG) + EPS); }
__device__ __forceinline__ void p4_sgu(const Ctx& C, int idx, int nblk) {
    unsigned char* ws = C.ws; const int tid = C.tid, lane = C.lane, wave = C.wave, r32 = lane & 31, hi = lane >> 5;
    const bf16* U = (const bf16*)(ws + WS_U); const bf16* VG = (const bf16*)(ws + WS_VG); const float* VSS = (const float*)(ws + WS_VSS);
    const bf16* WMB = (const bf16*)(ws + WS_WMB); bf16* OA = (bf16*)(ws + WS_OA);
    const float* gs = C.in[IN_GSGU]; const float* bs = C.in[IN_BSGU];
    LAS unsigned char* Vl = C.lds + RING_OFF;
    for (int unit = idx; unit < 256; unit += nblk) {
        const int n = unit >> 2, gp = unit & 3, rowbase = n * 128; const bool last = (n & 31) == 31; const int bb = n >> 5;
        __syncthreads();
        { const int sr = tid >> 4, sc = (tid & 15) * 8;
#pragma unroll
          for (int gl = 0; gl < 2; ++gl) { const int g = gp * 2 + gl; float gg[8];
#pragma unroll
              for (int k = 0; k < 8; ++k) gg[k] = gs[g * 128 + sc + k];
#pragma unroll
              for (int q = 0; q < 4; ++q) { const int s = q * 32 + sr, st = s >> 6, row = rowbase + s; float f[8];
                  unpack8(*(const GAS v4u*)(VG + (size_t)row * DG + g * 128 + sc), f); const float rs = rstd_v(VSS, row);
#pragma unroll
                  for (int k = 0; k < 8; ++k) f[k] = f[k] * rs * gg[k];
                  *(LAS v4u*)(Vl + (gl * 2 + st) * 16384 + v_st(s & 63, sc)) = pack8f(f);
                  if (last) { float* o = C.out + O_PSGU + ((size_t)bb * 128 + s) * DG + g * 128 + sc; *(GAS f32x4*)o = (f32x4){f[0], f[1], f[2], f[3]}; *(GAS f32x4*)(o + 4) = (f32x4){f[4], f[5], f[6], f[7]}; } } } }
        __syncthreads();
        const int tb = wave & 3, gl = wave >> 2, g = gp * 2 + gl;
        f32x16 o[4];
#pragma unroll
        for (int d0 = 0; d0 < 4; ++d0)
#pragma unroll
            for (int r = 0; r < 16; ++r) o[d0][r] = 0.f;
#pragma unroll
        for (int st = 0; st < 2; ++st) if (64 * st <= 32 * tb + 31) {
            const bf16* wp = WMB + ((size_t)g * 128 + tb * 32 + r32) * 128 + st * 64 + hi * 8;
            const bf16x8 pa0 = *(const GAS bf16x8*)(wp), pa1 = *(const GAS bf16x8*)(wp + 16), pa2 = *(const GAS bf16x8*)(wp + 32), pa3 = *(const GAS bf16x8*)(wp + 48);
            const int vb0 = (int)(unsigned)(uintptr_t)(Vl + (gl * 2 + st) * 16384) + v_rd_base(lane);
            pv_tile(o, vb0, pa0, pa1, pa2, pa3);
        }
#pragma unroll
        for (int r = 0; r < 16; ++r) { const int trow = tb * 32 + crow(r, hi); const float bv = bs[g * 128 + trow]; const size_t ro = (size_t)(rowbase + trow) * DG + g * 128, roa = (size_t)(rowbase + trow) * LD1 + g * 128;
#pragma unroll
            for (int d0 = 0; d0 < 4; ++d0) { const int c = d0 * 32 + r32; const float v = (o[d0][r] + bv) * bf2f(U[ro + c]); const float vn = __shfl_xor(v, 1);
                if ((r32 & 1) == 0) *(GAS unsigned*)(OA + tm_idx(rowbase + trow, g * 128 + c, DG / 64)) = pk2(v, vn); } }
    }
    { const int gt = idx * 512 + tid, NT = nblk * 512; const float* w = C.in[IN_WSGU];
      for (int i = gt; i < MSAMP * DG / 8; i += NT) { const int r = i >> 7, c = (i & 127) * 8, row = MPROMPT + r, g = c >> 7; float f[8], uu[8];
          unpack8(*(const GAS v4u*)(VG + (size_t)row * DG + c), f); unpack8(*(const GAS v4u*)(U + (size_t)row * DG + c), uu); const float rs = rstd_v(VSS, row), w00 = w[g * 16384], b0 = bs[g * 128];
#pragma unroll
          for (int k = 0; k < 8; ++k) { f[k] = f[k] * rs * gs[c + k]; uu[k] = uu[k] * (w00 * f[k] + b0); }
          float* o = C.out + O_SSGU + (size_t)r * DG + c; *(GAS f32x4*)o = (f32x4){f[0], f[1], f[2], f[3]}; *(GAS f32x4*)(o + 4) = (f32x4){f[4], f[5], f[6], f[7]};
          *(GAS v4u*)((bf16*)(ws + WS_SOA) + (size_t)r * LDS_G + c) = pack8f(uu); } }
}

struct AttItem { const bf16* q; int t; int ncmp; const bf16* kc; const bf16* vc; int nblk; const float* gates; bf16* out; const float* blut; };

__device__ __forceinline__ void ld8f(const float* p, float (&f)[8]) { const f32x4 a = *(const GAS f32x4*)p, b = *(const GAS f32x4*)(p + 4); f[0] = a.x; f[1] = a.y; f[2] = a.z; f[3] = a.w; f[4] = b.x; f[5] = b.y; f[6] = b.z; f[7] = b.w; }
struct PromptKV {
    const bf16 *ks, *vs, *kw, *vw;
    static constexpr bool NORM = false;
    __device__ __forceinline__ void selK(int pos, int d8, float (&k)[8]) const { unpack8(*(const GAS v4u*)(ks + (size_t)pos * 128 + d8), k); }
    __device__ __forceinline__ void selV(int pos, int d8, float (&k)[8]) const { unpack8(*(const GAS v4u*)(vs + (size_t)pos * 128 + d8), k); }
    __device__ __forceinline__ void winK(int pos, int d8, float (&k)[8]) const { unpack8(*(const GAS v4u*)(kw + (size_t)pos * 128 + d8), k); }
    __device__ __forceinline__ void winV(int pos, int d8, float (&k)[8]) const { unpack8(*(const GAS v4u*)(vw + (size_t)pos * 128 + d8), k); }
};
struct SampleKV {
    const float* csel; const int* pt; const float* nsel; const float* win; const float* nwin;
    static constexpr bool NORM = true;
    __device__ __forceinline__ const float* selp(int pos) const { return pos < PASTLEN ? csel + ((size_t)pt[pos >> 7] * 128 + (pos & 127)) * 512 : nsel; }
    __device__ __forceinline__ const float* winp(int pos) const { return pos < PASTLEN ? win + (size_t)(pos - (PASTLEN - 512)) * 512 : nwin; }
    __device__ __forceinline__ void selK(int pos, int d8, float (&k)[8]) const { ld8f(selp(pos) + d8, k); }
    __device__ __forceinline__ void selV(int pos, int d8, float (&k)[8]) const { ld8f(selp(pos) + 256 + d8, k); }
    __device__ __forceinline__ void winK(int pos, int d8, float (&k)[8]) const { ld8f(winp(pos) + d8, k); }
    __device__ __forceinline__ void winV(int pos, int d8, float (&k)[8]) const { ld8f(winp(pos) + 256 + d8, k); }
};
#define DPP_ADD(x, ctrl) ((x) + __int_as_float(__builtin_amdgcn_update_dpp(0, __float_as_int(x), (ctrl), 0xF, 0xF, true)))
__device__ __forceinline__ float row_sum16(float x) { x = DPP_ADD(x, 0xB1); x = DPP_ADD(x, 0x4E); x = DPP_ADD(x, 0x141); x = DPP_ADD(x, 0x140); return x; }
template <bool NORM>
__device__ __forceinline__ void score4(const float (&k)[8], const float (&gkv)[8], const float (&q)[4][8], float (&s)[4]) {
    float kk[8]; float ss = 0.f;
#pragma unroll
    for (int i = 0; i < 8; ++i) { if (NORM) { ss += k[i] * k[i]; kk[i] = k[i] * gkv[i]; } else kk[i] = k[i]; }
#pragma unroll
    for (int h = 0; h < 4; ++h) { float a = 0.f;
#pragma unroll
        for (int i = 0; i < 8; ++i) a += q[h][i] * kk[i];
        s[h] = row_sum16(a); }
    if (NORM) { ss = row_sum16(ss); const float rs = rsqrtf(ss * (1.0f / 128) + EPS);
#pragma unroll
        for (int h = 0; h < 4; ++h) s[h] *= rs; }
}
__device__ __forceinline__ void online4(const float (&s)[4], bool valid, float (&m)[4], float (&l)[4], float (&o)[4][8], const float (&v)[8]) {
#pragma unroll
    for (int h = 0; h < 4; ++h) { const float sv = valid ? s[h] : -__builtin_inff(); const float mn = fmaxf(m[h], sv);
        const float al = __builtin_amdgcn_exp2f(m[h] - mn), p = __builtin_amdgcn_exp2f(sv - mn); m[h] = mn; l[h] = l[h] * al + p;
#pragma unroll
        for (int i = 0; i < 8; ++i) o[h][i] = o[h][i] * al + p * v[i]; }
}
__device__ __forceinline__ void merge_store(float (&m)[4], float (&l)[4], float (&o)[4][8], LAS float* Cmb, int wave, int lane) {
#pragma unroll
    for (int h = 0; h < 4; ++h) { float M = fmaxf(m[h], __shfl_xor(m[h], 16)); M = fmaxf(M, __shfl_xor(M, 32));
        const float sc = __builtin_amdgcn_exp2f(m[h] - M); float ll = l[h] * sc; ll += __shfl_xor(ll, 16); ll += __shfl_xor(ll, 32);
        LAS float* dst = Cmb + (wave * 4 + h) * 132;
#pragma unroll
        for (int i = 0; i < 8; ++i) { float x = o[h][i] * sc; x += __shfl_xor(x, 16); x += __shfl_xor(x, 32); if (lane < 16) dst[lane * 8 + i] = x; }
        if (lane == 0) { dst[128] = M; dst[129] = ll; } }
}
__device__ __forceinline__ float combine8(const LAS float* Cmb, int hh, int dd) {
    float M = -1e30f;
#pragma unroll
    for (int w = 0; w < 8; ++w) M = fmaxf(M, Cmb[(w * 4 + hh) * 132 + 128]);
    float L = 0.f, O = 0.f;
#pragma unroll
    for (int w = 0; w < 8; ++w) { const LAS float* p = Cmb + (w * 4 + hh) * 132; const float sc = __builtin_amdgcn_exp2f(p[128] - M); L += p[129] * sc; O += p[dd] * sc; }
    return L > 0.f ? O / L : 0.f;
}

template <class KV, bool WIN>
__device__ __forceinline__ void nsa_stream(const KV& kv, int total, int wave, int grp, int d8, int t, int wlo, const LAS int* sl, const float (&gkv)[8], const float (&q)[4][8],
                                           const float* blut, float (&m)[4], float (&l)[4], float (&o)[4][8]) {
    const int nper = total > wave ? (total - wave + 7) >> 3 : 0;
    float kA[2][8], vA[2][8], kB[2][8], vB[2][8]; int ppA[2], ppB[2]; bool okA[2], okB[2];
#define NS_LOAD(K_, V_, PP_, OK_, i0_) do { _Pragma("unroll") for (int u = 0; u < 2; ++u) { const int ch = wave + 8 * ((i0_) + u); const bool in = (i0_) + u < nper; \
            int pos; if (WIN) pos = wlo + ch * 4 + grp; else pos = sl[in ? (ch >> 4) : 0] * 64 + (ch & 15) * 4 + grp; \
            OK_[u] = in && pos <= t; PP_[u] = OK_[u] ? pos : t; \
            if (WIN) { kv.winK(PP_[u], d8, K_[u]); kv.winV(PP_[u], d8, V_[u]); } else { kv.selK(PP_[u], d8, K_[u]); kv.selV(PP_[u], d8, V_[u]); } } } while (0)
#define NS_COMP(K_, V_, PP_, OK_, i0_) do { _Pragma("unroll") for (int u = 0; u < 2; ++u) if ((i0_) + u < nper) { float sc[4]; score4<KV::NORM>(K_[u], gkv, q, sc); \
            const int rel = t - PP_[u]; const int ri = rel > 128 ? 128 : rel; \
            _Pragma("unroll") for (int h = 0; h < 4; ++h) sc[h] += blut[h * 132 + ri]; \
            online4(sc, OK_[u], m, l, o, V_[u]); } } while (0)
    if (nper > 0) NS_LOAD(kA, vA, ppA, okA, 0);
    for (int i0 = 0; i0 < nper; i0 += 4) {
        if (i0 + 2 < nper) NS_LOAD(kB, vB, ppB, okB, i0 + 2);
        NS_COMP(kA, vA, ppA, okA, i0);
        if (i0 + 4 < nper) NS_LOAD(kA, vA, ppA, okA, i0 + 4);
        if (i0 + 2 < nper) NS_COMP(kB, vB, ppB, okB, i0 + 2);
    }
#undef NS_LOAD
#undef NS_COMP
}

template <class KV>
__device__ __forceinline__ void nsa_item(const Ctx& C, const AttItem& it, const KV& kv, const float* gk1, const float* gk2) {
    const int tid = C.tid, lane = C.lane, wave = C.wave, grp = lane >> 4, d8 = (lane & 15) * 8, t = it.t;
    LAS float* Sc = (LAS float*)(C.lds + RING_OFF);
    LAS float* Cmb = (LAS float*)(C.lds + RING_OFF + 4096);
    LAS int* sl = (LAS int*)(C.lds + RING_OFF + 4096 + 16896);
    const float NEG = -__builtin_inff();
    float q[4][8];
#pragma unroll
    for (int h = 0; h < 4; ++h) unpack8(*(const GAS v4u*)(it.q + h * 128 + d8), q[h]);
    const int hh = tid >> 7, dd = tid & 127;
    const float g0 = it.gates[hh * 3 + 0], g1 = it.gates[hh * 3 + 1], g2 = it.gates[hh * 3 + 2];
    float res = 0.f;
    float m[4], l[4], o[4][8], gkv[8];
#pragma unroll
    for (int i = 0; i < 8; ++i) gkv[i] = 1.f;

    int nvis = t >= 31 ? (t - 31) / 16 + 1 : 0; if (nvis > it.ncmp) nvis = it.ncmp;
    const int nch = (nvis + 3) >> 2;
    for (int ch = wave; ch < 64; ch += 8) {
        const int c = ch * 4 + grp; float s[4] = {NEG, NEG, NEG, NEG};
        if (ch < nch) {
            const bool valid = c < nvis; const int cc = valid ? c : 0; float k[8]; unpack8(*(const GAS v4u*)(it.kc + (size_t)cc * 128 + d8), k);
            float sc[4]; score4<false>(k, gkv, q, sc);
            const int rel = t - (16 * c + 31); const int ri = rel < 0 ? 0 : (rel > 128 ? 128 : rel);
#pragma unroll
            for (int h = 0; h < 4; ++h) s[h] = valid ? sc[h] + it.blut[h * 132 + ri] : NEG;
        }
        if ((lane & 15) == 0) {
#pragma unroll
            for (int h = 0; h < 4; ++h) Sc[h * 256 + c] = s[h]; }
    }
    __syncthreads();
    float mh[4], il[4];
#pragma unroll
    for (int h = 0; h < 4; ++h) { const f32x4 v = *(const LAS f32x4*)(Sc + h * 256 + lane * 4); float mx = fmaxf(fmaxf(v.x, v.y), fmaxf(v.z, v.w)); mx = fmaxf(wave_max(mx), -1e30f);
        float e = (__builtin_amdgcn_exp2f(v.x - mx) + __builtin_amdgcn_exp2f(v.y - mx)) + (__builtin_amdgcn_exp2f(v.z - mx) + __builtin_amdgcn_exp2f(v.w - mx)); e = wave_sum(e);
        mh[h] = mx; il[h] = e > 0.f ? 1.0f / e : 0.f; }
    float imp = 0.f;
#pragma unroll
    for (int h = 0; h < 4; ++h) { float a = 0.f;
#pragma unroll
        for (int k = 0; k < 5; ++k) { const int c = 4 * lane - 1 + k; if (c >= 0) a += __builtin_amdgcn_exp2f(Sc[h * 256 + c] - mh[h]); }
        imp += a * il[h]; }
    unsigned long long mask;
    { const int j = lane, cur = t >> 6; const bool forced = (j == 0) || (j == cur) || (j == cur - 1), elig = 64 * j <= t, exists = j < it.nblk;
      const float val = exists ? (forced ? 1e6f : (elig ? imp : -1.f)) : -2.f; int rank = 0;
      const int key = (int)((__float_as_uint(val) & ~63u) | (unsigned)(63 - j));
#pragma unroll
      for (int jp = 0; jp < 64; ++jp) rank += (__builtin_amdgcn_readlane(key, jp) > key) ? 1 : 0;
      const bool sel_ = rank < 16 && elig && exists; mask = __ballot(sel_);
      if (wave == 0 && sel_) sl[__builtin_popcountll(mask & ((1ull << j) - 1ull))] = j; }
#pragma unroll
    for (int h = 0; h < 4; ++h) { m[h] = mh[h]; l[h] = 0.f;
#pragma unroll
        for (int i = 0; i < 8; ++i) o[h][i] = 0.f; }
    for (int ch = wave; ch < nch; ch += 8) {
        const int c = ch * 4 + grp; const bool valid = c < nvis; const int cc = valid ? c : 0; float v[8]; unpack8(*(const GAS v4u*)(it.vc + (size_t)cc * 128 + d8), v);
#pragma unroll
        for (int h = 0; h < 4; ++h) { const float p = valid ? __builtin_amdgcn_exp2f(Sc[h * 256 + cc] - mh[h]) : 0.f; l[h] += p;
#pragma unroll
            for (int i = 0; i < 8; ++i) o[h][i] += p * v[i]; }
    }
    merge_store(m, l, o, Cmb, wave, lane);
    __syncthreads();
    res += g0 * combine8(Cmb, hh, dd);
    __syncthreads();

#pragma unroll
    for (int h = 0; h < 4; ++h) { m[h] = -1e30f; l[h] = 0.f;
#pragma unroll
        for (int i = 0; i < 8; ++i) o[h][i] = 0.f; }
    if (KV::NORM) {
#pragma unroll
        for (int i = 0; i < 8; ++i) gkv[i] = gk1[d8 + i]; }
    nsa_stream<KV, false>(kv, __builtin_popcountll(mask) * 16, wave, grp, d8, t, 0, sl, gkv, q, it.blut, m, l, o);
    merge_store(m, l, o, Cmb, wave, lane);
    __syncthreads();
    res += g1 * combine8(Cmb, hh, dd);
    __syncthreads();

#pragma unroll
    for (int h = 0; h < 4; ++h) { m[h] = -1e30f; l[h] = 0.f;
#pragma unroll
        for (int i = 0; i < 8; ++i) o[h][i] = 0.f; }
    if (KV::NORM) {
#pragma unroll
        for (int i = 0; i < 8; ++i) gkv[i] = gk2[d8 + i]; }
    const int wlo = t - 511 < 0 ? 0 : t - 511, nchw = (t - wlo + 4) >> 2;
    nsa_stream<KV, true>(kv, nchw, wave, grp, d8, t, wlo, sl, gkv, q, it.blut, m, l, o);
    merge_store(m, l, o, Cmb, wave, lane);
    __syncthreads();
    res += g2 * combine8(Cmb, hh, dd);
    it.out[hh * 128 + dd] = (bf16)f2bf(res);
    __syncthreads();
}


#define KSWZ(row, colB) ((row) * 256 + ((colB) ^ (((row) & 7) << 4)))
constexpr int AT_V = 0, AT_K = 32768, AT_PC = 65536, AT_X = 131584, AT_BLUT = AT_X, AT_SELM = AT_X + 2176, AT_WS = AT_SELM + 512;
static_assert(AT_WS + 8 * 256 + 64 <= LDS_BYTES && AT_X >= MISC_OFF + 128 && AT_PC + 64 * 256 * 4 <= LDSCTL_OFF, "attention LDS map");

__device__ __forceinline__ unsigned cvtpk(float lo, float hi) { unsigned r; asm volatile("v_cvt_pk_bf16_f32 %0, %1, %2" : "=v"(r) : "v"(lo), "v"(hi)); return r; }
__device__ __forceinline__ float swap_max(float x) { auto rr = __builtin_amdgcn_permlane32_swap(__float_as_uint(x), __float_as_uint(x), false, false); return fmaxf(__uint_as_float(rr[0]), __uint_as_float(rr[1])); }
__device__ __forceinline__ float swap_add(float x) { auto rr = __builtin_amdgcn_permlane32_swap(__float_as_uint(x), __float_as_uint(x), false, false); return __uint_as_float(rr[0]) + __uint_as_float(rr[1]); }
__device__ __forceinline__ float quad_sum(float x) {
    x += __int_as_float(__builtin_amdgcn_update_dpp(0, __float_as_int(x), 0xB1, 0xF, 0xF, true));
    x += __int_as_float(__builtin_amdgcn_update_dpp(0, __float_as_int(x), 0x4E, 0xF, 0xF, true));
    return x;
}
__device__ __forceinline__ void qkt_tile(f32x16& p0, f32x16& p1, const LAS unsigned char* Kt, int r32, int hi, const bf16x8 (&qr)[8]) {
#pragma unroll
    for (int r = 0; r < 16; ++r) { p0[r] = 0.f; p1[r] = 0.f; }
    const LAS unsigned char* kb[4];
#pragma unroll
    for (int dd = 0; dd < 4; ++dd) kb[dd] = Kt + KSWZ(r32, (dd * 16 + hi * 8) * 2);
#pragma unroll
    for (int d0 = 0; d0 < 8; ++d0) { const LAS unsigned char* a = kb[d0 & 3] + (d0 >> 2) * 128;
        const bf16x8 b0 = *(const LAS bf16x8*)a, b1 = *(const LAS bf16x8*)(a + 32 * 256);
        p0 = __builtin_amdgcn_mfma_f32_32x32x16_bf16(b0, qr[d0], p0, 0, 0, 0);
        p1 = __builtin_amdgcn_mfma_f32_32x32x16_bf16(b1, qr[d0], p1, 0, 0, 0); }
}
template <int MODE>
__device__ __forceinline__ void fix_tile(f32x16& p0, f32x16& p1, int tile, int tq, int tmin, int head, int hi, bool bit, const LAS float* lut) {
    const float NEG = -__builtin_inff(); const float c31 = lut[head * 132 + 128];
    bool fast;
    if (MODE == 0) fast = tmin - 16 * (64 * tile + 63) - 31 >= 128;
    else if (MODE == 2) fast = tmin - (64 * tile + 63) >= 128;
    else fast = (tmin - (64 * tile + 63) >= 128) && (tmin + 7 - 64 * tile < 512);
    if (fast) {
        if (MODE == 2) {
#pragma unroll
            for (int r = 0; r < 16; ++r) { p0[r] = bit ? p0[r] + c31 : NEG; p1[r] = bit ? p1[r] + c31 : NEG; }
        } else {
#pragma unroll
            for (int r = 0; r < 16; ++r) { p0[r] += c31; p1[r] += c31; }
        }
        return;
    }
    const LAS float* lh = lut + head * 132;
#pragma unroll
    for (int hf = 0; hf < 2; ++hf)
#pragma unroll
        for (int r = 0; r < 16; ++r) { const int cr = (r & 3) + 8 * (r >> 2); int rel;
            if (MODE == 0) rel = tq - 31 - 16 * (64 * tile + 32 * hf + 4 * hi + cr); else rel = tq - (64 * tile + 32 * hf + 4 * hi + cr);
            bool valid;
            if (MODE == 0) valid = rel >= 0; else if (MODE == 2) valid = rel >= 0 && bit; else valid = (unsigned)rel < 512u;
            const int ri = rel < 0 ? 0 : (rel > 128 ? 128 : rel); const float bv = lh[ri];
            if (hf == 0) p0[r] = valid ? p0[r] + bv : NEG; else p1[r] = valid ? p1[r] + bv : NEG; }
}
__device__ __forceinline__ void softmax_tile(f32x16& p0, f32x16& p1, float& m_reg, float& l_reg, float& alpha, bf16x8& pa0, bf16x8& pa1, bf16x8& pa2, bf16x8& pa3) {
    float pmax = p0[0];
#pragma unroll
    for (int r = 1; r < 16; ++r) pmax = fmaxf(pmax, p0[r]);
#pragma unroll
    for (int r = 0; r < 16; ++r) pmax = fmaxf(pmax, p1[r]);
    pmax = swap_max(pmax);
    const float mn = fmaxf(m_reg, pmax); alpha = __builtin_amdgcn_exp2f(m_reg - mn); m_reg = mn;
    float ps = 0.f;
#pragma unroll
    for (int r = 0; r < 16; ++r) { p0[r] = __builtin_amdgcn_exp2f(p0[r] - mn); p1[r] = __builtin_amdgcn_exp2f(p1[r] - mn); ps += p0[r] + p1[r]; }
    ps = swap_add(ps); l_reg = l_reg * alpha + ps;
#define PK4(P, B_, OUT) do { unsigned a0 = cvtpk(P[B_+0], P[B_+1]), a1 = cvtpk(P[B_+2], P[B_+3]); unsigned b0 = cvtpk(P[B_+4], P[B_+5]), b1 = cvtpk(P[B_+6], P[B_+7]); \
        auto r0 = __builtin_amdgcn_permlane32_swap(a0, b0, false, false); auto r1 = __builtin_amdgcn_permlane32_swap(a1, b1, false, false); \
        v4u w = {r0[0], r1[0], r0[1], r1[1]}; OUT = __builtin_bit_cast(bf16x8, w); } while (0)
    PK4(p0, 0, pa0); PK4(p0, 8, pa1); PK4(p1, 0, pa2); PK4(p1, 8, pa3);
#undef PK4
}

struct FlashSt {
    bf16x8 qr[8];
    int tq, tmin, head;
};
template <int MODE, bool PASS2, int ACC>
__device__ __forceinline__ void flash_branch(const Ctx& C, FlashSt& S, const bf16* Kb, const bf16* Vb, int j_lo, int j_hi, float gate, unsigned long long mymask, unsigned long long wor,
                                             float& m_reg, float& l_reg, float* OT, bf16* OBrow) {
    const int tid = C.tid, lane = C.lane, wave = C.wave, r32 = lane & 31, hi = lane >> 5;
    LAS unsigned char* Vl = C.lds + AT_V; LAS unsigned char* Kl = C.lds + AT_K; LAS float* Pc = (LAS float*)(C.lds + AT_PC);
    const LAS float* lut = (const LAS float*)(C.lds + AT_BLUT); LAS float* wsl = (LAS float*)(C.lds + AT_WS) + wave * 64;
    const int vb0 = (int)(unsigned)(uintptr_t)Vl + v_rd_base(lane);
    f32x16 o[4];
    if (!PASS2) {
#pragma unroll
        for (int d0 = 0; d0 < 4; ++d0)
#pragma unroll
            for (int r = 0; r < 16; ++r) o[d0][r] = 0.f;
        m_reg = -1e30f; l_reg = 0.f; }
    const float inv_l = PASS2 ? (l_reg > 0.f ? 1.0f / l_reg : 0.f) : 0.f;
    const int n = j_hi - j_lo;
    const int lrow = wave * 4 + (lane >> 4);
    const unsigned ksrc = (unsigned)(lrow * 256 + ((((lane & 15) << 4)) ^ ((lrow & 7) << 4)));
    const int vkk = (((wave * 2 + (lane >> 5)) >> 2) << 3) + ((lane & 31) >> 2);
    const int vk = (vkk & ~0xC) | ((vkk & 4) << 1) | ((vkk & 8) >> 1);
    const unsigned vsrc = (unsigned)(vk * 256 + ((((wave * 2 + (lane >> 5)) & 3) * 32 + (lane & 3) * 8) * 2));
#define ST_DMA(tile, bf) do { const char* kp = (const char*)(Kb + (size_t)(tile) * 64 * 128) + ksrc; \
        __builtin_amdgcn_global_load_lds((const unsigned*)kp, (LAS unsigned*)(Kl + (bf) * 16384 + wave * 1024), 16, 0, 0); \
        __builtin_amdgcn_global_load_lds((const unsigned*)(kp + 8192), (LAS unsigned*)(Kl + (bf) * 16384 + 8192 + wave * 1024), 16, 0, 0); \
        if (!PASS2) { const char* vp = (const char*)(Vb + (size_t)(tile) * 64 * 128) + vsrc; \
            __builtin_amdgcn_global_load_lds((const unsigned*)vp, (LAS unsigned*)(Vl + (bf) * 16384 + wave * 1024), 16, 0, 0); \
            __builtin_amdgcn_global_load_lds((const unsigned*)(vp + 8192), (LAS unsigned*)(Vl + (bf) * 16384 + 8192 + wave * 1024), 16, 0, 0); } } while (0)
    if (n > 0) ST_DMA(j_lo, 0);
    asm volatile("s_waitcnt vmcnt(0)" ::: "memory");
    __syncthreads();
    for (int i = 0; i < n; ++i) {
        const int tile = j_lo + i, buf = i & 1;
        if (i + 1 < n) ST_DMA(tile + 1, buf ^ 1);
        bool act;
        if (PASS2) act = true; else if (MODE == 0) act = 16 * (64 * tile) + 31 <= S.tmin + 7; else if (MODE == 2) act = (wor >> tile) & 1ull; else act = true;
        if (act) {
            f32x16 p0, p1; qkt_tile(p0, p1, Kl + buf * 16384, r32, hi, S.qr);
            const bool bit = MODE == 2 ? ((mymask >> tile) & 1ull) != 0ull : true;
            fix_tile<MODE>(p0, p1, tile, S.tq, S.tmin, S.head, hi, bit, lut);
            if (PASS2) {
#pragma unroll
                for (int r = 0; r < 16; ++r) { p0[r] = quad_sum(__builtin_amdgcn_exp2f(p0[r] - m_reg) * inv_l); p1[r] = quad_sum(__builtin_amdgcn_exp2f(p1[r] - m_reg) * inv_l); }
                if ((r32 & 3) == 0) { LAS float* pr = Pc + (wave * 8 + (r32 >> 2)) * 256 + tile * 64 + 4 * hi;
#pragma unroll
                    for (int r = 0; r < 16; ++r) { const int cr = (r & 3) + 8 * (r >> 2); pr[cr] = p0[r]; pr[32 + cr] = p1[r]; } }
            } else {
                float alpha; bf16x8 pa0, pa1, pa2, pa3;
                softmax_tile(p0, p1, m_reg, l_reg, alpha, pa0, pa1, pa2, pa3);
                if (__any(alpha < 1.f)) { if (hi == 0) wsl[r32] = alpha; asm volatile("s_waitcnt lgkmcnt(0)" ::: "memory"); const LAS float* wh = wsl + 4 * hi;
#pragma unroll
                    for (int r = 0; r < 16; ++r) { const float a = wh[(r & 3) + 8 * (r >> 2)];
#pragma unroll
                        for (int d0 = 0; d0 < 4; ++d0) o[d0][r] *= a; }
                    asm volatile("s_waitcnt lgkmcnt(0)" ::: "memory"); }
                pv_tile(o, vb0 + buf * 16384, pa0, pa1, pa2, pa3);
            }
        }
        asm volatile("s_waitcnt vmcnt(0)" ::: "memory");
        __syncthreads();
    }
#undef ST_DMA
    if (!PASS2) {
        const float scl = l_reg > 0.f ? gate / l_reg : 0.f;
        if (hi == 0) wsl[32 + r32] = scl; asm volatile("s_waitcnt lgkmcnt(0)" ::: "memory");
        const LAS float* wh = wsl + 32 + 4 * hi; GAS float* otl = (GAS float*)OT + (size_t)(4 * hi) * 128 + r32; GAS bf16* obl = (GAS bf16*)OBrow + (size_t)hi * 64 + r32;
        asm volatile("" : "+v"(otl), "+v"(obl));
#pragma unroll
        for (int r = 0; r < 16; ++r) { const int cr = (r & 3) + 8 * (r >> 2); const float a = wh[cr];
#pragma unroll
            for (int d0 = 0; d0 < 4; ++d0) { float v = o[d0][r] * a; if (ACC > 0) v += otl[cr * 128 + d0 * 32];
                if (ACC < 2) otl[cr * 128 + d0 * 32] = v;
                else { const float vn = __shfl_xor(v, 1); if ((r32 & 1) == 0) *(GAS unsigned*)(obl + ((r & 3) * 2 + (d0 >> 1)) * 16384 + (2 * (r >> 2)) * 64 + (d0 & 1) * 32) = cvtpk(v, vn); } } }
        asm volatile("s_waitcnt lgkmcnt(0)" ::: "memory");
    }
}

__device__ __forceinline__ void flash_unit(const Ctx& C, int b, int g, int qb) {
    unsigned char* ws = C.ws; const int tid = C.tid, lane = C.lane, wave = C.wave, r32 = lane & 31, hi = lane >> 5, t0 = qb * 64;
    LAS float* lut = (LAS float*)(C.lds + AT_BLUT); LAS float* Pc = (LAS float*)(C.lds + AT_PC); LAS unsigned long long* selm = (LAS unsigned long long*)(C.lds + AT_SELM);
    const float* BL = (const float*)(ws + WS_BLUT) + g * 4 * 132;
    for (int i = tid; i < 4 * 132; i += NWAVES * 64) lut[i] = BL[i];
    FlashSt S; S.tmin = t0 + wave * 8; S.tq = S.tmin + (r32 >> 2); S.head = r32 & 3;
    const int row = b * T + S.tq;
    { const bf16* qp = (const bf16*)(ws + WS_QN) + (size_t)row * DQ + (g * 4 + S.head) * 128 + hi * 8;
#pragma unroll
      for (int d0 = 0; d0 < 8; ++d0) S.qr[d0] = *(const GAS bf16x8*)(qp + d0 * 16); }
    const float* gn = (const float*)(ws + WS_GN) + (size_t)row * 32 + (g * 4 + S.head) * 3; const float gc = gn[0], gsel = gn[1], gw = gn[2];
    const size_t kvb = (size_t)(b * 2 + g) * T * 128, cb = (size_t)(b * 2 + g) * 256 * 128;
    const int cmax = (t0 + 63 - 31) >> 4;
    const int nct = (cmax >> 6) + 1;
    float m_c, l_c;
    float* OT = (float*)(ws + WS_OT) + ((size_t)blockIdx.x * 8 + wave) * 32 * 128;
    bf16* OBrow = (bf16*)(ws + WS_OB) + tm_idx(b * T + S.tmin, g * 512, DQ / 64);
    flash_branch<0, false, 0>(C, S, (const bf16*)(ws + WS_KCP) + cb, (const bf16*)(ws + WS_VCP) + cb, 0, nct, gc, 0ull, 0ull, m_c, l_c, OT, OBrow);
    flash_branch<0, true, 0>(C, S, (const bf16*)(ws + WS_KCP) + cb, nullptr, 0, nct, 0.f, 0ull, 0ull, m_c, l_c, OT, OBrow);
    unsigned long long wor = 0ull;
    { asm volatile("s_waitcnt lgkmcnt(0)" ::: "memory");
      const int ncomp = nct * 64;
#pragma unroll 1
      for (int qi = 0; qi < 8; ++qi) { const int ql = wave * 8 + qi, t = t0 + ql; const LAS float* pr = Pc + ql * 256; float imp = 0.f;
#pragma unroll
          for (int k = 0; k < 5; ++k) { const int c = 4 * lane - 1 + k; if (c >= 0 && c < ncomp) imp += pr[c]; }
          const int j = lane, cur = t >> 6; const bool forced = (j == 0) || (j == cur) || (j == cur - 1), elig = 64 * j <= t;
          const float val = forced ? 1e6f : (elig ? imp : -1.f); int rank = 0;
          const int key = (int)((__float_as_uint(val) & ~63u) | (unsigned)(63 - j));
#pragma unroll
          for (int jp = 0; jp < 64; ++jp) rank += (__builtin_amdgcn_readlane(key, jp) > key) ? 1 : 0;
          const unsigned long long mk = __ballot(rank < 16 && elig); wor |= mk;
          if (lane == 0) selm[ql] = mk; }
      asm volatile("s_waitcnt lgkmcnt(0)" ::: "memory"); }
    const unsigned long long mymask = selm[wave * 8 + (r32 >> 2)];
    float m_s, l_s;
    flash_branch<2, false, 1>(C, S, (const bf16*)(ws + WS_KS) + kvb, (const bf16*)(ws + WS_VS) + kvb, 0, qb + 1, gsel, mymask, wor, m_s, l_s, OT, OBrow);
    flash_branch<3, false, 2>(C, S, (const bf16*)(ws + WS_KW) + kvb, (const bf16*)(ws + WS_VW) + kvb, qb >= 8 ? qb - 8 : 0, qb + 1, gw, 0ull, 0ull, m_s, l_s, OT, OBrow);
    __syncthreads();
}


template <bool SPLIT = false>
__device__ __forceinline__ void skinny_core(const Ctx& C, const bf16* A, int lda, const bf16* Bs, int kbeg, int Kw, float (&out)[8], float* out2 = nullptr) {
    const int lane = C.lane, wave = C.wave, r32 = lane & 31, hi = lane >> 5, tid = C.tid;
    f32x16 acc[4];
#pragma unroll
    for (int rb = 0; rb < 4; ++rb)
#pragma unroll
        for (int r = 0; r < 16; ++r) acc[rb][r] = 0.f;
    const GAS bf16* ap0 = (const GAS bf16*)A + (size_t)r32 * lda + kbeg + hi * 32;
    const GAS bf16* bp = (const GAS bf16*)Bs + (size_t)r32 * 64 + (size_t)(kbeg >> 6) * 16384 + hi * 32;
    const GAS bf16* ap1 = ap0 + (size_t)32 * lda; const GAS bf16* ap2 = ap0 + (size_t)64 * lda; const GAS bf16* ap3 = ap0 + (size_t)96 * lda;
    asm volatile("" : "+v"(ap0), "+v"(ap1), "+v"(ap2), "+v"(ap3), "+v"(bp));
    bf16x8 a0[4][2], b0[2], a1[4][2], b1[2];
#define SK_OFF(st) ((((st) >> 1) << 6) + (((st) & 1) << 4))
#define SK_LOAD(a, b, st) do { const int k_ = SK_OFF(st), kb_ = (((st) >> 1) << 14) + (((st) & 1) << 4); _Pragma("unroll") for (int j = 0; j < 2; ++j) b[j] = *(const GAS bf16x8*)(bp + kb_ + 8 * j); \
        _Pragma("unroll") for (int j = 0; j < 2; ++j) { a[0][j] = *(const GAS bf16x8*)(ap0 + k_ + 8 * j); a[1][j] = *(const GAS bf16x8*)(ap1 + k_ + 8 * j); a[2][j] = *(const GAS bf16x8*)(ap2 + k_ + 8 * j); a[3][j] = *(const GAS bf16x8*)(ap3 + k_ + 8 * j); } } while (0)
#define SK_MMA(a, b) do { _Pragma("unroll") for (int j = 0; j < 2; ++j) _Pragma("unroll") for (int rb = 0; rb < 4; ++rb) acc[rb] = __builtin_amdgcn_mfma_f32_32x32x16_bf16(a[rb][j], b[j], acc[rb], 0, 0, 0); } while (0)
    const int ns = Kw >> 5;
    SK_LOAD(a0, b0, 0);
    for (int st = 0; st < ns; st += 2) {
        if (st + 1 < ns) SK_LOAD(a1, b1, st + 1);
        SK_MMA(a0, b0);
        if (st + 2 < ns) SK_LOAD(a0, b0, st + 2);
        if (st + 1 < ns) SK_MMA(a1, b1);
    }
#undef SK_OFF
#undef SK_LOAD
#undef SK_MMA
    LAS float* Red = (LAS float*)(C.lds + RING_OFF);
    LAS float* wr_ = Red + (wave * 128 + 4 * hi) * 32 + r32;
#pragma unroll
    for (int rb = 0; rb < 4; ++rb)
#pragma unroll
        for (int r = 0; r < 16; ++r) wr_[(32 * rb + (r & 3) + 8 * (r >> 2)) * 32] = acc[rb][r];
    __syncthreads();
    const LAS float* rd = Red + (tid >> 2) * 32 + (tid & 3) * 8;
    f32x4 s0 = *(const LAS f32x4*)rd, s1 = *(const LAS f32x4*)(rd + 4);
#pragma unroll
    for (int w = 1; w < (SPLIT ? 4 : 8); ++w) { s0 += *(const LAS f32x4*)(rd + w * 4096); s1 += *(const LAS f32x4*)(rd + w * 4096 + 4); }
    out[0] = s0.x; out[1] = s0.y; out[2] = s0.z; out[3] = s0.w; out[4] = s1.x; out[5] = s1.y; out[6] = s1.z; out[7] = s1.w;
    if (SPLIT) { f32x4 t0 = *(const LAS f32x4*)(rd + 4 * 4096), t1 = *(const LAS f32x4*)(rd + 4 * 4096 + 4);
#pragma unroll
        for (int w = 5; w < 8; ++w) { t0 += *(const LAS f32x4*)(rd + w * 4096); t1 += *(const LAS f32x4*)(rd + w * 4096 + 4); }
        out2[0] = t0.x; out2[1] = t0.y; out2[2] = t0.z; out2[3] = t0.w; out2[4] = t1.x; out2[5] = t1.y; out2[6] = t1.z; out2[7] = t1.w; }
    __syncthreads();
}
__device__ __forceinline__ void st8f(float* p, const float (&v)[8]) { *(GAS f32x4*)p = (f32x4){v[0], v[1], v[2], v[3]}; *(GAS f32x4*)(p + 4) = (f32x4){v[4], v[5], v[6], v[7]}; }

__device__ __forceinline__ void s_in(const Ctx& C, int idx, int nblk) {
    unsigned char* ws = C.ws; const int tid = C.tid, row = tid >> 2, c8 = (tid & 3) * 8, rg = MPROMPT + row;
    const float rs = ((const float*)(ws + WS_RSTD1))[rg];
    for (int u = idx; u < 273; u += nblk) {
        float v[8]; skinny_core(C, (const bf16*)(ws + WS_SXB), LDS_X, (const bf16*)(ws + WS_WIN) + ((size_t)(u >> 3) * (DM / 64) * 256 + (u & 7) * 32) * 64, C.wave * 256, 256, v);
        const int n = u * 32 + c8;
#pragma unroll
        for (int k = 0; k < 8; ++k) v[k] *= rs;
        if (n < 2048) {
#pragma unroll
            for (int k = 0; k < 8; ++k) v[k] = gelu_tanh(v[k]);
            if (n < 1024) *(GAS v4u*)((bf16*)(ws + WS_U) + (size_t)rg * DG + n) = pack8f(v);
            else { *(GAS v4u*)((bf16*)(ws + WS_VG) + (size_t)rg * DG + n - 1024) = pack8f(v); float ss = 0.f;
#pragma unroll
                for (int k = 0; k < 8; ++k) ss += v[k] * v[k];
                ss += __shfl_xor(ss, 1); ss += __shfl_xor(ss, 2);
                if ((tid & 3) == 0) ((float*)(ws + WS_VSS))[(size_t)rg * 32 + (n - 1024) / 32] = ss; }
        } else if (n < 3072) st8f((float*)(ws + WS_QRAW) + (size_t)rg * DQ + n - 2048, v);
        else if (n < 3584) st8f(C.out + O_SCMP + (size_t)row * 512 + n - 3072, v);
        else if (n < 4096) st8f(C.out + O_SSEL + (size_t)row * 512 + n - 3584, v);
        else if (n < 4608) st8f((float*)(ws + WS_KVWR) + (size_t)rg * 512 + n - 4096, v);
        else if (n < 8704) {
#pragma unroll
            for (int k = 0; k < 8; ++k) v[k] = sigmoidf_(v[k]);
            if (n < 6656) *(GAS v4u*)((bf16*)(ws + WS_GA) + (size_t)rg * DM + n - 4608) = pack8f(v); else *(GAS v4u*)((bf16*)(ws + WS_GB) + (size_t)rg * DM + n - 6656) = pack8f(v);
        } else if (n < 8728) {
#pragma unroll
            for (int k = 0; k < 8; ++k) v[k] = sigmoidf_(v[k]);
            st8f((float*)(ws + WS_GN) + (size_t)rg * 32 + n - 8704, v); }
    }
}
__device__ __forceinline__ void s_proj(const Ctx& C) {
    unsigned char* ws = C.ws; const int tid = C.tid, row = tid >> 2, c8 = (tid & 3) * 8, rg = MPROMPT + row;
    for (int u = blockIdx.x; u < 64; u += C.G) {
        float a[8], b[8], ga[8], gb[8]; const int n = u * 32 + c8;
        { const bool pb = C.wave >= 4;
          skinny_core<true>(C, (const bf16*)(ws + (pb ? WS_SOB : WS_SOA)), LDS_G, (const bf16*)(ws + (pb ? WS_WN : WS_WG)) + ((size_t)(u >> 3) * (DG / 64) * 256 + (u & 7) * 32) * 64, (C.wave & 3) * 256, 256, a, b); }
        unpack8(*(const GAS v4u*)((const bf16*)(ws + WS_GA) + (size_t)rg * DM + n), ga); unpack8(*(const GAS v4u*)((const bf16*)(ws + WS_GB) + (size_t)rg * DM + n), gb);
#pragma unroll
        for (int k = 0; k < 8; ++k) a[k] = ga[k] * a[k] + gb[k] * b[k];
        *(GAS v4u*)((bf16*)(ws + WS_SMIX) + (size_t)row * LDS_X + n) = pack8f(a);
    }
}
__device__ __forceinline__ void s_out(const Ctx& C) {
    unsigned char* ws = C.ws; const int tid = C.tid, row = tid >> 2, c8 = (tid & 3) * 8, rg = MPROMPT + row;
    for (int u = blockIdx.x; u < 64; u += C.G) {
        float v[8], x[8]; const int n = u * 32 + c8;
        skinny_core(C, (const bf16*)(ws + WS_SMIX), LDS_X, (const bf16*)(ws + WS_WO) + ((size_t)(u >> 3) * (DM / 64) * 256 + (u & 7) * 32) * 64, C.wave * 256, 256, v);
        ld8f(C.in[IN_XS] + (size_t)row * DM + n, x); float ss = 0.f;
#pragma unroll
        for (int k = 0; k < 8; ++k) { v[k] += x[k]; ss += v[k] * v[k]; }
        st8f(C.out + O_YS + (size_t)row * DM + n, v); *(GAS v4u*)((bf16*)(ws + WS_SX1B) + (size_t)row * LDS_X + n) = pack8f(v);
        ss += __shfl_xor(ss, 1); ss += __shfl_xor(ss, 2);
        if ((tid & 3) == 0) ((float*)(ws + WS_X1SS))[(size_t)MPROMPT * 32 + row * 64 + u] = ss;
    }
}
__device__ __forceinline__ void s_up(const Ctx& C) {
    unsigned char* ws = C.ws; const int tid = C.tid, row = tid >> 2, c8 = (tid & 3) * 8, rg = MPROMPT + row;
    float rs; { const GAS f32x4* sp = (const GAS f32x4*)((const float*)(ws + WS_X1SS) + (size_t)MPROMPT * 32 + row * 64); f32x4 s4 = sp[0];
#pragma unroll
        for (int k = 1; k < 16; ++k) s4 += sp[k];
        rs = rsqrtf(((s4.x + s4.y) + (s4.z + s4.w)) * (1.0f / DM) + EPS); }
    for (int u = blockIdx.x; u < 256; u += C.G) {
        float v[8]; skinny_core(C, (const bf16*)(ws + WS_SX1B), LDS_X, (const bf16*)(ws + WS_WUP) + ((size_t)(u >> 3) * (DM / 64) * 256 + (u & 7) * 32) * 64, C.wave * 256, 256, v);
#pragma unroll
        for (int k = 0; k < 8; ++k) { const float a = fmaxf(v[k] * rs, 0.f); v[k] = a * a; }
        *(GAS v4u*)((bf16*)(ws + WS_SH) + (size_t)row * LDS_H + u * 32 + c8) = pack8f(v);
    }
}
__device__ __forceinline__ void s_down(const Ctx& C) {
    unsigned char* ws = C.ws; const int tid = C.tid, row = tid >> 2, c8 = (tid & 3) * 8, rg = MPROMPT + row;
    float* PART = (float*)(ws + WS_SPART); gu32* tick = (gu32*)(ws + WS_CTL) + CW_TICK; LAS unsigned* flag = (LAS unsigned*)(C.lds + AT_X);
    for (int u = blockIdx.x; u < 256; u += C.G) { const int strip = u >> 2, kq = u & 3;
        float v[8]; skinny_core(C, (const bf16*)(ws + WS_SH), LDS_H, (const bf16*)(ws + WS_WDN) + ((size_t)(strip >> 3) * (DFF / 64) * 256 + (strip & 7) * 32) * 64, kq * 2048 + C.wave * 256, 256, v);
        { gu64* pp = (gu64*)(PART + ((size_t)(strip * 4 + kq) * 128 + row) * 32 + c8);
#pragma unroll
          for (int q = 0; q < 4; ++q) __hip_atomic_store(pp + q, ((unsigned long long)__float_as_uint(v[2 * q + 1]) << 32) | __float_as_uint(v[2 * q]), RLX_AGENT); }
        asm volatile("s_waitcnt vmcnt(0)" ::: "memory"); __syncthreads();
        if (tid == 0) { const unsigned old = __hip_atomic_fetch_add(tick + strip * 64, 1u, __ATOMIC_RELAXED, __HIP_MEMORY_SCOPE_AGENT); flag[0] = old; }
        __syncthreads();
        const bool last = flag[0] == 3u;
        __syncthreads();
        if (last) { __builtin_amdgcn_fence(__ATOMIC_ACQUIRE, "agent"); asm volatile("s_waitcnt vmcnt(0)" ::: "memory");
            float* y = C.out + O_YS + (size_t)row * DM + strip * 32 + c8; float acc[8]; ld8f(y, acc);
#pragma unroll
            for (int q = 0; q < 4; ++q) { const gu64* pp = (const gu64*)(PART + ((size_t)(strip * 4 + q) * 128 + row) * 32 + c8);
#pragma unroll
                for (int k = 0; k < 4; ++k) { const unsigned long long w = __hip_atomic_load(pp + k, RLX_AGENT); acc[2 * k] += __uint_as_float((unsigned)w); acc[2 * k + 1] += __uint_as_float((unsigned)(w >> 32)); } }
            st8f(y, acc); }
    }
}

__device__ __forceinline__ void fused_cmp_unit(const Ctx& C, int L, const epi::EpiCmp& E) {
    using pg8::bf16x8; using pg8::f32x4; using pg8::HTB;
    LAS unsigned char* lds = C.lds + RING_OFF;
    const Ctx Lf = fresh(C);
    const int tid = Lf.tid, wid = C.wave, lane = Lf.lane, wr = wid >> 2, wc = wid & 3, fr = lane & 15, fq = lane >> 4;
    const int b = L >> 1, kv = L & 1;
    const int* pt = (const int*)C.in[IN_PT] + b * 16;
    unsigned aofg[2][2], voffB[2];
#pragma unroll
    for (int i = 0; i < 2; ++i) { int R, Cx; pg8::stage_rc(tid * 16 + i * 8192, R, Cx);
        const unsigned page = (unsigned)pt[R >> 3];
#pragma unroll
        for (int h = 0; h < 2; ++h) aofg[h][i] = (((page * 128u + (unsigned)(R & 7) * 16u) * 512u) + (unsigned)((kv * 2 + h) * 128 + Cx)) * 4u;
        voffB[i] = (unsigned)(R * 64 + Cx) * 2u; }
    const char* cA = (const char*)C.in[IN_CCMP];
    const char* cB = (const char*)(C.ws + WS_WC) + (size_t)kv * 32 * 32768;
    const size_t hstepB = 16384;
    const int aoff = pg8::lds_byte(wr * 64 + fr, fq * 8), boff = pg8::lds_byte(wc * 32 + fr, fq * 8);
#define FC_SA(bf, h) (((bf) * 2 + (h)) * HTB)
#define FC_SB(bf, h) ((4 + (bf) * 2 + (h)) * HTB)
#define FC_LOADA(kt) do { const unsigned ko_ = (unsigned)((kt) >> 1) * 2048u + (unsigned)((kt) & 1) * 256u; \
        _Pragma("unroll") for (int h = 0; h < 2; ++h) _Pragma("unroll") for (int i = 0; i < 2; ++i) { const char* p_ = cA + aofg[h][i] + ko_; \
            ar[h][i][0] = *(const GAS f32x4*)p_; ar[h][i][1] = *(const GAS f32x4*)(p_ + 16); } } while (0)
#define FC_WRITEA(bf) do { _Pragma("unroll") for (int h = 0; h < 2; ++h) _Pragma("unroll") for (int i = 0; i < 2; ++i) { v4u w_; \
            w_.x = pk2(ar[h][i][0].x, ar[h][i][0].y); w_.y = pk2(ar[h][i][0].z, ar[h][i][0].w); w_.z = pk2(ar[h][i][1].x, ar[h][i][1].y); w_.w = pk2(ar[h][i][1].z, ar[h][i][1].w); \
            *(LAS v4u*)(lds + FC_SA(bf, h) + tid * 16 + i * 8192) = w_; } } while (0)
#define FC_DMAB(kt, bf) do { _Pragma("unroll") for (int h = 0; h < 2; ++h) _Pragma("unroll") for (int i = 0; i < 2; ++i) \
            __builtin_amdgcn_global_load_lds((const unsigned*)(cB + h * hstepB + (size_t)(kt) * 32768 + voffB[i]), (LAS unsigned*)(lds + FC_SB(bf, h) + wid * 1024 + i * 8192), 16, 0, 0); } while (0)
#define FC_LDA(dst, bf, h) do { _Pragma("unroll") for (int m = 0; m < 4; ++m) _Pragma("unroll") for (int k = 0; k < 2; ++k) dst[m][k] = *(const LAS bf16x8*)(lds + FC_SA(bf, h) + aoff + m * 2048 + k * 1024); } while (0)
#define FC_LDB(dst, bf, h) do { _Pragma("unroll") for (int n = 0; n < 2; ++n) _Pragma("unroll") for (int k = 0; k < 2; ++k) dst[n][k] = *(const LAS bf16x8*)(lds + FC_SB(bf, h) + boff + n * 2048 + k * 1024); } while (0)
#define FC_MMA(ai, bj, At_, Bt_) do { _Pragma("unroll") for (int m = 0; m < 4; ++m) _Pragma("unroll") for (int n = 0; n < 2; ++n) _Pragma("unroll") for (int k = 0; k < 2; ++k) \
        acc[ai][bj][m][n] = __builtin_amdgcn_mfma_f32_16x16x32_bf16(Bt_[n][k], At_[m][k], acc[ai][bj][m][n], 0, 0, 0); } while (0)
    f32x4 acc[2][2][4][2];
#pragma unroll
    for (int a = 0; a < 2; ++a)
#pragma unroll
        for (int bb = 0; bb < 2; ++bb)
#pragma unroll
            for (int m = 0; m < 4; ++m)
#pragma unroll
                for (int n = 0; n < 2; ++n) acc[a][bb][m][n] = (f32x4){0.f, 0.f, 0.f, 0.f};
    f32x4 ar[2][2][2];
    bf16x8 At[4][2], B0[2][2];
    __syncthreads();
    FC_LOADA(0); FC_DMAB(0, 0); FC_WRITEA(0);
    asm volatile("s_waitcnt vmcnt(0) lgkmcnt(0)" ::: "memory"); __syncthreads();
#pragma unroll 1
    for (int kt = 0; kt < 32; ++kt) { const int bf = kt & 1;
        if (kt + 1 < 32) { FC_LOADA(kt + 1); FC_DMAB(kt + 1, bf ^ 1); }
        FC_LDB(B0, bf, 0); FC_LDA(At, bf, 0); FC_MMA(0, 0, At, B0);
        FC_LDA(At, bf, 1); FC_MMA(1, 0, At, B0);
        FC_LDB(B0, bf, 1); FC_MMA(1, 1, At, B0);
        FC_LDA(At, bf, 0); FC_MMA(0, 1, At, B0);
        if (kt + 1 < 32) FC_WRITEA(bf ^ 1);
        asm volatile("s_waitcnt vmcnt(0) lgkmcnt(0)" ::: "memory"); __syncthreads();
    }
    const pg8::Unit u{L, kv};
    { const Ctx Le = fresh(C); E(acc, u, wr, wc, Le.lane & 15, Le.lane >> 4); }
#undef FC_SA
#undef FC_SB
#undef FC_LOADA
#undef FC_WRITEA
#undef FC_DMAB
#undef FC_LDA
#undef FC_LDB
#undef FC_MMA
}

constexpr int LATE_P1 = 4096;
constexpr int WINCOPY_P2 = 0;
constexpr int LATE_P2 = I_LATE - LATE_P1;
constexpr int LATE_P12 = LATE_P1 + LATE_P2;
constexpr int NLATE_W = (I_LATE - LATE_P12 + 31) / 32, P5_HEAVY = 160, P5_SAMP0 = P5_HEAVY, P5_LIGHT0 = P5_SAMP0 + 256, P5_STREAM0 = P5_LIGHT0 + (256 - P5_HEAVY),
              P5_ITEMS = P5_STREAM0 + NLATE_W + WINCOPY_ITEMS - WINCOPY_P2;
__device__ __forceinline__ void p5_attn_flash(const Ctx& C, const int it_lo = 0, const int it_hi = P5_ITEMS) {
    unsigned char* ws = C.ws; gu32* ctl = (gu32*)(ws + WS_CTL); gu32* qa = ctl + CW_Q5;
    LAS float* scr = (LAS float*)(C.lds + RING_OFF + C.wave * 16384);
    for (;;) {
        gu32* qa_ = qa; unsigned qo_ = AT_WS + 2048; asm volatile("" : "+s"(qa_), "+s"(qo_));
        LAS unsigned* qf_ = (LAS unsigned*)(C.lds + qo_);
        __syncthreads();
        if (C.wave == 0 && lane_now() == 0) qf_[0] = __hip_atomic_fetch_add(qa_, 1u, __ATOMIC_RELAXED, __HIP_MEMORY_SCOPE_AGENT);
        __syncthreads();
        const int it = __builtin_amdgcn_readfirstlane((int)qf_[0]) + it_lo;
        if (it >= it_hi) break;
        const Ctx L = fresh(C);
        if (it < P5_HEAVY || (it >= P5_LIGHT0 && it < P5_STREAM0)) { const int un = it < P5_HEAVY ? it : it - P5_LIGHT0 + P5_HEAVY;
            const int qb_ = 63 - (un >> 2), bg = un & 3; flash_unit(L, bg >> 1, bg & 1, qb_); }
        else if (it < P5_LIGHT0) { const int si = it - P5_SAMP0, b = si >> 1, g = si & 1, row = MPROMPT + b;
            AttItem ai{(const bf16*)(ws + WS_QN) + (size_t)row * DQ + g * 512, PASTLEN, 127, (const bf16*)(ws + WS_KCS) + (size_t)(b * 2 + g) * 128 * 128, (const bf16*)(ws + WS_VCS) + (size_t)(b * 2 + g) * 128 * 128, 33,
                       (const float*)(ws + WS_GN) + (size_t)row * 32 + g * 12, (bf16*)(ws + WS_SOB) + (size_t)b * LDS_G + g * 512, (const float*)(ws + WS_BLUT) + g * 4 * 132};
            SampleKV kv{C.in[IN_CSEL] + g * 128, (const int*)C.in[IN_PT] + b * 16, C.out + O_SSEL + (size_t)b * 512 + g * 128, C.in[IN_WINB] + (size_t)b * 512 * 512 + g * 128,
                        (const float*)(ws + WS_KVWR) + (size_t)row * 512 + g * 128};
            nsa_item<SampleKV>(L, ai, kv, C.in[IN_GK] + 128, C.in[IN_GK] + 256); }
        else if (it < P5_STREAM0 + NLATE_W) { const int base = LATE_P12 + (it - P5_STREAM0) * 32;
#pragma unroll 1
            for (int k = 0; k < 4; ++k) { const int r = base + k * 8 + C.wave; if (r < I_LATE) w_item_late(L, r, scr); } }
        else wincopy_item(L, WINCOPY_P2 + it - P5_STREAM0 - NLATE_W);
    }
}

#ifndef MK_N_LAUNCHES
#define MK_N_LAUNCHES 1
#endif
constexpr int NPHASES = 10;

__device__ __forceinline__ void ph1(const Ctx& C, LAS unsigned char* ring) { unsigned char* ws = C.ws;
    pg8::Gemm g{(const bf16*)(ws + WS_XB), (const bf16*)(ws + WS_WIN), MPROMPT, NINP, DM, LD2, LD2, 1, 1}; pg8::StaticOrder S; S.init(MPROMPT, NINP, C.G, (int)blockIdx.x);
    epi::EpiIn E{(const float*)(ws + WS_RSTD1), (bf16*)(ws + WS_U), (bf16*)(ws + WS_VG), (float*)(ws + WS_VSS), (float*)(ws + WS_QRAW), (float*)(ws + WS_KVWR),
                 (bf16*)(ws + WS_GA), (bf16*)(ws + WS_GB), (float*)(ws + WS_GN), C.out, (bf16*)(ws + WS_ACP)};
    pg8::gemm_phase<epi::EpiIn, pg8::StaticOrder, true, true>(ring, g, S, E, C.tid);
    { const int nu = (MPROMPT / 256) * (NINP / 256), full = nu % C.G, nlight = full ? C.G - full : C.G, idx = full ? (int)blockIdx.x - full : (int)blockIdx.x;
      if (idx >= 0) { s_in(C, idx, nlight);
          const Ctx L = fresh(C); LAS float* scr = (LAS float*)(C.lds + RING_OFF + C.wave * 16384); __syncthreads();
          for (int r = idx * NWAVES + C.wave; r < LATE_P1; r += nlight * NWAVES) w_item_late(L, r, scr); } } }
__device__ __forceinline__ void ph2(const Ctx& C, LAS unsigned char* ring) { unsigned char* ws = C.ws;
    { const int skip = C.G > 32 ? 16 : 0; if ((int)blockIdx.x >= skip) p2_post(C, (int)blockIdx.x - skip, C.G - skip); }
    { epi::EpiCmp E{(float*)(ws + WS_YCS), 127};
      for (int Lu = (int)blockIdx.x; Lu < 256; Lu += C.G) { fused_cmp_unit(C, Lu, E);
          asm volatile("s_waitcnt vmcnt(0)" ::: "memory"); __syncthreads();
          const Ctx Lc = fresh(C);
          cmp_combine_rows(Lc, false, Lu * 256, 256); } }
    __syncthreads();
    const int ngb = C.G > 16 ? 8 : 0;
    if (ngb == 0 || (int)blockIdx.x < ngb) {
        { pg8::Gemm g{(const bf16*)(ws + WS_ACP), (const bf16*)(ws + WS_WC), 2048, 512, 2048, LD2, LD2, 1, 1}; epi::CmpOrder S{8, C.G, (int)blockIdx.x, 1};
          epi::EpiCmp E{(float*)(ws + WS_YCP), 255};
          const Ctx Lg = fresh(C); pg8::gemm_phase<epi::EpiCmp, epi::CmpOrder, true, true>(ring, g, S, E, Lg.tid); }
        asm volatile("s_waitcnt vmcnt(0)" ::: "memory"); __syncthreads();
        const Ctx Lc = fresh(C);
        for (int L = (int)blockIdx.x; L < 8; L += C.G) cmp_combine_rows(Lc, true, L * 256, 256); }
    { const Ctx Ls = fresh(C);
      if (ngb == 0) p4_sgu(Ls, (int)blockIdx.x, C.G); else if ((int)blockIdx.x >= ngb) p4_sgu(Ls, (int)blockIdx.x - ngb, C.G - ngb); }
    { const int skip = C.G > 32 ? 16 : 0;
      if ((int)blockIdx.x >= skip) { const Ctx L = fresh(C); LAS float* scr = (LAS float*)(C.lds + RING_OFF + C.wave * 16384); __syncthreads();
          for (int r = LATE_P1 + ((int)blockIdx.x - skip) * NWAVES + C.wave; r < LATE_P12; r += (C.G - skip) * NWAVES) w_item_late(L, r, scr);
          for (int c = (int)blockIdx.x - skip; c < WINCOPY_P2; c += C.G - skip) wincopy_item(L, c); } } }
__device__ __forceinline__ void ph6(const Ctx& C, LAS unsigned char* ring) { unsigned char* ws = C.ws;
    { pg8::Gemm g{(const bf16*)(ws + WS_OA), (const bf16*)(ws + WS_WG), MPROMPT, DM, DG, LD1, LD1, 1, 1}; pg8::StaticOrder S; S.init(MPROMPT, DM, C.G, (int)blockIdx.x);
      epi::EpiMixA E{(const bf16*)(ws + WS_GA), (bf16*)(ws + WS_MIXA)};
      pg8::gemm_phase<epi::EpiMixA, pg8::StaticOrder, true, true>(ring, g, S, E, C.tid); }
    { pg8::Gemm g{(const bf16*)(ws + WS_OB), (const bf16*)(ws + WS_WN), MPROMPT, DM, DQ, LD1, LD1, 1, 1}; pg8::StaticOrder S; S.init(MPROMPT, DM, C.G, (int)blockIdx.x);
      epi::EpiMixB E{(const bf16*)(ws + WS_GB), (const bf16*)(ws + WS_MIXA), (bf16*)(ws + WS_MIX)};
      pg8::gemm_phase<epi::EpiMixB, pg8::StaticOrder, true, true>(ring, g, S, E, C.tid); }
    s_proj(C); }
__device__ __forceinline__ void ph7(const Ctx& C, LAS unsigned char* ring) { unsigned char* ws = C.ws;
    pg8::Gemm g{(const bf16*)(ws + WS_MIX), (const bf16*)(ws + WS_WO), MPROMPT, DM, DM, LD2, LD2, 1, 1}; pg8::StaticOrder S; S.init(MPROMPT, DM, C.G, (int)blockIdx.x);
    epi::EpiOut E{C.in[IN_XP], C.in[IN_XS], C.out, (bf16*)(ws + WS_X1B), (float*)(ws + WS_X1SS)};
    pg8::gemm_phase<epi::EpiOut, pg8::StaticOrder, true, true>(ring, g, S, E, C.tid);
    s_out(C); }
__device__ __forceinline__ void ph8(const Ctx& C, LAS unsigned char* ring) { unsigned char* ws = C.ws;
    pg8::Gemm g{(const bf16*)(ws + WS_X1B), (const bf16*)(ws + WS_WUP), MPROMPT, DFF, DM, LD2, LD2, 1, 1}; pg8::StaticOrder S; S.init(MPROMPT, DFF, C.G, (int)blockIdx.x);
    epi::EpiUp E{(const float*)(ws + WS_X1SS), (bf16*)(ws + WS_H)};
    const bool first = (C.G % 8 == 0) && (blockIdx.x & 1);
    if (first) s_up(C);
    pg8::gemm_phase<epi::EpiUp, pg8::StaticOrder, true, true>(ring, g, S, E, fresh(C).tid);
    if (!first) s_up(fresh(C)); }
template <bool DUMMY>
__device__ __forceinline__ void ph9(const Ctx& C, LAS unsigned char* ring) { unsigned char* ws = C.ws;
    pg8::Gemm g{(const bf16*)(ws + WS_H), (const bf16*)(ws + WS_WDN), MPROMPT, DM, DFF, LD8, LD8, 1, 1}; pg8::StaticOrder S; S.init(MPROMPT, DM, C.G, (int)blockIdx.x);
    epi::EpiDown E{DUMMY ? (float*)(ws + WS_DUMMY) : C.out, (const bf16*)(ws + WS_X1B)};
    const bool first = (C.G % 8 == 0) && (blockIdx.x & 1);
    if (!DUMMY && first) s_down(C);
    pg8::gemm_phase<epi::EpiDown, pg8::StaticOrder, true, true>(ring, g, S, E, fresh(C).tid);
    if (!DUMMY && !first) s_down(fresh(C)); }

struct Args { const float* in[24]; float* out; unsigned char* ws; int ph_lo, ph_hi; };
static_assert(sizeof(Args) == 24 * 8 + 8 + 8 + 8, "no padding bytes in the kernel argument struct");

__global__ void __launch_bounds__(NWAVES * 64, 2) nsa_fwd(Args args) {
    extern __shared__ __attribute__((aligned(16))) unsigned char lds_raw[];
    Ctx C;
    C.in = args.in;
    C.out = args.out; C.ws = args.ws; C.lds = (LAS unsigned char*)lds_raw;
    C.tid = threadIdx.x; C.lane = C.tid & 63; C.wave = __builtin_amdgcn_readfirstlane(C.tid >> 6);
    C.G = gridDim.x; { const int bx = blockIdx.x; C.vcu = (C.G % 8 == 0) ? (bx % 8) * (C.G / 8) + bx / 8 : bx; }
    volatile LAS unsigned* MISC = (volatile LAS unsigned*)(C.lds + MISC_OFF);
    gu32* ctl = (gu32*)(args.ws + WS_CTL);
    for (int u = C.tid; u < (LDS_BYTES - LDSCTL_OFF) / 4; u += NWAVES * 64) ((LAS unsigned*)(C.lds + LDSCTL_OFF))[u] = 0u;
    __syncthreads();
    const int lo = args.ph_lo, hi = args.ph_hi;
    XcdBarrier bar; bar.bar = (unsigned*)(ctl + CW_BAR); bar.x = 0; bar.w = 0; bar.st = nullptr;
    if (hi - lo > 1) bar = xcd_barrier_post((unsigned*)(ctl + CW_BAR), MISC + 8);
#ifndef ONLY_PHASES
#define ONLY_PHASES 0x3ff
#endif
#define IN(k) (((ONLY_PHASES >> (k)) & 1) && lo <= (k) && (k) < hi)
#ifndef PROBE_SLACK
#define PROBE_SLACK -1
#endif
#ifndef PROBE_SLACK_PH
#define PROBE_SLACK_PH 2
#endif
#if PROBE_SLACK >= 0
    unsigned long long ps0_ = 0;
#define SEAM2(k, n) do { if (IN(k) && IN(n)) { if ((k) == PROBE_SLACK_PH) { __syncthreads(); ps0_ = __builtin_amdgcn_s_memrealtime(); } xcd_barrier(bar); \
        if ((k) == PROBE_SLACK_PH) { if ((int)blockIdx.x == PROBE_SLACK && C.wave == 0) { const unsigned long long d_ = __builtin_amdgcn_s_memrealtime() - ps0_, t0_ = __builtin_amdgcn_s_memrealtime(); \
                while (__builtin_amdgcn_s_memrealtime() - t0_ < d_ * 10ull) __builtin_amdgcn_s_sleep(16); } \
            xcd_barrier(bar); } } } while (0)
#else
#define SEAM2(k, n) do { if (IN(k) && IN(n)) xcd_barrier(bar); } while (0)
#endif
#define SEAM(k) SEAM2(k, (k) + 1)
    LAS unsigned char* ring = C.lds + RING_OFF;

#define PROBE2(k, call) do { if ((PROBE_MASK >> (k)) & 1) { xcd_barrier(bar); call; } } while (0)
    if (IN(0)) { p0_prologue(fresh(C)); PROBE2(0, p0_prologue(fresh(C))); } SEAM(0);
    if (IN(1)) { ph1(fresh(C), ring); PROBE2(1, ph1(fresh(C), ring)); } SEAM(1);
    if (IN(2)) { ph2(fresh(C), ring); PROBE2(2, ph2(fresh(C), ring)); } SEAM2(2, 5);
    if (IN(5)) { p5_attn_flash(fresh(C));
#define P5_RERUN(lo_, hi_) do { xcd_barrier(bar); if (blockIdx.x == 0 && C.wave == 0 && lane_now() == 0) __hip_atomic_store(ctl + CW_Q5, 0u, RLX_AGENT); xcd_barrier(bar); p5_attn_flash(fresh(C), lo_, hi_); } while (0)
        if ((PROBE_MASK >> 5) & 1) P5_RERUN(0, P5_ITEMS);
        if ((PROBE_MASK >> 13) & 1) { P5_RERUN(0, P5_HEAVY); }
        if ((PROBE_MASK >> 14) & 1) { P5_RERUN(P5_SAMP0, P5_LIGHT0); }
        if ((PROBE_MASK >> 15) & 1) { P5_RERUN(P5_STREAM0, P5_ITEMS); }
} SEAM(5);
    if (IN(6)) { ph6(fresh(C), ring); PROBE2(6, ph6(fresh(C), ring)); } SEAM(6);
    if (IN(7)) { ph7(fresh(C), ring); PROBE2(7, ph7(fresh(C), ring)); } SEAM(7);
#if (PROBE_MASK >> 20) & 1
    long long pc0_ = 0; unsigned long long pr0_ = 0; if (IN(8)) { pc0_ = clock64(); pr0_ = __builtin_amdgcn_s_memrealtime(); }
#endif
    if (IN(8)) { ph8(fresh(C), ring); PROBE2(8, ph8(fresh(C), ring)); }
#if (PROBE_MASK >> 20) & 1
    if (IN(8) && blockIdx.x == 0 && C.wave == 0) { const long long dc_ = clock64() - pc0_; const unsigned long long dr_ = __builtin_amdgcn_s_memrealtime() - pr0_;
        const unsigned long long mhz_ = (unsigned long long)dc_ * 100ull / (dr_ ? dr_ : 1ull); const unsigned long long t0_ = __builtin_amdgcn_s_memrealtime();
        while (__builtin_amdgcn_s_memrealtime() - t0_ < mhz_ * 100ull) __builtin_amdgcn_s_sleep(16); }
#endif
    SEAM(8);
    if (IN(9)) { PROBE2(9, ph9<true>(fresh(C), ring)); if ((PROBE_MASK >> 9) & 1) xcd_barrier(bar); ph9<false>(fresh(C), ring); }
#undef PROBE2
#undef IN
#undef SEAM
#undef SEAM2
}

extern "C" void kernel_launch(void* const* d_in, const int* in_sizes, int n_in, void* d_out, int out_size, void* d_ws, size_t ws_size, hipStream_t stream) {
    static int grid = 0;
    if (grid == 0) {
        if (n_in != 24 || out_size != (int)O_END || ws_size < WS_END) {
            fprintf(stderr, "kernel_launch: built for 24 inputs, %zu outputs, >= %zu bytes of workspace; got n_in %d out %d ws %zu; nothing launched\n", (size_t)O_END, (size_t)WS_END, n_in, out_size, ws_size);
            grid = -1; return; }
        int dev = 0, cus = 0, per_cu = 0;
        if (hipGetDevice(&dev) != hipSuccess || hipDeviceGetAttribute(&cus, hipDeviceAttributeMultiprocessorCount, dev) != hipSuccess) { fprintf(stderr, "kernel_launch: device query failed\n"); grid = -1; return; }
        if (hipFuncSetAttribute((const void*)nsa_fwd, hipFuncAttributeMaxDynamicSharedMemorySize, LDS_BYTES) != hipSuccess) { fprintf(stderr, "kernel_launch: hipFuncSetAttribute failed\n"); grid = -1; return; }
        if (hipOccupancyMaxActiveBlocksPerMultiprocessor(&per_cu, (const void*)nsa_fwd, NWAVES * 64, LDS_BYTES) != hipSuccess || per_cu < 1)
            fprintf(stderr, "kernel_launch: note: occupancy query reports %d workgroups per CU\n", per_cu);
        (void)hipGetLastError();
        grid = cus;
    }
    if (grid < 0) return;
    if (hipMemsetAsync((char*)d_ws + WS_CTL, 0, CTL_ZERO_BYTES, stream) != hipSuccess) { fprintf(stderr, "kernel_launch: memset failed\n"); return; }
    Args a{};
    for (int i = 0; i < 24; ++i) a.in[i] = (const float*)d_in[i];
    a.out = (float*)d_out; a.ws = (unsigned char*)d_ws;
    const int nl = MK_N_LAUNCHES;
    for (int li = 0; li < nl; ++li) {
        a.ph_lo = nl == 1 ? 0 : li; a.ph_hi = nl == 1 ? NPHASES : li + 1;
        hipLaunchKernelGGL(nsa_fwd, dim3(grid), dim3(NWAVES * 64), LDS_BYTES, stream, a);
        const hipError_t le = hipPeekAtLastError();
        if (le != hipSuccess) { fprintf(stderr, "kernel_launch: launch %d failed: %s\n", li, hipGetErrorName(le)); break; }
    }
}
```

```cpp
#include <hip/hip_runtime.h>
#include <cstdio>
#include <cstdint>
namespace pg8 {
#define PG8_LAS __attribute__((address_space(3)))
typedef unsigned short bf16_t;
typedef short bf16x8 __attribute__((ext_vector_type(8)));
typedef float f32x4 __attribute__((ext_vector_type(4)));
typedef unsigned u32x4 __attribute__((ext_vector_type(4)));
constexpr int BM = 256, BK = 64, HALF = 128, HTB = HALF * BK * 2  , STAGE_BYTES = 8 * HTB, NXCD = 8, WGM = 8;

__host__ __device__ __forceinline__ int lds_byte(int r, int c) { const int st = (r >> 4) * 2 + (c >> 5), rr = r & 15, cc = c & 31, ob = rr * 64 + cc * 2; return st * 1024 + (ob ^ (((ob >> 9) & 1) << 5)); }
__host__ __device__ __forceinline__ void stage_rc(int b, int& R, int& C) { const int st = b / 1024, sb = b % 1024, swz = sb ^ (((sb >> 9) & 1) << 5); R = (st >> 1) * 16 + swz / 64; C = (st & 1) * 32 + (swz % 64) / 2; }
__host__ __device__ __forceinline__ int perm32(int rho) { const int n = rho >> 4, i = rho & 15; return 8 * (i >> 2) + 4 * n + (i & 3); }

struct Unit { int pm, pn; };
struct Gemm { const bf16_t* A; const bf16_t* Bt; int M, N, K, lda, ldb; int tileA = 0, tileB = 0; };

struct StaticOrder {
    int nM, nN, nwg, G, c;
    __host__ __device__ void init(int M, int N, int G_, int c_) { nM = M / BM; nN = N / BM; nwg = nM * nN; G = G_; c = c_; }
    __host__ __device__ bool next(int i, Unit& u) const {
        const long L = (long)i * G + c; if (L >= nwg) return false;
        int wgid = (int)L; { const int q = nwg / NXCD, r = nwg % NXCD, xcd = wgid % NXCD, off = wgid / NXCD; wgid = (xcd < r ? xcd * (q + 1) : r * (q + 1) + (xcd - r) * q) + off; }
        const int nig = WGM * nN, gid = wgid / nig, fm = gid * WGM, gsz = (nM - fm) < WGM ? (nM - fm) : WGM;
        u.pm = fm + ((wgid % nig) % gsz); u.pn = (wgid % nig) / gsz; return true;
    }
    __device__ __forceinline__ void a_ready(const Unit&) const {}
    __device__ __forceinline__ void done(const Unit&) const {}
};

__device__ __forceinline__ unsigned cvt_pk_bf16(float lo, float hi) { unsigned r; asm volatile("v_cvt_pk_bf16_f32 %0, %1, %2" : "=v"(r) : "v"(lo), "v"(hi)); return r; }
typedef float f32x2 __attribute__((ext_vector_type(2)));
template <class Epi, class Sched, bool ALIGN_EPI = false, bool SP2 = false>
__device__ __forceinline__ void gemm_phase(PG8_LAS unsigned char* lds, const Gemm g, const Sched& S, const Epi& E, const int tid) {
    const int wid = __builtin_amdgcn_readfirstlane(tid >> 6), lane = tid & 63, wr = wid >> 2, wc = wid & 3, fr = lane & 15, fq = lane >> 4;
    const int K = g.K, nt = K / BK;
    unsigned voffA[2], voffB[2];
#pragma unroll
    for (int i = 0; i < 2; ++i) { int R, C; stage_rc(tid * 16 + i * 8192, R, C); const int Rb = Epi::PERM ? ((R & ~31) + perm32(R & 31)) : R;
        voffA[i] = (unsigned)(R * (g.tileA ? 64 : g.lda) + C) * 2u; voffB[i] = (unsigned)(Rb * (g.tileB ? 64 : g.ldb) + C) * 2u; }
    const size_t kstepA = g.tileA ? (size_t)32768 : (size_t)(BK * 2), kstepB = g.tileB ? (size_t)32768 : (size_t)(BK * 2);
    const size_t hstepA = g.tileA ? (size_t)16384 : (size_t)HALF * g.lda * 2, hstepB = g.tileB ? (size_t)16384 : (size_t)HALF * g.ldb * 2;
    const size_t tstepA = g.tileA ? (size_t)(g.K / BK) * 32768 : 2 * hstepA, tstepB = g.tileB ? (size_t)(g.K / BK) * 32768 : 2 * hstepB;
    const unsigned ldsw = (unsigned)wid * 1024u;
    const int aoff = lds_byte(wr * 64 + fr, fq * 8), boff = lds_byte(wc * 32 + fr, fq * 8);
#define PG8_SA(b, h) (((b) * 2 + (h)) * HTB)
#define PG8_SB(b, h) ((4 + (b) * 2 + (h)) * HTB)
#define PG8_STAGE(bufoff, gbase, voff) do { _Pragma("unroll") for (int _i = 0; _i < 2; ++_i) \
        __builtin_amdgcn_global_load_lds((const unsigned*)((const char*)(gbase) + (voff)[_i]), (PG8_LAS unsigned*)(lds + (bufoff) + ldsw + _i * 8192), 16, 0, 0); } while (0)
#define PG8_LDA(dst, b, h) do { _Pragma("unroll") for (int m = 0; m < 4; ++m) _Pragma("unroll") for (int k = 0; k < 2; ++k) dst[m][k] = *(const PG8_LAS bf16x8*)(lds + PG8_SA(b, h) + aoff + m * 2048 + k * 1024); } while (0)
#define PG8_LDB(dst, b, h) do { _Pragma("unroll") for (int n = 0; n < 2; ++n) _Pragma("unroll") for (int k = 0; k < 2; ++k) dst[n][k] = *(const PG8_LAS bf16x8*)(lds + PG8_SB(b, h) + boff + n * 2048 + k * 1024); } while (0)
#define PG8_MMA(ai, bj, At, Bt) do { __builtin_amdgcn_s_setprio(1); _Pragma("unroll") for (int m = 0; m < 4; ++m) _Pragma("unroll") for (int n = 0; n < 2; ++n) _Pragma("unroll") for (int k = 0; k < 2; ++k) \
        acc[ai][bj][m][n] = __builtin_amdgcn_mfma_f32_16x16x32_bf16(Bt[n][k], At[m][k], acc[ai][bj][m][n], 0, 0, 0); __builtin_amdgcn_s_setprio(0); } while (0)
#define PG8_WAIT_V(n) asm volatile("s_waitcnt vmcnt(" #n ")" ::: "memory")
#define PG8_WAIT_L(n) asm volatile("s_waitcnt lgkmcnt(" #n ")" ::: "memory")
#define PG8_BAR __builtin_amdgcn_s_barrier()
#define PG8_SCHED __builtin_amdgcn_sched_barrier(0)
    Unit cur, nxt; int ui = 0;
    if (!S.next(0, cur)) return;
    f32x4 acc[2][2][4][2];
#pragma unroll
    for (int a = 0; a < 2; ++a)
#pragma unroll
        for (int b = 0; b < 2; ++b)
#pragma unroll
            for (int m = 0; m < 4; ++m)
#pragma unroll
                for (int n = 0; n < 2; ++n) acc[a][b][m][n] = (f32x4){0.f, 0.f, 0.f, 0.f};
    bf16x8 At[4][2], B0[2][2], B1[2][2];
    const char* cA = (const char*)g.A + (size_t)cur.pm * tstepA; const char* cB = (const char*)g.Bt + (size_t)cur.pn * tstepB;
    S.a_ready(cur);
    if constexpr (SP2) {
        PG8_STAGE(PG8_SB(0, 0), cB, voffB); PG8_STAGE(PG8_SB(0, 1), cB + hstepB, voffB); PG8_STAGE(PG8_SA(0, 0), cA, voffA); PG8_STAGE(PG8_SA(0, 1), cA + hstepA, voffA);
        if (wr == 1) PG8_BAR;
        PG8_WAIT_V(2); PG8_BAR;
        PG8_STAGE(PG8_SB(1, 0), cB + kstepB, voffB); PG8_STAGE(PG8_SA(1, 0), cA + kstepA, voffA); PG8_STAGE(PG8_SB(1, 1), cB + hstepB + kstepB, voffB);
        PG8_WAIT_V(6); PG8_BAR;
    } else {
        PG8_STAGE(PG8_SB(0, 0), cB, voffB); PG8_STAGE(PG8_SA(0, 0), cA, voffA); PG8_STAGE(PG8_SB(0, 1), cB + hstepB, voffB); PG8_STAGE(PG8_SA(0, 1), cA + hstepA, voffA);
        if (wr == 1) PG8_BAR;
        PG8_WAIT_V(4); PG8_BAR;
        PG8_STAGE(PG8_SB(1, 0), cB + kstepB, voffB); PG8_STAGE(PG8_SA(1, 0), cA + kstepA, voffA); PG8_STAGE(PG8_SB(1, 1), cB + hstepB + kstepB, voffB);
        PG8_WAIT_V(6); PG8_BAR;
    }
    for (;;) {
        const bool has_next = S.next(ui + 1, nxt);
        const char* nA = has_next ? (const char*)g.A + (size_t)nxt.pm * tstepA : cA; const char* nB = has_next ? (const char*)g.Bt + (size_t)nxt.pn * tstepB : cB;
        for (int t = 0; t < nt; t += 2) {
            const bool last = (t == nt - 2);
            const char* a1 = cA + (size_t)(t + 1) * kstepA;
            const char* a2 = last ? nA : cA + (size_t)(t + 2) * kstepA; const char* b2 = last ? nB : cB + (size_t)(t + 2) * kstepB;
            const char* a3 = a2 + kstepA; const char* b3 = b2 + kstepB;
            if (last && has_next) S.a_ready(nxt);
            if constexpr (SP2) {
            PG8_LDB(B0, 0, 0); PG8_LDB(B1, 0, 1); PG8_SCHED; PG8_LDA(At, 0, 0); PG8_STAGE(PG8_SA(1, 1), a1 + hstepA, voffA);
            PG8_WAIT_V(8); PG8_WAIT_L(0); PG8_BAR; PG8_MMA(0, 0, At, B0); PG8_MMA(0, 1, At, B1); PG8_BAR; PG8_SCHED;
            PG8_LDA(At, 0, 1); PG8_STAGE(PG8_SB(0, 0), b2, voffB); PG8_STAGE(PG8_SB(0, 1), b2 + hstepB, voffB); PG8_STAGE(PG8_SA(0, 0), a2, voffA);
            PG8_WAIT_V(8); PG8_WAIT_L(0); PG8_BAR; PG8_MMA(1, 0, At, B0); PG8_MMA(1, 1, At, B1); PG8_BAR; PG8_SCHED;
            PG8_LDB(B0, 1, 0); PG8_LDB(B1, 1, 1); PG8_SCHED; PG8_LDA(At, 1, 0); PG8_STAGE(PG8_SA(0, 1), a2 + hstepA, voffA);
            PG8_WAIT_V(8); PG8_WAIT_L(0); PG8_BAR; PG8_MMA(0, 0, At, B0); PG8_MMA(0, 1, At, B1); PG8_BAR; PG8_SCHED;
            PG8_LDA(At, 1, 1); PG8_STAGE(PG8_SB(1, 0), b3, voffB); PG8_STAGE(PG8_SB(1, 1), b3 + hstepB, voffB); PG8_STAGE(PG8_SA(1, 0), a3, voffA);
            PG8_WAIT_V(8); PG8_WAIT_L(0); PG8_BAR; PG8_MMA(1, 0, At, B0); PG8_MMA(1, 1, At, B1); PG8_BAR; PG8_SCHED;
            } else {
            PG8_LDB(B0, 0, 0); PG8_SCHED; PG8_LDA(At, 0, 0); PG8_STAGE(PG8_SA(1, 1), a1 + hstepA, voffA);
            PG8_WAIT_L(8); PG8_BAR; PG8_WAIT_L(0); PG8_MMA(0, 0, At, B0); PG8_BAR; PG8_SCHED;
            PG8_LDB(B1, 0, 1); PG8_STAGE(PG8_SB(0, 0), b2, voffB);
            PG8_BAR; PG8_WAIT_L(0); PG8_MMA(0, 1, At, B1); PG8_BAR;
            PG8_LDA(At, 0, 1); PG8_STAGE(PG8_SA(0, 0), a2, voffA);
            PG8_BAR; PG8_WAIT_L(0); PG8_MMA(1, 0, At, B0); PG8_BAR; PG8_SCHED;
            PG8_STAGE(PG8_SB(0, 1), b2 + hstepB, voffB);
            PG8_WAIT_V(6); PG8_BAR; PG8_MMA(1, 1, At, B1); PG8_BAR;
            PG8_LDB(B0, 1, 0); PG8_SCHED; PG8_LDA(At, 1, 0); PG8_STAGE(PG8_SA(0, 1), a2 + hstepA, voffA);
            PG8_WAIT_L(8); PG8_BAR; PG8_WAIT_L(0); PG8_MMA(0, 0, At, B0); PG8_BAR; PG8_SCHED;
            PG8_LDB(B1, 1, 1); PG8_STAGE(PG8_SB(1, 0), b3, voffB);
            PG8_BAR; PG8_WAIT_L(0); PG8_MMA(0, 1, At, B1); PG8_BAR;
            PG8_LDA(At, 1, 1); PG8_STAGE(PG8_SA(1, 0), a3, voffA);
            PG8_BAR; PG8_WAIT_L(0); PG8_MMA(1, 0, At, B0); PG8_BAR; PG8_SCHED;
            PG8_STAGE(PG8_SB(1, 1), b3 + hstepB, voffB);
            PG8_WAIT_V(6); PG8_BAR; PG8_MMA(1, 1, At, B1); PG8_BAR;
            }
        }
        if constexpr (ALIGN_EPI) { if (wr == 0) PG8_BAR; }
        if constexpr (!Epi::AFTER_DRAIN) { E(acc, cur, wr, wc, fr, fq); S.done(cur); }
        if (!has_next) break;
#pragma unroll
        for (int a = 0; a < 2; ++a)
#pragma unroll
            for (int b = 0; b < 2; ++b)
#pragma unroll
                for (int m = 0; m < 4; ++m)
#pragma unroll
                    for (int n = 0; n < 2; ++n) acc[a][b][m][n] = (f32x4){0.f, 0.f, 0.f, 0.f};
        cur = nxt; cA = nA; cB = nB; ++ui;
        if constexpr (ALIGN_EPI) { if (wr == 1) PG8_BAR; }
    }
    PG8_WAIT_V(0);
    if constexpr (!ALIGN_EPI) { if (wr == 0) PG8_BAR; }
    PG8_BAR;
    if constexpr (Epi::AFTER_DRAIN) { E.fused(acc, cur, wr, wc, fr, fq, lds, wid, lane); S.done(cur); }
#undef PG8_SA
#undef PG8_SB
#undef PG8_STAGE
#undef PG8_LDA
#undef PG8_LDB
#undef PG8_MMA
#undef PG8_WAIT_V
#undef PG8_WAIT_L
#undef PG8_BAR
#undef PG8_SCHED
}
}
#define GAS __attribute__((address_space(1)))
#define LAS __attribute__((address_space(3)))
typedef unsigned short bf16;
typedef unsigned v4u __attribute__((ext_vector_type(4)));
typedef float f32x4 __attribute__((ext_vector_type(4)));
typedef short bf16x8 __attribute__((ext_vector_type(8)));
typedef GAS unsigned gu32;
typedef GAS unsigned long long gu64;
#define RLX_AGENT __ATOMIC_RELAXED, __HIP_MEMORY_SCOPE_AGENT
#define LDS_WAIT() asm volatile("s_waitcnt lgkmcnt(0)" ::: "memory")
#define VM_WAIT() asm volatile("s_waitcnt vmcnt(0)" ::: "memory")
__device__ __forceinline__ unsigned long long rt() { return __builtin_amdgcn_s_memrealtime(); }
__device__ __forceinline__ unsigned f2bf(float f) { unsigned u = __builtin_bit_cast(unsigned, f); return (u + 0x7fffu + ((u >> 16) & 1u)) >> 16; }
__device__ __forceinline__ unsigned pk2(float lo, float hi) { return f2bf(lo) | (f2bf(hi) << 16); }

#define XB_TMO      128
#define XB_XCNT(j)  (256  + 64 * (j))
#define XB_XSUB(j)  (1280 + 64 * (j))
#define XB_XGEN(j)  (2304 + 64 * (j))
#define XB_TOP      3328
#define XB_TOPGEN   3392
#define XCD_BAR_WORDS 3456
#define XB_SPIN_CAP (1u << 24)

__device__ __forceinline__ unsigned xb_ld(unsigned* p)              { return __hip_atomic_load(p, __ATOMIC_RELAXED, __HIP_MEMORY_SCOPE_AGENT); }
__device__ __forceinline__ unsigned xb_add(unsigned* p, unsigned v) { return __hip_atomic_fetch_add(p, v, __ATOMIC_RELAXED, __HIP_MEMORY_SCOPE_AGENT); }
__device__ __forceinline__ unsigned xb_xcc_id() { return (unsigned)__builtin_amdgcn_s_getreg((3 << 11) | 20) & 0xFu; }
#define XB_SPIN(cond, bar) do { unsigned _sp = 0; while (cond) { __builtin_amdgcn_s_sleep(1); \
    if ((++_sp & 255u) == 0u) { if (xb_ld(&(bar)[XB_TMO])) break; if (_sp > XB_SPIN_CAP) { atomicAdd(&(bar)[XB_TMO], 1u); break; } } } } while (0)

__device__ __forceinline__ unsigned xb_lane() { unsigned l_; asm volatile("v_mbcnt_lo_u32_b32 %0, -1, 0\n\tv_mbcnt_hi_u32_b32 %0, -1, %0" : "=&v"(l_)); return l_; }
struct XcdBarrier {
    unsigned* bar; unsigned x; unsigned w;
    volatile LAS unsigned* st;
};

__device__ __forceinline__ XcdBarrier xcd_barrier_post(unsigned* bar, volatile LAS unsigned* st) {
    XcdBarrier b; b.bar = bar; b.x = xb_xcc_id(); b.st = st; b.w = (unsigned)__builtin_amdgcn_readfirstlane(threadIdx.x >> 6);
    if (threadIdx.x == 0) (void)xb_add(&bar[XB_XCNT(b.x)], 1u);
    return b;
}
__device__ __forceinline__ void xcd_barrier_complete(unsigned* bar, unsigned x, unsigned& nloc, unsigned& nx) {
    const unsigned G = gridDim.x * gridDim.y * gridDim.z;
    unsigned sum, cnt, mine, sp = 0u;
    for (;;) {
        sum = 0u; cnt = 0u; mine = 0u;
#pragma unroll
        for (unsigned j = 0; j < 16; ++j) { const unsigned c = xb_ld(&bar[XB_XCNT(j)]); sum += c; cnt += (c > 0u) ? 1u : 0u; mine = (j == x) ? c : mine; }
        if (sum == G) break;
        __builtin_amdgcn_s_sleep(1);
        if ((++sp & 255u) == 0u) { if (xb_ld(&bar[XB_TMO])) break; if (sp > XB_SPIN_CAP) { atomicAdd(&bar[XB_TMO], 1u); break; } }
    }
    nloc = mine > 0u ? mine : 1u; nx = cnt > 0u ? cnt : 1u;
}

__device__ __forceinline__ void xcd_barrier(const XcdBarrier& b) {
    asm volatile("s_waitcnt vmcnt(0)" ::: "memory");
    __syncthreads();
    if (b.w == 0u && xb_lane() == 0u) {
        unsigned* bar = b.bar;
        __builtin_amdgcn_s_waitcnt(0);
        unsigned nloc = b.st[0], nx = b.st[1];
        if (nloc == 0u) { xcd_barrier_complete(bar, b.x, nloc, nx); b.st[0] = nloc; b.st[1] = nx; }
        const unsigned old = xb_add(&bar[XB_XSUB(b.x)], 1u);
        const unsigned gen = old / nloc;
        if (old + 1u == (gen + 1u) * nloc) {
            __builtin_amdgcn_fence(__ATOMIC_RELEASE, "agent");
            asm volatile("s_waitcnt vmcnt(0)" ::: "memory");
            const unsigned og = xb_add(&bar[XB_TOP], 1u);
            const unsigned tg = og / nx;
            if (og + 1u == (tg + 1u) * nx) xb_add(&bar[XB_TOPGEN], 1u);
            else XB_SPIN(xb_ld(&bar[XB_TOPGEN]) == tg, bar);
            __builtin_amdgcn_fence(__ATOMIC_ACQUIRE, "agent");
            xb_add(&bar[XB_XGEN(b.x)], 1u);
            asm volatile("s_waitcnt vmcnt(0)" ::: "memory");
        } else {
            XB_SPIN(xb_ld(&bar[XB_XGEN(b.x)]) == gen, bar);
            __builtin_amdgcn_fence(__ATOMIC_ACQUIRE, "agent");
            asm volatile("s_waitcnt vmcnt(0)" ::: "memory");
        }
    }
    __syncthreads();
}
#ifndef PROBE_MASK
#define PROBE_MASK 0
#endif

constexpr int T = 4096, NBATCH = 2, MPROMPT = 8192, MSAMP = 128, MREAL = 8320, MPAD = 8448;
constexpr int DM = 2048, DG = 1024, DQ = 1024, DFF = 8192, NIN = 8728, NINP = 8960;
constexpr int PASTLEN = 2048;
constexpr float EPS = 1e-6f;
constexpr float LOG2E = 1.4426950408889634f;
constexpr float QSCALE = 0.08838834764831845f * 1.4426950408889634f;
constexpr int NWAVES = 8;
constexpr int LD2 = DM + 64, LD1 = DG + 64, LD8 = DFF + 64;

constexpr size_t O_YP = 0, O_YS = 16777216, O_PCMP = O_YS + 262144, O_PSEL = O_PCMP + 4194304, O_PWIN = O_PSEL + 4194304,
                 O_PSGU = O_PWIN + 524288, O_SCMP = O_PSGU + 262144, O_SSEL = O_SCMP + 65536, O_SWIN = O_SSEL + 65536,
                 O_SSGU = O_SWIN + 33554432, O_END = O_SSGU + 131072;
static_assert(O_END == 60030976, "output size");

constexpr size_t MiB = 1ull << 20;
constexpr size_t al(size_t x) { return (x + MiB - 1) / MiB * MiB; }
constexpr size_t WS_CTL = 0, CTL_ZERO_BYTES = 1 * MiB;
constexpr size_t WS_WIN  = 1 * MiB;
constexpr size_t WS_WG   = WS_WIN  + al((size_t)NINP * LD2 * 2);
constexpr size_t WS_WN   = WS_WG   + al((size_t)DM * LD1 * 2);
constexpr size_t WS_WO   = WS_WN   + al((size_t)DM * LD1 * 2);
constexpr size_t WS_WUP  = WS_WO   + al((size_t)DM * LD2 * 2);
constexpr size_t WS_WDN  = WS_WUP  + al((size_t)DFF * LD2 * 2);
constexpr size_t WS_WC   = WS_WDN  + al((size_t)DM * LD8 * 2);
constexpr size_t WS_XB   = WS_WC   + al((size_t)512 * LD2 * 2);
constexpr size_t WS_RSTD1= WS_XB   + al((size_t)MPAD * LD2 * 2);
constexpr size_t WS_U    = WS_RSTD1+ al((size_t)MPAD * 4);
constexpr size_t WS_VG   = WS_U    + al((size_t)MPAD * DG * 2);
constexpr size_t WS_VSS  = WS_VG   + al((size_t)MPAD * DG * 2);
constexpr size_t WS_RSTDV= WS_VSS  + al((size_t)MPAD * 32 * 4);
constexpr size_t WS_QRAW = WS_RSTDV+ al((size_t)MPAD * 4);
constexpr size_t WS_KVWR = WS_QRAW + al((size_t)MPAD * DQ * 4);
constexpr size_t WS_GA   = WS_KVWR + al((size_t)MPAD * 512 * 4);
constexpr size_t WS_GB   = WS_GA   + al((size_t)MPAD * DM * 2);
constexpr size_t WS_GN   = WS_GB   + al((size_t)MPAD * DM * 2);
constexpr size_t WS_QN   = WS_GN   + al((size_t)MPAD * 32 * 4);
constexpr size_t WS_KS   = WS_QN   + al((size_t)MPAD * DQ * 2);
constexpr size_t WS_VS   = WS_KS   + 4 * MiB;
constexpr size_t WS_KW   = WS_VS   + 4 * MiB;
constexpr size_t WS_VW   = WS_KW   + 4 * MiB;
constexpr size_t WS_ACP  = WS_VW   + 4 * MiB;
constexpr size_t WS_ACS  = WS_ACP  + al((size_t)2048 * LD2 * 2);
constexpr size_t WS_YCP  = WS_ACS  + al((size_t)65536 * LD2 * 2);
constexpr size_t WS_YCS  = WS_YCP  + 2 * MiB;
constexpr size_t WS_KCP  = WS_YCS  + 64 * MiB;
constexpr size_t WS_VCP  = WS_KCP  + 1 * MiB;
constexpr size_t WS_KCS  = WS_VCP  + 1 * MiB;
constexpr size_t WS_VCS  = WS_KCS  + 8 * MiB;
constexpr size_t WS_CBP  = WS_VCS  + 8 * MiB;
constexpr size_t WS_WMB  = WS_CBP  + 1 * MiB;
constexpr size_t WS_BLUT = WS_WMB  + 1 * MiB;
constexpr size_t WS_OA   = WS_BLUT + 1 * MiB;
constexpr size_t WS_OB   = WS_OA   + al((size_t)MPAD * LD1 * 2);
constexpr size_t WS_MIXA = WS_OB   + al((size_t)MPAD * LD1 * 2);
constexpr size_t WS_MIX  = WS_MIXA + al((size_t)MPAD * DM * 2);
constexpr size_t WS_X1B  = WS_MIX  + al((size_t)MPAD * LD2 * 2);
constexpr size_t WS_X1F  = WS_X1B  + al((size_t)MPAD * LD2 * 2);
constexpr size_t WS_X1SS = WS_X1F  + al((size_t)128 * DM * 4);
constexpr size_t WS_H    = WS_X1SS + al((size_t)MPAD * 32 * 4);
constexpr size_t WS_OT   = WS_H    + al((size_t)MPAD * LD8 * 2);
constexpr size_t WS_SPART= WS_OT   + 32 * MiB;
constexpr int LDS_X = DM + 64, LDS_G = DG + 64, LDS_H = DFF + 64;
constexpr size_t WS_SXB  = WS_SPART+ 4 * MiB;
constexpr size_t WS_SOA  = WS_SXB  + 1 * MiB;
constexpr size_t WS_SOB  = WS_SOA  + 1 * MiB;
constexpr size_t WS_SMIX = WS_SOB  + 1 * MiB;
constexpr size_t WS_SX1B = WS_SMIX + 1 * MiB;
constexpr size_t WS_SH   = WS_SX1B + 1 * MiB;
constexpr size_t WS_DUMMY= WS_SH   + 3 * MiB;
constexpr size_t WS_END  = WS_DUMMY+ 72 * MiB;

constexpr int CW_TMO = 0, CW_CODE = 1;
constexpr int CW_BAR = 4096;
constexpr int CW_Q5 = 8192;
constexpr int CW_FLAG = 16384;
constexpr int CW_TICK = 65536;
static_assert((CW_TICK + 64 * 64) * 4 <= (int)CTL_ZERO_BYTES && (CW_BAR + 16 * 3456) * 4 <= (int)CTL_ZERO_BYTES, "CTL words inside the memset region");

constexpr int RING_OFF = 0, RING_BYTES = 131072;
constexpr int LDSCTL_OFF = RING_BYTES, MISC_OFF = LDSCTL_OFF + 320;
constexpr int LDS_BYTES = 147456;
static_assert(MISC_OFF + 128 <= LDS_BYTES, "LDS map");

__constant__ unsigned char kBkt[128] = {0, 1, 2, 3, 4, 5, 6, 7, 8, 9, 10, 11, 12, 13, 14, 15, 16, 16, 16, 17, 17, 18, 18, 18, 19, 19, 19, 20, 20, 20, 20, 21, 21, 21, 21, 22, 22, 22, 22, 22, 23, 23, 23, 23, 23, 23, 24, 24, 24, 24, 24, 24, 25, 25, 25, 25, 25, 25, 25, 26, 26, 26, 26, 26, 26, 26, 26, 27, 27, 27, 27, 27, 27, 27, 27, 27, 27, 28, 28, 28, 28, 28, 28, 28, 28, 28, 28, 29, 29, 29, 29, 29, 29, 29, 29, 29, 29, 29, 29, 30, 30, 30, 30, 30, 30, 30, 30, 30, 30, 30, 30, 30, 30, 31, 31, 31, 31, 31, 31, 31, 31, 31, 31, 31, 31, 31, 31, 31};

__host__ __device__ __forceinline__ size_t tm_idx(int row, int col, int nkt) { return ((size_t)((row >> 8) * nkt + (col >> 6)) * 256 + (row & 255)) * 64 + (col & 63); }

typedef unsigned v2u __attribute__((ext_vector_type(2)));
struct Ctx {
    const float* const* in; float* out; unsigned char* ws;
    LAS unsigned char* lds;
    int tid, lane, wave, vcu, G;
};
__device__ __forceinline__ int lane_now() { int l_; asm volatile("v_mbcnt_lo_u32_b32 %0, -1, 0\n\tv_mbcnt_hi_u32_b32 %0, -1, %0" : "=&v"(l_) : : "memory"); return l_; }
__device__ __forceinline__ Ctx fresh(const Ctx& C) { Ctx L = C; const int l_ = lane_now(); L.lane = l_; L.tid = C.wave * 64 + l_; return L; }
#define IN_XP 0
#define IN_XS 1
#define IN_CCMP 2
#define IN_CSEL 3
#define IN_WINB 4
#define IN_PT 5
#define IN_RELB 6
#define IN_GMIX 7
#define IN_WIN 8
#define IN_GSGU 9
#define IN_WSGU 10
#define IN_BSGU 11
#define IN_GQ 12
#define IN_GK 13
#define IN_POSK 14
#define IN_WCK 15
#define IN_POSV 16
#define IN_WCV 17
#define IN_WPG 18
#define IN_WPN 19
#define IN_WOUT 20
#define IN_GMLP 21
#define IN_WUP 22
#define IN_WDN 23

__device__ __forceinline__ float bf2f(unsigned short b) { return __uint_as_float((unsigned)b << 16); }
__device__ __forceinline__ float bflo(unsigned w) { return __uint_as_float(w << 16); }
__device__ __forceinline__ float bfhi(unsigned w) { return __uint_as_float(w & 0xffff0000u); }
__device__ __forceinline__ void unpack8(v4u w, float (&f)[8]) {
    f[0] = bflo(w.x); f[1] = bfhi(w.x); f[2] = bflo(w.y); f[3] = bfhi(w.y); f[4] = bflo(w.z); f[5] = bfhi(w.z); f[6] = bflo(w.w); f[7] = bfhi(w.w);
}
__device__ __forceinline__ v4u pack8f(const float (&f)[8]) { v4u w; w.x = pk2(f[0], f[1]); w.y = pk2(f[2], f[3]); w.z = pk2(f[4], f[5]); w.w = pk2(f[6], f[7]); return w; }
__device__ __forceinline__ float wave_sum(float v) {
#pragma unroll
    for (int o = 1; o < 64; o <<= 1) v += __shfl_xor(v, o);
    return v;
}
__device__ __forceinline__ float wave_max(float v) {
#pragma unroll
    for (int o = 1; o < 64; o <<= 1) v = fmaxf(v, __shfl_xor(v, o));
    return v;
}
__device__ __forceinline__ float sigmoidf_(float x) { return 1.0f / (1.0f + __expf(-x)); }
__device__ __forceinline__ float gelu_tanh(float x) {
    const float u = 0.7978845608028654f * (x + 0.044715f * x * x * x);
    return x / (1.0f + __expf(-2.0f * u));
}

__device__ __forceinline__ void tr_item(const float* W, int ldw, int srccol0, int nvalid, const float* kscale, bf16* WT, int nkt, int dst_row0, int k0, LAS float* scr, int lane) {
    const int n = lane & 31;
    float vv[32];
#pragma unroll
    for (int i = 0; i < 32; ++i) { const int kk = 2 * i + (lane >> 5); vv[i] = (n < nvalid) ? __builtin_nontemporal_load(W + (size_t)(k0 + kk) * ldw + srccol0 + n) : 0.f; }
    if (kscale) {
#pragma unroll
        for (int i = 0; i < 32; ++i) vv[i] *= kscale[k0 + 2 * i + (lane >> 5)]; }
#pragma unroll
    for (int i = 0; i < 32; ++i) scr[(2 * i + (lane >> 5)) * 33 + n] = vv[i];
    LDS_WAIT(); asm volatile("" ::: "memory");
    const int c = lane & 7;
#pragma unroll
    for (int j = 0; j < 4; ++j) { const int nn = (lane >> 3) + 8 * j; const LAS float* s = scr + (8 * c) * 33 + nn;
        v4u o; o.x = pk2(s[0 * 33], s[1 * 33]); o.y = pk2(s[2 * 33], s[3 * 33]); o.z = pk2(s[4 * 33], s[5 * 33]); o.w = pk2(s[6 * 33], s[7 * 33]);
        { const int n_ = dst_row0 + nn; *(GAS v4u*)(WT + ((size_t)((n_ >> 8) * nkt + (k0 >> 6)) * 256 + (n_ & 255)) * 64 + 8 * c) = o; } }
    LDS_WAIT(); asm volatile("" ::: "memory");
}

constexpr int I_IN = 32 * 280, I_PG = 16 * 64, I_PN = 16 * 64, I_OUT = 32 * 64, I_UP = 32 * 256, I_DN = 128 * 64, I_C = 4 * 128;
constexpr int I_LATE = I_PG + I_PN + I_OUT + I_UP + I_DN;
__device__ __forceinline__ void w_item_in(const Ctx& C, int r, LAS float* scr) {
    const int kb = r / 280, nb = r % 280, n0 = nb * 32;
    const int src = n0 < 4608 ? n0 : (n0 < 8704 ? n0 + 24 : n0 - 8704 + 4608);
    const int nv = n0 < 8704 ? 32 : (n0 == 8704 ? 24 : 0);
    tr_item(C.in[IN_WIN], NIN, src, nv, C.in[IN_GMIX], (bf16*)(C.ws + WS_WIN), DM / 64, n0, kb * 64, scr, C.lane);
}
__device__ __forceinline__ void w_item_cmp(const Ctx& C, int r, LAS float* scr) {
    const int sub = r / 128, rr = r % 128, kv = sub >> 1, hf = sub & 1, kb = rr / 4, nb = rr % 4;
    const float* W = (kv ? C.in[IN_WCV] : C.in[IN_WCK]) + (size_t)hf * 2048 * 128;
    tr_item(W, 128, nb * 32, 32, nullptr, (bf16*)(C.ws + WS_WC), 2048 / 64, kv * 256 + hf * 128 + nb * 32, kb * 64, scr, C.lane);
}
__device__ __forceinline__ void w_item_late(const Ctx& C, int r, LAS float* scr) {
    unsigned char* ws = C.ws; const int lane = C.lane;
    if (r < I_PG) { const int kb = r / 64, nb = r % 64; tr_item(C.in[IN_WPG], DM, nb * 32, 32, nullptr, (bf16*)(ws + WS_WG), DG / 64, nb * 32, kb * 64, scr, lane); return; } r -= I_PG;
    if (r < I_PN) { const int kb = r / 64, nb = r % 64; tr_item(C.in[IN_WPN], DM, nb * 32, 32, nullptr, (bf16*)(ws + WS_WN), DQ / 64, nb * 32, kb * 64, scr, lane); return; } r -= I_PN;
    if (r < I_OUT) { const int kb = r / 64, nb = r % 64; tr_item(C.in[IN_WOUT], DM, nb * 32, 32, nullptr, (bf16*)(ws + WS_WO), DM / 64, nb * 32, kb * 64, scr, lane); return; } r -= I_OUT;
    if (r < I_UP) { const int kb = r / 256, nb = r % 256; tr_item(C.in[IN_WUP], DFF, nb * 32, 32, C.in[IN_GMLP], (bf16*)(ws + WS_WUP), DM / 64, nb * 32, kb * 64, scr, lane); return; } r -= I_UP;
    { const int kb = r / 64, nb = r % 64; tr_item(C.in[IN_WDN], DM, nb * 32, 32, nullptr, (bf16*)(ws + WS_WDN), DFF / 64, nb * 32, kb * 64, scr, lane); }
}
__device__ __forceinline__ void gather_item(const Ctx& C, int it) {
    const int lane = C.lane, kvg = lane >> 4, d = (lane & 15) * 8;
    const int b = it >> 7, p = (it >> 3) & 15, sg = it & 7, page = ((const int*)C.in[IN_PT])[b * 16 + p], j = p * 8 + sg;
    const float* src = C.in[IN_CCMP] + ((size_t)page * 128 + sg * 16) * 512 + lane * 8;
    bf16* dst = (bf16*)(C.ws + WS_ACS) + (size_t)((b * 4 + kvg) * 128 + j) * LD2 + d;
#pragma unroll
    for (int h = 0; h < 2; ++h) { f32x4 a[8], c2[8];
#pragma unroll
        for (int s = 0; s < 8; ++s) { a[s] = __builtin_nontemporal_load((const GAS f32x4*)(src + (h * 8 + s) * 512)); c2[s] = __builtin_nontemporal_load((const GAS f32x4*)(src + (h * 8 + s) * 512 + 4)); }
#pragma unroll
        for (int s = 0; s < 8; ++s) { v4u o; o.x = pk2(a[s].x, a[s].y); o.y = pk2(a[s].z, a[s].w); o.z = pk2(c2[s].x, c2[s].y); o.w = pk2(c2[s].z, c2[s].w);
            *(GAS v4u*)(dst + (h * 8 + s) * 128) = o; } }
}
constexpr int WINCOPY_F4 = 128 * 65408, WINCOPY_CHUNK = 16384, WINCOPY_ITEMS = (WINCOPY_F4 + WINCOPY_CHUNK - 1) / WINCOPY_CHUNK;
__device__ __forceinline__ void wincopy_item(const Ctx& C, int chunk) {
    const GAS f32x4* src = (const GAS f32x4*)C.in[IN_WINB]; GAS f32x4* dst = (GAS f32x4*)(C.out + O_SWIN);
    const int base = chunk * WINCOPY_CHUNK + C.tid;
#pragma unroll
    for (int h = 0; h < 2; ++h) { f32x4 v[16];
#pragma unroll
        for (int k = 0; k < 16; ++k) { const int i = base + (h * 16 + k) * NWAVES * 64; if (i < WINCOPY_F4) { const int b = i / 65408, r = i - b * 65408; v[k] = __builtin_nontemporal_load(src + b * 65536 + 128 + r); } }
#pragma unroll
        for (int k = 0; k < 16; ++k) { const int i = base + (h * 16 + k) * NWAVES * 64; if (i < WINCOPY_F4) { const int b = i / 65408, r = i - b * 65408; __builtin_nontemporal_store(v[k], dst + b * 65536 + r); } } }
}

__device__ __forceinline__ void p0_prologue(const Ctx& C) {
    unsigned char* ws = C.ws;
    LAS float* scr = (LAS float*)(C.lds + RING_OFF + C.wave * 16384);
    const int gw = C.vcu * NWAVES + C.wave, NGW = C.G * NWAVES, lane = C.lane;
    for (int rep = 0; rep < (((PROBE_MASK >> 10) & 1) ? 2 : 1); ++rep)
    for (int it = gw; it < I_IN + I_C; it += NGW) { if (it < I_IN) w_item_in(C, it, scr); else w_item_cmp(C, it - I_IN, scr); }
    {
        bf16* XB = (bf16*)(ws + WS_XB); float* RS = (float*)(ws + WS_RSTD1);
        for (int rep = 0; rep < (((PROBE_MASK >> 12) & 1) ? 2 : 1); ++rep)
        for (int m = gw; m < MREAL; m += NGW) {
            const bool pr_ = m < MPROMPT;
            GAS v2u* o8 = pr_ ? (GAS v2u*)(XB + tm_idx(m, 4 * (lane & 15), DM / 64)) + 0 : (GAS v2u*)((bf16*)(ws + WS_SXB) + (size_t)(m - MPROMPT) * LDS_X) + lane;
            const float* xr = m < MPROMPT ? C.in[IN_XP] + (size_t)m * DM : C.in[IN_XS] + (size_t)(m - MPROMPT) * DM;
            const GAS f32x4* x4 = (const GAS f32x4*)xr + lane; f32x4 v[8]; float s = 0.f;
#pragma unroll
            for (int j = 0; j < 8; ++j) { v[j] = x4[64 * j]; s += (v[j].x * v[j].x + v[j].y * v[j].y) + (v[j].z * v[j].z + v[j].w * v[j].w); }
            s = wave_sum(s);
#pragma unroll
            for (int j = 0; j < 8; ++j) o8[pr_ ? (size_t)((lane >> 4) + 4 * j) * 4096 : (size_t)64 * j] = (v2u){pk2(v[j].x, v[j].y), pk2(v[j].z, v[j].w)};
            if (lane == 0) RS[m] = rsqrtf(s * (1.0f / DM) + EPS);
        }
    }
    {
        float* CBP = (float*)(ws + WS_CBP);
        for (int it = gw; it < 64; it += NGW) { const int kv = it >> 5, eb = (it >> 4) & 1, kc = it & 15, e = eb * 64 + lane;
            const float* pos = kv ? C.in[IN_POSV] : C.in[IN_POSK]; const float* W = kv ? C.in[IN_WCV] : C.in[IN_WCK]; float a = 0.f;
#pragma unroll 8
            for (int k = kc * 256; k < kc * 256 + 256; ++k) a += pos[k] * W[(size_t)k * 128 + e];
            CBP[(kv * 16 + kc) * 128 + e] = a; }
    }
    {
        const float* w = C.in[IN_WSGU]; bf16* WMB = (bf16*)(ws + WS_WMB);
        for (int i = gw * 64 + lane; i < 8 * 128 * 128 / 8; i += NGW * 64) { const int e0 = i * 8, t = (e0 >> 7) & 127, s0 = e0 & 127; float f[8];
#pragma unroll
            for (int k = 0; k < 8; ++k) f[k] = (s0 + k <= t) ? w[e0 + k] : 0.f;
            *(GAS v4u*)(WMB + e0) = pack8f(f); }
        float* BL = (float*)(ws + WS_BLUT); const float* rb = C.in[IN_RELB];
        for (int i = gw * 64 + lane; i < 8 * 132; i += NGW * 64) { const int h = i / 132, rel = i % 132; const int bk = rel < 128 ? kBkt[rel] : 31; BL[i] = rb[bk * 8 + h] * LOG2E; }
    }
}

namespace epi {
using pg8::f32x4; using pg8::Unit; using pg8::cvt_pk_bf16;
typedef unsigned u32x4 __attribute__((ext_vector_type(4)));
__device__ __forceinline__ u32x4 pack8v(f32x4 a, f32x4 b) { u32x4 w; w.x = cvt_pk_bf16(a[0], a[1]); w.y = cvt_pk_bf16(a[2], a[3]); w.z = cvt_pk_bf16(b[0], b[1]); w.w = cvt_pk_bf16(b[2], b[3]); return w; }

struct EpiIn {
    static constexpr bool PERM = true, AFTER_DRAIN = false;
    const float* rstd; bf16* U; bf16* VG; float* VSS; float* QRAW; float* KVWR; bf16* GA; bf16* GB; float* GN; float* out; bf16* ACP;
    __device__ __forceinline__ void operator()(const f32x4 (&acc)[2][2][4][2], const Unit& u, int wr, int wc, int fr, int fq) const {
        const int row0 = u.pm * 256 + wr * 64 + fr, cl = wc * 32 + 8 * fq, pn = u.pn;
#pragma unroll
        for (int ai = 0; ai < 2; ++ai)
#pragma unroll
            for (int m = 0; m < 4; ++m) { const int row = row0 + ai * 128 + m * 16; const float rs = rstd[row];
#pragma unroll
                for (int bj = 0; bj < 2; ++bj) { f32x4 v0 = acc[ai][bj][m][0] * rs, v1 = acc[ai][bj][m][1] * rs; const int c = cl + bj * 128;
                    if (pn < 8) {
#pragma unroll
                        for (int k = 0; k < 4; ++k) { v0[k] = gelu_tanh(v0[k]); v1[k] = gelu_tanh(v1[k]); }
                        if (pn < 4) *(u32x4*)(U + (size_t)row * DG + pn * 256 + c) = pack8v(v0, v1);
                        else { *(u32x4*)(VG + (size_t)row * DG + (pn - 4) * 256 + c) = pack8v(v0, v1);
                            float ss = (v0[0] * v0[0] + v0[1] * v0[1]) + (v0[2] * v0[2] + v0[3] * v0[3]) + (v1[0] * v1[0] + v1[1] * v1[1]) + (v1[2] * v1[2] + v1[3] * v1[3]);
                            ss += __shfl_xor(ss, 16); ss += __shfl_xor(ss, 32);
                            if (fq == 0) VSS[(size_t)row * 32 + (pn - 4) * 8 + bj * 4 + wc] = ss; }
                    } else if (pn < 12) { float* q = QRAW + (size_t)row * DQ + (pn - 8) * 256 + c; *(f32x4*)q = v0; *(f32x4*)(q + 4) = v1;
                    } else if (pn < 16) {
                        const int cc = ((pn - 12) & 1) * 256 + c; float* o = nullptr;
                        if (row < MPROMPT) o = out + (pn < 14 ? O_PCMP : O_PSEL) + (size_t)row * 512 + cc;
                        else if (row < MREAL) o = out + (pn < 14 ? O_SCMP : O_SSEL) + (size_t)(row - MPROMPT) * 512 + cc;
                        if (o) { *(f32x4*)o = v0; *(f32x4*)(o + 4) = v1; }
                        if (pn < 14 && row < MPROMPT) {
                            const int b_ = row >> 12, t_ = row & 4095;
                            *(u32x4*)(ACP + tm_idx(((b_ * 2 + (cc >> 8)) * 2 + ((cc >> 7) & 1)) * 256 + (t_ >> 4), (t_ & 15) * 128 + (cc & 127), 2048 / 64)) = pack8v(v0, v1); }
                    } else if (pn < 18) { float* o = KVWR + (size_t)row * 512 + (pn - 16) * 256 + c; *(f32x4*)o = v0; *(f32x4*)(o + 4) = v1;
                    } else if (pn < 34) {
#pragma unroll
                        for (int k = 0; k < 4; ++k) { v0[k] = sigmoidf_(v0[k]); v1[k] = sigmoidf_(v1[k]); }
                        bf16* g = (pn < 26 ? GA + (size_t)row * DM + (pn - 18) * 256 : GB + (size_t)row * DM + (pn - 26) * 256) + c; *(u32x4*)g = pack8v(v0, v1);
                    } else { if (c < 24) {
#pragma unroll
                        for (int k = 0; k < 4; ++k) { v0[k] = sigmoidf_(v0[k]); v1[k] = sigmoidf_(v1[k]); }
                        float* o = GN + (size_t)row * 32 + c; *(f32x4*)o = v0; *(f32x4*)(o + 4) = v1; } }
                } }
    }
};
struct EpiCmp {
    static constexpr bool PERM = false, AFTER_DRAIN = false;
    float* YC; int segmask;
    __device__ __forceinline__ void operator()(const f32x4 (&acc)[2][2][4][2], const Unit& u, int wr, int wc, int fr, int fq) const {
        const int row0 = u.pm * 256 + wr * 64 + fr, cl = wc * 32 + 4 * fq;
#pragma unroll
        for (int ai = 0; ai < 2; ++ai)
#pragma unroll
            for (int m = 0; m < 4; ++m) { const int row = row0 + ai * 128 + m * 16;
#pragma unroll
                for (int n = 0; n < 2; ++n) { *(f32x4*)(YC + (size_t)row * 256 + cl + n * 16) = acc[ai][0][m][n];
                    if ((row & segmask) != 0) *(f32x4*)(YC + (size_t)(row - 1) * 256 + 128 + cl + n * 16) = acc[ai][1][m][n]; } }
    }
};
struct EpiMixA {
    static constexpr bool PERM = true, AFTER_DRAIN = false;
    const bf16* GA; bf16* MIXA;
    __device__ __forceinline__ void operator()(const f32x4 (&acc)[2][2][4][2], const Unit& u, int wr, int wc, int fr, int fq) const {
        const int row0 = u.pm * 256 + wr * 64 + fr, c0 = u.pn * 256 + wc * 32 + 8 * fq;
#pragma unroll
        for (int ai = 0; ai < 2; ++ai) { v4u gv[4][2];
#pragma unroll
            for (int m = 0; m < 4; ++m)
#pragma unroll
                for (int bj = 0; bj < 2; ++bj) gv[m][bj] = *(const v4u*)(GA + (size_t)(row0 + ai * 128 + m * 16) * DM + c0 + bj * 128);
#pragma unroll
            for (int m = 0; m < 4; ++m) { const size_t ro = (size_t)(row0 + ai * 128 + m * 16) * DM;
#pragma unroll
                for (int bj = 0; bj < 2; ++bj) { const size_t o = ro + c0 + bj * 128; float g[8]; unpack8(gv[m][bj], g);
                    f32x4 v0 = acc[ai][bj][m][0], v1 = acc[ai][bj][m][1];
                    v0[0] *= g[0]; v0[1] *= g[1]; v0[2] *= g[2]; v0[3] *= g[3]; v1[0] *= g[4]; v1[1] *= g[5]; v1[2] *= g[6]; v1[3] *= g[7];
                    *(u32x4*)(MIXA + o) = pack8v(v0, v1); } } }
    }
};
struct EpiMixB {
    static constexpr bool PERM = true, AFTER_DRAIN = false;
    const bf16* GB; const bf16* MIXA; bf16* MIX;
    __device__ __forceinline__ void operator()(const f32x4 (&acc)[2][2][4][2], const Unit& u, int wr, int wc, int fr, int fq) const {
        const int row0 = u.pm * 256 + wr * 64 + fr, c0 = u.pn * 256 + wc * 32 + 8 * fq;
#pragma unroll
        for (int ai = 0; ai < 2; ++ai) { v4u gv[4][2], av[4][2];
#pragma unroll
            for (int m = 0; m < 4; ++m)
#pragma unroll
                for (int bj = 0; bj < 2; ++bj) { const size_t o = (size_t)(row0 + ai * 128 + m * 16) * DM + c0 + bj * 128; gv[m][bj] = *(const v4u*)(GB + o); av[m][bj] = *(const v4u*)(MIXA + o); }
#pragma unroll
            for (int m = 0; m < 4; ++m)
#pragma unroll
                for (int bj = 0; bj < 2; ++bj) { float g[8], a[8]; unpack8(gv[m][bj], g); unpack8(av[m][bj], a);
                    f32x4 v0 = acc[ai][bj][m][0], v1 = acc[ai][bj][m][1];
                    v0[0] = a[0] + v0[0] * g[0]; v0[1] = a[1] + v0[1] * g[1]; v0[2] = a[2] + v0[2] * g[2]; v0[3] = a[3] + v0[3] * g[3];
                    v1[0] = a[4] + v1[0] * g[4]; v1[1] = a[5] + v1[1] * g[5]; v1[2] = a[6] + v1[2] * g[6]; v1[3] = a[7] + v1[3] * g[7];
                    *(u32x4*)(MIX + tm_idx(row0 + ai * 128 + m * 16, c0 + bj * 128, DM / 64)) = pack8v(v0, v1); } }
    }
};
struct EpiOut {
    static constexpr bool PERM = true, AFTER_DRAIN = false;
    const float* xp; const float* xs; float* out; bf16* X1B; float* SS;
    __device__ __forceinline__ void operator()(const f32x4 (&acc)[2][2][4][2], const Unit& u, int wr, int wc, int fr, int fq) const {
        const int row0 = u.pm * 256 + wr * 64 + fr, c0 = u.pn * 256 + wc * 32 + 8 * fq;
#pragma unroll
        for (int ai = 0; ai < 2; ++ai) { f32x4 xv[4][2][2];
#pragma unroll
            for (int m = 0; m < 4; ++m)
#pragma unroll
                for (int bj = 0; bj < 2; ++bj) { const float* xr = xp + (size_t)(row0 + ai * 128 + m * 16) * DM + c0 + bj * 128; xv[m][bj][0] = *(const f32x4*)xr; xv[m][bj][1] = *(const f32x4*)(xr + 4); }
#pragma unroll
            for (int m = 0; m < 4; ++m) { const int row = row0 + ai * 128 + m * 16; float ss = 0.f;
#pragma unroll
                for (int bj = 0; bj < 2; ++bj) { const int c = c0 + bj * 128; const f32x4 v0 = acc[ai][bj][m][0] + xv[m][bj][0], v1 = acc[ai][bj][m][1] + xv[m][bj][1];
                    *(u32x4*)(X1B + tm_idx(row, c, DM / 64)) = pack8v(v0, v1);
                    ss += (v0[0] * v0[0] + v0[1] * v0[1]) + (v0[2] * v0[2] + v0[3] * v0[3]) + (v1[0] * v1[0] + v1[1] * v1[1]) + (v1[2] * v1[2] + v1[3] * v1[3]); }
                ss += __shfl_xor(ss, 16); ss += __shfl_xor(ss, 32);
                if (fq == 0) SS[(size_t)row * 32 + u.pn * 4 + wc] = ss; } }
    }
};
struct EpiUp {
    static constexpr bool PERM = true, AFTER_DRAIN = false;
    const float* SS; bf16* H;
    __device__ __forceinline__ void operator()(const f32x4 (&acc)[2][2][4][2], const Unit& u, int wr, int wc, int fr, int fq) const {
        const int row0 = u.pm * 256 + wr * 64 + fr, c0 = u.pn * 256 + wc * 32 + 8 * fq;
#pragma unroll
        for (int ai = 0; ai < 2; ++ai)
#pragma unroll
            for (int m = 0; m < 4; ++m) { const int row = row0 + ai * 128 + m * 16; const f32x4* sp = (const f32x4*)(SS + (size_t)row * 32) + 2 * fq;
                const f32x4 s4 = sp[0] + sp[1]; float st = (s4[0] + s4[1]) + (s4[2] + s4[3]); st += __shfl_xor(st, 16); st += __shfl_xor(st, 32);
                const float rs = rsqrtf(st * (1.0f / DM) + EPS);
#pragma unroll
                for (int bj = 0; bj < 2; ++bj) { f32x4 v0 = acc[ai][bj][m][0] * rs, v1 = acc[ai][bj][m][1] * rs;
#pragma unroll
                    for (int k = 0; k < 4; ++k) { const float a = fmaxf(v0[k], 0.f), b = fmaxf(v1[k], 0.f); v0[k] = a * a; v1[k] = b * b; }
                    { const int col = c0 + bj * 128; *(u32x4*)(H + ((size_t)((row >> 8) * (DFF / 64) + (col >> 6)) * 256 + (row & 255)) * 64 + (col & 63)) = pack8v(v0, v1); } } }
    }
};
struct EpiDown {
    static constexpr bool PERM = true, AFTER_DRAIN = false;
    float* out; const bf16* X1B;
    __device__ __forceinline__ void operator()(const f32x4 (&acc)[2][2][4][2], const Unit& u, int wr, int wc, int fr, int fq) const {
        const int row0 = u.pm * 256 + wr * 64 + fr, c0 = u.pn * 256 + wc * 32 + 8 * fq;
#pragma unroll
        for (int ai = 0; ai < 2; ++ai) { u32x4 xv[4][2];
#pragma unroll
            for (int m = 0; m < 4; ++m)
#pragma unroll
                for (int bj = 0; bj < 2; ++bj) xv[m][bj] = *(const u32x4*)(X1B + tm_idx(row0 + ai * 128 + m * 16, c0 + bj * 128, DM / 64));
#pragma unroll
            for (int m = 0; m < 4; ++m)
#pragma unroll
                for (int bj = 0; bj < 2; ++bj) { float* p = out + O_YP + (size_t)(row0 + ai * 128 + m * 16) * DM + c0 + bj * 128; const u32x4 w = xv[m][bj];
                    const f32x4 x0 = {__uint_as_float(w.x << 16), __uint_as_float(w.x & 0xffff0000u), __uint_as_float(w.y << 16), __uint_as_float(w.y & 0xffff0000u)};
                    const f32x4 x1 = {__uint_as_float(w.z << 16), __uint_as_float(w.z & 0xffff0000u), __uint_as_float(w.w << 16), __uint_as_float(w.w & 0xffff0000u)};
                    *(f32x4*)p = x0 + acc[ai][bj][m][0]; *(f32x4*)(p + 4) = x1 + acc[ai][bj][m][1]; } }
    }
};
struct CmpOrder {
    int n, G, c, shift;
    __device__ __forceinline__ bool next(int i, Unit& u) const { const int L = i * G + c; if (L >= n) return false; u.pm = L; u.pn = (L >> shift) & 1; return true; }
    __device__ __forceinline__ void a_ready(const Unit&) const {}
    __device__ __forceinline__ void done(const Unit&) const {}
};
}

__device__ __forceinline__ float grp_sum8(float v) { v += __shfl_xor(v, 1); v += __shfl_xor(v, 2); v += __shfl_xor(v, 4); return v; }
__device__ __forceinline__ float grp_sum16(float v) { v = grp_sum8(v); v += __shfl_xor(v, 8); return v; }
__device__ __forceinline__ float grp_sum32(float v) { v = grp_sum16(v); v += __shfl_xor(v, 16); return v; }

__device__ __forceinline__ void p2_post(const Ctx& C, int idx, int nblk) {
    unsigned char* ws = C.ws; const int gw = idx * NWAVES + C.wave, NGW = nblk * NWAVES, lane = C.lane;
    const float* QRAW = (const float*)(ws + WS_QRAW); bf16* QN = (bf16*)(ws + WS_QN); const float* KVWR = (const float*)(ws + WS_KVWR);
    const float* gq = C.in[IN_GQ]; const float* gk = C.in[IN_GK];
    const int kv = lane >> 5, g = (lane >> 4) & 1, d = (lane & 15) * 8;
    for (int row = gw; row < MREAL; row += NGW) {
        const bool pr = row < MPROMPT; const int b = row >> 12, t = row & 4095, bs = row - MPROMPT;
        const GAS f32x4* q4 = (const GAS f32x4*)(QRAW + (size_t)row * DQ + lane * 16); f32x4 v[4];
#pragma unroll
        for (int j2 = 0; j2 < 4; ++j2) v[j2] = q4[j2];
        const float* wsrc = KVWR + (size_t)row * 512 + lane * 8; const f32x4 wa = *(const GAS f32x4*)wsrc, wc2 = *(const GAS f32x4*)(wsrc + 4);
        f32x4 sa = {0.f, 0.f, 0.f, 0.f}, sc2 = sa;
        if (pr) { const float* ssrc = C.out + O_PSEL + (size_t)row * 512 + lane * 8; sa = *(const GAS f32x4*)ssrc; sc2 = *(const GAS f32x4*)(ssrc + 4);
 }
        float vs = lane < 32 ? ((const float*)(ws + WS_VSS))[(size_t)row * 32 + lane] : 0.f;
        { float ss = 0.f;
#pragma unroll
          for (int j2 = 0; j2 < 4; ++j2) ss += (v[j2].x * v[j2].x + v[j2].y * v[j2].y) + (v[j2].z * v[j2].z + v[j2].w * v[j2].w);
          ss = grp_sum8(ss); const float rs = rsqrtf(ss * (1.0f / 128) + EPS) * QSCALE; const float* gg = gq + (lane & 7) * 16; float f[16];
#pragma unroll
          for (int j2 = 0; j2 < 4; ++j2) { f[4 * j2] = v[j2].x * rs * gg[4 * j2]; f[4 * j2 + 1] = v[j2].y * rs * gg[4 * j2 + 1]; f[4 * j2 + 2] = v[j2].z * rs * gg[4 * j2 + 2]; f[4 * j2 + 3] = v[j2].w * rs * gg[4 * j2 + 3]; }
          GAS v4u* o = (GAS v4u*)(QN + (size_t)row * DQ + lane * 16);
          o[0] = (v4u){pk2(f[0], f[1]), pk2(f[2], f[3]), pk2(f[4], f[5]), pk2(f[6], f[7])}; o[1] = (v4u){pk2(f[8], f[9]), pk2(f[10], f[11]), pk2(f[12], f[13]), pk2(f[14], f[15])}; }
        if (pr) { float ss = (sa.x * sa.x + sa.y * sa.y) + (sa.z * sa.z + sa.w * sa.w) + (sc2.x * sc2.x + sc2.y * sc2.y) + (sc2.z * sc2.z + sc2.w * sc2.w); ss = grp_sum16(ss);
            const float rs = kv == 0 ? rsqrtf(ss * (1.0f / 128) + EPS) : 1.f; const float* gg = gk + 128 + d; float f[8] = {sa.x, sa.y, sa.z, sa.w, sc2.x, sc2.y, sc2.z, sc2.w};
#pragma unroll
            for (int k = 0; k < 8; ++k) f[k] = kv == 0 ? f[k] * rs * gg[k] : f[k];
            bf16* dst = (bf16*)(ws + (kv == 0 ? WS_KS : WS_VS)) + ((size_t)(b * 2 + g) * T + t) * 128 + d; *(GAS v4u*)dst = pack8f(f); }
        if (pr) { float ss = (wa.x * wa.x + wa.y * wa.y) + (wa.z * wa.z + wa.w * wa.w) + (wc2.x * wc2.x + wc2.y * wc2.y) + (wc2.z * wc2.z + wc2.w * wc2.w); ss = grp_sum16(ss);
            const float rs = kv == 0 ? rsqrtf(ss * (1.0f / 128) + EPS) : 1.f; const float* gg = gk + 256 + d; float f[8] = {wa.x, wa.y, wa.z, wa.w, wc2.x, wc2.y, wc2.z, wc2.w};
#pragma unroll
            for (int k = 0; k < 8; ++k) f[k] = kv == 0 ? f[k] * rs * gg[k] : f[k];
            bf16* dst = (bf16*)(ws + (kv == 0 ? WS_KW : WS_VW)) + ((size_t)(b * 2 + g) * T + t) * 128 + d; *(GAS v4u*)dst = pack8f(f);
            if (t >= T - 512) { float* o = C.out + O_PWIN + ((size_t)b * 512 + (t - (T - 512))) * 512 + lane * 8; *(GAS f32x4*)o = wa; *(GAS f32x4*)(o + 4) = wc2; }
        } else { float* o = C.out + O_SWIN + ((size_t)bs * 512 + 511) * 512 + lane * 8; *(GAS f32x4*)o = wa; *(GAS f32x4*)(o + 4) = wc2; }
        { vs = wave_sum(vs); if (lane == 0) ((float*)(ws + WS_RSTDV))[row] = rsqrtf(vs * (1.0f / DG) + EPS); }
    }
}

__device__ __forceinline__ float shx(float v, int mask, int lane) { return __int_as_float(__builtin_amdgcn_ds_bpermute((lane ^ mask) << 2, __float_as_int(v))); }
template <bool WT = false>
__device__ __forceinline__ void cmp_combine_rows(const Ctx& C, bool pr, int row0, int nrows) {
    unsigned char* ws = C.ws; const int hw = C.wave * 2 + (C.lane >> 5), l32 = C.lane & 31, e = l32 * 4;
    const float* CBP = (const float*)(ws + WS_CBP); const float* gk0 = C.in[IN_GK];
    f32x4 cb0 = {0.f, 0.f, 0.f, 0.f}, cb1 = {0.f, 0.f, 0.f, 0.f};
#pragma unroll
    for (int kc = 0; kc < 16; ++kc) { cb0 += *(const GAS f32x4*)(CBP + kc * 128 + e); cb1 += *(const GAS f32x4*)(CBP + (16 + kc) * 128 + e); }
    const f32x4 g4 = *(const GAS f32x4*)(gk0 + e);
    const int segs = pr ? 256 : 128;
    for (int rr = row0 + hw; rr < row0 + nrows; rr += 16) {
        const int j = rr & (segs - 1), grp = rr / segs, g = grp & 1, kv = (grp >> 1) & 1, b = grp >> 2;
        const float* Y = (const float*)(ws + (pr ? WS_YCP : WS_YCS)) + (size_t)rr * 256;
        f32x4 v = {0.f, 0.f, 0.f, 0.f};
        if (j < segs - 1) { v = *(const GAS f32x4*)(Y + e) + *(const GAS f32x4*)(Y + 128 + e) + (kv ? cb1 : cb0); }
        float ss = (v.x * v.x + v.y * v.y) + (v.z * v.z + v.w * v.w);
#pragma unroll
        for (int o = 1; o < 32; o <<= 1) ss += shx(ss, o, C.lane);
        if (kv == 0) { const float rs = rsqrtf(ss * (1.0f / 128) + EPS); v = v * rs * g4; }
        bf16* dst = (bf16*)(ws + (pr ? (kv ? WS_VCP : WS_KCP) : (kv ? WS_VCS : WS_KCS))) + ((size_t)(b * 2 + g) * segs + j) * 128 + e;
        if (WT) __hip_atomic_store((gu64*)dst, ((unsigned long long)pk2(v.z, v.w) << 32) | pk2(v.x, v.y), RLX_AGENT); else *(GAS v2u*)dst = (v2u){pk2(v.x, v.y), pk2(v.z, v.w)};
    }
}

typedef short s16x4 __attribute__((ext_vector_type(4)));
typedef float f32x16 __attribute__((ext_vector_type(16)));
__device__ __forceinline__ int v_st(int k, int c) { const int kk = (k & ~0xC) | ((k & 4) << 1) | ((k & 8) >> 1); return ((kk >> 3) * 4 + (c >> 5)) * 512 + ((kk & 7) * 32 + (c & 31)) * 2; }
__device__ __forceinline__ int v_rd_base(int lane) { return ((lane & 3) << 3) | (((lane >> 2) & 3) << 6) | (((lane >> 4) & 1) << 5) | (((lane >> 5) & 1) << 8); }
constexpr int v_rd_off(int d0, int ks, int half) { return d0 * 512 + ks * 4096 + half * 2048; }
__device__ __forceinline__ int crow(int r, int hi) { return (r & 3) + 8 * (r >> 2) + 4 * hi; }
#define SBAR() __builtin_amdgcn_sched_barrier(0)
__device__ __forceinline__ void pv_tile(f32x16* o, int vb0, bf16x8 pa0, bf16x8 pa1, bf16x8 pa2, bf16x8 pa3) {
#define TRRD(dst, off) asm volatile("ds_read_b64_tr_b16 %0, %1 offset:%2" : "=&v"(dst) : "v"(vb0), "i"(off) : "memory")
#define PV_D0(d0) do { s16x4 l0, l1, l2, l3, h0, h1, h2, h3; constexpr int b_ = v_rd_off(d0, 0, 0); \
        TRRD(l0, b_); TRRD(h0, b_ + 2048); TRRD(l1, b_ + 4096); TRRD(h1, b_ + 6144); TRRD(l2, b_ + 8192); TRRD(h2, b_ + 10240); TRRD(l3, b_ + 12288); TRRD(h3, b_ + 14336); \
        asm volatile("s_waitcnt lgkmcnt(0)" ::: "memory"); SBAR(); \
        o[d0] = __builtin_amdgcn_mfma_f32_32x32x16_bf16(pa0, (bf16x8){l0[0], l0[1], l0[2], l0[3], h0[0], h0[1], h0[2], h0[3]}, o[d0], 0, 0, 0); \
        o[d0] = __builtin_amdgcn_mfma_f32_32x32x16_bf16(pa1, (bf16x8){l1[0], l1[1], l1[2], l1[3], h1[0], h1[1], h1[2], h1[3]}, o[d0], 0, 0, 0); \
        o[d0] = __builtin_amdgcn_mfma_f32_32x32x16_bf16(pa2, (bf16x8){l2[0], l2[1], l2[2], l2[3], h2[0], h2[1], h2[2], h2[3]}, o[d0], 0, 0, 0); \
        o[d0] = __builtin_amdgcn_mfma_f32_32x32x16_bf16(pa3, (bf16x8){l3[0], l3[1], l3[2], l3[3], h3[0], h3[1], h3[2], h3[3]}, o[d0], 0, 0, 0); } while (0)
    PV_D0(0); PV_D0(1); PV_D0(2); PV_D0(3);
#undef PV_D0
#undef TRRD
}

__device__ __forceinline__ float rstd_v(const float* VSS, int row) { const GAS f32x4* p = (const GAS f32x4*)(VSS + (size_t)row * 32); f32x4 s = p[0];
#pragma unroll
    for (int k = 1; k < 8; ++k) s += p[k];
    return rsqrtf(((s.x + s.y) + (s.z + s.w)) * (1.0f / DG) + EPS); }
__device__ __forceinline__ void p4_sgu(const Ctx& C, int idx, int nblk) {
    unsigned char* ws = C.ws; const int tid = C.tid, lane = C.lane, wave = C.wave, r32 = lane & 31, hi = lane >> 5;
    const bf16* U = (const bf16*)(ws + WS_U); const bf16* VG = (const bf16*)(ws + WS_VG); const float* VSS = (const float*)(ws + WS_VSS);
    const bf16* WMB = (const bf16*)(ws + WS_WMB); bf16* OA = (bf16*)(ws + WS_OA);
    const float* gs = C.in[IN_GSGU]; const float* bs = C.in[IN_BSGU];
    LAS unsigned char* Vl = C.lds + RING_OFF;
    for (int unit = idx; unit < 256; unit += nblk) {
        const int n = unit >> 2, gp = unit & 3, rowbase = n * 128; const bool last = (n & 31) == 31; const int bb = n >> 5;
        __syncthreads();
        { const int sr = tid >> 4, sc = (tid & 15) * 8;
#pragma unroll
          for (int gl = 0; gl < 2; ++gl) { const int g = gp * 2 + gl; float gg[8];
#pragma unroll
              for (int k = 0; k < 8; ++k) gg[k] = gs[g * 128 + sc + k];
#pragma unroll
              for (int q = 0; q < 4; ++q) { const int s = q * 32 + sr, st = s >> 6, row = rowbase + s; float f[8];
                  unpack8(*(const GAS v4u*)(VG + (size_t)row * DG + g * 128 + sc), f); const float rs = rstd_v(VSS, row);
#pragma unroll
                  for (int k = 0; k < 8; ++k) f[k] = f[k] * rs * gg[k];
                  *(LAS v4u*)(Vl + (gl * 2 + st) * 16384 + v_st(s & 63, sc)) = pack8f(f);
                  if (last) { float* o = C.out + O_PSGU + ((size_t)bb * 128 + s) * DG + g * 128 + sc; *(GAS f32x4*)o = (f32x4){f[0], f[1], f[2], f[3]}; *(GAS f32x4*)(o + 4) = (f32x4){f[4], f[5], f[6], f[7]}; } } } }
        __syncthreads();
        const int tb = wave & 3, gl = wave >> 2, g = gp * 2 + gl;
        f32x16 o[4];
#pragma unroll
        for (int d0 = 0; d0 < 4; ++d0)
#pragma unroll
            for (int r = 0; r < 16; ++r) o[d0][r] = 0.f;
#pragma unroll
        for (int st = 0; st < 2; ++st) if (64 * st <= 32 * tb + 31) {
            const bf16* wp = WMB + ((size_t)g * 128 + tb * 32 + r32) * 128 + st * 64 + hi * 8;
            const bf16x8 pa0 = *(const GAS bf16x8*)(wp), pa1 = *(const GAS bf16x8*)(wp + 16), pa2 = *(const GAS bf16x8*)(wp + 32), pa3 = *(const GAS bf16x8*)(wp + 48);
            const int vb0 = (int)(unsigned)(uintptr_t)(Vl + (gl * 2 + st) * 16384) + v_rd_base(lane);
            pv_tile(o, vb0, pa0, pa1, pa2, pa3);
        }
#pragma unroll
        for (int r = 0; r < 16; ++r) { const int trow = tb * 32 + crow(r, hi); const float bv = bs[g * 128 + trow]; const size_t ro = (size_t)(rowbase + trow) * DG + g * 128, roa = (size_t)(rowbase + trow) * LD1 + g * 128;
#pragma unroll
            for (int d0 = 0; d0 < 4; ++d0) { const int c = d0 * 32 + r32; const float v = (o[d0][r] + bv) * bf2f(U[ro + c]); const float vn = __shfl_xor(v, 1);
                if ((r32 & 1) == 0) *(GAS unsigned*)(OA + tm_idx(rowbase + trow, g * 128 + c, DG / 64)) = pk2(v, vn); } }
    }
    { const int gt = idx * 512 + tid, NT = nblk * 512; const float* w = C.in[IN_WSGU];
      for (int i = gt; i < MSAMP * DG / 8; i += NT) { const int r = i >> 7, c = (i & 127) * 8, row = MPROMPT + r, g = c >> 7; float f[8], uu[8];
          unpack8(*(const GAS v4u*)(VG + (size_t)row * DG + c), f); unpack8(*(const GAS v4u*)(U + (size_t)row * DG + c), uu); const float rs = rstd_v(VSS, row), w00 = w[g * 16384], b0 = bs[g * 128];
#pragma unroll
          for (int k = 0; k < 8; ++k) { f[k] = f[k] * rs * gs[c + k]; uu[k] = uu[k] * (w00 * f[k] + b0); }
          float* o = C.out + O_SSGU + (size_t)r * DG + c; *(GAS f32x4*)o = (f32x4){f[0], f[1], f[2], f[3]}; *(GAS f32x4*)(o + 4) = (f32x4){f[4], f[5], f[6], f[7]};
          *(GAS v4u*)((bf16*)(ws + WS_SOA) + (size_t)r * LDS_G + c) = pack8f(uu); } }
}

struct AttItem { const bf16* q; int t; int ncmp; const bf16* kc; const bf16* vc; int nblk; const float* gates; bf16* out; const float* blut; };

__device__ __forceinline__ void ld8f(const float* p, float (&f)[8]) { const f32x4 a = *(const GAS f32x4*)p, b = *(const GAS f32x4*)(p + 4); f[0] = a.x; f[1] = a.y; f[2] = a.z; f[3] = a.w; f[4] = b.x; f[5] = b.y; f[6] = b.z; f[7] = b.w; }
struct PromptKV {
    const bf16 *ks, *vs, *kw, *vw;
    static constexpr bool NORM = false;
    __device__ __forceinline__ void selK(int pos, int d8, float (&k)[8]) const { unpack8(*(const GAS v4u*)(ks + (size_t)pos * 128 + d8), k); }
    __device__ __forceinline__ void selV(int pos, int d8, float (&k)[8]) const { unpack8(*(const GAS v4u*)(vs + (size_t)pos * 128 + d8), k); }
    __device__ __forceinline__ void winK(int pos, int d8, float (&k)[8]) const { unpack8(*(const GAS v4u*)(kw + (size_t)pos * 128 + d8), k); }
    __device__ __forceinline__ void winV(int pos, int d8, float (&k)[8]) const { unpack8(*(const GAS v4u*)(vw + (size_t)pos * 128 + d8), k); }
};
struct SampleKV {
    const float* csel; const int* pt; const float* nsel; const float* win; const float* nwin;
    static constexpr bool NORM = true;
    __device__ __forceinline__ const float* selp(int pos) const { return pos < PASTLEN ? csel + ((size_t)pt[pos >> 7] * 128 + (pos & 127)) * 512 : nsel; }
    __device__ __forceinline__ const float* winp(int pos) const { return pos < PASTLEN ? win + (size_t)(pos - (PASTLEN - 512)) * 512 : nwin; }
    __device__ __forceinline__ void selK(int pos, int d8, float (&k)[8]) const { ld8f(selp(pos) + d8, k); }
    __device__ __forceinline__ void selV(int pos, int d8, float (&k)[8]) const { ld8f(selp(pos) + 256 + d8, k); }
    __device__ __forceinline__ void winK(int pos, int d8, float (&k)[8]) const { ld8f(winp(pos) + d8, k); }
    __device__ __forceinline__ void winV(int pos, int d8, float (&k)[8]) const { ld8f(winp(pos) + 256 + d8, k); }
};
#define DPP_ADD(x, ctrl) ((x) + __int_as_float(__builtin_amdgcn_update_dpp(0, __float_as_int(x), (ctrl), 0xF, 0xF, true)))
__device__ __forceinline__ float row_sum16(float x) { x = DPP_ADD(x, 0xB1); x = DPP_ADD(x, 0x4E); x = DPP_ADD(x, 0x141); x = DPP_ADD(x, 0x140); return x; }
template <bool NORM>
__device__ __forceinline__ void score4(const float (&k)[8], const float (&gkv)[8], const float (&q)[4][8], float (&s)[4]) {
    float kk[8]; float ss = 0.f;
#pragma unroll
    for (int i = 0; i < 8; ++i) { if (NORM) { ss += k[i] * k[i]; kk[i] = k[i] * gkv[i]; } else kk[i] = k[i]; }
#pragma unroll
    for (int h = 0; h < 4; ++h) { float a = 0.f;
#pragma unroll
        for (int i = 0; i < 8; ++i) a += q[h][i] * kk[i];
        s[h] = row_sum16(a); }
    if (NORM) { ss = row_sum16(ss); const float rs = rsqrtf(ss * (1.0f / 128) + EPS);
#pragma unroll
        for (int h = 0; h < 4; ++h) s[h] *= rs; }
}
__device__ __forceinline__ void online4(const float (&s)[4], bool valid, float (&m)[4], float (&l)[4], float (&o)[4][8], const float (&v)[8]) {
#pragma unroll
    for (int h = 0; h < 4; ++h) { const float sv = valid ? s[h] : -__builtin_inff(); const float mn = fmaxf(m[h], sv);
        const float al = __builtin_amdgcn_exp2f(m[h] - mn), p = __builtin_amdgcn_exp2f(sv - mn); m[h] = mn; l[h] = l[h] * al + p;
#pragma unroll
        for (int i = 0; i < 8; ++i) o[h][i] = o[h][i] * al + p * v[i]; }
}
__device__ __forceinline__ void merge_store(float (&m)[4], float (&l)[4], float (&o)[4][8], LAS float* Cmb, int wave, int lane) {
#pragma unroll
    for (int h = 0; h < 4; ++h) { float M = fmaxf(m[h], __shfl_xor(m[h], 16)); M = fmaxf(M, __shfl_xor(M, 32));
        const float sc = __builtin_amdgcn_exp2f(m[h] - M); float ll = l[h] * sc; ll += __shfl_xor(ll, 16); ll += __shfl_xor(ll, 32);
        LAS float* dst = Cmb + (wave * 4 + h) * 132;
#pragma unroll
        for (int i = 0; i < 8; ++i) { float x = o[h][i] * sc; x += __shfl_xor(x, 16); x += __shfl_xor(x, 32); if (lane < 16) dst[lane * 8 + i] = x; }
        if (lane == 0) { dst[128] = M; dst[129] = ll; } }
}
__device__ __forceinline__ float combine8(const LAS float* Cmb, int hh, int dd) {
    float M = -1e30f;
#pragma unroll
    for (int w = 0; w < 8; ++w) M = fmaxf(M, Cmb[(w * 4 + hh) * 132 + 128]);
    float L = 0.f, O = 0.f;
#pragma unroll
    for (int w = 0; w < 8; ++w) { const LAS float* p = Cmb + (w * 4 + hh) * 132; const float sc = __builtin_amdgcn_exp2f(p[128] - M); L += p[129] * sc; O += p[dd] * sc; }
    return L > 0.f ? O / L : 0.f;
}

template <class KV, bool WIN>
__device__ __forceinline__ void nsa_stream(const KV& kv, int total, int wave, int grp, int d8, int t, int wlo, const LAS int* sl, const float (&gkv)[8], const float (&q)[4][8],
                                           const float* blut, float (&m)[4], float (&l)[4], float (&o)[4][8]) {
    const int nper = total > wave ? (total - wave + 7) >> 3 : 0;
    float kA[2][8], vA[2][8], kB[2][8], vB[2][8]; int ppA[2], ppB[2]; bool okA[2], okB[2];
#define NS_LOAD(K_, V_, PP_, OK_, i0_) do { _Pragma("unroll") for (int u = 0; u < 2; ++u) { const int ch = wave + 8 * ((i0_) + u); const bool in = (i0_) + u < nper; \
            int pos; if (WIN) pos = wlo + ch * 4 + grp; else pos = sl[in ? (ch >> 4) : 0] * 64 + (ch & 15) * 4 + grp; \
            OK_[u] = in && pos <= t; PP_[u] = OK_[u] ? pos : t; \
            if (WIN) { kv.winK(PP_[u], d8, K_[u]); kv.winV(PP_[u], d8, V_[u]); } else { kv.selK(PP_[u], d8, K_[u]); kv.selV(PP_[u], d8, V_[u]); } } } while (0)
#define NS_COMP(K_, V_, PP_, OK_, i0_) do { _Pragma("unroll") for (int u = 0; u < 2; ++u) if ((i0_) + u < nper) { float sc[4]; score4<KV::NORM>(K_[u], gkv, q, sc); \
            const int rel = t - PP_[u]; const int ri = rel > 128 ? 128 : rel; \
            _Pragma("unroll") for (int h = 0; h < 4; ++h) sc[h] += blut[h * 132 + ri]; \
            online4(sc, OK_[u], m, l, o, V_[u]); } } while (0)
    if (nper > 0) NS_LOAD(kA, vA, ppA, okA, 0);
    for (int i0 = 0; i0 < nper; i0 += 4) {
        if (i0 + 2 < nper) NS_LOAD(kB, vB, ppB, okB, i0 + 2);
        NS_COMP(kA, vA, ppA, okA, i0);
        if (i0 + 4 < nper) NS_LOAD(kA, vA, ppA, okA, i0 + 4);
        if (i0 + 2 < nper) NS_COMP(kB, vB, ppB, okB, i0 + 2);
    }
#undef NS_LOAD
#undef NS_COMP
}

template <class KV>
__device__ __forceinline__ void nsa_item(const Ctx& C, const AttItem& it, const KV& kv, const float* gk1, const float* gk2) {
    const int tid = C.tid, lane = C.lane, wave = C.wave, grp = lane >> 4, d8 = (lane & 15) * 8, t = it.t;
    LAS float* Sc = (LAS float*)(C.lds + RING_OFF);
    LAS float* Cmb = (LAS float*)(C.lds + RING_OFF + 4096);
    LAS int* sl = (LAS int*)(C.lds + RING_OFF + 4096 + 16896);
    const float NEG = -__builtin_inff();
    float q[4][8];
#pragma unroll
    for (int h = 0; h < 4; ++h) unpack8(*(const GAS v4u*)(it.q + h * 128 + d8), q[h]);
    const int hh = tid >> 7, dd = tid & 127;
    const float g0 = it.gates[hh * 3 + 0], g1 = it.gates[hh * 3 + 1], g2 = it.gates[hh * 3 + 2];
    float res = 0.f;
    float m[4], l[4], o[4][8], gkv[8];
#pragma unroll
    for (int i = 0; i < 8; ++i) gkv[i] = 1.f;

    int nvis = t >= 31 ? (t - 31) / 16 + 1 : 0; if (nvis > it.ncmp) nvis = it.ncmp;
    const int nch = (nvis + 3) >> 2;
    for (int ch = wave; ch < 64; ch += 8) {
        const int c = ch * 4 + grp; float s[4] = {NEG, NEG, NEG, NEG};
        if (ch < nch) {
            const bool valid = c < nvis; const int cc = valid ? c : 0; float k[8]; unpack8(*(const GAS v4u*)(it.kc + (size_t)cc * 128 + d8), k);
            float sc[4]; score4<false>(k, gkv, q, sc);
            const int rel = t - (16 * c + 31); const int ri = rel < 0 ? 0 : (rel > 128 ? 128 : rel);
#pragma unroll
            for (int h = 0; h < 4; ++h) s[h] = valid ? sc[h] + it.blut[h * 132 + ri] : NEG;
        }
        if ((lane & 15) == 0) {
#pragma unroll
            for (int h = 0; h < 4; ++h) Sc[h * 256 + c] = s[h]; }
    }
    __syncthreads();
    float mh[4], il[4];
#pragma unroll
    for (int h = 0; h < 4; ++h) { const f32x4 v = *(const LAS f32x4*)(Sc + h * 256 + lane * 4); float mx = fmaxf(fmaxf(v.x, v.y), fmaxf(v.z, v.w)); mx = fmaxf(wave_max(mx), -1e30f);
        float e = (__builtin_amdgcn_exp2f(v.x - mx) + __builtin_amdgcn_exp2f(v.y - mx)) + (__builtin_amdgcn_exp2f(v.z - mx) + __builtin_amdgcn_exp2f(v.w - mx)); e = wave_sum(e);
        mh[h] = mx; il[h] = e > 0.f ? 1.0f / e : 0.f; }
    float imp = 0.f;
#pragma unroll
    for (int h = 0; h < 4; ++h) { float a = 0.f;
#pragma unroll
        for (int k = 0; k < 5; ++k) { const int c = 4 * lane - 1 + k; if (c >= 0) a += __builtin_amdgcn_exp2f(Sc[h * 256 + c] - mh[h]); }
        imp += a * il[h]; }
    unsigned long long mask;
    { const int j = lane, cur = t >> 6; const bool forced = (j == 0) || (j == cur) || (j == cur - 1), elig = 64 * j <= t, exists = j < it.nblk;
      const float val = exists ? (forced ? 1e6f : (elig ? imp : -1.f)) : -2.f; int rank = 0;
      const int key = (int)((__float_as_uint(val) & ~63u) | (unsigned)(63 - j));
#pragma unroll
      for (int jp = 0; jp < 64; ++jp) rank += (__builtin_amdgcn_readlane(key, jp) > key) ? 1 : 0;
      const bool sel_ = rank < 16 && elig && exists; mask = __ballot(sel_);
      if (wave == 0 && sel_) sl[__builtin_popcountll(mask & ((1ull << j) - 1ull))] = j; }
#pragma unroll
    for (int h = 0; h < 4; ++h) { m[h] = mh[h]; l[h] = 0.f;
#pragma unroll
        for (int i = 0; i < 8; ++i) o[h][i] = 0.f; }
    for (int ch = wave; ch < nch; ch += 8) {
        const int c = ch * 4 + grp; const bool valid = c < nvis; const int cc = valid ? c : 0; float v[8]; unpack8(*(const GAS v4u*)(it.vc + (size_t)cc * 128 + d8), v);
#pragma unroll
        for (int h = 0; h < 4; ++h) { const float p = valid ? __builtin_amdgcn_exp2f(Sc[h * 256 + cc] - mh[h]) : 0.f; l[h] += p;
#pragma unroll
            for (int i = 0; i < 8; ++i) o[h][i] += p * v[i]; }
    }
    merge_store(m, l, o, Cmb, wave, lane);
    __syncthreads();
    res += g0 * combine8(Cmb, hh, dd);
    __syncthreads();

#pragma unroll
    for (int h = 0; h < 4; ++h) { m[h] = -1e30f; l[h] = 0.f;
#pragma unroll
        for (int i = 0; i < 8; ++i) o[h][i] = 0.f; }
    if (KV::NORM) {
#pragma unroll
        for (int i = 0; i < 8; ++i) gkv[i] = gk1[d8 + i]; }
    nsa_stream<KV, false>(kv, __builtin_popcountll(mask) * 16, wave, grp, d8, t, 0, sl, gkv, q, it.blut, m, l, o);
    merge_store(m, l, o, Cmb, wave, lane);
    __syncthreads();
    res += g1 * combine8(Cmb, hh, dd);
    __syncthreads();

#pragma unroll
    for (int h = 0; h < 4; ++h) { m[h] = -1e30f; l[h] = 0.f;
#pragma unroll
        for (int i = 0; i < 8; ++i) o[h][i] = 0.f; }
    if (KV::NORM) {
#pragma unroll
        for (int i = 0; i < 8; ++i) gkv[i] = gk2[d8 + i]; }
    const int wlo = t - 511 < 0 ? 0 : t - 511, nchw = (t - wlo + 4) >> 2;
    nsa_stream<KV, true>(kv, nchw, wave, grp, d8, t, wlo, sl, gkv, q, it.blut, m, l, o);
    merge_store(m, l, o, Cmb, wave, lane);
    __syncthreads();
    res += g2 * combine8(Cmb, hh, dd);
    it.out[hh * 128 + dd] = (bf16)f2bf(res);
    __syncthreads();
}


#define KSWZ(row, colB) ((row) * 256 + ((colB) ^ (((row) & 7) << 4)))
constexpr int AT_V = 0, AT_K = 32768, AT_PC = 65536, AT_X = 131584, AT_BLUT = AT_X, AT_SELM = AT_X + 2176, AT_WS = AT_SELM + 512;
static_assert(AT_WS + 8 * 256 + 64 <= LDS_BYTES && AT_X >= MISC_OFF + 128 && AT_PC + 64 * 256 * 4 <= LDSCTL_OFF, "attention LDS map");

__device__ __forceinline__ unsigned cvtpk(float lo, float hi) { unsigned r; asm volatile("v_cvt_pk_bf16_f32 %0, %1, %2" : "=v"(r) : "v"(lo), "v"(hi)); return r; }
__device__ __forceinline__ float swap_max(float x) { auto rr = __builtin_amdgcn_permlane32_swap(__float_as_uint(x), __float_as_uint(x), false, false); return fmaxf(__uint_as_float(rr[0]), __uint_as_float(rr[1])); }
__device__ __forceinline__ float swap_add(float x) { auto rr = __builtin_amdgcn_permlane32_swap(__float_as_uint(x), __float_as_uint(x), false, false); return __uint_as_float(rr[0]) + __uint_as_float(rr[1]); }
__device__ __forceinline__ float quad_sum(float x) {
    x += __int_as_float(__builtin_amdgcn_update_dpp(0, __float_as_int(x), 0xB1, 0xF, 0xF, true));
    x += __int_as_float(__builtin_amdgcn_update_dpp(0, __float_as_int(x), 0x4E, 0xF, 0xF, true));
    return x;
}
__device__ __forceinline__ void qkt_tile(f32x16& p0, f32x16& p1, const LAS unsigned char* Kt, int r32, int hi, const bf16x8 (&qr)[8]) {
#pragma unroll
    for (int r = 0; r < 16; ++r) { p0[r] = 0.f; p1[r] = 0.f; }
    const LAS unsigned char* kb[4];
#pragma unroll
    for (int dd = 0; dd < 4; ++dd) kb[dd] = Kt + KSWZ(r32, (dd * 16 + hi * 8) * 2);
#pragma unroll
    for (int d0 = 0; d0 < 8; ++d0) { const LAS unsigned char* a = kb[d0 & 3] + (d0 >> 2) * 128;
        const bf16x8 b0 = *(const LAS bf16x8*)a, b1 = *(const LAS bf16x8*)(a + 32 * 256);
        p0 = __builtin_amdgcn_mfma_f32_32x32x16_bf16(b0, qr[d0], p0, 0, 0, 0);
        p1 = __builtin_amdgcn_mfma_f32_32x32x16_bf16(b1, qr[d0], p1, 0, 0, 0); }
}
template <int MODE>
__device__ __forceinline__ void fix_tile(f32x16& p0, f32x16& p1, int tile, int tq, int tmin, int head, int hi, bool bit, const LAS float* lut) {
    const float NEG = -__builtin_inff(); const float c31 = lut[head * 132 + 128];
    bool fast;
    if (MODE == 0) fast = tmin - 16 * (64 * tile + 63) - 31 >= 128;
    else if (MODE == 2) fast = tmin - (64 * tile + 63) >= 128;
    else fast = (tmin - (64 * tile + 63) >= 128) && (tmin + 7 - 64 * tile < 512);
    if (fast) {
        if (MODE == 2) {
#pragma unroll
            for (int r = 0; r < 16; ++r) { p0[r] = bit ? p0[r] + c31 : NEG; p1[r] = bit ? p1[r] + c31 : NEG; }
        } else {
#pragma unroll
            for (int r = 0; r < 16; ++r) { p0[r] += c31; p1[r] += c31; }
        }
        return;
    }
    const LAS float* lh = lut + head * 132;
#pragma unroll
    for (int hf = 0; hf < 2; ++hf)
#pragma unroll
        for (int r = 0; r < 16; ++r) { const int cr = (r & 3) + 8 * (r >> 2); int rel;
            if (MODE == 0) rel = tq - 31 - 16 * (64 * tile + 32 * hf + 4 * hi + cr); else rel = tq - (64 * tile + 32 * hf + 4 * hi + cr);
            bool valid;
            if (MODE == 0) valid = rel >= 0; else if (MODE == 2) valid = rel >= 0 && bit; else valid = (unsigned)rel < 512u;
            const int ri = rel < 0 ? 0 : (rel > 128 ? 128 : rel); const float bv = lh[ri];
            if (hf == 0) p0[r] = valid ? p0[r] + bv : NEG; else p1[r] = valid ? p1[r] + bv : NEG; }
}
__device__ __forceinline__ void softmax_tile(f32x16& p0, f32x16& p1, float& m_reg, float& l_reg, float& alpha, bf16x8& pa0, bf16x8& pa1, bf16x8& pa2, bf16x8& pa3) {
    float pmax = p0[0];
#pragma unroll
    for (int r = 1; r < 16; ++r) pmax = fmaxf(pmax, p0[r]);
#pragma unroll
    for (int r = 0; r < 16; ++r) pmax = fmaxf(pmax, p1[r]);
    pmax = swap_max(pmax);
    const float mn = fmaxf(m_reg, pmax); alpha = __builtin_amdgcn_exp2f(m_reg - mn); m_reg = mn;
    float ps = 0.f;
#pragma unroll
    for (int r = 0; r < 16; ++r) { p0[r] = __builtin_amdgcn_exp2f(p0[r] - mn); p1[r] = __builtin_amdgcn_exp2f(p1[r] - mn); ps += p0[r] + p1[r]; }
    ps = swap_add(ps); l_reg = l_reg * alpha + ps;
#define PK4(P, B_, OUT) do { unsigned a0 = cvtpk(P[B_+0], P[B_+1]), a1 = cvtpk(P[B_+2], P[B_+3]); unsigned b0 = cvtpk(P[B_+4], P[B_+5]), b1 = cvtpk(P[B_+6], P[B_+7]); \
        auto r0 = __builtin_amdgcn_permlane32_swap(a0, b0, false, false); auto r1 = __builtin_amdgcn_permlane32_swap(a1, b1, false, false); \
        v4u w = {r0[0], r1[0], r0[1], r1[1]}; OUT = __builtin_bit_cast(bf16x8, w); } while (0)
    PK4(p0, 0, pa0); PK4(p0, 8, pa1); PK4(p1, 0, pa2); PK4(p1, 8, pa3);
#undef PK4
}

struct FlashSt {
    bf16x8 qr[8];
    int tq, tmin, head;
};
template <int MODE, bool PASS2, int ACC>
__device__ __forceinline__ void flash_branch(const Ctx& C, FlashSt& S, const bf16* Kb, const bf16* Vb, int j_lo, int j_hi, float gate, unsigned long long mymask, unsigned long long wor,
                                             float& m_reg, float& l_reg, float* OT, bf16* OBrow) {
    const int tid = C.tid, lane = C.lane, wave = C.wave, r32 = lane & 31, hi = lane >> 5;
    LAS unsigned char* Vl = C.lds + AT_V; LAS unsigned char* Kl = C.lds + AT_K; LAS float* Pc = (LAS float*)(C.lds + AT_PC);
    const LAS float* lut = (const LAS float*)(C.lds + AT_BLUT); LAS float* wsl = (LAS float*)(C.lds + AT_WS) + wave * 64;
    const int vb0 = (int)(unsigned)(uintptr_t)Vl + v_rd_base(lane);
    f32x16 o[4];
    if (!PASS2) {
#pragma unroll
        for (int d0 = 0; d0 < 4; ++d0)
#pragma unroll
            for (int r = 0; r < 16; ++r) o[d0][r] = 0.f;
        m_reg = -1e30f; l_reg = 0.f; }
    const float inv_l = PASS2 ? (l_reg > 0.f ? 1.0f / l_reg : 0.f) : 0.f;
    const int n = j_hi - j_lo;
    const int lrow = wave * 4 + (lane >> 4);
    const unsigned ksrc = (unsigned)(lrow * 256 + ((((lane & 15) << 4)) ^ ((lrow & 7) << 4)));
    const int vkk = (((wave * 2 + (lane >> 5)) >> 2) << 3) + ((lane & 31) >> 2);
    const int vk = (vkk & ~0xC) | ((vkk & 4) << 1) | ((vkk & 8) >> 1);
    const unsigned vsrc = (unsigned)(vk * 256 + ((((wave * 2 + (lane >> 5)) & 3) * 32 + (lane & 3) * 8) * 2));
#define ST_DMA(tile, bf) do { const char* kp = (const char*)(Kb + (size_t)(tile) * 64 * 128) + ksrc; \
        __builtin_amdgcn_global_load_lds((const unsigned*)kp, (LAS unsigned*)(Kl + (bf) * 16384 + wave * 1024), 16, 0, 0); \
        __builtin_amdgcn_global_load_lds((const unsigned*)(kp + 8192), (LAS unsigned*)(Kl + (bf) * 16384 + 8192 + wave * 1024), 16, 0, 0); \
        if (!PASS2) { const char* vp = (const char*)(Vb + (size_t)(tile) * 64 * 128) + vsrc; \
            __builtin_amdgcn_global_load_lds((const unsigned*)vp, (LAS unsigned*)(Vl + (bf) * 16384 + wave * 1024), 16, 0, 0); \
            __builtin_amdgcn_global_load_lds((const unsigned*)(vp + 8192), (LAS unsigned*)(Vl + (bf) * 16384 + 8192 + wave * 1024), 16, 0, 0); } } while (0)
    if (n > 0) ST_DMA(j_lo, 0);
    asm volatile("s_waitcnt vmcnt(0)" ::: "memory");
    __syncthreads();
    for (int i = 0; i < n; ++i) {
        const int tile = j_lo + i, buf = i & 1;
        if (i + 1 < n) ST_DMA(tile + 1, buf ^ 1);
        bool act;
        if (PASS2) act = true; else if (MODE == 0) act = 16 * (64 * tile) + 31 <= S.tmin + 7; else if (MODE == 2) act = (wor >> tile) & 1ull; else act = true;
        if (act) {
            f32x16 p0, p1; qkt_tile(p0, p1, Kl + buf * 16384, r32, hi, S.qr);
            const bool bit = MODE == 2 ? ((mymask >> tile) & 1ull) != 0ull : true;
            fix_tile<MODE>(p0, p1, tile, S.tq, S.tmin, S.head, hi, bit, lut);
            if (PASS2) {
#pragma unroll
                for (int r = 0; r < 16; ++r) { p0[r] = quad_sum(__builtin_amdgcn_exp2f(p0[r] - m_reg) * inv_l); p1[r] = quad_sum(__builtin_amdgcn_exp2f(p1[r] - m_reg) * inv_l); }
                if ((r32 & 3) == 0) { LAS float* pr = Pc + (wave * 8 + (r32 >> 2)) * 256 + tile * 64 + 4 * hi;
#pragma unroll
                    for (int r = 0; r < 16; ++r) { const int cr = (r & 3) + 8 * (r >> 2); pr[cr] = p0[r]; pr[32 + cr] = p1[r]; } }
            } else {
                float alpha; bf16x8 pa0, pa1, pa2, pa3;
                softmax_tile(p0, p1, m_reg, l_reg, alpha, pa0, pa1, pa2, pa3);
                if (__any(alpha < 1.f)) { if (hi == 0) wsl[r32] = alpha; asm volatile("s_waitcnt lgkmcnt(0)" ::: "memory"); const LAS float* wh = wsl + 4 * hi;
#pragma unroll
                    for (int r = 0; r < 16; ++r) { const float a = wh[(r & 3) + 8 * (r >> 2)];
#pragma unroll
                        for (int d0 = 0; d0 < 4; ++d0) o[d0][r] *= a; }
                    asm volatile("s_waitcnt lgkmcnt(0)" ::: "memory"); }
                pv_tile(o, vb0 + buf * 16384, pa0, pa1, pa2, pa3);
            }
        }
        asm volatile("s_waitcnt vmcnt(0)" ::: "memory");
        __syncthreads();
    }
#undef ST_DMA
    if (!PASS2) {
        const float scl = l_reg > 0.f ? gate / l_reg : 0.f;
        if (hi == 0) wsl[32 + r32] = scl; asm volatile("s_waitcnt lgkmcnt(0)" ::: "memory");
        const LAS float* wh = wsl + 32 + 4 * hi; GAS float* otl = (GAS float*)OT + (size_t)(4 * hi) * 128 + r32; GAS bf16* obl = (GAS bf16*)OBrow + (size_t)hi * 64 + r32;
        asm volatile("" : "+v"(otl), "+v"(obl));
#pragma unroll
        for (int r = 0; r < 16; ++r) { const int cr = (r & 3) + 8 * (r >> 2); const float a = wh[cr];
#pragma unroll
            for (int d0 = 0; d0 < 4; ++d0) { float v = o[d0][r] * a; if (ACC > 0) v += otl[cr * 128 + d0 * 32];
                if (ACC < 2) otl[cr * 128 + d0 * 32] = v;
                else { const float vn = __shfl_xor(v, 1); if ((r32 & 1) == 0) *(GAS unsigned*)(obl + ((r & 3) * 2 + (d0 >> 1)) * 16384 + (2 * (r >> 2)) * 64 + (d0 & 1) * 32) = cvtpk(v, vn); } } }
        asm volatile("s_waitcnt lgkmcnt(0)" ::: "memory");
    }
}

__device__ __forceinline__ void flash_unit(const Ctx& C, int b, int g, int qb) {
    unsigned char* ws = C.ws; const int tid = C.tid, lane = C.lane, wave = C.wave, r32 = lane & 31, hi = lane >> 5, t0 = qb * 64;
    LAS float* lut = (LAS float*)(C.lds + AT_BLUT); LAS float* Pc = (LAS float*)(C.lds + AT_PC); LAS unsigned long long* selm = (LAS unsigned long long*)(C.lds + AT_SELM);
    const float* BL = (const float*)(ws + WS_BLUT) + g * 4 * 132;
    for (int i = tid; i < 4 * 132; i += NWAVES * 64) lut[i] = BL[i];
    FlashSt S; S.tmin = t0 + wave * 8; S.tq = S.tmin + (r32 >> 2); S.head = r32 & 3;
    const int row = b * T + S.tq;
    { const bf16* qp = (const bf16*)(ws + WS_QN) + (size_t)row * DQ + (g * 4 + S.head) * 128 + hi * 8;
#pragma unroll
      for (int d0 = 0; d0 < 8; ++d0) S.qr[d0] = *(const GAS bf16x8*)(qp + d0 * 16); }
    const float* gn = (const float*)(ws + WS_GN) + (size_t)row * 32 + (g * 4 + S.head) * 3; const float gc = gn[0], gsel = gn[1], gw = gn[2];
    const size_t kvb = (size_t)(b * 2 + g) * T * 128, cb = (size_t)(b * 2 + g) * 256 * 128;
    const int cmax = (t0 + 63 - 31) >> 4;
    const int nct = (cmax >> 6) + 1;
    float m_c, l_c;
    float* OT = (float*)(ws + WS_OT) + ((size_t)blockIdx.x * 8 + wave) * 32 * 128;
    bf16* OBrow = (bf16*)(ws + WS_OB) + tm_idx(b * T + S.tmin, g * 512, DQ / 64);
    flash_branch<0, false, 0>(C, S, (const bf16*)(ws + WS_KCP) + cb, (const bf16*)(ws + WS_VCP) + cb, 0, nct, gc, 0ull, 0ull, m_c, l_c, OT, OBrow);
    flash_branch<0, true, 0>(C, S, (const bf16*)(ws + WS_KCP) + cb, nullptr, 0, nct, 0.f, 0ull, 0ull, m_c, l_c, OT, OBrow);
    unsigned long long wor = 0ull;
    { asm volatile("s_waitcnt lgkmcnt(0)" ::: "memory");
      const int ncomp = nct * 64;
#pragma unroll 1
      for (int qi = 0; qi < 8; ++qi) { const int ql = wave * 8 + qi, t = t0 + ql; const LAS float* pr = Pc + ql * 256; float imp = 0.f;
#pragma unroll
          for (int k = 0; k < 5; ++k) { const int c = 4 * lane - 1 + k; if (c >= 0 && c < ncomp) imp += pr[c]; }
          const int j = lane, cur = t >> 6; const bool forced = (j == 0) || (j == cur) || (j == cur - 1), elig = 64 * j <= t;
          const float val = forced ? 1e6f : (elig ? imp : -1.f); int rank = 0;
          const int key = (int)((__float_as_uint(val) & ~63u) | (unsigned)(63 - j));
#pragma unroll
          for (int jp = 0; jp < 64; ++jp) rank += (__builtin_amdgcn_readlane(key, jp) > key) ? 1 : 0;
          const unsigned long long mk = __ballot(rank < 16 && elig); wor |= mk;
          if (lane == 0) selm[ql] = mk; }
      asm volatile("s_waitcnt lgkmcnt(0)" ::: "memory"); }
    const unsigned long long mymask = selm[wave * 8 + (r32 >> 2)];
    float m_s, l_s;
    flash_branch<2, false, 1>(C, S, (const bf16*)(ws + WS_KS) + kvb, (const bf16*)(ws + WS_VS) + kvb, 0, qb + 1, gsel, mymask, wor, m_s, l_s, OT, OBrow);
    flash_branch<3, false, 2>(C, S, (const bf16*)(ws + WS_KW) + kvb, (const bf16*)(ws + WS_VW) + kvb, qb >= 8 ? qb - 8 : 0, qb + 1, gw, 0ull, 0ull, m_s, l_s, OT, OBrow);
    __syncthreads();
}


template <bool SPLIT = false>
__device__ __forceinline__ void skinny_core(const Ctx& C, const bf16* A, int lda, const bf16* Bs, int kbeg, int Kw, float (&out)[8], float* out2 = nullptr) {
    const int lane = C.lane, wave = C.wave, r32 = lane & 31, hi = lane >> 5, tid = C.tid;
    f32x16 acc[4];
#pragma unroll
    for (int rb = 0; rb < 4; ++rb)
#pragma unroll
        for (int r = 0; r < 16; ++r) acc[rb][r] = 0.f;
    const GAS bf16* ap0 = (const GAS bf16*)A + (size_t)r32 * lda + kbeg + hi * 32;
    const GAS bf16* bp = (const GAS bf16*)Bs + (size_t)r32 * 64 + (size_t)(kbeg >> 6) * 16384 + hi * 32;
    const GAS bf16* ap1 = ap0 + (size_t)32 * lda; const GAS bf16* ap2 = ap0 + (size_t)64 * lda; const GAS bf16* ap3 = ap0 + (size_t)96 * lda;
    asm volatile("" : "+v"(ap0), "+v"(ap1), "+v"(ap2), "+v"(ap3), "+v"(bp));
    bf16x8 a0[4][2], b0[2], a1[4][2], b1[2];
#define SK_OFF(st) ((((st) >> 1) << 6) + (((st) & 1) << 4))
#define SK_LOAD(a, b, st) do { const int k_ = SK_OFF(st), kb_ = (((st) >> 1) << 14) + (((st) & 1) << 4); _Pragma("unroll") for (int j = 0; j < 2; ++j) b[j] = *(const GAS bf16x8*)(bp + kb_ + 8 * j); \
        _Pragma("unroll") for (int j = 0; j < 2; ++j) { a[0][j] = *(const GAS bf16x8*)(ap0 + k_ + 8 * j); a[1][j] = *(const GAS bf16x8*)(ap1 + k_ + 8 * j); a[2][j] = *(const GAS bf16x8*)(ap2 + k_ + 8 * j); a[3][j] = *(const GAS bf16x8*)(ap3 + k_ + 8 * j); } } while (0)
#define SK_MMA(a, b) do { _Pragma("unroll") for (int j = 0; j < 2; ++j) _Pragma("unroll") for (int rb = 0; rb < 4; ++rb) acc[rb] = __builtin_amdgcn_mfma_f32_32x32x16_bf16(a[rb][j], b[j], acc[rb], 0, 0, 0); } while (0)
    const int ns = Kw >> 5;
    SK_LOAD(a0, b0, 0);
    for (int st = 0; st < ns; st += 2) {
        if (st + 1 < ns) SK_LOAD(a1, b1, st + 1);
        SK_MMA(a0, b0);
        if (st + 2 < ns) SK_LOAD(a0, b0, st + 2);
        if (st + 1 < ns) SK_MMA(a1, b1);
    }
#undef SK_OFF
#undef SK_LOAD
#undef SK_MMA
    LAS float* Red = (LAS float*)(C.lds + RING_OFF);
    LAS float* wr_ = Red + (wave * 128 + 4 * hi) * 32 + r32;
#pragma unroll
    for (int rb = 0; rb < 4; ++rb)
#pragma unroll
        for (int r = 0; r < 16; ++r) wr_[(32 * rb + (r & 3) + 8 * (r >> 2)) * 32] = acc[rb][r];
    __syncthreads();
    const LAS float* rd = Red + (tid >> 2) * 32 + (tid & 3) * 8;
    f32x4 s0 = *(const LAS f32x4*)rd, s1 = *(const LAS f32x4*)(rd + 4);
#pragma unroll
    for (int w = 1; w < (SPLIT ? 4 : 8); ++w) { s0 += *(const LAS f32x4*)(rd + w * 4096); s1 += *(const LAS f32x4*)(rd + w * 4096 + 4); }
    out[0] = s0.x; out[1] = s0.y; out[2] = s0.z; out[3] = s0.w; out[4] = s1.x; out[5] = s1.y; out[6] = s1.z; out[7] = s1.w;
    if (SPLIT) { f32x4 t0 = *(const LAS f32x4*)(rd + 4 * 4096), t1 = *(const LAS f32x4*)(rd + 4 * 4096 + 4);
#pragma unroll
        for (int w = 5; w < 8; ++w) { t0 += *(const LAS f32x4*)(rd + w * 4096); t1 += *(const LAS f32x4*)(rd + w * 4096 + 4); }
        out2[0] = t0.x; out2[1] = t0.y; out2[2] = t0.z; out2[3] = t0.w; out2[4] = t1.x; out2[5] = t1.y; out2[6] = t1.z; out2[7] = t1.w; }
    __syncthreads();
}
__device__ __forceinline__ void st8f(float* p, const float (&v)[8]) { *(GAS f32x4*)p = (f32x4){v[0], v[1], v[2], v[3]}; *(GAS f32x4*)(p + 4) = (f32x4){v[4], v[5], v[6], v[7]}; }

__device__ __forceinline__ void s_in(const Ctx& C, int idx, int nblk) {
    unsigned char* ws = C.ws; const int tid = C.tid, row = tid >> 2, c8 = (tid & 3) * 8, rg = MPROMPT + row;
    const float rs = ((const float*)(ws + WS_RSTD1))[rg];
    for (int u = idx; u < 273; u += nblk) {
        float v[8]; skinny_core(C, (const bf16*)(ws + WS_SXB), LDS_X, (const bf16*)(ws + WS_WIN) + ((size_t)(u >> 3) * (DM / 64) * 256 + (u & 7) * 32) * 64, C.wave * 256, 256, v);
        const int n = u * 32 + c8;
#pragma unroll
        for (int k = 0; k < 8; ++k) v[k] *= rs;
        if (n < 2048) {
#pragma unroll
            for (int k = 0; k < 8; ++k) v[k] = gelu_tanh(v[k]);
            if (n < 1024) *(GAS v4u*)((bf16*)(ws + WS_U) + (size_t)rg * DG + n) = pack8f(v);
            else { *(GAS v4u*)((bf16*)(ws + WS_VG) + (size_t)rg * DG + n - 1024) = pack8f(v); float ss = 0.f;
#pragma unroll
                for (int k = 0; k < 8; ++k) ss += v[k] * v[k];
                ss += __shfl_xor(ss, 1); ss += __shfl_xor(ss, 2);
                if ((tid & 3) == 0) ((float*)(ws + WS_VSS))[(size_t)rg * 32 + (n - 1024) / 32] = ss; }
        } else if (n < 3072) st8f((float*)(ws + WS_QRAW) + (size_t)rg * DQ + n - 2048, v);
        else if (n < 3584) st8f(C.out + O_SCMP + (size_t)row * 512 + n - 3072, v);
        else if (n < 4096) st8f(C.out + O_SSEL + (size_t)row * 512 + n - 3584, v);
        else if (n < 4608) st8f((float*)(ws + WS_KVWR) + (size_t)rg * 512 + n - 4096, v);
        else if (n < 8704) {
#pragma unroll
            for (int k = 0; k < 8; ++k) v[k] = sigmoidf_(v[k]);
            if (n < 6656) *(GAS v4u*)((bf16*)(ws + WS_GA) + (size_t)rg * DM + n - 4608) = pack8f(v); else *(GAS v4u*)((bf16*)(ws + WS_GB) + (size_t)rg * DM + n - 6656) = pack8f(v);
        } else if (n < 8728) {
#pragma unroll
            for (int k = 0; k < 8; ++k) v[k] = sigmoidf_(v[k]);
            st8f((float*)(ws + WS_GN) + (size_t)rg * 32 + n - 8704, v); }
    }
}
__device__ __forceinline__ void s_proj(const Ctx& C) {
    unsigned char* ws = C.ws; const int tid = C.tid, row = tid >> 2, c8 = (tid & 3) * 8, rg = MPROMPT + row;
    for (int u = blockIdx.x; u < 64; u += C.G) {
        float a[8], b[8], ga[8], gb[8]; const int n = u * 32 + c8;
        { const bool pb = C.wave >= 4;
          skinny_core<true>(C, (const bf16*)(ws + (pb ? WS_SOB : WS_SOA)), LDS_G, (const bf16*)(ws + (pb ? WS_WN : WS_WG)) + ((size_t)(u >> 3) * (DG / 64) * 256 + (u & 7) * 32) * 64, (C.wave & 3) * 256, 256, a, b); }
        unpack8(*(const GAS v4u*)((const bf16*)(ws + WS_GA) + (size_t)rg * DM + n), ga); unpack8(*(const GAS v4u*)((const bf16*)(ws + WS_GB) + (size_t)rg * DM + n), gb);
#pragma unroll
        for (int k = 0; k < 8; ++k) a[k] = ga[k] * a[k] + gb[k] * b[k];
        *(GAS v4u*)((bf16*)(ws + WS_SMIX) + (size_t)row * LDS_X + n) = pack8f(a);
    }
}
__device__ __forceinline__ void s_out(const Ctx& C, int idx, int nblk) {
    unsigned char* ws = C.ws; const int tid = C.tid, row = tid >> 2, c8 = (tid & 3) * 8, rg = MPROMPT + row;
    for (int u = idx; u < 64; u += nblk) {
        float v[8], x[8]; const int n = u * 32 + c8;
        skinny_core(C, (const bf16*)(ws + WS_SMIX), LDS_X, (const bf16*)(ws + WS_WO) + ((size_t)(u >> 3) * (DM / 64) * 256 + (u & 7) * 32) * 64, C.wave * 256, 256, v);
        ld8f(C.in[IN_XS] + (size_t)row * DM + n, x); float ss = 0.f;
#pragma unroll
        for (int k = 0; k < 8; ++k) { v[k] += x[k]; ss += v[k] * v[k]; }
        st8f(C.out + O_YS + (size_t)row * DM + n, v); *(GAS v4u*)((bf16*)(ws + WS_SX1B) + (size_t)row * LDS_X + n) = pack8f(v);
        ss += __shfl_xor(ss, 1); ss += __shfl_xor(ss, 2);
        if ((tid & 3) == 0) ((float*)(ws + WS_X1SS))[(size_t)MPROMPT * 32 + row * 64 + u] = ss;
    }
}
__device__ __forceinline__ void s_up(const Ctx& C) {
    unsigned char* ws = C.ws; const int tid = C.tid, row = tid >> 2, c8 = (tid & 3) * 8, rg = MPROMPT + row;
    float rs; { const GAS f32x4* sp = (const GAS f32x4*)((const float*)(ws + WS_X1SS) + (size_t)MPROMPT * 32 + row * 64); f32x4 s4 = sp[0];
#pragma unroll
        for (int k = 1; k < 16; ++k) s4 += sp[k];
        rs = rsqrtf(((s4.x + s4.y) + (s4.z + s4.w)) * (1.0f / DM) + EPS); }
    for (int u = blockIdx.x; u < 256; u += C.G) {
        float v[8]; skinny_core(C, (const bf16*)(ws + WS_SX1B), LDS_X, (const bf16*)(ws + WS_WUP) + ((size_t)(u >> 3) * (DM / 64) * 256 + (u & 7) * 32) * 64, C.wave * 256, 256, v);
#pragma unroll
        for (int k = 0; k < 8; ++k) { const float a = fmaxf(v[k] * rs, 0.f); v[k] = a * a; }
        *(GAS v4u*)((bf16*)(ws + WS_SH) + (size_t)row * LDS_H + u * 32 + c8) = pack8f(v);
    }
}
__device__ __forceinline__ void s_down(const Ctx& C) {
    unsigned char* ws = C.ws; const int tid = C.tid, row = tid >> 2, c8 = (tid & 3) * 8, rg = MPROMPT + row;
    float* PART = (float*)(ws + WS_SPART); gu32* tick = (gu32*)(ws + WS_CTL) + CW_TICK; LAS unsigned* flag = (LAS unsigned*)(C.lds + AT_X);
    for (int u = blockIdx.x; u < 256; u += C.G) { const int strip = u >> 2, kq = u & 3;
        float v[8]; skinny_core(C, (const bf16*)(ws + WS_SH), LDS_H, (const bf16*)(ws + WS_WDN) + ((size_t)(strip >> 3) * (DFF / 64) * 256 + (strip & 7) * 32) * 64, kq * 2048 + C.wave * 256, 256, v);
        { gu64* pp = (gu64*)(PART + ((size_t)(strip * 4 + kq) * 128 + row) * 32 + c8);
#pragma unroll
          for (int q = 0; q < 4; ++q) __hip_atomic_store(pp + q, ((unsigned long long)__float_as_uint(v[2 * q + 1]) << 32) | __float_as_uint(v[2 * q]), RLX_AGENT); }
        asm volatile("s_waitcnt vmcnt(0)" ::: "memory"); __syncthreads();
        if (tid == 0) { const unsigned old = __hip_atomic_fetch_add(tick + strip * 64, 1u, __ATOMIC_RELAXED, __HIP_MEMORY_SCOPE_AGENT); flag[0] = old; }
        __syncthreads();
        const bool last = flag[0] == 3u;
        __syncthreads();
        if (last) { __builtin_amdgcn_fence(__ATOMIC_ACQUIRE, "agent"); asm volatile("s_waitcnt vmcnt(0)" ::: "memory");
            float* y = C.out + O_YS + (size_t)row * DM + strip * 32 + c8; float acc[8]; ld8f(y, acc);
#pragma unroll
            for (int q = 0; q < 4; ++q) { const gu64* pp = (const gu64*)(PART + ((size_t)(strip * 4 + q) * 128 + row) * 32 + c8);
#pragma unroll
                for (int k = 0; k < 4; ++k) { const unsigned long long w = __hip_atomic_load(pp + k, RLX_AGENT); acc[2 * k] += __uint_as_float((unsigned)w); acc[2 * k + 1] += __uint_as_float((unsigned)(w >> 32)); } }
            st8f(y, acc); }
    }
}

__device__ __forceinline__ void fused_cmp_unit(const Ctx& C, int L, const epi::EpiCmp& E) {
    using pg8::bf16x8; using pg8::f32x4; using pg8::HTB;
    LAS unsigned char* lds = C.lds + RING_OFF;
    const Ctx Lf = fresh(C);
    const int tid = Lf.tid, wid = C.wave, lane = Lf.lane, wr = wid >> 2, wc = wid & 3, fr = lane & 15, fq = lane >> 4;
    const int b = L >> 1, kv = L & 1;
    const int* pt = (const int*)C.in[IN_PT] + b * 16;
    unsigned aofg[2][2], voffB[2];
#pragma unroll
    for (int i = 0; i < 2; ++i) { int R, Cx; pg8::stage_rc(tid * 16 + i * 8192, R, Cx);
        const unsigned page = (unsigned)pt[R >> 3];
#pragma unroll
        for (int h = 0; h < 2; ++h) aofg[h][i] = (((page * 128u + (unsigned)(R & 7) * 16u) * 512u) + (unsigned)((kv * 2 + h) * 128 + Cx)) * 4u;
        voffB[i] = (unsigned)(R * 64 + Cx) * 2u; }
    const char* cA = (const char*)C.in[IN_CCMP];
    const char* cB = (const char*)(C.ws + WS_WC) + (size_t)kv * 32 * 32768;
    const size_t hstepB = 16384;
    const int aoff = pg8::lds_byte(wr * 64 + fr, fq * 8), boff = pg8::lds_byte(wc * 32 + fr, fq * 8);
#define FC_SA(bf, h) (((bf) * 2 + (h)) * HTB)
#define FC_SB(bf, h) ((4 + (bf) * 2 + (h)) * HTB)
#define FC_LOADA(kt) do { const unsigned ko_ = (unsigned)((kt) >> 1) * 2048u + (unsigned)((kt) & 1) * 256u; \
        _Pragma("unroll") for (int h = 0; h < 2; ++h) _Pragma("unroll") for (int i = 0; i < 2; ++i) { const char* p_ = cA + aofg[h][i] + ko_; \
            ar[h][i][0] = *(const GAS f32x4*)p_; ar[h][i][1] = *(const GAS f32x4*)(p_ + 16); } } while (0)
#define FC_WRITEA(bf) do { _Pragma("unroll") for (int h = 0; h < 2; ++h) _Pragma("unroll") for (int i = 0; i < 2; ++i) { v4u w_; \
            w_.x = pk2(ar[h][i][0].x, ar[h][i][0].y); w_.y = pk2(ar[h][i][0].z, ar[h][i][0].w); w_.z = pk2(ar[h][i][1].x, ar[h][i][1].y); w_.w = pk2(ar[h][i][1].z, ar[h][i][1].w); \
            *(LAS v4u*)(lds + FC_SA(bf, h) + tid * 16 + i * 8192) = w_; } } while (0)
#define FC_DMAB(kt, bf) do { _Pragma("unroll") for (int h = 0; h < 2; ++h) _Pragma("unroll") for (int i = 0; i < 2; ++i) \
            __builtin_amdgcn_global_load_lds((const unsigned*)(cB + h * hstepB + (size_t)(kt) * 32768 + voffB[i]), (LAS unsigned*)(lds + FC_SB(bf, h) + wid * 1024 + i * 8192), 16, 0, 0); } while (0)
#define FC_LDA(dst, bf, h) do { _Pragma("unroll") for (int m = 0; m < 4; ++m) _Pragma("unroll") for (int k = 0; k < 2; ++k) dst[m][k] = *(const LAS bf16x8*)(lds + FC_SA(bf, h) + aoff + m * 2048 + k * 1024); } while (0)
#define FC_LDB(dst, bf, h) do { _Pragma("unroll") for (int n = 0; n < 2; ++n) _Pragma("unroll") for (int k = 0; k < 2; ++k) dst[n][k] = *(const LAS bf16x8*)(lds + FC_SB(bf, h) + boff + n * 2048 + k * 1024); } while (0)
#define FC_MMA(ai, bj, At_, Bt_) do { _Pragma("unroll") for (int m = 0; m < 4; ++m) _Pragma("unroll") for (int n = 0; n < 2; ++n) _Pragma("unroll") for (int k = 0; k < 2; ++k) \
        acc[ai][bj][m][n] = __builtin_amdgcn_mfma_f32_16x16x32_bf16(Bt_[n][k], At_[m][k], acc[ai][bj][m][n], 0, 0, 0); } while (0)
    f32x4 acc[2][2][4][2];
#pragma unroll
    for (int a = 0; a < 2; ++a)
#pragma unroll
        for (int bb = 0; bb < 2; ++bb)
#pragma unroll
            for (int m = 0; m < 4; ++m)
#pragma unroll
                for (int n = 0; n < 2; ++n) acc[a][bb][m][n] = (f32x4){0.f, 0.f, 0.f, 0.f};
    f32x4 ar[2][2][2];
    bf16x8 At[4][2], B0[2][2];
    __syncthreads();
    FC_LOADA(0); FC_DMAB(0, 0); FC_WRITEA(0);
    asm volatile("s_waitcnt vmcnt(0) lgkmcnt(0)" ::: "memory"); __syncthreads();
#pragma unroll 1
    for (int kt = 0; kt < 32; ++kt) { const int bf = kt & 1;
        if (kt + 1 < 32) { FC_LOADA(kt + 1); FC_DMAB(kt + 1, bf ^ 1); }
        FC_LDB(B0, bf, 0); FC_LDA(At, bf, 0); FC_MMA(0, 0, At, B0);
        FC_LDA(At, bf, 1); FC_MMA(1, 0, At, B0);
        FC_LDB(B0, bf, 1); FC_MMA(1, 1, At, B0);
        FC_LDA(At, bf, 0); FC_MMA(0, 1, At, B0);
        if (kt + 1 < 32) FC_WRITEA(bf ^ 1);
        asm volatile("s_waitcnt vmcnt(0) lgkmcnt(0)" ::: "memory"); __syncthreads();
    }
    const pg8::Unit u{L, kv};
    { const Ctx Le = fresh(C); E(acc, u, wr, wc, Le.lane & 15, Le.lane >> 4); }
#undef FC_SA
#undef FC_SB
#undef FC_LOADA
#undef FC_WRITEA
#undef FC_DMAB
#undef FC_LDA
#undef FC_LDB
#undef FC_MMA
}

constexpr int LATE_P1 = 4096;
constexpr int WINCOPY_P2 = 0;
constexpr int LATE_P2 = I_LATE - LATE_P1;
constexpr int LATE_P12 = LATE_P1 + LATE_P2;
constexpr int NLATE_W = (I_LATE - LATE_P12 + 31) / 32, P5_HEAVY = 160, P5_SAMP0 = P5_HEAVY, P5_LIGHT0 = P5_SAMP0 + 256, P5_STREAM0 = P5_LIGHT0 + (256 - P5_HEAVY),
              P5_ITEMS = P5_STREAM0 + NLATE_W + WINCOPY_ITEMS - WINCOPY_P2;
__device__ __forceinline__ void p5_attn_flash(const Ctx& C, const int it_lo = 0, const int it_hi = P5_ITEMS) {
    unsigned char* ws = C.ws; gu32* ctl = (gu32*)(ws + WS_CTL); gu32* qa = ctl + CW_Q5;
    LAS float* scr = (LAS float*)(C.lds + RING_OFF + C.wave * 16384);
    for (;;) {
        gu32* qa_ = qa; unsigned qo_ = AT_WS + 2048; asm volatile("" : "+s"(qa_), "+s"(qo_));
        LAS unsigned* qf_ = (LAS unsigned*)(C.lds + qo_);
        __syncthreads();
        if (C.wave == 0 && lane_now() == 0) qf_[0] = __hip_atomic_fetch_add(qa_, 1u, __ATOMIC_RELAXED, __HIP_MEMORY_SCOPE_AGENT);
        __syncthreads();
        const int it = __builtin_amdgcn_readfirstlane((int)qf_[0]) + it_lo;
        if (it >= it_hi) break;
        const Ctx L = fresh(C);
        if (it < P5_HEAVY || (it >= P5_LIGHT0 && it < P5_STREAM0)) { const int un = it < P5_HEAVY ? it : it - P5_LIGHT0 + P5_HEAVY;
            const int qb_ = 63 - (un >> 2), bg = un & 3; flash_unit(L, bg >> 1, bg & 1, qb_); }
        else if (it < P5_LIGHT0) { const int si = it - P5_SAMP0, b = si >> 1, g = si & 1, row = MPROMPT + b;
            AttItem ai{(const bf16*)(ws + WS_QN) + (size_t)row * DQ + g * 512, PASTLEN, 127, (const bf16*)(ws + WS_KCS) + (size_t)(b * 2 + g) * 128 * 128, (const bf16*)(ws + WS_VCS) + (size_t)(b * 2 + g) * 128 * 128, 33,
                       (const float*)(ws + WS_GN) + (size_t)row * 32 + g * 12, (bf16*)(ws + WS_SOB) + (size_t)b * LDS_G + g * 512, (const float*)(ws + WS_BLUT) + g * 4 * 132};
            SampleKV kv{C.in[IN_CSEL] + g * 128, (const int*)C.in[IN_PT] + b * 16, C.out + O_SSEL + (size_t)b * 512 + g * 128, C.in[IN_WINB] + (size_t)b * 512 * 512 + g * 128,
                        (const float*)(ws + WS_KVWR) + (size_t)row * 512 + g * 128};
            nsa_item<SampleKV>(L, ai, kv, C.in[IN_GK] + 128, C.in[IN_GK] + 256); }
        else if (it < P5_STREAM0 + NLATE_W) { const int base = LATE_P12 + (it - P5_STREAM0) * 32;
#pragma unroll 1
            for (int k = 0; k < 4; ++k) { const int r = base + k * 8 + C.wave; if (r < I_LATE) w_item_late(L, r, scr); } }
        else wincopy_item(L, WINCOPY_P2 + it - P5_STREAM0 - NLATE_W);
    }
}

#ifndef MK_N_LAUNCHES
#define MK_N_LAUNCHES 1
#endif
constexpr int NPHASES = 10;

__device__ __forceinline__ void ph1(const Ctx& C, LAS unsigned char* ring) { unsigned char* ws = C.ws;
    pg8::Gemm g{(const bf16*)(ws + WS_XB), (const bf16*)(ws + WS_WIN), MPROMPT, NINP, DM, LD2, LD2, 1, 1}; pg8::StaticOrder S; S.init(MPROMPT, NINP, C.G, (int)blockIdx.x);
    epi::EpiIn E{(const float*)(ws + WS_RSTD1), (bf16*)(ws + WS_U), (bf16*)(ws + WS_VG), (float*)(ws + WS_VSS), (float*)(ws + WS_QRAW), (float*)(ws + WS_KVWR),
                 (bf16*)(ws + WS_GA), (bf16*)(ws + WS_GB), (float*)(ws + WS_GN), C.out, (bf16*)(ws + WS_ACP)};
    const int nu = (MPROMPT / 256) * (NINP / 256), full = nu % C.G, nlight = full ? C.G - full : C.G, idx = full ? (int)blockIdx.x - full : (int)blockIdx.x;
    const bool sfirst = idx >= 0 && (C.G % 8 == 0) && (blockIdx.x & 1);
    if (sfirst) s_in(C, idx, nlight);
    pg8::gemm_phase<epi::EpiIn, pg8::StaticOrder, true, true>(ring, g, S, E, fresh(C).tid);
    { if (idx >= 0) { if (!sfirst) s_in(fresh(C), idx, nlight);
          const Ctx L = fresh(C); LAS float* scr = (LAS float*)(C.lds + RING_OFF + C.wave * 16384); __syncthreads();
          for (int r = idx * NWAVES + C.wave; r < LATE_P1; r += nlight * NWAVES) w_item_late(L, r, scr); } } }
__device__ __forceinline__ void ph2(const Ctx& C, LAS unsigned char* ring) { unsigned char* ws = C.ws;
    { const int skip = C.G > 32 ? 16 : 0; if ((int)blockIdx.x >= skip) p2_post(C, (int)blockIdx.x - skip, C.G - skip); }
    { epi::EpiCmp E{(float*)(ws + WS_YCS), 127};
      for (int Lu = (int)blockIdx.x; Lu < 256; Lu += C.G) { fused_cmp_unit(C, Lu, E);
          asm volatile("s_waitcnt vmcnt(0)" ::: "memory"); __syncthreads();
          const Ctx Lc = fresh(C);
          cmp_combine_rows(Lc, false, Lu * 256, 256); } }
    __syncthreads();
    const int ngb = C.G > 16 ? 8 : 0;
    if (ngb == 0 || (int)blockIdx.x < ngb) {
        { pg8::Gemm g{(const bf16*)(ws + WS_ACP), (const bf16*)(ws + WS_WC), 2048, 512, 2048, LD2, LD2, 1, 1}; epi::CmpOrder S{8, C.G, (int)blockIdx.x, 1};
          epi::EpiCmp E{(float*)(ws + WS_YCP), 255};
          const Ctx Lg = fresh(C); pg8::gemm_phase<epi::EpiCmp, epi::CmpOrder, true, true>(ring, g, S, E, Lg.tid); }
        asm volatile("s_waitcnt vmcnt(0)" ::: "memory"); __syncthreads();
        const Ctx Lc = fresh(C);
        for (int L = (int)blockIdx.x; L < 8; L += C.G) cmp_combine_rows(Lc, true, L * 256, 256); }
    { const Ctx Ls = fresh(C);
      if (ngb == 0) p4_sgu(Ls, (int)blockIdx.x, C.G); else if ((int)blockIdx.x >= ngb) p4_sgu(Ls, (int)blockIdx.x - ngb, C.G - ngb); }
    { const int skip = C.G > 32 ? 16 : 0;
      if ((int)blockIdx.x >= skip) { const Ctx L = fresh(C); LAS float* scr = (LAS float*)(C.lds + RING_OFF + C.wave * 16384); __syncthreads();
          for (int r = LATE_P1 + ((int)blockIdx.x - skip) * NWAVES + C.wave; r < LATE_P12; r += (C.G - skip) * NWAVES) w_item_late(L, r, scr);
          for (int c = (int)blockIdx.x - skip; c < WINCOPY_P2; c += C.G - skip) wincopy_item(L, c); } } }
__device__ __forceinline__ void ph6(const Ctx& C, LAS unsigned char* ring) { unsigned char* ws = C.ws;
    { pg8::Gemm g{(const bf16*)(ws + WS_OA), (const bf16*)(ws + WS_WG), MPROMPT, DM, DG, LD1, LD1, 1, 1}; pg8::StaticOrder S; S.init(MPROMPT, DM, C.G, (int)blockIdx.x);
      epi::EpiMixA E{(const bf16*)(ws + WS_GA), (bf16*)(ws + WS_MIXA)};
      pg8::gemm_phase<epi::EpiMixA, pg8::StaticOrder, true, true>(ring, g, S, E, C.tid); }
    { pg8::Gemm g{(const bf16*)(ws + WS_OB), (const bf16*)(ws + WS_WN), MPROMPT, DM, DQ, LD1, LD1, 1, 1}; pg8::StaticOrder S; S.init(MPROMPT, DM, C.G, (int)blockIdx.x);
      epi::EpiMixB E{(const bf16*)(ws + WS_GB), (const bf16*)(ws + WS_MIXA), (bf16*)(ws + WS_MIX)};
      pg8::gemm_phase<epi::EpiMixB, pg8::StaticOrder, true, true>(ring, g, S, E, C.tid); }
    s_proj(C); }
__device__ __forceinline__ void ph7(const Ctx& C, LAS unsigned char* ring) { unsigned char* ws = C.ws;
    pg8::Gemm g{(const bf16*)(ws + WS_MIX), (const bf16*)(ws + WS_WO), MPROMPT, DM, DM, LD2, LD2, 1, 1}; pg8::StaticOrder S; S.init(MPROMPT, DM, C.G, (int)blockIdx.x);
    epi::EpiOut E{C.in[IN_XP], C.in[IN_XS], C.out, (bf16*)(ws + WS_X1B), (float*)(ws + WS_X1SS)};
    const bool odd64 = (C.G % 8 == 0) && C.G >= 128;
    if (odd64) { if ((blockIdx.x & 1) && blockIdx.x < 128) s_out(C, (int)blockIdx.x >> 1, 64); }
    pg8::gemm_phase<epi::EpiOut, pg8::StaticOrder, true, true>(ring, g, S, E, fresh(C).tid);
    if (!odd64) s_out(fresh(C), (int)blockIdx.x, C.G); }
__device__ __forceinline__ void ph8(const Ctx& C, LAS unsigned char* ring) { unsigned char* ws = C.ws;
    pg8::Gemm g{(const bf16*)(ws + WS_X1B), (const bf16*)(ws + WS_WUP), MPROMPT, DFF, DM, LD2, LD2, 1, 1}; pg8::StaticOrder S; S.init(MPROMPT, DFF, C.G, (int)blockIdx.x);
    epi::EpiUp E{(const float*)(ws + WS_X1SS), (bf16*)(ws + WS_H)};
    const bool first = (C.G % 8 == 0) && (blockIdx.x & 1);
    if (first) s_up(C);
    pg8::gemm_phase<epi::EpiUp, pg8::StaticOrder, true, true>(ring, g, S, E, fresh(C).tid);
    if (!first) s_up(fresh(C)); }
template <bool DUMMY>
__device__ __forceinline__ void ph9(const Ctx& C, LAS unsigned char* ring) { unsigned char* ws = C.ws;
    pg8::Gemm g{(const bf16*)(ws + WS_H), (const bf16*)(ws + WS_WDN), MPROMPT, DM, DFF, LD8, LD8, 1, 1}; pg8::StaticOrder S; S.init(MPROMPT, DM, C.G, (int)blockIdx.x);
    epi::EpiDown E{DUMMY ? (float*)(ws + WS_DUMMY) : C.out, (const bf16*)(ws + WS_X1B)};
    const bool first = (C.G % 8 == 0) && (blockIdx.x & 1);
    if (!DUMMY && first) s_down(C);
    pg8::gemm_phase<epi::EpiDown, pg8::StaticOrder, true, true>(ring, g, S, E, fresh(C).tid);
    if (!DUMMY && !first) s_down(fresh(C)); }

struct Args { const float* in[24]; float* out; unsigned char* ws; int ph_lo, ph_hi; };
static_assert(sizeof(Args) == 24 * 8 + 8 + 8 + 8, "no padding bytes in the kernel argument struct");

__global__ void __launch_bounds__(NWAVES * 64, 2) nsa_fwd(Args args) {
    extern __shared__ __attribute__((aligned(16))) unsigned char lds_raw[];
    Ctx C;
    C.in = args.in;
    C.out = args.out; C.ws = args.ws; C.lds = (LAS unsigned char*)lds_raw;
    C.tid = threadIdx.x; C.lane = C.tid & 63; C.wave = __builtin_amdgcn_readfirstlane(C.tid >> 6);
    C.G = gridDim.x; { const int bx = blockIdx.x; C.vcu = (C.G % 8 == 0) ? (bx % 8) * (C.G / 8) + bx / 8 : bx; }
    volatile LAS unsigned* MISC = (volatile LAS unsigned*)(C.lds + MISC_OFF);
    gu32* ctl = (gu32*)(args.ws + WS_CTL);
    for (int u = C.tid; u < (LDS_BYTES - LDSCTL_OFF) / 4; u += NWAVES * 64) ((LAS unsigned*)(C.lds + LDSCTL_OFF))[u] = 0u;
    __syncthreads();
    const int lo = args.ph_lo, hi = args.ph_hi;
    XcdBarrier bar; bar.bar = (unsigned*)(ctl + CW_BAR); bar.x = 0; bar.w = 0; bar.st = nullptr;
    if (hi - lo > 1) bar = xcd_barrier_post((unsigned*)(ctl + CW_BAR), MISC + 8);
#ifndef ONLY_PHASES
#define ONLY_PHASES 0x3ff
#endif
#define IN(k) (((ONLY_PHASES >> (k)) & 1) && lo <= (k) && (k) < hi)
#ifndef PROBE_SLACK
#define PROBE_SLACK -1
#endif
#ifndef PROBE_SLACK_PH
#define PROBE_SLACK_PH 2
#endif
#if PROBE_SLACK >= 0
    unsigned long long ps0_ = 0;
#define SEAM2(k, n) do { if (IN(k) && IN(n)) { if ((k) == PROBE_SLACK_PH) { __syncthreads(); ps0_ = __builtin_amdgcn_s_memrealtime(); } xcd_barrier(bar); \
        if ((k) == PROBE_SLACK_PH) { if ((int)blockIdx.x == PROBE_SLACK && C.wave == 0) { const unsigned long long d_ = __builtin_amdgcn_s_memrealtime() - ps0_, t0_ = __builtin_amdgcn_s_memrealtime(); \
                while (__builtin_amdgcn_s_memrealtime() - t0_ < d_ * 10ull) __builtin_amdgcn_s_sleep(16); } \
            xcd_barrier(bar); } } } while (0)
#else
#define SEAM2(k, n) do { if (IN(k) && IN(n)) xcd_barrier(bar); } while (0)
#endif
#define SEAM(k) SEAM2(k, (k) + 1)
    LAS unsigned char* ring = C.lds + RING_OFF;

#define PROBE2(k, call) do { if ((PROBE_MASK >> (k)) & 1) { xcd_barrier(bar); call; } } while (0)
    if (IN(0)) { p0_prologue(fresh(C)); PROBE2(0, p0_prologue(fresh(C))); } SEAM(0);
    if (IN(1)) { ph1(fresh(C), ring); PROBE2(1, ph1(fresh(C), ring)); } SEAM(1);
    if (IN(2)) { ph2(fresh(C), ring); PROBE2(2, ph2(fresh(C), ring)); } SEAM2(2, 5);
    if (IN(5)) { p5_attn_flash(fresh(C));
#define P5_RERUN(lo_, hi_) do { xcd_barrier(bar); if (blockIdx.x == 0 && C.wave == 0 && lane_now() == 0) __hip_atomic_store(ctl + CW_Q5, 0u, RLX_AGENT); xcd_barrier(bar); p5_attn_flash(fresh(C), lo_, hi_); } while (0)
        if ((PROBE_MASK >> 5) & 1) P5_RERUN(0, P5_ITEMS);
        if ((PROBE_MASK >> 13) & 1) { P5_RERUN(0, P5_HEAVY); }
        if ((PROBE_MASK >> 14) & 1) { P5_RERUN(P5_SAMP0, P5_LIGHT0); }
        if ((PROBE_MASK >> 15) & 1) { P5_RERUN(P5_STREAM0, P5_ITEMS); }
} SEAM(5);
    if (IN(6)) { ph6(fresh(C), ring); PROBE2(6, ph6(fresh(C), ring)); } SEAM(6);
    if (IN(7)) { ph7(fresh(C), ring); PROBE2(7, ph7(fresh(C), ring)); } SEAM(7);
#if (PROBE_MASK >> 20) & 1
    long long pc0_ = 0; unsigned long long pr0_ = 0; if (IN(8)) { pc0_ = clock64(); pr0_ = __builtin_amdgcn_s_memrealtime(); }
#endif
    if (IN(8)) { ph8(fresh(C), ring); PROBE2(8, ph8(fresh(C), ring)); }
#if (PROBE_MASK >> 20) & 1
    if (IN(8) && blockIdx.x == 0 && C.wave == 0) { const long long dc_ = clock64() - pc0_; const unsigned long long dr_ = __builtin_amdgcn_s_memrealtime() - pr0_;
        const unsigned long long mhz_ = (unsigned long long)dc_ * 100ull / (dr_ ? dr_ : 1ull); const unsigned long long t0_ = __builtin_amdgcn_s_memrealtime();
        while (__builtin_amdgcn_s_memrealtime() - t0_ < mhz_ * 100ull) __builtin_amdgcn_s_sleep(16); }
#endif
    SEAM(8);
    if (IN(9)) { PROBE2(9, ph9<true>(fresh(C), ring)); if ((PROBE_MASK >> 9) & 1) xcd_barrier(bar); ph9<false>(fresh(C), ring); }
#undef PROBE2
#undef IN
#undef SEAM
#undef SEAM2
}

extern "C" void kernel_launch(void* const* d_in, const int* in_sizes, int n_in, void* d_out, int out_size, void* d_ws, size_t ws_size, hipStream_t stream) {
    static int grid = 0;
    if (grid == 0) {
        if (n_in != 24 || out_size != (int)O_END || ws_size < WS_END) {
            fprintf(stderr, "kernel_launch: built for 24 inputs, %zu outputs, >= %zu bytes of workspace; got n_in %d out %d ws %zu; nothing launched\n", (size_t)O_END, (size_t)WS_END, n_in, out_size, ws_size);
            grid = -1; return; }
        int dev = 0, cus = 0, per_cu = 0;
        if (hipGetDevice(&dev) != hipSuccess || hipDeviceGetAttribute(&cus, hipDeviceAttributeMultiprocessorCount, dev) != hipSuccess) { fprintf(stderr, "kernel_launch: device query failed\n"); grid = -1; return; }
        if (hipFuncSetAttribute((const void*)nsa_fwd, hipFuncAttributeMaxDynamicSharedMemorySize, LDS_BYTES) != hipSuccess) { fprintf(stderr, "kernel_launch: hipFuncSetAttribute failed\n"); grid = -1; return; }
        if (hipOccupancyMaxActiveBlocksPerMultiprocessor(&per_cu, (const void*)nsa_fwd, NWAVES * 64, LDS_BYTES) != hipSuccess || per_cu < 1)
            fprintf(stderr, "kernel_launch: note: occupancy query reports %d workgroups per CU\n", per_cu);
        (void)hipGetLastError();
        grid = cus;
    }
    if (grid < 0) return;
    if (hipMemsetAsync((char*)d_ws + WS_CTL, 0, CTL_ZERO_BYTES, stream) != hipSuccess) { fprintf(stderr, "kernel_launch: memset failed\n"); return; }
    Args a{};
    for (int i = 0; i < 24; ++i) a.in[i] = (const float*)d_in[i];
    a.out = (float*)d_out; a.ws = (unsigned char*)d_ws;
    const int nl = MK_N_LAUNCHES;
    for (int li = 0; li < nl; ++li) {
        a.ph_lo = nl == 1 ? 0 : li; a.ph_hi = nl == 1 ? NPHASES : li + 1;
        hipLaunchKernelGGL(nsa_fwd, dim3(grid), dim3(NWAVES * 64), LDS_BYTES, stream, a);
        const hipError_t le = hipPeekAtLastError();
        if (le != hipSuccess) { fprintf(stderr, "kernel_launch: launch %d failed: %s\n", li, hipGetErrorName(le)); break; }
    }
}
```

```cpp
#include <hip/hip_runtime.h>
#include <cstdio>
#include <cstdint>
namespace pg8 {
#define PG8_LAS __attribute__((address_space(3)))
typedef unsigned short bf16_t;
typedef short bf16x8 __attribute__((ext_vector_type(8)));
typedef float f32x4 __attribute__((ext_vector_type(4)));
typedef unsigned u32x4 __attribute__((ext_vector_type(4)));
constexpr int BM = 256, BK = 64, HALF = 128, HTB = HALF * BK * 2  , STAGE_BYTES = 8 * HTB, NXCD = 8, WGM = 8;

__host__ __device__ __forceinline__ int lds_byte(int r, int c) { const int st = (r >> 4) * 2 + (c >> 5), rr = r & 15, cc = c & 31, ob = rr * 64 + cc * 2; return st * 1024 + (ob ^ (((ob >> 9) & 1) << 5)); }
__host__ __device__ __forceinline__ void stage_rc(int b, int& R, int& C) { const int st = b / 1024, sb = b % 1024, swz = sb ^ (((sb >> 9) & 1) << 5); R = (st >> 1) * 16 + swz / 64; C = (st & 1) * 32 + (swz % 64) / 2; }
__host__ __device__ __forceinline__ int perm32(int rho) { const int n = rho >> 4, i = rho & 15; return 8 * (i >> 2) + 4 * n + (i & 3); }

struct Unit { int pm, pn; };
struct Gemm { const bf16_t* A; const bf16_t* Bt; int M, N, K, lda, ldb; int tileA = 0, tileB = 0; };

struct StaticOrder {
    int nM, nN, nwg, G, c;
    __host__ __device__ void init(int M, int N, int G_, int c_) { nM = M / BM; nN = N / BM; nwg = nM * nN; G = G_; c = c_; }
    __host__ __device__ bool next(int i, Unit& u) const {
        const long L = (long)i * G + c; if (L >= nwg) return false;
        int wgid = (int)L; { const int q = nwg / NXCD, r = nwg % NXCD, xcd = wgid % NXCD, off = wgid / NXCD; wgid = (xcd < r ? xcd * (q + 1) : r * (q + 1) + (xcd - r) * q) + off; }
        const int nig = WGM * nN, gid = wgid / nig, fm = gid * WGM, gsz = (nM - fm) < WGM ? (nM - fm) : WGM;
        u.pm = fm + ((wgid % nig) % gsz); u.pn = (wgid % nig) / gsz; return true;
    }
    __device__ __forceinline__ void a_ready(const Unit&) const {}
    __device__ __forceinline__ void done(const Unit&) const {}
};

__device__ __forceinline__ unsigned cvt_pk_bf16(float lo, float hi) { unsigned r; asm volatile("v_cvt_pk_bf16_f32 %0, %1, %2" : "=v"(r) : "v"(lo), "v"(hi)); return r; }
typedef float f32x2 __attribute__((ext_vector_type(2)));
template <class Epi, class Sched, bool ALIGN_EPI = false, bool SP2 = false>
__device__ __forceinline__ void gemm_phase(PG8_LAS unsigned char* lds, const Gemm g, const Sched& S, const Epi& E, const int tid) {
    const int wid = __builtin_amdgcn_readfirstlane(tid >> 6), lane = tid & 63, wr = wid >> 2, wc = wid & 3, fr = lane & 15, fq = lane >> 4;
    const int K = g.K, nt = K / BK;
    unsigned voffA[2], voffB[2];
#pragma unroll
    for (int i = 0; i < 2; ++i) { int R, C; stage_rc(tid * 16 + i * 8192, R, C); const int Rb = Epi::PERM ? ((R & ~31) + perm32(R & 31)) : R;
        voffA[i] = (unsigned)(R * (g.tileA ? 64 : g.lda) + C) * 2u; voffB[i] = (unsigned)(Rb * (g.tileB ? 64 : g.ldb) + C) * 2u; }
    const size_t kstepA = g.tileA ? (size_t)32768 : (size_t)(BK * 2), kstepB = g.tileB ? (size_t)32768 : (size_t)(BK * 2);
    const size_t hstepA = g.tileA ? (size_t)16384 : (size_t)HALF * g.lda * 2, hstepB = g.tileB ? (size_t)16384 : (size_t)HALF * g.ldb * 2;
    const size_t tstepA = g.tileA ? (size_t)(g.K / BK) * 32768 : 2 * hstepA, tstepB = g.tileB ? (size_t)(g.K / BK) * 32768 : 2 * hstepB;
    const unsigned ldsw = (unsigned)wid * 1024u;
    const int aoff = lds_byte(wr * 64 + fr, fq * 8), boff = lds_byte(wc * 32 + fr, fq * 8);
#define PG8_SA(b, h) (((b) * 2 + (h)) * HTB)
#define PG8_SB(b, h) ((4 + (b) * 2 + (h)) * HTB)
#define PG8_STAGE(bufoff, gbase, voff) do { _Pragma("unroll") for (int _i = 0; _i < 2; ++_i) \
        __builtin_amdgcn_global_load_lds((const unsigned*)((const char*)(gbase) + (voff)[_i]), (PG8_LAS unsigned*)(lds + (bufoff) + ldsw + _i * 8192), 16, 0, 0); } while (0)
#define PG8_LDA(dst, b, h) do { _Pragma("unroll") for (int m = 0; m < 4; ++m) _Pragma("unroll") for (int k = 0; k < 2; ++k) dst[m][k] = *(const PG8_LAS bf16x8*)(lds + PG8_SA(b, h) + aoff + m * 2048 + k * 1024); } while (0)
#define PG8_LDB(dst, b, h) do { _Pragma("unroll") for (int n = 0; n < 2; ++n) _Pragma("unroll") for (int k = 0; k < 2; ++k) dst[n][k] = *(const PG8_LAS bf16x8*)(lds + PG8_SB(b, h) + boff + n * 2048 + k * 1024); } while (0)
#define PG8_MMA(ai, bj, At, Bt) do { __builtin_amdgcn_s_setprio(1); _Pragma("unroll") for (int m = 0; m < 4; ++m) _Pragma("unroll") for (int n = 0; n < 2; ++n) _Pragma("unroll") for (int k = 0; k < 2; ++k) \
        acc[ai][bj][m][n] = __builtin_amdgcn_mfma_f32_16x16x32_bf16(Bt[n][k], At[m][k], acc[ai][bj][m][n], 0, 0, 0); __builtin_amdgcn_s_setprio(0); } while (0)
#define PG8_WAIT_V(n) asm volatile("s_waitcnt vmcnt(" #n ")" ::: "memory")
#define PG8_WAIT_L(n) asm volatile("s_waitcnt lgkmcnt(" #n ")" ::: "memory")
#define PG8_BAR __builtin_amdgcn_s_barrier()
#define PG8_SCHED __builtin_amdgcn_sched_barrier(0)
    Unit cur, nxt; int ui = 0;
    if (!S.next(0, cur)) return;
    f32x4 acc[2][2][4][2];
#pragma unroll
    for (int a = 0; a < 2; ++a)
#pragma unroll
        for (int b = 0; b < 2; ++b)
#pragma unroll
            for (int m = 0; m < 4; ++m)
#pragma unroll
                for (int n = 0; n < 2; ++n) acc[a][b][m][n] = (f32x4){0.f, 0.f, 0.f, 0.f};
    bf16x8 At[4][2], B0[2][2], B1[2][2];
    const char* cA = (const char*)g.A + (size_t)cur.pm * tstepA; const char* cB = (const char*)g.Bt + (size_t)cur.pn * tstepB;
    S.a_ready(cur);
    if constexpr (SP2) {
        PG8_STAGE(PG8_SB(0, 0), cB, voffB); PG8_STAGE(PG8_SB(0, 1), cB + hstepB, voffB); PG8_STAGE(PG8_SA(0, 0), cA, voffA); PG8_STAGE(PG8_SA(0, 1), cA + hstepA, voffA);
        if (wr == 1) PG8_BAR;
        PG8_WAIT_V(2); PG8_BAR;
        PG8_STAGE(PG8_SB(1, 0), cB + kstepB, voffB); PG8_STAGE(PG8_SA(1, 0), cA + kstepA, voffA); PG8_STAGE(PG8_SB(1, 1), cB + hstepB + kstepB, voffB);
        PG8_WAIT_V(6); PG8_BAR;
    } else {
        PG8_STAGE(PG8_SB(0, 0), cB, voffB); PG8_STAGE(PG8_SA(0, 0), cA, voffA); PG8_STAGE(PG8_SB(0, 1), cB + hstepB, voffB); PG8_STAGE(PG8_SA(0, 1), cA + hstepA, voffA);
        if (wr == 1) PG8_BAR;
        PG8_WAIT_V(4); PG8_BAR;
        PG8_STAGE(PG8_SB(1, 0), cB + kstepB, voffB); PG8_STAGE(PG8_SA(1, 0), cA + kstepA, voffA); PG8_STAGE(PG8_SB(1, 1), cB + hstepB + kstepB, voffB);
        PG8_WAIT_V(6); PG8_BAR;
    }
    for (;;) {
        const bool has_next = S.next(ui + 1, nxt);
        const char* nA = has_next ? (const char*)g.A + (size_t)nxt.pm * tstepA : cA; const char* nB = has_next ? (const char*)g.Bt + (size_t)nxt.pn * tstepB : cB;
        for (int t = 0; t < nt; t += 2) {
            const bool last = (t == nt - 2);
            const char* a1 = cA + (size_t)(t + 1) * kstepA;
            const char* a2 = last ? nA : cA + (size_t)(t + 2) * kstepA; const char* b2 = last ? nB : cB + (size_t)(t + 2) * kstepB;
            const char* a3 = a2 + kstepA; const char* b3 = b2 + kstepB;
            if (last && has_next) S.a_ready(nxt);
            if constexpr (SP2) {
            PG8_LDB(B0, 0, 0); PG8_LDB(B1, 0, 1); PG8_SCHED; PG8_LDA(At, 0, 0); PG8_STAGE(PG8_SA(1, 1), a1 + hstepA, voffA);
            PG8_WAIT_V(8); PG8_WAIT_L(0); PG8_BAR; PG8_MMA(0, 0, At, B0); PG8_MMA(0, 1, At, B1); PG8_BAR; PG8_SCHED;
            PG8_LDA(At, 0, 1); PG8_STAGE(PG8_SB(0, 0), b2, voffB); PG8_STAGE(PG8_SB(0, 1), b2 + hstepB, voffB); PG8_STAGE(PG8_SA(0, 0), a2, voffA);
            PG8_WAIT_V(8); PG8_WAIT_L(0); PG8_BAR; PG8_MMA(1, 0, At, B0); PG8_MMA(1, 1, At, B1); PG8_BAR; PG8_SCHED;
            PG8_LDB(B0, 1, 0); PG8_LDB(B1, 1, 1); PG8_SCHED; PG8_LDA(At, 1, 0); PG8_STAGE(PG8_SA(0, 1), a2 + hstepA, voffA);
            PG8_WAIT_V(8); PG8_WAIT_L(0); PG8_BAR; PG8_MMA(0, 0, At, B0); PG8_MMA(0, 1, At, B1); PG8_BAR; PG8_SCHED;
            PG8_LDA(At, 1, 1); PG8_STAGE(PG8_SB(1, 0), b3, voffB); PG8_STAGE(PG8_SB(1, 1), b3 + hstepB, voffB); PG8_STAGE(PG8_SA(1, 0), a3, voffA);
            PG8_WAIT_V(8); PG8_WAIT_L(0); PG8_BAR; PG8_MMA(1, 0, At, B0); PG8_MMA(1, 1, At, B1); PG8_BAR; PG8_SCHED;
            } else {
            PG8_LDB(B0, 0, 0); PG8_SCHED; PG8_LDA(At, 0, 0); PG8_STAGE(PG8_SA(1, 1), a1 + hstepA, voffA);
            PG8_WAIT_L(8); PG8_BAR; PG8_WAIT_L(0); PG8_MMA(0, 0, At, B0); PG8_BAR; PG8_SCHED;
            PG8_LDB(B1, 0, 1); PG8_STAGE(PG8_SB(0, 0), b2, voffB);
            PG8_BAR; PG8_WAIT_L(0); PG8_MMA(0, 1, At, B1); PG8_BAR;
            PG8_LDA(At, 0, 1); PG8_STAGE(PG8_SA(0, 0), a2, voffA);
            PG8_BAR; PG8_WAIT_L(0); PG8_MMA(1, 0, At, B0); PG8_BAR; PG8_SCHED;
            PG8_STAGE(PG8_SB(0, 1), b2 + hstepB, voffB);
            PG8_WAIT_V(6); PG8_BAR; PG8_MMA(1, 1, At, B1); PG8_BAR;
            PG8_LDB(B0, 1, 0); PG8_SCHED; PG8_LDA(At, 1, 0); PG8_STAGE(PG8_SA(0, 1), a2 + hstepA, voffA);
            PG8_WAIT_L(8); PG8_BAR; PG8_WAIT_L(0); PG8_MMA(0, 0, At, B0); PG8_BAR; PG8_SCHED;
            PG8_LDB(B1, 1, 1); PG8_STAGE(PG8_SB(1, 0), b3, voffB);
            PG8_BAR; PG8_WAIT_L(0); PG8_MMA(0, 1, At, B1); PG8_BAR;
            PG8_LDA(At, 1, 1); PG8_STAGE(PG8_SA(1, 0), a3, voffA);
            PG8_BAR; PG8_WAIT_L(0); PG8_MMA(1, 0, At, B0); PG8_BAR; PG8_SCHED;
            PG8_STAGE(PG8_SB(1, 1), b3 + hstepB, voffB);
            PG8_WAIT_V(6); PG8_BAR; PG8_MMA(1, 1, At, B1); PG8_BAR;
            }
        }
        if constexpr (ALIGN_EPI) { if (wr == 0) PG8_BAR; }
        if constexpr (!Epi::AFTER_DRAIN) { E(acc, cur, wr, wc, fr, fq); S.done(cur); }
        if (!has_next) break;
#pragma unroll
        for (int a = 0; a < 2; ++a)
#pragma unroll
            for (int b = 0; b < 2; ++b)
#pragma unroll
                for (int m = 0; m < 4; ++m)
#pragma unroll
                    for (int n = 0; n < 2; ++n) acc[a][b][m][n] = (f32x4){0.f, 0.f, 0.f, 0.f};
        cur = nxt; cA = nA; cB = nB; ++ui;
        if constexpr (ALIGN_EPI) { if (wr == 1) PG8_BAR; }
    }
    PG8_WAIT_V(0);
    if constexpr (!ALIGN_EPI) { if (wr == 0) PG8_BAR; }
    PG8_BAR;
    if constexpr (Epi::AFTER_DRAIN) { E.fused(acc, cur, wr, wc, fr, fq, lds, wid, lane); S.done(cur); }
#undef PG8_SA
#undef PG8_SB
#undef PG8_STAGE
#undef PG8_LDA
#undef PG8_LDB
#undef PG8_MMA
#undef PG8_WAIT_V
#undef PG8_WAIT_L
#undef PG8_BAR
#undef PG8_SCHED
}
}
#define GAS __attribute__((address_space(1)))
#define LAS __attribute__((address_space(3)))
typedef unsigned short bf16;
typedef unsigned v4u __attribute__((ext_vector_type(4)));
typedef float f32x4 __attribute__((ext_vector_type(4)));
typedef short bf16x8 __attribute__((ext_vector_type(8)));
typedef GAS unsigned gu32;
typedef GAS unsigned long long gu64;
#define RLX_AGENT __ATOMIC_RELAXED, __HIP_MEMORY_SCOPE_AGENT
#define LDS_WAIT() asm volatile("s_waitcnt lgkmcnt(0)" ::: "memory")
#define VM_WAIT() asm volatile("s_waitcnt vmcnt(0)" ::: "memory")
__device__ __forceinline__ unsigned long long rt() { return __builtin_amdgcn_s_memrealtime(); }
__device__ __forceinline__ unsigned f2bf(float f) { unsigned u = __builtin_bit_cast(unsigned, f); return (u + 0x7fffu + ((u >> 16) & 1u)) >> 16; }
__device__ __forceinline__ unsigned pk2(float lo, float hi) { return f2bf(lo) | (f2bf(hi) << 16); }

#define XB_TMO      128
#define XB_XCNT(j)  (256  + 64 * (j))
#define XB_XSUB(j)  (1280 + 64 * (j))
#define XB_XGEN(j)  (2304 + 64 * (j))
#define XB_TOP      3328
#define XB_TOPGEN   3392
#define XCD_BAR_WORDS 3456
#define XB_SPIN_CAP (1u << 24)

__device__ __forceinline__ unsigned xb_ld(unsigned* p)              { return __hip_atomic_load(p, __ATOMIC_RELAXED, __HIP_MEMORY_SCOPE_AGENT); }
__device__ __forceinline__ unsigned xb_add(unsigned* p, unsigned v) { return __hip_atomic_fetch_add(p, v, __ATOMIC_RELAXED, __HIP_MEMORY_SCOPE_AGENT); }
__device__ __forceinline__ unsigned xb_xcc_id() { return (unsigned)__builtin_amdgcn_s_getreg((3 << 11) | 20) & 0xFu; }
#define XB_SPIN(cond, bar) do { unsigned _sp = 0; while (cond) { __builtin_amdgcn_s_sleep(1); \
    if ((++_sp & 255u) == 0u) { if (xb_ld(&(bar)[XB_TMO])) break; if (_sp > XB_SPIN_CAP) { atomicAdd(&(bar)[XB_TMO], 1u); break; } } } } while (0)

__device__ __forceinline__ unsigned xb_lane() { unsigned l_; asm volatile("v_mbcnt_lo_u32_b32 %0, -1, 0\n\tv_mbcnt_hi_u32_b32 %0, -1, %0" : "=&v"(l_)); return l_; }
struct XcdBarrier {
    unsigned* bar; unsigned x; unsigned w;
    volatile LAS unsigned* st;
};

__device__ __forceinline__ XcdBarrier xcd_barrier_post(unsigned* bar, volatile LAS unsigned* st) {
    XcdBarrier b; b.bar = bar; b.x = xb_xcc_id(); b.st = st; b.w = (unsigned)__builtin_amdgcn_readfirstlane(threadIdx.x >> 6);
    if (threadIdx.x == 0) (void)xb_add(&bar[XB_XCNT(b.x)], 1u);
    return b;
}
__device__ __forceinline__ void xcd_barrier_complete(unsigned* bar, unsigned x, unsigned& nloc, unsigned& nx) {
    const unsigned G = gridDim.x * gridDim.y * gridDim.z;
    unsigned sum, cnt, mine, sp = 0u;
    for (;;) {
        sum = 0u; cnt = 0u; mine = 0u;
#pragma unroll
        for (unsigned j = 0; j < 16; ++j) { const unsigned c = xb_ld(&bar[XB_XCNT(j)]); sum += c; cnt += (c > 0u) ? 1u : 0u; mine = (j == x) ? c : mine; }
        if (sum == G) break;
        __builtin_amdgcn_s_sleep(1);
        if ((++sp & 255u) == 0u) { if (xb_ld(&bar[XB_TMO])) break; if (sp > XB_SPIN_CAP) { atomicAdd(&bar[XB_TMO], 1u); break; } }
    }
    nloc = mine > 0u ? mine : 1u; nx = cnt > 0u ? cnt : 1u;
}

__device__ __forceinline__ void xcd_barrier(const XcdBarrier& b) {
    asm volatile("s_waitcnt vmcnt(0)" ::: "memory");
    __syncthreads();
    if (b.w == 0u && xb_lane() == 0u) {
        unsigned* bar = b.bar;
        __builtin_amdgcn_s_waitcnt(0);
        unsigned nloc = b.st[0], nx = b.st[1];
        if (nloc == 0u) { xcd_barrier_complete(bar, b.x, nloc, nx); b.st[0] = nloc; b.st[1] = nx; }
        const unsigned old = xb_add(&bar[XB_XSUB(b.x)], 1u);
        const unsigned gen = old / nloc;
        if (old + 1u == (gen + 1u) * nloc) {
            __builtin_amdgcn_fence(__ATOMIC_RELEASE, "agent");
            asm volatile("s_waitcnt vmcnt(0)" ::: "memory");
            const unsigned og = xb_add(&bar[XB_TOP], 1u);
            const unsigned tg = og / nx;
            if (og + 1u == (tg + 1u) * nx) xb_add(&bar[XB_TOPGEN], 1u);
            else XB_SPIN(xb_ld(&bar[XB_TOPGEN]) == tg, bar);
            __builtin_amdgcn_fence(__ATOMIC_ACQUIRE, "agent");
            xb_add(&bar[XB_XGEN(b.x)], 1u);
            asm volatile("s_waitcnt vmcnt(0)" ::: "memory");
        } else {
            XB_SPIN(xb_ld(&bar[XB_XGEN(b.x)]) == gen, bar);
            __builtin_amdgcn_fence(__ATOMIC_ACQUIRE, "agent");
            asm volatile("s_waitcnt vmcnt(0)" ::: "memory");
        }
    }
    __syncthreads();
}
#ifndef PROBE_MASK
#define PROBE_MASK 0
#endif

constexpr int T = 4096, NBATCH = 2, MPROMPT = 8192, MSAMP = 128, MREAL = 8320, MPAD = 8448;
constexpr int DM = 2048, DG = 1024, DQ = 1024, DFF = 8192, NIN = 8728, NINP = 8960;
constexpr int PASTLEN = 2048;
constexpr float EPS = 1e-6f;
constexpr float LOG2E = 1.4426950408889634f;
constexpr float QSCALE = 0.08838834764831845f * 1.4426950408889634f;
constexpr int NWAVES = 8;
constexpr int LD2 = DM + 64, LD1 = DG + 64, LD8 = DFF + 64;

constexpr size_t O_YP = 0, O_YS = 16777216, O_PCMP = O_YS + 262144, O_PSEL = O_PCMP + 4194304, O_PWIN = O_PSEL + 4194304,
                 O_PSGU = O_PWIN + 524288, O_SCMP = O_PSGU + 262144, O_SSEL = O_SCMP + 65536, O_SWIN = O_SSEL + 65536,
                 O_SSGU = O_SWIN + 33554432, O_END = O_SSGU + 131072;
static_assert(O_END == 60030976, "output size");

constexpr size_t MiB = 1ull << 20;
constexpr size_t al(size_t x) { return (x + MiB - 1) / MiB * MiB; }
constexpr size_t WS_CTL = 0, CTL_ZERO_BYTES = 1 * MiB;
constexpr size_t WS_WIN  = 1 * MiB;
constexpr size_t WS_WG   = WS_WIN  + al((size_t)NINP * LD2 * 2);
constexpr size_t WS_WN   = WS_WG   + al((size_t)DM * LD1 * 2);
constexpr size_t WS_WO   = WS_WN   + al((size_t)DM * LD1 * 2);
constexpr size_t WS_WUP  = WS_WO   + al((size_t)DM * LD2 * 2);
constexpr size_t WS_WDN  = WS_WUP  + al((size_t)DFF * LD2 * 2);
constexpr size_t WS_WC   = WS_WDN  + al((size_t)DM * LD8 * 2);
constexpr size_t WS_XB   = WS_WC   + al((size_t)512 * LD2 * 2);
constexpr size_t WS_RSTD1= WS_XB   + al((size_t)MPAD * LD2 * 2);
constexpr size_t WS_U    = WS_RSTD1+ al((size_t)MPAD * 4);
constexpr size_t WS_VG   = WS_U    + al((size_t)MPAD * DG * 2);
constexpr size_t WS_VSS  = WS_VG   + al((size_t)MPAD * DG * 2);
constexpr size_t WS_RSTDV= WS_VSS  + al((size_t)MPAD * 32 * 4);
constexpr size_t WS_QRAW = WS_RSTDV+ al((size_t)MPAD * 4);
constexpr size_t WS_KVWR = WS_QRAW + al((size_t)MPAD * DQ * 4);
constexpr size_t WS_GA   = WS_KVWR + al((size_t)MPAD * 512 * 4);
constexpr size_t WS_GB   = WS_GA   + al((size_t)MPAD * DM * 2);
constexpr size_t WS_GN   = WS_GB   + al((size_t)MPAD * DM * 2);
constexpr size_t WS_QN   = WS_GN   + al((size_t)MPAD * 32 * 4);
constexpr size_t WS_KS   = WS_QN   + al((size_t)MPAD * DQ * 2);
constexpr size_t WS_VS   = WS_KS   + 4 * MiB;
constexpr size_t WS_KW   = WS_VS   + 4 * MiB;
constexpr size_t WS_VW   = WS_KW   + 4 * MiB;
constexpr size_t WS_ACP  = WS_VW   + 4 * MiB;
constexpr size_t WS_ACS  = WS_ACP  + al((size_t)2048 * LD2 * 2);
constexpr size_t WS_YCP  = WS_ACS  + al((size_t)65536 * LD2 * 2);
constexpr size_t WS_YCS  = WS_YCP  + 2 * MiB;
constexpr size_t WS_KCP  = WS_YCS  + 64 * MiB;
constexpr size_t WS_VCP  = WS_KCP  + 1 * MiB;
constexpr size_t WS_KCS  = WS_VCP  + 1 * MiB;
constexpr size_t WS_VCS  = WS_KCS  + 8 * MiB;
constexpr size_t WS_CBP  = WS_VCS  + 8 * MiB;
constexpr size_t WS_WMB  = WS_CBP  + 1 * MiB;
constexpr size_t WS_BLUT = WS_WMB  + 1 * MiB;
constexpr size_t WS_OA   = WS_BLUT + 1 * MiB;
constexpr size_t WS_OB   = WS_OA   + al((size_t)MPAD * LD1 * 2);
constexpr size_t WS_MIXA = WS_OB   + al((size_t)MPAD * LD1 * 2);
constexpr size_t WS_MIX  = WS_MIXA + al((size_t)MPAD * DM * 2);
constexpr size_t WS_X1B  = WS_MIX  + al((size_t)MPAD * LD2 * 2);
constexpr size_t WS_X1F  = WS_X1B  + al((size_t)MPAD * LD2 * 2);
constexpr size_t WS_X1SS = WS_X1F  + al((size_t)128 * DM * 4);
constexpr size_t WS_H    = WS_X1SS + al((size_t)MPAD * 32 * 4);
constexpr size_t WS_OT   = WS_H    + al((size_t)MPAD * LD8 * 2);
constexpr size_t WS_SPART= WS_OT   + 32 * MiB;
constexpr int LDS_X = DM + 64, LDS_G = DG + 64, LDS_H = DFF + 64;
constexpr size_t WS_SXB  = WS_SPART+ 4 * MiB;
constexpr size_t WS_SOA  = WS_SXB  + 1 * MiB;
constexpr size_t WS_SOB  = WS_SOA  + 1 * MiB;
constexpr size_t WS_SMIX = WS_SOB  + 1 * MiB;
constexpr size_t WS_SX1B = WS_SMIX + 1 * MiB;
constexpr size_t WS_SH   = WS_SX1B + 1 * MiB;
constexpr size_t WS_DUMMY= WS_SH   + 3 * MiB;
constexpr size_t WS_END  = WS_DUMMY+ 72 * MiB;

constexpr int CW_TMO = 0, CW_CODE = 1;
constexpr int CW_BAR = 4096;
constexpr int CW_Q5 = 8192;
constexpr int CW_FLAG = 16384;
constexpr int CW_TICK = 65536;
static_assert((CW_TICK + 64 * 64) * 4 <= (int)CTL_ZERO_BYTES && (CW_BAR + 16 * 3456) * 4 <= (int)CTL_ZERO_BYTES, "CTL words inside the memset region");

constexpr int RING_OFF = 0, RING_BYTES = 131072;
constexpr int LDSCTL_OFF = RING_BYTES, MISC_OFF = LDSCTL_OFF + 320;
constexpr int LDS_BYTES = 147456;
static_assert(MISC_OFF + 128 <= LDS_BYTES, "LDS map");

__constant__ unsigned char kBkt[128] = {0, 1, 2, 3, 4, 5, 6, 7, 8, 9, 10, 11, 12, 13, 14, 15, 16, 16, 16, 17, 17, 18, 18, 18, 19, 19, 19, 20, 20, 20, 20, 21, 21, 21, 21, 22, 22, 22, 22, 22, 23, 23, 23, 23, 23, 23, 24, 24, 24, 24, 24, 24, 25, 25, 25, 25, 25, 25, 25, 26, 26, 26, 26, 26, 26, 26, 26, 27, 27, 27, 27, 27, 27, 27, 27, 27, 27, 28, 28, 28, 28, 28, 28, 28, 28, 28, 28, 29, 29, 29, 29, 29, 29, 29, 29, 29, 29, 29, 29, 30, 30, 30, 30, 30, 30, 30, 30, 30, 30, 30, 30, 30, 30, 31, 31, 31, 31, 31, 31, 31, 31, 31, 31, 31, 31, 31, 31, 31};

__host__ __device__ __forceinline__ size_t tm_idx(int row, int col, int nkt) { return ((size_t)((row >> 8) * nkt + (col >> 6)) * 256 + (row & 255)) * 64 + (col & 63); }

typedef unsigned v2u __attribute__((ext_vector_type(2)));
struct Ctx {
    const float* const* in; float* out; unsigned char* ws;
    LAS unsigned char* lds;
    int tid, lane, wave, vcu, G;
};
__device__ __forceinline__ int lane_now() { int l_; asm volatile("v_mbcnt_lo_u32_b32 %0, -1, 0\n\tv_mbcnt_hi_u32_b32 %0, -1, %0" : "=&v"(l_) : : "memory"); return l_; }
__device__ __forceinline__ Ctx fresh(const Ctx& C) { Ctx L = C; const int l_ = lane_now(); L.lane = l_; L.tid = C.wave * 64 + l_; return L; }
#define IN_XP 0
#define IN_XS 1
#define IN_CCMP 2
#define IN_CSEL 3
#define IN_WINB 4
#define IN_PT 5
#define IN_RELB 6
#define IN_GMIX 7
#define IN_WIN 8
#define IN_GSGU 9
#define IN_WSGU 10
#define IN_BSGU 11
#define IN_GQ 12
#define IN_GK 13
#define IN_POSK 14
#define IN_WCK 15
#define IN_POSV 16
#define IN_WCV 17
#define IN_WPG 18
#define IN_WPN 19
#define IN_WOUT 20
#define IN_GMLP 21
#define IN_WUP 22
#define IN_WDN 23

__device__ __forceinline__ float bf2f(unsigned short b) { return __uint_as_float((unsigned)b << 16); }
__device__ __forceinline__ float bflo(unsigned w) { return __uint_as_float(w << 16); }
__device__ __forceinline__ float bfhi(unsigned w) { return __uint_as_float(w & 0xffff0000u); }
__device__ __forceinline__ void unpack8(v4u w, float (&f)[8]) {
    f[0] = bflo(w.x); f[1] = bfhi(w.x); f[2] = bflo(w.y); f[3] = bfhi(w.y); f[4] = bflo(w.z); f[5] = bfhi(w.z); f[6] = bflo(w.w); f[7] = bfhi(w.w);
}
__device__ __forceinline__ v4u pack8f(const float (&f)[8]) { v4u w; w.x = pk2(f[0], f[1]); w.y = pk2(f[2], f[3]); w.z = pk2(f[4], f[5]); w.w = pk2(f[6], f[7]); return w; }
__device__ __forceinline__ float wave_sum(float v) {
#pragma unroll
    for (int o = 1; o < 64; o <<= 1) v += __shfl_xor(v, o);
    return v;
}
__device__ __forceinline__ float wave_max(float v) {
#pragma unroll
    for (int o = 1; o < 64; o <<= 1) v = fmaxf(v, __shfl_xor(v, o));
    return v;
}
__device__ __forceinline__ float sigmoidf_(float x) { return 1.0f / (1.0f + __expf(-x)); }
__device__ __forceinline__ float gelu_tanh(float x) {
    const float u = 0.7978845608028654f * (x + 0.044715f * x * x * x);
    return x / (1.0f + __expf(-2.0f * u));
}

__device__ __forceinline__ void tr_item(const float* W, int ldw, int srccol0, int nvalid, const float* kscale, bf16* WT, int nkt, int dst_row0, int k0, LAS float* scr, int lane) {
    const int n = lane & 31;
    float vv[32];
#pragma unroll
    for (int i = 0; i < 32; ++i) { const int kk = 2 * i + (lane >> 5); vv[i] = (n < nvalid) ? __builtin_nontemporal_load(W + (size_t)(k0 + kk) * ldw + srccol0 + n) : 0.f; }
    if (kscale) {
#pragma unroll
        for (int i = 0; i < 32; ++i) vv[i] *= kscale[k0 + 2 * i + (lane >> 5)]; }
#pragma unroll
    for (int i = 0; i < 32; ++i) scr[(2 * i + (lane >> 5)) * 33 + n] = vv[i];
    LDS_WAIT(); asm volatile("" ::: "memory");
    const int c = lane & 7;
#pragma unroll
    for (int j = 0; j < 4; ++j) { const int nn = (lane >> 3) + 8 * j; const LAS float* s = scr + (8 * c) * 33 + nn;
        v4u o; o.x = pk2(s[0 * 33], s[1 * 33]); o.y = pk2(s[2 * 33], s[3 * 33]); o.z = pk2(s[4 * 33], s[5 * 33]); o.w = pk2(s[6 * 33], s[7 * 33]);
        { const int n_ = dst_row0 + nn; *(GAS v4u*)(WT + ((size_t)((n_ >> 8) * nkt + (k0 >> 6)) * 256 + (n_ & 255)) * 64 + 8 * c) = o; } }
    LDS_WAIT(); asm volatile("" ::: "memory");
}

constexpr int I_IN = 32 * 280, I_PG = 16 * 64, I_PN = 16 * 64, I_OUT = 32 * 64, I_UP = 32 * 256, I_DN = 128 * 64, I_C = 4 * 128;
constexpr int I_LATE = I_PG + I_PN + I_OUT + I_UP + I_DN;
__device__ __forceinline__ void w_item_in(const Ctx& C, int r, LAS float* scr) {
    const int kb = r / 280, nb = r % 280, n0 = nb * 32;
    const int src = n0 < 4608 ? n0 : (n0 < 8704 ? n0 + 24 : n0 - 8704 + 4608);
    const int nv = n0 < 8704 ? 32 : (n0 == 8704 ? 24 : 0);
    tr_item(C.in[IN_WIN], NIN, src, nv, C.in[IN_GMIX], (bf16*)(C.ws + WS_WIN), DM / 64, n0, kb * 64, scr, C.lane);
}
__device__ __forceinline__ void w_item_cmp(const Ctx& C, int r, LAS float* scr) {
    const int sub = r / 128, rr = r % 128, kv = sub >> 1, hf = sub & 1, kb = rr / 4, nb = rr % 4;
    const float* W = (kv ? C.in[IN_WCV] : C.in[IN_WCK]) + (size_t)hf * 2048 * 128;
    tr_item(W, 128, nb * 32, 32, nullptr, (bf16*)(C.ws + WS_WC), 2048 / 64, kv * 256 + hf * 128 + nb * 32, kb * 64, scr, C.lane);
}
__device__ __forceinline__ void w_item_late(const Ctx& C, int r, LAS float* scr) {
    unsigned char* ws = C.ws; const int lane = C.lane;
    if (r < I_PG) { const int kb = r / 64, nb = r % 64; tr_item(C.in[IN_WPG], DM, nb * 32, 32, nullptr, (bf16*)(ws + WS_WG), DG / 64, nb * 32, kb * 64, scr, lane); return; } r -= I_PG;
    if (r < I_PN) { const int kb = r / 64, nb = r % 64; tr_item(C.in[IN_WPN], DM, nb * 32, 32, nullptr, (bf16*)(ws + WS_WN), DQ / 64, nb * 32, kb * 64, scr, lane); return; } r -= I_PN;
    if (r < I_OUT) { const int kb = r / 64, nb = r % 64; tr_item(C.in[IN_WOUT], DM, nb * 32, 32, nullptr, (bf16*)(ws + WS_WO), DM / 64, nb * 32, kb * 64, scr, lane); return; } r -= I_OUT;
    if (r < I_UP) { const int kb = r / 256, nb = r % 256; tr_item(C.in[IN_WUP], DFF, nb * 32, 32, C.in[IN_GMLP], (bf16*)(ws + WS_WUP), DM / 64, nb * 32, kb * 64, scr, lane); return; } r -= I_UP;
    { const int kb = r / 64, nb = r % 64; tr_item(C.in[IN_WDN], DM, nb * 32, 32, nullptr, (bf16*)(ws + WS_WDN), DFF / 64, nb * 32, kb * 64, scr, lane); }
}
__device__ __forceinline__ void gather_item(const Ctx& C, int it) {
    const int lane = C.lane, kvg = lane >> 4, d = (lane & 15) * 8;
    const int b = it >> 7, p = (it >> 3) & 15, sg = it & 7, page = ((const int*)C.in[IN_PT])[b * 16 + p], j = p * 8 + sg;
    const float* src = C.in[IN_CCMP] + ((size_t)page * 128 + sg * 16) * 512 + lane * 8;
    bf16* dst = (bf16*)(C.ws + WS_ACS) + (size_t)((b * 4 + kvg) * 128 + j) * LD2 + d;
#pragma unroll
    for (int h = 0; h < 2; ++h) { f32x4 a[8], c2[8];
#pragma unroll
        for (int s = 0; s < 8; ++s) { a[s] = __builtin_nontemporal_load((const GAS f32x4*)(src + (h * 8 + s) * 512)); c2[s] = __builtin_nontemporal_load((const GAS f32x4*)(src + (h * 8 + s) * 512 + 4)); }
#pragma unroll
        for (int s = 0; s < 8; ++s) { v4u o; o.x = pk2(a[s].x, a[s].y); o.y = pk2(a[s].z, a[s].w); o.z = pk2(c2[s].x, c2[s].y); o.w = pk2(c2[s].z, c2[s].w);
            *(GAS v4u*)(dst + (h * 8 + s) * 128) = o; } }
}
constexpr int WINCOPY_F4 = 128 * 65408, WINCOPY_CHUNK = 16384, WINCOPY_ITEMS = (WINCOPY_F4 + WINCOPY_CHUNK - 1) / WINCOPY_CHUNK;
__device__ __forceinline__ void wincopy_item(const Ctx& C, int chunk) {
    const GAS f32x4* src = (const GAS f32x4*)C.in[IN_WINB]; GAS f32x4* dst = (GAS f32x4*)(C.out + O_SWIN);
    const int base = chunk * WINCOPY_CHUNK + C.tid;
#pragma unroll
    for (int h = 0; h < 2; ++h) { f32x4 v[16];
#pragma unroll
        for (int k = 0; k < 16; ++k) { const int i = base + (h * 16 + k) * NWAVES * 64; if (i < WINCOPY_F4) { const int b = i / 65408, r = i - b * 65408; v[k] = __builtin_nontemporal_load(src + b * 65536 + 128 + r); } }
#pragma unroll
        for (int k = 0; k < 16; ++k) { const int i = base + (h * 16 + k) * NWAVES * 64; if (i < WINCOPY_F4) { const int b = i / 65408, r = i - b * 65408; __builtin_nontemporal_store(v[k], dst + b * 65536 + r); } } }
}

__device__ __forceinline__ void p0_prologue(const Ctx& C) {
    unsigned char* ws = C.ws;
    LAS float* scr = (LAS float*)(C.lds + RING_OFF + C.wave * 16384);
    const int gw = C.vcu * NWAVES + C.wave, NGW = C.G * NWAVES, lane = C.lane;
    for (int rep = 0; rep < (((PROBE_MASK >> 10) & 1) ? 2 : 1); ++rep)
    for (int it = gw; it < I_IN + I_C; it += NGW) { if (it < I_IN) w_item_in(C, it, scr); else w_item_cmp(C, it - I_IN, scr); }
    {
        bf16* XB = (bf16*)(ws + WS_XB); float* RS = (float*)(ws + WS_RSTD1);
        for (int rep = 0; rep < (((PROBE_MASK >> 12) & 1) ? 2 : 1); ++rep)
        for (int m = gw; m < MREAL; m += NGW) {
            const bool pr_ = m < MPROMPT;
            GAS v2u* o8 = pr_ ? (GAS v2u*)(XB + tm_idx(m, 4 * (lane & 15), DM / 64)) + 0 : (GAS v2u*)((bf16*)(ws + WS_SXB) + (size_t)(m - MPROMPT) * LDS_X) + lane;
            const float* xr = m < MPROMPT ? C.in[IN_XP] + (size_t)m * DM : C.in[IN_XS] + (size_t)(m - MPROMPT) * DM;
            const GAS f32x4* x4 = (const GAS f32x4*)xr + lane; f32x4 v[8]; float s = 0.f;
#pragma unroll
            for (int j = 0; j < 8; ++j) { v[j] = x4[64 * j]; s += (v[j].x * v[j].x + v[j].y * v[j].y) + (v[j].z * v[j].z + v[j].w * v[j].w); }
            s = wave_sum(s);
#pragma unroll
            for (int j = 0; j < 8; ++j) o8[pr_ ? (size_t)((lane >> 4) + 4 * j) * 4096 : (size_t)64 * j] = (v2u){pk2(v[j].x, v[j].y), pk2(v[j].z, v[j].w)};
            if (lane == 0) RS[m] = rsqrtf(s * (1.0f / DM) + EPS);
        }
    }
    {
        float* CBP = (float*)(ws + WS_CBP);
        for (int it = gw; it < 64; it += NGW) { const int kv = it >> 5, eb = (it >> 4) & 1, kc = it & 15, e = eb * 64 + lane;
            const float* pos = kv ? C.in[IN_POSV] : C.in[IN_POSK]; const float* W = kv ? C.in[IN_WCV] : C.in[IN_WCK]; float a = 0.f;
#pragma unroll 8
            for (int k = kc * 256; k < kc * 256 + 256; ++k) a += pos[k] * W[(size_t)k * 128 + e];
            CBP[(kv * 16 + kc) * 128 + e] = a; }
    }
    {
        const float* w = C.in[IN_WSGU]; bf16* WMB = (bf16*)(ws + WS_WMB);
        for (int i = gw * 64 + lane; i < 8 * 128 * 128 / 8; i += NGW * 64) { const int e0 = i * 8, t = (e0 >> 7) & 127, s0 = e0 & 127; float f[8];
#pragma unroll
            for (int k = 0; k < 8; ++k) f[k] = (s0 + k <= t) ? w[e0 + k] : 0.f;
            *(GAS v4u*)(WMB + e0) = pack8f(f); }
        float* BL = (float*)(ws + WS_BLUT); const float* rb = C.in[IN_RELB];
        for (int i = gw * 64 + lane; i < 8 * 132; i += NGW * 64) { const int h = i / 132, rel = i % 132; const int bk = rel < 128 ? kBkt[rel] : 31; BL[i] = rb[bk * 8 + h] * LOG2E; }
    }
}

namespace epi {
using pg8::f32x4; using pg8::Unit; using pg8::cvt_pk_bf16;
typedef unsigned u32x4 __attribute__((ext_vector_type(4)));
__device__ __forceinline__ u32x4 pack8v(f32x4 a, f32x4 b) { u32x4 w; w.x = cvt_pk_bf16(a[0], a[1]); w.y = cvt_pk_bf16(a[2], a[3]); w.z = cvt_pk_bf16(b[0], b[1]); w.w = cvt_pk_bf16(b[2], b[3]); return w; }

struct EpiIn {
    static constexpr bool PERM = true, AFTER_DRAIN = false;
    const float* rstd; bf16* U; bf16* VG; float* VSS; float* QRAW; float* KVWR; bf16* GA; bf16* GB; float* GN; float* out; bf16* ACP;
    __device__ __forceinline__ void operator()(const f32x4 (&acc)[2][2][4][2], const Unit& u, int wr, int wc, int fr, int fq) const {
        const int row0 = u.pm * 256 + wr * 64 + fr, cl = wc * 32 + 8 * fq, pn = u.pn;
#pragma unroll
        for (int ai = 0; ai < 2; ++ai)
#pragma unroll
            for (int m = 0; m < 4; ++m) { const int row = row0 + ai * 128 + m * 16; const float rs = rstd[row];
#pragma unroll
                for (int bj = 0; bj < 2; ++bj) { f32x4 v0 = acc[ai][bj][m][0] * rs, v1 = acc[ai][bj][m][1] * rs; const int c = cl + bj * 128;
                    if (pn < 8) {
#pragma unroll
                        for (int k = 0; k < 4; ++k) { v0[k] = gelu_tanh(v0[k]); v1[k] = gelu_tanh(v1[k]); }
                        if (pn < 4) *(u32x4*)(U + (size_t)row * DG + pn * 256 + c) = pack8v(v0, v1);
                        else { *(u32x4*)(VG + (size_t)row * DG + (pn - 4) * 256 + c) = pack8v(v0, v1);
                            float ss = (v0[0] * v0[0] + v0[1] * v0[1]) + (v0[2] * v0[2] + v0[3] * v0[3]) + (v1[0] * v1[0] + v1[1] * v1[1]) + (v1[2] * v1[2] + v1[3] * v1[3]);
                            ss += __shfl_xor(ss, 16); ss += __shfl_xor(ss, 32);
                            if (fq == 0) VSS[(size_t)row * 32 + (pn - 4) * 8 + bj * 4 + wc] = ss; }
                    } else if (pn < 12) { float* q = QRAW + (size_t)row * DQ + (pn - 8) * 256 + c; *(f32x4*)q = v0; *(f32x4*)(q + 4) = v1;
                    } else if (pn < 16) {
                        const int cc = ((pn - 12) & 1) * 256 + c; float* o = nullptr;
                        if (row < MPROMPT) o = out + (pn < 14 ? O_PCMP : O_PSEL) + (size_t)row * 512 + cc;
                        else if (row < MREAL) o = out + (pn < 14 ? O_SCMP : O_SSEL) + (size_t)(row - MPROMPT) * 512 + cc;
                        if (o) { *(f32x4*)o = v0; *(f32x4*)(o + 4) = v1; }
                        if (pn < 14 && row < MPROMPT) {
                            const int b_ = row >> 12, t_ = row & 4095;
                            *(u32x4*)(ACP + tm_idx(((b_ * 2 + (cc >> 8)) * 2 + ((cc >> 7) & 1)) * 256 + (t_ >> 4), (t_ & 15) * 128 + (cc & 127), 2048 / 64)) = pack8v(v0, v1); }
                    } else if (pn < 18) { float* o = KVWR + (size_t)row * 512 + (pn - 16) * 256 + c; *(f32x4*)o = v0; *(f32x4*)(o + 4) = v1;
                    } else if (pn < 34) {
#pragma unroll
                        for (int k = 0; k < 4; ++k) { v0[k] = sigmoidf_(v0[k]); v1[k] = sigmoidf_(v1[k]); }
                        bf16* g = (pn < 26 ? GA + (size_t)row * DM + (pn - 18) * 256 : GB + (size_t)row * DM + (pn - 26) * 256) + c; *(u32x4*)g = pack8v(v0, v1);
                    } else { if (c < 24) {
#pragma unroll
                        for (int k = 0; k < 4; ++k) { v0[k] = sigmoidf_(v0[k]); v1[k] = sigmoidf_(v1[k]); }
                        float* o = GN + (size_t)row * 32 + c; *(f32x4*)o = v0; *(f32x4*)(o + 4) = v1; } }
                } }
    }
};
struct EpiCmp {
    static constexpr bool PERM = false, AFTER_DRAIN = false;
    float* YC; int segmask;
    __device__ __forceinline__ void operator()(const f32x4 (&acc)[2][2][4][2], const Unit& u, int wr, int wc, int fr, int fq) const {
        const int row0 = u.pm * 256 + wr * 64 + fr, cl = wc * 32 + 4 * fq;
#pragma unroll
        for (int ai = 0; ai < 2; ++ai)
#pragma unroll
            for (int m = 0; m < 4; ++m) { const int row = row0 + ai * 128 + m * 16;
#pragma unroll
                for (int n = 0; n < 2; ++n) { *(f32x4*)(YC + (size_t)row * 256 + cl + n * 16) = acc[ai][0][m][n];
                    if ((row & segmask) != 0) *(f32x4*)(YC + (size_t)(row - 1) * 256 + 128 + cl + n * 16) = acc[ai][1][m][n]; } }
    }
};
struct EpiMixA {
    static constexpr bool PERM = true, AFTER_DRAIN = false;
    const bf16* GA; bf16* MIXA;
    __device__ __forceinline__ void operator()(const f32x4 (&acc)[2][2][4][2], const Unit& u, int wr, int wc, int fr, int fq) const {
        const int row0 = u.pm * 256 + wr * 64 + fr, c0 = u.pn * 256 + wc * 32 + 8 * fq;
#pragma unroll
        for (int ai = 0; ai < 2; ++ai) { v4u gv[4][2];
#pragma unroll
            for (int m = 0; m < 4; ++m)
#pragma unroll
                for (int bj = 0; bj < 2; ++bj) gv[m][bj] = *(const v4u*)(GA + (size_t)(row0 + ai * 128 + m * 16) * DM + c0 + bj * 128);
#pragma unroll
            for (int m = 0; m < 4; ++m) { const size_t ro = (size_t)(row0 + ai * 128 + m * 16) * DM;
#pragma unroll
                for (int bj = 0; bj < 2; ++bj) { const size_t o = ro + c0 + bj * 128; float g[8]; unpack8(gv[m][bj], g);
                    f32x4 v0 = acc[ai][bj][m][0], v1 = acc[ai][bj][m][1];
                    v0[0] *= g[0]; v0[1] *= g[1]; v0[2] *= g[2]; v0[3] *= g[3]; v1[0] *= g[4]; v1[1] *= g[5]; v1[2] *= g[6]; v1[3] *= g[7];
                    *(u32x4*)(MIXA + o) = pack8v(v0, v1); } } }
    }
};
struct EpiMixB {
    static constexpr bool PERM = true, AFTER_DRAIN = false;
    const bf16* GB; const bf16* MIXA; bf16* MIX;
    __device__ __forceinline__ void operator()(const f32x4 (&acc)[2][2][4][2], const Unit& u, int wr, int wc, int fr, int fq) const {
        const int row0 = u.pm * 256 + wr * 64 + fr, c0 = u.pn * 256 + wc * 32 + 8 * fq;
#pragma unroll
        for (int ai = 0; ai < 2; ++ai) { v4u gv[4][2], av[4][2];
#pragma unroll
            for (int m = 0; m < 4; ++m)
#pragma unroll
                for (int bj = 0; bj < 2; ++bj) { const size_t o = (size_t)(row0 + ai * 128 + m * 16) * DM + c0 + bj * 128; gv[m][bj] = *(const v4u*)(GB + o); av[m][bj] = *(const v4u*)(MIXA + o); }
#pragma unroll
            for (int m = 0; m < 4; ++m)
#pragma unroll
                for (int bj = 0; bj < 2; ++bj) { float g[8], a[8]; unpack8(gv[m][bj], g); unpack8(av[m][bj], a);
                    f32x4 v0 = acc[ai][bj][m][0], v1 = acc[ai][bj][m][1];
                    v0[0] = a[0] + v0[0] * g[0]; v0[1] = a[1] + v0[1] * g[1]; v0[2] = a[2] + v0[2] * g[2]; v0[3] = a[3] + v0[3] * g[3];
                    v1[0] = a[4] + v1[0] * g[4]; v1[1] = a[5] + v1[1] * g[5]; v1[2] = a[6] + v1[2] * g[6]; v1[3] = a[7] + v1[3] * g[7];
                    *(u32x4*)(MIX + tm_idx(row0 + ai * 128 + m * 16, c0 + bj * 128, DM / 64)) = pack8v(v0, v1); } }
    }
};
struct EpiOut {
    static constexpr bool PERM = true, AFTER_DRAIN = false;
    const float* xp; const float* xs; float* out; bf16* X1B; float* SS;
    __device__ __forceinline__ void operator()(const f32x4 (&acc)[2][2][4][2], const Unit& u, int wr, int wc, int fr, int fq) const {
        const int row0 = u.pm * 256 + wr * 64 + fr, c0 = u.pn * 256 + wc * 32 + 8 * fq;
#pragma unroll
        for (int ai = 0; ai < 2; ++ai) { f32x4 xv[4][2][2];
#pragma unroll
            for (int m = 0; m < 4; ++m)
#pragma unroll
                for (int bj = 0; bj < 2; ++bj) { const float* xr = xp + (size_t)(row0 + ai * 128 + m * 16) * DM + c0 + bj * 128; xv[m][bj][0] = *(const f32x4*)xr; xv[m][bj][1] = *(const f32x4*)(xr + 4); }
#pragma unroll
            for (int m = 0; m < 4; ++m) { const int row = row0 + ai * 128 + m * 16; float ss = 0.f;
#pragma unroll
                for (int bj = 0; bj < 2; ++bj) { const int c = c0 + bj * 128; const f32x4 v0 = acc[ai][bj][m][0] + xv[m][bj][0], v1 = acc[ai][bj][m][1] + xv[m][bj][1];
                    *(u32x4*)(X1B + tm_idx(row, c, DM / 64)) = pack8v(v0, v1);
                    ss += (v0[0] * v0[0] + v0[1] * v0[1]) + (v0[2] * v0[2] + v0[3] * v0[3]) + (v1[0] * v1[0] + v1[1] * v1[1]) + (v1[2] * v1[2] + v1[3] * v1[3]); }
                ss += __shfl_xor(ss, 16); ss += __shfl_xor(ss, 32);
                if (fq == 0) SS[(size_t)row * 32 + u.pn * 4 + wc] = ss; } }
    }
};
struct EpiUp {
    static constexpr bool PERM = true, AFTER_DRAIN = false;
    const float* SS; bf16* H;
    __device__ __forceinline__ void operator()(const f32x4 (&acc)[2][2][4][2], const Unit& u, int wr, int wc, int fr, int fq) const {
        const int row0 = u.pm * 256 + wr * 64 + fr, c0 = u.pn * 256 + wc * 32 + 8 * fq;
#pragma unroll
        for (int ai = 0; ai < 2; ++ai)
#pragma unroll
            for (int m = 0; m < 4; ++m) { const int row = row0 + ai * 128 + m * 16; const f32x4* sp = (const f32x4*)(SS + (size_t)row * 32) + 2 * fq;
                const f32x4 s4 = sp[0] + sp[1]; float st = (s4[0] + s4[1]) + (s4[2] + s4[3]); st += __shfl_xor(st, 16); st += __shfl_xor(st, 32);
                const float rs = rsqrtf(st * (1.0f / DM) + EPS);
#pragma unroll
                for (int bj = 0; bj < 2; ++bj) { f32x4 v0 = acc[ai][bj][m][0] * rs, v1 = acc[ai][bj][m][1] * rs;
#pragma unroll
                    for (int k = 0; k < 4; ++k) { const float a = fmaxf(v0[k], 0.f), b = fmaxf(v1[k], 0.f); v0[k] = a * a; v1[k] = b * b; }
                    { const int col = c0 + bj * 128; *(u32x4*)(H + ((size_t)((row >> 8) * (DFF / 64) + (col >> 6)) * 256 + (row & 255)) * 64 + (col & 63)) = pack8v(v0, v1); } } }
    }
};
struct EpiDown {
    static constexpr bool PERM = true, AFTER_DRAIN = false;
    float* out; const bf16* X1B;
    __device__ __forceinline__ void operator()(const f32x4 (&acc)[2][2][4][2], const Unit& u, int wr, int wc, int fr, int fq) const {
        const int row0 = u.pm * 256 + wr * 64 + fr, c0 = u.pn * 256 + wc * 32 + 8 * fq;
#pragma unroll
        for (int ai = 0; ai < 2; ++ai) { u32x4 xv[4][2];
#pragma unroll
            for (int m = 0; m < 4; ++m)
#pragma unroll
                for (int bj = 0; bj < 2; ++bj) xv[m][bj] = *(const u32x4*)(X1B + tm_idx(row0 + ai * 128 + m * 16, c0 + bj * 128, DM / 64));
#pragma unroll
            for (int m = 0; m < 4; ++m)
#pragma unroll
                for (int bj = 0; bj < 2; ++bj) { float* p = out + O_YP + (size_t)(row0 + ai * 128 + m * 16) * DM + c0 + bj * 128; const u32x4 w = xv[m][bj];
                    const f32x4 x0 = {__uint_as_float(w.x << 16), __uint_as_float(w.x & 0xffff0000u), __uint_as_float(w.y << 16), __uint_as_float(w.y & 0xffff0000u)};
                    const f32x4 x1 = {__uint_as_float(w.z << 16), __uint_as_float(w.z & 0xffff0000u), __uint_as_float(w.w << 16), __uint_as_float(w.w & 0xffff0000u)};
                    *(f32x4*)p = x0 + acc[ai][bj][m][0]; *(f32x4*)(p + 4) = x1 + acc[ai][bj][m][1]; } }
    }
};
struct CmpOrder {
    int n, G, c, shift;
    __device__ __forceinline__ bool next(int i, Unit& u) const { const int L = i * G + c; if (L >= n) return false; u.pm = L; u.pn = (L >> shift) & 1; return true; }
    __device__ __forceinline__ void a_ready(const Unit&) const {}
    __device__ __forceinline__ void done(const Unit&) const {}
};
}

__device__ __forceinline__ float grp_sum8(float v) { v += __shfl_xor(v, 1); v += __shfl_xor(v, 2); v += __shfl_xor(v, 4); return v; }
__device__ __forceinline__ float grp_sum16(float v) { v = grp_sum8(v); v += __shfl_xor(v, 8); return v; }
__device__ __forceinline__ float grp_sum32(float v) { v = grp_sum16(v); v += __shfl_xor(v, 16); return v; }

__device__ __forceinline__ void p2_post(const Ctx& C, int idx, int nblk) {
    unsigned char* ws = C.ws; const int gw = idx * NWAVES + C.wave, NGW = nblk * NWAVES, lane = C.lane;
    const float* QRAW = (const float*)(ws + WS_QRAW); bf16* QN = (bf16*)(ws + WS_QN); const float* KVWR = (const float*)(ws + WS_KVWR);
    const float* gq = C.in[IN_GQ]; const float* gk = C.in[IN_GK];
    const int kv = lane >> 5, g = (lane >> 4) & 1, d = (lane & 15) * 8;
    for (int row = gw; row < MREAL; row += NGW) {
        const bool pr = row < MPROMPT; const int b = row >> 12, t = row & 4095, bs = row - MPROMPT;
        const GAS f32x4* q4 = (const GAS f32x4*)(QRAW + (size_t)row * DQ + lane * 16); f32x4 v[4];
#pragma unroll
        for (int j2 = 0; j2 < 4; ++j2) v[j2] = q4[j2];
        const float* wsrc = KVWR + (size_t)row * 512 + lane * 8; const f32x4 wa = *(const GAS f32x4*)wsrc, wc2 = *(const GAS f32x4*)(wsrc + 4);
        f32x4 sa = {0.f, 0.f, 0.f, 0.f}, sc2 = sa;
        if (pr) { const float* ssrc = C.out + O_PSEL + (size_t)row * 512 + lane * 8; sa = *(const GAS f32x4*)ssrc; sc2 = *(const GAS f32x4*)(ssrc + 4);
 }
        float vs = lane < 32 ? ((const float*)(ws + WS_VSS))[(size_t)row * 32 + lane] : 0.f;
        { float ss = 0.f;
#pragma unroll
          for (int j2 = 0; j2 < 4; ++j2) ss += (v[j2].x * v[j2].x + v[j2].y * v[j2].y) + (v[j2].z * v[j2].z + v[j2].w * v[j2].w);
          ss = grp_sum8(ss); const float rs = rsqrtf(ss * (1.0f / 128) + EPS) * QSCALE; const float* gg = gq + (lane & 7) * 16; float f[16];
#pragma unroll
          for (int j2 = 0; j2 < 4; ++j2) { f[4 * j2] = v[j2].x * rs * gg[4 * j2]; f[4 * j2 + 1] = v[j2].y * rs * gg[4 * j2 + 1]; f[4 * j2 + 2] = v[j2].z * rs * gg[4 * j2 + 2]; f[4 * j2 + 3] = v[j2].w * rs * gg[4 * j2 + 3]; }
          GAS v4u* o = (GAS v4u*)(QN + (size_t)row * DQ + lane * 16);
          o[0] = (v4u){pk2(f[0], f[1]), pk2(f[2], f[3]), pk2(f[4], f[5]), pk2(f[6], f[7])}; o[1] = (v4u){pk2(f[8], f[9]), pk2(f[10], f[11]), pk2(f[12], f[13]), pk2(f[14], f[15])}; }
        if (pr) { float ss = (sa.x * sa.x + sa.y * sa.y) + (sa.z * sa.z + sa.w * sa.w) + (sc2.x * sc2.x + sc2.y * sc2.y) + (sc2.z * sc2.z + sc2.w * sc2.w); ss = grp_sum16(ss);
            const float rs = kv == 0 ? rsqrtf(ss * (1.0f / 128) + EPS) : 1.f; const float* gg = gk + 128 + d; float f[8] = {sa.x, sa.y, sa.z, sa.w, sc2.x, sc2.y, sc2.z, sc2.w};
#pragma unroll
            for (int k = 0; k < 8; ++k) f[k] = kv == 0 ? f[k] * rs * gg[k] : f[k];
            bf16* dst = (bf16*)(ws + (kv == 0 ? WS_KS : WS_VS)) + ((size_t)(b * 2 + g) * T + t) * 128 + d; *(GAS v4u*)dst = pack8f(f); }
        if (pr) { float ss = (wa.x * wa.x + wa.y * wa.y) + (wa.z * wa.z + wa.w * wa.w) + (wc2.x * wc2.x + wc2.y * wc2.y) + (wc2.z * wc2.z + wc2.w * wc2.w); ss = grp_sum16(ss);
            const float rs = kv == 0 ? rsqrtf(ss * (1.0f / 128) + EPS) : 1.f; const float* gg = gk + 256 + d; float f[8] = {wa.x, wa.y, wa.z, wa.w, wc2.x, wc2.y, wc2.z, wc2.w};
#pragma unroll
            for (int k = 0; k < 8; ++k) f[k] = kv == 0 ? f[k] * rs * gg[k] : f[k];
            bf16* dst = (bf16*)(ws + (kv == 0 ? WS_KW : WS_VW)) + ((size_t)(b * 2 + g) * T + t) * 128 + d; *(GAS v4u*)dst = pack8f(f);
            if (t >= T - 512) { float* o = C.out + O_PWIN + ((size_t)b * 512 + (t - (T - 512))) * 512 + lane * 8; *(GAS f32x4*)o = wa; *(GAS f32x4*)(o + 4) = wc2; }
        } else { float* o = C.out + O_SWIN + ((size_t)bs * 512 + 511) * 512 + lane * 8; *(GAS f32x4*)o = wa; *(GAS f32x4*)(o + 4) = wc2; }
        { vs = wave_sum(vs); if (lane == 0) ((float*)(ws + WS_RSTDV))[row] = rsqrtf(vs * (1.0f / DG) + EPS); }
    }
}

__device__ __forceinline__ float shx(float v, int mask, int lane) { return __int_as_float(__builtin_amdgcn_ds_bpermute((lane ^ mask) << 2, __float_as_int(v))); }
template <bool WT = false>
__device__ __forceinline__ void cmp_combine_rows(const Ctx& C, bool pr, int row0, int nrows) {
    unsigned char* ws = C.ws; const int hw = C.wave * 2 + (C.lane >> 5), l32 = C.lane & 31, e = l32 * 4;
    const float* CBP = (const float*)(ws + WS_CBP); const float* gk0 = C.in[IN_GK];
    f32x4 cb0 = {0.f, 0.f, 0.f, 0.f}, cb1 = {0.f, 0.f, 0.f, 0.f};
#pragma unroll
    for (int kc = 0; kc < 16; ++kc) { cb0 += *(const GAS f32x4*)(CBP + kc * 128 + e); cb1 += *(const GAS f32x4*)(CBP + (16 + kc) * 128 + e); }
    const f32x4 g4 = *(const GAS f32x4*)(gk0 + e);
    const int segs = pr ? 256 : 128;
    for (int rr = row0 + hw; rr < row0 + nrows; rr += 16) {
        const int j = rr & (segs - 1), grp = rr / segs, g = grp & 1, kv = (grp >> 1) & 1, b = grp >> 2;
        const float* Y = (const float*)(ws + (pr ? WS_YCP : WS_YCS)) + (size_t)rr * 256;
        f32x4 v = {0.f, 0.f, 0.f, 0.f};
        if (j < segs - 1) { v = *(const GAS f32x4*)(Y + e) + *(const GAS f32x4*)(Y + 128 + e) + (kv ? cb1 : cb0); }
        float ss = (v.x * v.x + v.y * v.y) + (v.z * v.z + v.w * v.w);
#pragma unroll
        for (int o = 1; o < 32; o <<= 1) ss += shx(ss, o, C.lane);
        if (kv == 0) { const float rs = rsqrtf(ss * (1.0f / 128) + EPS); v = v * rs * g4; }
        bf16* dst = (bf16*)(ws + (pr ? (kv ? WS_VCP : WS_KCP) : (kv ? WS_VCS : WS_KCS))) + ((size_t)(b * 2 + g) * segs + j) * 128 + e;
        if (WT) __hip_atomic_store((gu64*)dst, ((unsigned long long)pk2(v.z, v.w) << 32) | pk2(v.x, v.y), RLX_AGENT); else *(GAS v2u*)dst = (v2u){pk2(v.x, v.y), pk2(v.z, v.w)};
    }
}

typedef short s16x4 __attribute__((ext_vector_type(4)));
typedef float f32x16 __attribute__((ext_vector_type(16)));
__device__ __forceinline__ int v_st(int k, int c) { const int kk = (k & ~0xC) | ((k & 4) << 1) | ((k & 8) >> 1); return ((kk >> 3) * 4 + (c >> 5)) * 512 + ((kk & 7) * 32 + (c & 31)) * 2; }
__device__ __forceinline__ int v_rd_base(int lane) { return ((lane & 3) << 3) | (((lane >> 2) & 3) << 6) | (((lane >> 4) & 1) << 5) | (((lane >> 5) & 1) << 8); }
constexpr int v_rd_off(int d0, int ks, int half) { return d0 * 512 + ks * 4096 + half * 2048; }
__device__ __forceinline__ int crow(int r, int hi) { return (r & 3) + 8 * (r >> 2) + 4 * hi; }
#define SBAR() __builtin_amdgcn_sched_barrier(0)
__device__ __forceinline__ void pv_tile(f32x16* o, int vb0, bf16x8 pa0, bf16x8 pa1, bf16x8 pa2, bf16x8 pa3) {
#define TRRD(dst, off) asm volatile("ds_read_b64_tr_b16 %0, %1 offset:%2" : "=&v"(dst) : "v"(vb0), "i"(off) : "memory")
#define PV_D0(d0) do { s16x4 l0, l1, l2, l3, h0, h1, h2, h3; constexpr int b_ = v_rd_off(d0, 0, 0); \
        TRRD(l0, b_); TRRD(h0, b_ + 2048); TRRD(l1, b_ + 4096); TRRD(h1, b_ + 6144); TRRD(l2, b_ + 8192); TRRD(h2, b_ + 10240); TRRD(l3, b_ + 12288); TRRD(h3, b_ + 14336); \
        asm volatile("s_waitcnt lgkmcnt(0)" ::: "memory"); SBAR(); \
        o[d0] = __builtin_amdgcn_mfma_f32_32x32x16_bf16(pa0, (bf16x8){l0[0], l0[1], l0[2], l0[3], h0[0], h0[1], h0[2], h0[3]}, o[d0], 0, 0, 0); \
        o[d0] = __builtin_amdgcn_mfma_f32_32x32x16_bf16(pa1, (bf16x8){l1[0], l1[1], l1[2], l1[3], h1[0], h1[1], h1[2], h1[3]}, o[d0], 0, 0, 0); \
        o[d0] = __builtin_amdgcn_mfma_f32_32x32x16_bf16(pa2, (bf16x8){l2[0], l2[1], l2[2], l2[3], h2[0], h2[1], h2[2], h2[3]}, o[d0], 0, 0, 0); \
        o[d0] = __builtin_amdgcn_mfma_f32_32x32x16_bf16(pa3, (bf16x8){l3[0], l3[1], l3[2], l3[3], h3[0], h3[1], h3[2], h3[3]}, o[d0], 0, 0, 0); } while (0)
    PV_D0(0); PV_D0(1); PV_D0(2); PV_D0(3);
#undef PV_D0
#undef TRRD
}

__device__ __forceinline__ float rstd_v(const float* VSS, int row) { const GAS f32x4* p = (const GAS f32x4*)(VSS + (size_t)row * 32); f32x4 s = p[0];
#pragma unroll
    for (int k = 1; k < 8; ++k) s += p[k];
    return rsqrtf(((s.x + s.y) + (s.z + s.w)) * (1.0f / DG) + EPS); }
__device__ __forceinline__ void p4_sgu(const Ctx& C, int idx, int nblk) {
    unsigned char* ws = C.ws; const int tid = C.tid, lane = C.lane, wave = C.wave, r32 = lane & 31, hi = lane >> 5;
    const bf16* U = (const bf16*)(ws + WS_U); const bf16* VG = (const bf16*)(ws + WS_VG); const float* VSS = (const float*)(ws + WS_VSS);
    const bf16* WMB = (const bf16*)(ws + WS_WMB); bf16* OA = (bf16*)(ws + WS_OA);
    const float* gs = C.in[IN_GSGU]; const float* bs = C.in[IN_BSGU];
    LAS unsigned char* Vl = C.lds + RING_OFF;
    for (int unit = idx; unit < 256; unit += nblk) {
        const int n = unit >> 2, gp = unit & 3, rowbase = n * 128; const bool last = (n & 31) == 31; const int bb = n >> 5;
        __syncthreads();
        { const int sr = tid >> 4, sc = (tid & 15) * 8;
#pragma unroll
          for (int gl = 0; gl < 2; ++gl) { const int g = gp * 2 + gl; float gg[8];
#pragma unroll
              for (int k = 0; k < 8; ++k) gg[k] = gs[g * 128 + sc + k];
#pragma unroll
              for (int q = 0; q < 4; ++q) { const int s = q * 32 + sr, st = s >> 6, row = rowbase + s; float f[8];
                  unpack8(*(const GAS v4u*)(VG + (size_t)row * DG + g * 128 + sc), f); const float rs = rstd_v(VSS, row);
#pragma unroll
                  for (int k = 0; k < 8; ++k) f[k] = f[k] * rs * gg[k];
                  *(LAS v4u*)(Vl + (gl * 2 + st) * 16384 + v_st(s & 63, sc)) = pack8f(f);
                  if (last) { float* o = C.out + O_PSGU + ((size_t)bb * 128 + s) * DG + g * 128 + sc; *(GAS f32x4*)o = (f32x4){f[0], f[1], f[2], f[3]}; *(GAS f32x4*)(o + 4) = (f32x4){f[4], f[5], f[6], f[7]}; } } } }
        __syncthreads();
        const int tb = wave & 3, gl = wave >> 2, g = gp * 2 + gl;
        f32x16 o[4];
#pragma unroll
        for (int d0 = 0; d0 < 4; ++d0)
#pragma unroll
            for (int r = 0; r < 16; ++r) o[d0][r] = 0.f;
#pragma unroll
        for (int st = 0; st < 2; ++st) if (64 * st <= 32 * tb + 31) {
            const bf16* wp = WMB + ((size_t)g * 128 + tb * 32 + r32) * 128 + st * 64 + hi * 8;
            const bf16x8 pa0 = *(const GAS bf16x8*)(wp), pa1 = *(const GAS bf16x8*)(wp + 16), pa2 = *(const GAS bf16x8*)(wp + 32), pa3 = *(const GAS bf16x8*)(wp + 48);
            const int vb0 = (int)(unsigned)(uintptr_t)(Vl + (gl * 2 + st) * 16384) + v_rd_base(lane);
            pv_tile(o, vb0, pa0, pa1, pa2, pa3);
        }
#pragma unroll
        for (int r = 0; r < 16; ++r) { const int trow = tb * 32 + crow(r, hi); const float bv = bs[g * 128 + trow]; const size_t ro = (size_t)(rowbase + trow) * DG + g * 128, roa = (size_t)(rowbase + trow) * LD1 + g * 128;
#pragma unroll
            for (int d0 = 0; d0 < 4; ++d0) { const int c = d0 * 32 + r32; const float v = (o[d0][r] + bv) * bf2f(U[ro + c]); const float vn = __shfl_xor(v, 1);
                if ((r32 & 1) == 0) *(GAS unsigned*)(OA + tm_idx(rowbase + trow, g * 128 + c, DG / 64)) = pk2(v, vn); } }
    }
    { const int gt = idx * 512 + tid, NT = nblk * 512; const float* w = C.in[IN_WSGU];
      for (int i = gt; i < MSAMP * DG / 8; i += NT) { const int r = i >> 7, c = (i & 127) * 8, row = MPROMPT + r, g = c >> 7; float f[8], uu[8];
          unpack8(*(const GAS v4u*)(VG + (size_t)row * DG + c), f); unpack8(*(const GAS v4u*)(U + (size_t)row * DG + c), uu); const float rs = rstd_v(VSS, row), w00 = w[g * 16384], b0 = bs[g * 128];
#pragma unroll
          for (int k = 0; k < 8; ++k) { f[k] = f[k] * rs * gs[c + k]; uu[k] = uu[k] * (w00 * f[k] + b0); }
          float* o = C.out + O_SSGU + (size_t)r * DG + c; *(GAS f32x4*)o = (f32x4){f[0], f[1], f[2], f[3]}; *(GAS f32x4*)(o + 4) = (f32x4){f[4], f[5], f[6], f[7]};
          *(GAS v4u*)((bf16*)(ws + WS_SOA) + (size_t)r * LDS_G + c) = pack8f(uu); } }
}

struct AttItem { const bf16* q; int t; int ncmp; const bf16* kc; const bf16* vc; int nblk; const float* gates; bf16* out; const float* blut; };

__device__ __forceinline__ void ld8f(const float* p, float (&f)[8]) { const f32x4 a = *(const GAS f32x4*)p, b = *(const GAS f32x4*)(p + 4); f[0] = a.x; f[1] = a.y; f[2] = a.z; f[3] = a.w; f[4] = b.x; f[5] = b.y; f[6] = b.z; f[7] = b.w; }
struct PromptKV {
    const bf16 *ks, *vs, *kw, *vw;
    static constexpr bool NORM = false;
    __device__ __forceinline__ void selK(int pos, int d8, float (&k)[8]) const { unpack8(*(const GAS v4u*)(ks + (size_t)pos * 128 + d8), k); }
    __device__ __forceinline__ void selV(int pos, int d8, float (&k)[8]) const { unpack8(*(const GAS v4u*)(vs + (size_t)pos * 128 + d8), k); }
    __device__ __forceinline__ void winK(int pos, int d8, float (&k)[8]) const { unpack8(*(const GAS v4u*)(kw + (size_t)pos * 128 + d8), k); }
    __device__ __forceinline__ void winV(int pos, int d8, float (&k)[8]) const { unpack8(*(const GAS v4u*)(vw + (size_t)pos * 128 + d8), k); }
};
struct SampleKV {
    const float* csel; const int* pt; const float* nsel; const float* win; const float* nwin;
    static constexpr bool NORM = true;
    __device__ __forceinline__ const float* selp(int pos) const { return pos < PASTLEN ? csel + ((size_t)pt[pos >> 7] * 128 + (pos & 127)) * 512 : nsel; }
    __device__ __forceinline__ const float* winp(int pos) const { return pos < PASTLEN ? win + (size_t)(pos - (PASTLEN - 512)) * 512 : nwin; }
    __device__ __forceinline__ void selK(int pos, int d8, float (&k)[8]) const { ld8f(selp(pos) + d8, k); }
    __device__ __forceinline__ void selV(int pos, int d8, float (&k)[8]) const { ld8f(selp(pos) + 256 + d8, k); }
    __device__ __forceinline__ void winK(int pos, int d8, float (&k)[8]) const { ld8f(winp(pos) + d8, k); }
    __device__ __forceinline__ void winV(int pos, int d8, float (&k)[8]) const { ld8f(winp(pos) + 256 + d8, k); }
};
#define DPP_ADD(x, ctrl) ((x) + __int_as_float(__builtin_amdgcn_update_dpp(0, __float_as_int(x), (ctrl), 0xF, 0xF, true)))
__device__ __forceinline__ float row_sum16(float x) { x = DPP_ADD(x, 0xB1); x = DPP_ADD(x, 0x4E); x = DPP_ADD(x, 0x141); x = DPP_ADD(x, 0x140); return x; }
template <bool NORM>
__device__ __forceinline__ void score4(const float (&k)[8], const float (&gkv)[8], const float (&q)[4][8], float (&s)[4]) {
    float kk[8]; float ss = 0.f;
#pragma unroll
    for (int i = 0; i < 8; ++i) { if (NORM) { ss += k[i] * k[i]; kk[i] = k[i] * gkv[i]; } else kk[i] = k[i]; }
#pragma unroll
    for (int h = 0; h < 4; ++h) { float a = 0.f;
#pragma unroll
        for (int i = 0; i < 8; ++i) a += q[h][i] * kk[i];
        s[h] = row_sum16(a); }
    if (NORM) { ss = row_sum16(ss); const float rs = rsqrtf(ss * (1.0f / 128) + EPS);
#pragma unroll
        for (int h = 0; h < 4; ++h) s[h] *= rs; }
}
__device__ __forceinline__ void online4(const float (&s)[4], bool valid, float (&m)[4], float (&l)[4], float (&o)[4][8], const float (&v)[8]) {
#pragma unroll
    for (int h = 0; h < 4; ++h) { const float sv = valid ? s[h] : -__builtin_inff(); const float mn = fmaxf(m[h], sv);
        const float al = __builtin_amdgcn_exp2f(m[h] - mn), p = __builtin_amdgcn_exp2f(sv - mn); m[h] = mn; l[h] = l[h] * al + p;
#pragma unroll
        for (int i = 0; i < 8; ++i) o[h][i] = o[h][i] * al + p * v[i]; }
}
__device__ __forceinline__ void merge_store(float (&m)[4], float (&l)[4], float (&o)[4][8], LAS float* Cmb, int wave, int lane) {
#pragma unroll
    for (int h = 0; h < 4; ++h) { float M = fmaxf(m[h], __shfl_xor(m[h], 16)); M = fmaxf(M, __shfl_xor(M, 32));
        const float sc = __builtin_amdgcn_exp2f(m[h] - M); float ll = l[h] * sc; ll += __shfl_xor(ll, 16); ll += __shfl_xor(ll, 32);
        LAS float* dst = Cmb + (wave * 4 + h) * 132;
#pragma unroll
        for (int i = 0; i < 8; ++i) { float x = o[h][i] * sc; x += __shfl_xor(x, 16); x += __shfl_xor(x, 32); if (lane < 16) dst[lane * 8 + i] = x; }
        if (lane == 0) { dst[128] = M; dst[129] = ll; } }
}
__device__ __forceinline__ float combine8(const LAS float* Cmb, int hh, int dd) {
    float M = -1e30f;
#pragma unroll
    for (int w = 0; w < 8; ++w) M = fmaxf(M, Cmb[(w * 4 + hh) * 132 + 128]);
    float L = 0.f, O = 0.f;
#pragma unroll
    for (int w = 0; w < 8; ++w) { const LAS float* p = Cmb + (w * 4 + hh) * 132; const float sc = __builtin_amdgcn_exp2f(p[128] - M); L += p[129] * sc; O += p[dd] * sc; }
    return L > 0.f ? O / L : 0.f;
}

template <class KV, bool WIN>
__device__ __forceinline__ void nsa_stream(const KV& kv, int total, int wave, int grp, int d8, int t, int wlo, const LAS int* sl, const float (&gkv)[8], const float (&q)[4][8],
                                           const float* blut, float (&m)[4], float (&l)[4], float (&o)[4][8]) {
    const int nper = total > wave ? (total - wave + 7) >> 3 : 0;
    float kA[2][8], vA[2][8], kB[2][8], vB[2][8]; int ppA[2], ppB[2]; bool okA[2], okB[2];
#define NS_LOAD(K_, V_, PP_, OK_, i0_) do { _Pragma("unroll") for (int u = 0; u < 2; ++u) { const int ch = wave + 8 * ((i0_) + u); const bool in = (i0_) + u < nper; \
            int pos; if (WIN) pos = wlo + ch * 4 + grp; else pos = sl[in ? (ch >> 4) : 0] * 64 + (ch & 15) * 4 + grp; \
            OK_[u] = in && pos <= t; PP_[u] = OK_[u] ? pos : t; \
            if (WIN) { kv.winK(PP_[u], d8, K_[u]); kv.winV(PP_[u], d8, V_[u]); } else { kv.selK(PP_[u], d8, K_[u]); kv.selV(PP_[u], d8, V_[u]); } } } while (0)
#define NS_COMP(K_, V_, PP_, OK_, i0_) do { _Pragma("unroll") for (int u = 0; u < 2; ++u) if ((i0_) + u < nper) { float sc[4]; score4<KV::NORM>(K_[u], gkv, q, sc); \
            const int rel = t - PP_[u]; const int ri = rel > 128 ? 128 : rel; \
            _Pragma("unroll") for (int h = 0; h < 4; ++h) sc[h] += blut[h * 132 + ri]; \
            online4(sc, OK_[u], m, l, o, V_[u]); } } while (0)
    if (nper > 0) NS_LOAD(kA, vA, ppA, okA, 0);
    for (int i0 = 0; i0 < nper; i0 += 4) {
        if (i0 + 2 < nper) NS_LOAD(kB, vB, ppB, okB, i0 + 2);
        NS_COMP(kA, vA, ppA, okA, i0);
        if (i0 + 4 < nper) NS_LOAD(kA, vA, ppA, okA, i0 + 4);
        if (i0 + 2 < nper) NS_COMP(kB, vB, ppB, okB, i0 + 2);
    }
#undef NS_LOAD
#undef NS_COMP
}

template <class KV>
__device__ __forceinline__ void nsa_item(const Ctx& C, const AttItem& it, const KV& kv, const float* gk1, const float* gk2) {
    const int tid = C.tid, lane = C.lane, wave = C.wave, grp = lane >> 4, d8 = (lane & 15) * 8, t = it.t;
    LAS float* Sc = (LAS float*)(C.lds + RING_OFF);
    LAS float* Cmb = (LAS float*)(C.lds + RING_OFF + 4096);
    LAS int* sl = (LAS int*)(C.lds + RING_OFF + 4096 + 16896);
    const float NEG = -__builtin_inff();
    float q[4][8];
#pragma unroll
    for (int h = 0; h < 4; ++h) unpack8(*(const GAS v4u*)(it.q + h * 128 + d8), q[h]);
    const int hh = tid >> 7, dd = tid & 127;
    const float g0 = it.gates[hh * 3 + 0], g1 = it.gates[hh * 3 + 1], g2 = it.gates[hh * 3 + 2];
    float res = 0.f;
    float m[4], l[4], o[4][8], gkv[8];
#pragma unroll
    for (int i = 0; i < 8; ++i) gkv[i] = 1.f;

    int nvis = t >= 31 ? (t - 31) / 16 + 1 : 0; if (nvis > it.ncmp) nvis = it.ncmp;
    const int nch = (nvis + 3) >> 2;
    for (int ch = wave; ch < 64; ch += 8) {
        const int c = ch * 4 + grp; float s[4] = {NEG, NEG, NEG, NEG};
        if (ch < nch) {
            const bool valid = c < nvis; const int cc = valid ? c : 0; float k[8]; unpack8(*(const GAS v4u*)(it.kc + (size_t)cc * 128 + d8), k);
            float sc[4]; score4<false>(k, gkv, q, sc);
            const int rel = t - (16 * c + 31); const int ri = rel < 0 ? 0 : (rel > 128 ? 128 : rel);
#pragma unroll
            for (int h = 0; h < 4; ++h) s[h] = valid ? sc[h] + it.blut[h * 132 + ri] : NEG;
        }
        if ((lane & 15) == 0) {
#pragma unroll
            for (int h = 0; h < 4; ++h) Sc[h * 256 + c] = s[h]; }
    }
    __syncthreads();
    float mh[4], il[4];
#pragma unroll
    for (int h = 0; h < 4; ++h) { const f32x4 v = *(const LAS f32x4*)(Sc + h * 256 + lane * 4); float mx = fmaxf(fmaxf(v.x, v.y), fmaxf(v.z, v.w)); mx = fmaxf(wave_max(mx), -1e30f);
        float e = (__builtin_amdgcn_exp2f(v.x - mx) + __builtin_amdgcn_exp2f(v.y - mx)) + (__builtin_amdgcn_exp2f(v.z - mx) + __builtin_amdgcn_exp2f(v.w - mx)); e = wave_sum(e);
        mh[h] = mx; il[h] = e > 0.f ? 1.0f / e : 0.f; }
    float imp = 0.f;
#pragma unroll
    for (int h = 0; h < 4; ++h) { float a = 0.f;
#pragma unroll
        for (int k = 0; k < 5; ++k) { const int c = 4 * lane - 1 + k; if (c >= 0) a += __builtin_amdgcn_exp2f(Sc[h * 256 + c] - mh[h]); }
        imp += a * il[h]; }
    unsigned long long mask;
    { const int j = lane, cur = t >> 6; const bool forced = (j == 0) || (j == cur) || (j == cur - 1), elig = 64 * j <= t, exists = j < it.nblk;
      const float val = exists ? (forced ? 1e6f : (elig ? imp : -1.f)) : -2.f; int rank = 0;
      const int key = (int)((__float_as_uint(val) & ~63u) | (unsigned)(63 - j));
#pragma unroll
      for (int jp = 0; jp < 64; ++jp) rank += (__builtin_amdgcn_readlane(key, jp) > key) ? 1 : 0;
      const bool sel_ = rank < 16 && elig && exists; mask = __ballot(sel_);
      if (wave == 0 && sel_) sl[__builtin_popcountll(mask & ((1ull << j) - 1ull))] = j; }
#pragma unroll
    for (int h = 0; h < 4; ++h) { m[h] = mh[h]; l[h] = 0.f;
#pragma unroll
        for (int i = 0; i < 8; ++i) o[h][i] = 0.f; }
    for (int ch = wave; ch < nch; ch += 8) {
        const int c = ch * 4 + grp; const bool valid = c < nvis; const int cc = valid ? c : 0; float v[8]; unpack8(*(const GAS v4u*)(it.vc + (size_t)cc * 128 + d8), v);
#pragma unroll
        for (int h = 0; h < 4; ++h) { const float p = valid ? __builtin_amdgcn_exp2f(Sc[h * 256 + cc] - mh[h]) : 0.f; l[h] += p;
#pragma unroll
            for (int i = 0; i < 8; ++i) o[h][i] += p * v[i]; }
    }
    merge_store(m, l, o, Cmb, wave, lane);
    __syncthreads();
    res += g0 * combine8(Cmb, hh, dd);
    __syncthreads();

#pragma unroll
    for (int h = 0; h < 4; ++h) { m[h] = -1e30f; l[h] = 0.f;
#pragma unroll
        for (int i = 0; i < 8; ++i) o[h][i] = 0.f; }
    if (KV::NORM) {
#pragma unroll
        for (int i = 0; i < 8; ++i) gkv[i] = gk1[d8 + i]; }
    nsa_stream<KV, false>(kv, __builtin_popcountll(mask) * 16, wave, grp, d8, t, 0, sl, gkv, q, it.blut, m, l, o);
    merge_store(m, l, o, Cmb, wave, lane);
    __syncthreads();
    res += g1 * combine8(Cmb, hh, dd);
    __syncthreads();

#pragma unroll
    for (int h = 0; h < 4; ++h) { m[h] = -1e30f; l[h] = 0.f;
#pragma unroll
        for (int i = 0; i < 8; ++i) o[h][i] = 0.f; }
    if (KV::NORM) {
#pragma unroll
        for (int i = 0; i < 8; ++i) gkv[i] = gk2[d8 + i]; }
    const int wlo = t - 511 < 0 ? 0 : t - 511, nchw = (t - wlo + 4) >> 2;
    nsa_stream<KV, true>(kv, nchw, wave, grp, d8, t, wlo, sl, gkv, q, it.blut, m, l, o);
    merge_store(m, l, o, Cmb, wave, lane);
    __syncthreads();
    res += g2 * combine8(Cmb, hh, dd);
    it.out[hh * 128 + dd] = (bf16)f2bf(res);
    __syncthreads();
}


#define KSWZ(row, colB) ((row) * 256 + ((colB) ^ (((row) & 7) << 4)))
constexpr int AT_V = 0, AT_K = 32768, AT_PC = 65536, AT_X = 131584, AT_BLUT = AT_X, AT_SELM = AT_X + 2176, AT_WS = AT_SELM + 512;
static_assert(AT_WS + 8 * 256 + 64 <= LDS_BYTES && AT_X >= MISC_OFF + 128 && AT_PC + 64 * 256 * 4 <= LDSCTL_OFF, "attention LDS map");

__device__ __forceinline__ unsigned cvtpk(float lo, float hi) { unsigned r; asm volatile("v_cvt_pk_bf16_f32 %0, %1, %2" : "=v"(r) : "v"(lo), "v"(hi)); return r; }
__device__ __forceinline__ float swap_max(float x) { auto rr = __builtin_amdgcn_permlane32_swap(__float_as_uint(x), __float_as_uint(x), false, false); return fmaxf(__uint_as_float(rr[0]), __uint_as_float(rr[1])); }
__device__ __forceinline__ float swap_add(float x) { auto rr = __builtin_amdgcn_permlane32_swap(__float_as_uint(x), __float_as_uint(x), false, false); return __uint_as_float(rr[0]) + __uint_as_float(rr[1]); }
__device__ __forceinline__ float quad_sum(float x) {
    x += __int_as_float(__builtin_amdgcn_update_dpp(0, __float_as_int(x), 0xB1, 0xF, 0xF, true));
    x += __int_as_float(__builtin_amdgcn_update_dpp(0, __float_as_int(x), 0x4E, 0xF, 0xF, true));
    return x;
}
__device__ __forceinline__ void qkt_tile(f32x16& p0, f32x16& p1, const LAS unsigned char* Kt, int r32, int hi, const bf16x8 (&qr)[8]) {
#pragma unroll
    for (int r = 0; r < 16; ++r) { p0[r] = 0.f; p1[r] = 0.f; }
    const LAS unsigned char* kb[4];
#pragma unroll
    for (int dd = 0; dd < 4; ++dd) kb[dd] = Kt + KSWZ(r32, (dd * 16 + hi * 8) * 2);
#pragma unroll
    for (int d0 = 0; d0 < 8; ++d0) { const LAS unsigned char* a = kb[d0 & 3] + (d0 >> 2) * 128;
        const bf16x8 b0 = *(const LAS bf16x8*)a, b1 = *(const LAS bf16x8*)(a + 32 * 256);
        p0 = __builtin_amdgcn_mfma_f32_32x32x16_bf16(b0, qr[d0], p0, 0, 0, 0);
        p1 = __builtin_amdgcn_mfma_f32_32x32x16_bf16(b1, qr[d0], p1, 0, 0, 0); }
}
template <int MODE>
__device__ __forceinline__ void fix_tile(f32x16& p0, f32x16& p1, int tile, int tq, int tmin, int head, int hi, bool bit, const LAS float* lut) {
    const float NEG = -__builtin_inff(); const float c31 = lut[head * 132 + 128];
    bool fast;
    if (MODE == 0) fast = tmin - 16 * (64 * tile + 63) - 31 >= 128;
    else if (MODE == 2) fast = tmin - (64 * tile + 63) >= 128;
    else fast = (tmin - (64 * tile + 63) >= 128) && (tmin + 7 - 64 * tile < 512);
    if (fast) {
        if (MODE == 2) {
#pragma unroll
            for (int r = 0; r < 16; ++r) { p0[r] = bit ? p0[r] + c31 : NEG; p1[r] = bit ? p1[r] + c31 : NEG; }
        } else {
#pragma unroll
            for (int r = 0; r < 16; ++r) { p0[r] += c31; p1[r] += c31; }
        }
        return;
    }
    const LAS float* lh = lut + head * 132;
#pragma unroll
    for (int hf = 0; hf < 2; ++hf)
#pragma unroll
        for (int r = 0; r < 16; ++r) { const int cr = (r & 3) + 8 * (r >> 2); int rel;
            if (MODE == 0) rel = tq - 31 - 16 * (64 * tile + 32 * hf + 4 * hi + cr); else rel = tq - (64 * tile + 32 * hf + 4 * hi + cr);
            bool valid;
            if (MODE == 0) valid = rel >= 0; else if (MODE == 2) valid = rel >= 0 && bit; else valid = (unsigned)rel < 512u;
            const int ri = rel < 0 ? 0 : (rel > 128 ? 128 : rel); const float bv = lh[ri];
            if (hf == 0) p0[r] = valid ? p0[r] + bv : NEG; else p1[r] = valid ? p1[r] + bv : NEG; }
}
__device__ __forceinline__ void softmax_tile(f32x16& p0, f32x16& p1, float& m_reg, float& l_reg, float& alpha, bf16x8& pa0, bf16x8& pa1, bf16x8& pa2, bf16x8& pa3) {
    float pmax = p0[0];
#pragma unroll
    for (int r = 1; r < 16; ++r) pmax = fmaxf(pmax, p0[r]);
#pragma unroll
    for (int r = 0; r < 16; ++r) pmax = fmaxf(pmax, p1[r]);
    pmax = swap_max(pmax);
    const float mn = fmaxf(m_reg, pmax); alpha = __builtin_amdgcn_exp2f(m_reg - mn); m_reg = mn;
    float ps = 0.f;
#pragma unroll
    for (int r = 0; r < 16; ++r) { p0[r] = __builtin_amdgcn_exp2f(p0[r] - mn); p1[r] = __builtin_amdgcn_exp2f(p1[r] - mn); ps += p0[r] + p1[r]; }
    ps = swap_add(ps); l_reg = l_reg * alpha + ps;
#define PK4(P, B_, OUT) do { unsigned a0 = cvtpk(P[B_+0], P[B_+1]), a1 = cvtpk(P[B_+2], P[B_+3]); unsigned b0 = cvtpk(P[B_+4], P[B_+5]), b1 = cvtpk(P[B_+6], P[B_+7]); \
        auto r0 = __builtin_amdgcn_permlane32_swap(a0, b0, false, false); auto r1 = __builtin_amdgcn_permlane32_swap(a1, b1, false, false); \
        v4u w = {r0[0], r1[0], r0[1], r1[1]}; OUT = __builtin_bit_cast(bf16x8, w); } while (0)
    PK4(p0, 0, pa0); PK4(p0, 8, pa1); PK4(p1, 0, pa2); PK4(p1, 8, pa3);
#undef PK4
}

struct FlashSt {
    bf16x8 qr[8];
    int tq, tmin, head;
};
template <int MODE, bool PASS2, int ACC>
__device__ __forceinline__ void flash_branch(const Ctx& C, FlashSt& S, const bf16* Kb, const bf16* Vb, int j_lo, int j_hi, float gate, unsigned long long mymask, unsigned long long wor,
                                             float& m_reg, float& l_reg, float* OT, bf16* OBrow) {
    const int tid = C.tid, lane = C.lane, wave = C.wave, r32 = lane & 31, hi = lane >> 5;
    LAS unsigned char* Vl = C.lds + AT_V; LAS unsigned char* Kl = C.lds + AT_K; LAS float* Pc = (LAS float*)(C.lds + AT_PC);
    const LAS float* lut = (const LAS float*)(C.lds + AT_BLUT); LAS float* wsl = (LAS float*)(C.lds + AT_WS) + wave * 64;
    const int vb0 = (int)(unsigned)(uintptr_t)Vl + v_rd_base(lane);
    f32x16 o[4];
    if (!PASS2) {
#pragma unroll
        for (int d0 = 0; d0 < 4; ++d0)
#pragma unroll
            for (int r = 0; r < 16; ++r) o[d0][r] = 0.f;
        m_reg = -1e30f; l_reg = 0.f; }
    const float inv_l = PASS2 ? (l_reg > 0.f ? 1.0f / l_reg : 0.f) : 0.f;
    const int n = j_hi - j_lo;
    const int lrow = wave * 4 + (lane >> 4);
    const unsigned ksrc = (unsigned)(lrow * 256 + ((((lane & 15) << 4)) ^ ((lrow & 7) << 4)));
    const int vkk = (((wave * 2 + (lane >> 5)) >> 2) << 3) + ((lane & 31) >> 2);
    const int vk = (vkk & ~0xC) | ((vkk & 4) << 1) | ((vkk & 8) >> 1);
    const unsigned vsrc = (unsigned)(vk * 256 + ((((wave * 2 + (lane >> 5)) & 3) * 32 + (lane & 3) * 8) * 2));
#define ST_DMA(tile, bf) do { const char* kp = (const char*)(Kb + (size_t)(tile) * 64 * 128) + ksrc; \
        __builtin_amdgcn_global_load_lds((const unsigned*)kp, (LAS unsigned*)(Kl + (bf) * 16384 + wave * 1024), 16, 0, 0); \
        __builtin_amdgcn_global_load_lds((const unsigned*)(kp + 8192), (LAS unsigned*)(Kl + (bf) * 16384 + 8192 + wave * 1024), 16, 0, 0); \
        if (!PASS2) { const char* vp = (const char*)(Vb + (size_t)(tile) * 64 * 128) + vsrc; \
            __builtin_amdgcn_global_load_lds((const unsigned*)vp, (LAS unsigned*)(Vl + (bf) * 16384 + wave * 1024), 16, 0, 0); \
            __builtin_amdgcn_global_load_lds((const unsigned*)(vp + 8192), (LAS unsigned*)(Vl + (bf) * 16384 + 8192 + wave * 1024), 16, 0, 0); } } while (0)
    if (n > 0) ST_DMA(j_lo, 0);
    asm volatile("s_waitcnt vmcnt(0)" ::: "memory");
    __syncthreads();
    for (int i = 0; i < n; ++i) {
        const int tile = j_lo + i, buf = i & 1;
        if (i + 1 < n) ST_DMA(tile + 1, buf ^ 1);
        bool act;
        if (PASS2) act = true; else if (MODE == 0) act = 16 * (64 * tile) + 31 <= S.tmin + 7; else if (MODE == 2) act = (wor >> tile) & 1ull; else act = true;
        if (act) {
            f32x16 p0, p1; qkt_tile(p0, p1, Kl + buf * 16384, r32, hi, S.qr);
            const bool bit = MODE == 2 ? ((mymask >> tile) & 1ull) != 0ull : true;
            fix_tile<MODE>(p0, p1, tile, S.tq, S.tmin, S.head, hi, bit, lut);
            if (PASS2) {
#pragma unroll
                for (int r = 0; r < 16; ++r) { p0[r] = quad_sum(__builtin_amdgcn_exp2f(p0[r] - m_reg) * inv_l); p1[r] = quad_sum(__builtin_amdgcn_exp2f(p1[r] - m_reg) * inv_l); }
                if ((r32 & 3) == 0) { LAS float* pr = Pc + (wave * 8 + (r32 >> 2)) * 256 + tile * 64 + 4 * hi;
#pragma unroll
                    for (int r = 0; r < 16; ++r) { const int cr = (r & 3) + 8 * (r >> 2); pr[cr] = p0[r]; pr[32 + cr] = p1[r]; } }
            } else {
                float alpha; bf16x8 pa0, pa1, pa2, pa3;
                softmax_tile(p0, p1, m_reg, l_reg, alpha, pa0, pa1, pa2, pa3);
                if (__any(alpha < 1.f)) { if (hi == 0) wsl[r32] = alpha; asm volatile("s_waitcnt lgkmcnt(0)" ::: "memory"); const LAS float* wh = wsl + 4 * hi;
#pragma unroll
                    for (int r = 0; r < 16; ++r) { const float a = wh[(r & 3) + 8 * (r >> 2)];
#pragma unroll
                        for (int d0 = 0; d0 < 4; ++d0) o[d0][r] *= a; }
                    asm volatile("s_waitcnt lgkmcnt(0)" ::: "memory"); }
                pv_tile(o, vb0 + buf * 16384, pa0, pa1, pa2, pa3);
            }
        }
        asm volatile("s_waitcnt vmcnt(0)" ::: "memory");
        __syncthreads();
    }
#undef ST_DMA
    if (!PASS2) {
        const float scl = l_reg > 0.f ? gate / l_reg : 0.f;
        if (hi == 0) wsl[32 + r32] = scl; asm volatile("s_waitcnt lgkmcnt(0)" ::: "memory");
        const LAS float* wh = wsl + 32 + 4 * hi; GAS float* otl = (GAS float*)OT + (size_t)(4 * hi) * 128 + r32; GAS bf16* obl = (GAS bf16*)OBrow + (size_t)hi * 64 + r32;
        asm volatile("" : "+v"(otl), "+v"(obl));
#pragma unroll
        for (int r = 0; r < 16; ++r) { const int cr = (r & 3) + 8 * (r >> 2); const float a = wh[cr];
#pragma unroll
            for (int d0 = 0; d0 < 4; ++d0) { float v = o[d0][r] * a; if (ACC > 0) v += otl[cr * 128 + d0 * 32];
                if (ACC < 2) otl[cr * 128 + d0 * 32] = v;
                else { const float vn = __shfl_xor(v, 1); if ((r32 & 1) == 0) *(GAS unsigned*)(obl + ((r & 3) * 2 + (d0 >> 1)) * 16384 + (2 * (r >> 2)) * 64 + (d0 & 1) * 32) = cvtpk(v, vn); } } }
        asm volatile("s_waitcnt lgkmcnt(0)" ::: "memory");
    }
}

__device__ __forceinline__ void flash_unit(const Ctx& C, int b, int g, int qb) {
    unsigned char* ws = C.ws; const int tid = C.tid, lane = C.lane, wave = C.wave, r32 = lane & 31, hi = lane >> 5, t0 = qb * 64;
    LAS float* lut = (LAS float*)(C.lds + AT_BLUT); LAS float* Pc = (LAS float*)(C.lds + AT_PC); LAS unsigned long long* selm = (LAS unsigned long long*)(C.lds + AT_SELM);
    const float* BL = (const float*)(ws + WS_BLUT) + g * 4 * 132;
    for (int i = tid; i < 4 * 132; i += NWAVES * 64) lut[i] = BL[i];
    FlashSt S; S.tmin = t0 + wave * 8; S.tq = S.tmin + (r32 >> 2); S.head = r32 & 3;
    const int row = b * T + S.tq;
    { const bf16* qp = (const bf16*)(ws + WS_QN) + (size_t)row * DQ + (g * 4 + S.head) * 128 + hi * 8;
#pragma unroll
      for (int d0 = 0; d0 < 8; ++d0) S.qr[d0] = *(const GAS bf16x8*)(qp + d0 * 16); }
    const float* gn = (const float*)(ws + WS_GN) + (size_t)row * 32 + (g * 4 + S.head) * 3; const float gc = gn[0], gsel = gn[1], gw = gn[2];
    const size_t kvb = (size_t)(b * 2 + g) * T * 128, cb = (size_t)(b * 2 + g) * 256 * 128;
    const int cmax = (t0 + 63 - 31) >> 4;
    const int nct = (cmax >> 6) + 1;
    float m_c, l_c;
    float* OT = (float*)(ws + WS_OT) + ((size_t)blockIdx.x * 8 + wave) * 32 * 128;
    bf16* OBrow = (bf16*)(ws + WS_OB) + tm_idx(b * T + S.tmin, g * 512, DQ / 64);
    flash_branch<0, false, 0>(C, S, (const bf16*)(ws + WS_KCP) + cb, (const bf16*)(ws + WS_VCP) + cb, 0, nct, gc, 0ull, 0ull, m_c, l_c, OT, OBrow);
    flash_branch<0, true, 0>(C, S, (const bf16*)(ws + WS_KCP) + cb, nullptr, 0, nct, 0.f, 0ull, 0ull, m_c, l_c, OT, OBrow);
    unsigned long long wor = 0ull;
    { asm volatile("s_waitcnt lgkmcnt(0)" ::: "memory");
      const int ncomp = nct * 64;
#pragma unroll 1
      for (int qi = 0; qi < 8; ++qi) { const int ql = wave * 8 + qi, t = t0 + ql; const LAS float* pr = Pc + ql * 256; float imp = 0.f;
#pragma unroll
          for (int k = 0; k < 5; ++k) { const int c = 4 * lane - 1 + k; if (c >= 0 && c < ncomp) imp += pr[c]; }
          const int j = lane, cur = t >> 6; const bool forced = (j == 0) || (j == cur) || (j == cur - 1), elig = 64 * j <= t;
          const float val = forced ? 1e6f : (elig ? imp : -1.f); int rank = 0;
          const int key = (int)((__float_as_uint(val) & ~63u) | (unsigned)(63 - j));
#pragma unroll
          for (int jp = 0; jp < 64; ++jp) rank += (__builtin_amdgcn_readlane(key, jp) > key) ? 1 : 0;
          const unsigned long long mk = __ballot(rank < 16 && elig); wor |= mk;
          if (lane == 0) selm[ql] = mk; }
      asm volatile("s_waitcnt lgkmcnt(0)" ::: "memory"); }
    const unsigned long long mymask = selm[wave * 8 + (r32 >> 2)];
    float m_s, l_s;
    flash_branch<2, false, 1>(C, S, (const bf16*)(ws + WS_KS) + kvb, (const bf16*)(ws + WS_VS) + kvb, 0, qb + 1, gsel, mymask, wor, m_s, l_s, OT, OBrow);
    flash_branch<3, false, 2>(C, S, (const bf16*)(ws + WS_KW) + kvb, (const bf16*)(ws + WS_VW) + kvb, qb >= 8 ? qb - 8 : 0, qb + 1, gw, 0ull, 0ull, m_s, l_s, OT, OBrow);
    __syncthreads();
}


template <bool SPLIT = false>
__device__ __forceinline__ void skinny_core(const Ctx& C, const bf16* A, int lda, const bf16* Bs, int kbeg, int Kw, float (&out)[8], float* out2 = nullptr) {
    const int lane = C.lane, wave = C.wave, r32 = lane & 31, hi = lane >> 5, tid = C.tid;
    f32x16 acc[4];
#pragma unroll
    for (int rb = 0; rb < 4; ++rb)
#pragma unroll
        for (int r = 0; r < 16; ++r) acc[rb][r] = 0.f;
    const GAS bf16* ap0 = (const GAS bf16*)A + (size_t)r32 * lda + kbeg + hi * 32;
    const GAS bf16* bp = (const GAS bf16*)Bs + (size_t)r32 * 64 + (size_t)(kbeg >> 6) * 16384 + hi * 32;
    const GAS bf16* ap1 = ap0 + (size_t)32 * lda; const GAS bf16* ap2 = ap0 + (size_t)64 * lda; const GAS bf16* ap3 = ap0 + (size_t)96 * lda;
    asm volatile("" : "+v"(ap0), "+v"(ap1), "+v"(ap2), "+v"(ap3), "+v"(bp));
    bf16x8 a0[4][2], b0[2], a1[4][2], b1[2];
#define SK_OFF(st) ((((st) >> 1) << 6) + (((st) & 1) << 4))
#define SK_LOAD(a, b, st) do { const int k_ = SK_OFF(st), kb_ = (((st) >> 1) << 14) + (((st) & 1) << 4); _Pragma("unroll") for (int j = 0; j < 2; ++j) b[j] = *(const GAS bf16x8*)(bp + kb_ + 8 * j); \
        _Pragma("unroll") for (int j = 0; j < 2; ++j) { a[0][j] = *(const GAS bf16x8*)(ap0 + k_ + 8 * j); a[1][j] = *(const GAS bf16x8*)(ap1 + k_ + 8 * j); a[2][j] = *(const GAS bf16x8*)(ap2 + k_ + 8 * j); a[3][j] = *(const GAS bf16x8*)(ap3 + k_ + 8 * j); } } while (0)
#define SK_MMA(a, b) do { _Pragma("unroll") for (int j = 0; j < 2; ++j) _Pragma("unroll") for (int rb = 0; rb < 4; ++rb) acc[rb] = __builtin_amdgcn_mfma_f32_32x32x16_bf16(a[rb][j], b[j], acc[rb], 0, 0, 0); } while (0)
    const int ns = Kw >> 5;
    SK_LOAD(a0, b0, 0);
    for (int st = 0; st < ns; st += 2) {
        if (st + 1 < ns) SK_LOAD(a1, b1, st + 1);
        SK_MMA(a0, b0);
        if (st + 2 < ns) SK_LOAD(a0, b0, st + 2);
        if (st + 1 < ns) SK_MMA(a1, b1);
    }
#undef SK_OFF
#undef SK_LOAD
#undef SK_MMA
    LAS float* Red = (LAS float*)(C.lds + RING_OFF);
    LAS float* wr_ = Red + (wave * 128 + 4 * hi) * 32 + r32;
#pragma unroll
    for (int rb = 0; rb < 4; ++rb)
#pragma unroll
        for (int r = 0; r < 16; ++r) wr_[(32 * rb + (r & 3) + 8 * (r >> 2)) * 32] = acc[rb][r];
    __syncthreads();
    const LAS float* rd = Red + (tid >> 2) * 32 + (tid & 3) * 8;
    f32x4 s0 = *(const LAS f32x4*)rd, s1 = *(const LAS f32x4*)(rd + 4);
#pragma unroll
    for (int w = 1; w < (SPLIT ? 4 : 8); ++w) { s0 += *(const LAS f32x4*)(rd + w * 4096); s1 += *(const LAS f32x4*)(rd + w * 4096 + 4); }
    out[0] = s0.x; out[1] = s0.y; out[2] = s0.z; out[3] = s0.w; out[4] = s1.x; out[5] = s1.y; out[6] = s1.z; out[7] = s1.w;
    if (SPLIT) { f32x4 t0 = *(const LAS f32x4*)(rd + 4 * 4096), t1 = *(const LAS f32x4*)(rd + 4 * 4096 + 4);
#pragma unroll
        for (int w = 5; w < 8; ++w) { t0 += *(const LAS f32x4*)(rd + w * 4096); t1 += *(const LAS f32x4*)(rd + w * 4096 + 4); }
        out2[0] = t0.x; out2[1] = t0.y; out2[2] = t0.z; out2[3] = t0.w; out2[4] = t1.x; out2[5] = t1.y; out2[6] = t1.z; out2[7] = t1.w; }
    __syncthreads();
}
__device__ __forceinline__ void st8f(float* p, const float (&v)[8]) { *(GAS f32x4*)p = (f32x4){v[0], v[1], v[2], v[3]}; *(GAS f32x4*)(p + 4) = (f32x4){v[4], v[5], v[6], v[7]}; }

__device__ __forceinline__ void s_in(const Ctx& C, int idx, int nblk) {
    unsigned char* ws = C.ws; const int tid = C.tid, row = tid >> 2, c8 = (tid & 3) * 8, rg = MPROMPT + row;
    const float rs = ((const float*)(ws + WS_RSTD1))[rg];
    for (int u = idx; u < 273; u += nblk) {
        float v[8]; skinny_core(C, (const bf16*)(ws + WS_SXB), LDS_X, (const bf16*)(ws + WS_WIN) + ((size_t)(u >> 3) * (DM / 64) * 256 + (u & 7) * 32) * 64, C.wave * 256, 256, v);
        const int n = u * 32 + c8;
#pragma unroll
        for (int k = 0; k < 8; ++k) v[k] *= rs;
        if (n < 2048) {
#pragma unroll
            for (int k = 0; k < 8; ++k) v[k] = gelu_tanh(v[k]);
            if (n < 1024) *(GAS v4u*)((bf16*)(ws + WS_U) + (size_t)rg * DG + n) = pack8f(v);
            else { *(GAS v4u*)((bf16*)(ws + WS_VG) + (size_t)rg * DG + n - 1024) = pack8f(v); float ss = 0.f;
#pragma unroll
                for (int k = 0; k < 8; ++k) ss += v[k] * v[k];
                ss += __shfl_xor(ss, 1); ss += __shfl_xor(ss, 2);
                if ((tid & 3) == 0) ((float*)(ws + WS_VSS))[(size_t)rg * 32 + (n - 1024) / 32] = ss; }
        } else if (n < 3072) st8f((float*)(ws + WS_QRAW) + (size_t)rg * DQ + n - 2048, v);
        else if (n < 3584) st8f(C.out + O_SCMP + (size_t)row * 512 + n - 3072, v);
        else if (n < 4096) st8f(C.out + O_SSEL + (size_t)row * 512 + n - 3584, v);
        else if (n < 4608) st8f((float*)(ws + WS_KVWR) + (size_t)rg * 512 + n - 4096, v);
        else if (n < 8704) {
#pragma unroll
            for (int k = 0; k < 8; ++k) v[k] = sigmoidf_(v[k]);
            if (n < 6656) *(GAS v4u*)((bf16*)(ws + WS_GA) + (size_t)rg * DM + n - 4608) = pack8f(v); else *(GAS v4u*)((bf16*)(ws + WS_GB) + (size_t)rg * DM + n - 6656) = pack8f(v);
        } else if (n < 8728) {
#pragma unroll
            for (int k = 0; k < 8; ++k) v[k] = sigmoidf_(v[k]);
            st8f((float*)(ws + WS_GN) + (size_t)rg * 32 + n - 8704, v); }
    }
}
__device__ __forceinline__ void s_proj(const Ctx& C, int idx, int nblk) {
    unsigned char* ws = C.ws; const int tid = C.tid, row = tid >> 2, c8 = (tid & 3) * 8, rg = MPROMPT + row;
    for (int u = idx; u < 64; u += nblk) {
        float a[8], b[8], ga[8], gb[8]; const int n = u * 32 + c8;
        { const bool pb = C.wave >= 4;
          skinny_core<true>(C, (const bf16*)(ws + (pb ? WS_SOB : WS_SOA)), LDS_G, (const bf16*)(ws + (pb ? WS_WN : WS_WG)) + ((size_t)(u >> 3) * (DG / 64) * 256 + (u & 7) * 32) * 64, (C.wave & 3) * 256, 256, a, b); }
        unpack8(*(const GAS v4u*)((const bf16*)(ws + WS_GA) + (size_t)rg * DM + n), ga); unpack8(*(const GAS v4u*)((const bf16*)(ws + WS_GB) + (size_t)rg * DM + n), gb);
#pragma unroll
        for (int k = 0; k < 8; ++k) a[k] = ga[k] * a[k] + gb[k] * b[k];
        *(GAS v4u*)((bf16*)(ws + WS_SMIX) + (size_t)row * LDS_X + n) = pack8f(a);
    }
}
__device__ __forceinline__ void s_out(const Ctx& C, int idx, int nblk) {
    unsigned char* ws = C.ws; const int tid = C.tid, row = tid >> 2, c8 = (tid & 3) * 8, rg = MPROMPT + row;
    for (int u = idx; u < 64; u += nblk) {
        float v[8], x[8]; const int n = u * 32 + c8;
        skinny_core(C, (const bf16*)(ws + WS_SMIX), LDS_X, (const bf16*)(ws + WS_WO) + ((size_t)(u >> 3) * (DM / 64) * 256 + (u & 7) * 32) * 64, C.wave * 256, 256, v);
        ld8f(C.in[IN_XS] + (size_t)row * DM + n, x); float ss = 0.f;
#pragma unroll
        for (int k = 0; k < 8; ++k) { v[k] += x[k]; ss += v[k] * v[k]; }
        st8f(C.out + O_YS + (size_t)row * DM + n, v); *(GAS v4u*)((bf16*)(ws + WS_SX1B) + (size_t)row * LDS_X + n) = pack8f(v);
        ss += __shfl_xor(ss, 1); ss += __shfl_xor(ss, 2);
        if ((tid & 3) == 0) ((float*)(ws + WS_X1SS))[(size_t)MPROMPT * 32 + row * 64 + u] = ss;
    }
}
__device__ __forceinline__ void s_up(const Ctx& C) {
    unsigned char* ws = C.ws; const int tid = C.tid, row = tid >> 2, c8 = (tid & 3) * 8, rg = MPROMPT + row;
    float rs; { const GAS f32x4* sp = (const GAS f32x4*)((const float*)(ws + WS_X1SS) + (size_t)MPROMPT * 32 + row * 64); f32x4 s4 = sp[0];
#pragma unroll
        for (int k = 1; k < 16; ++k) s4 += sp[k];
        rs = rsqrtf(((s4.x + s4.y) + (s4.z + s4.w)) * (1.0f / DM) + EPS); }
    for (int u = blockIdx.x; u < 256; u += C.G) {
        float v[8]; skinny_core(C, (const bf16*)(ws + WS_SX1B), LDS_X, (const bf16*)(ws + WS_WUP) + ((size_t)(u >> 3) * (DM / 64) * 256 + (u & 7) * 32) * 64, C.wave * 256, 256, v);
#pragma unroll
        for (int k = 0; k < 8; ++k) { const float a = fmaxf(v[k] * rs, 0.f); v[k] = a * a; }
        *(GAS v4u*)((bf16*)(ws + WS_SH) + (size_t)row * LDS_H + u * 32 + c8) = pack8f(v);
    }
}
__device__ __forceinline__ void s_down(const Ctx& C) {
    unsigned char* ws = C.ws; const int tid = C.tid, row = tid >> 2, c8 = (tid & 3) * 8, rg = MPROMPT + row;
    float* PART = (float*)(ws + WS_SPART); gu32* tick = (gu32*)(ws + WS_CTL) + CW_TICK; LAS unsigned* flag = (LAS unsigned*)(C.lds + AT_X);
    for (int u = blockIdx.x; u < 256; u += C.G) { const int strip = u >> 2, kq = u & 3;
        float v[8]; skinny_core(C, (const bf16*)(ws + WS_SH), LDS_H, (const bf16*)(ws + WS_WDN) + ((size_t)(strip >> 3) * (DFF / 64) * 256 + (strip & 7) * 32) * 64, kq * 2048 + C.wave * 256, 256, v);
        { gu64* pp = (gu64*)(PART + ((size_t)(strip * 4 + kq) * 128 + row) * 32 + c8);
#pragma unroll
          for (int q = 0; q < 4; ++q) __hip_atomic_store(pp + q, ((unsigned long long)__float_as_uint(v[2 * q + 1]) << 32) | __float_as_uint(v[2 * q]), RLX_AGENT); }
        asm volatile("s_waitcnt vmcnt(0)" ::: "memory"); __syncthreads();
        if (tid == 0) { const unsigned old = __hip_atomic_fetch_add(tick + strip * 64, 1u, __ATOMIC_RELAXED, __HIP_MEMORY_SCOPE_AGENT); flag[0] = old; }
        __syncthreads();
        const bool last = flag[0] == 3u;
        __syncthreads();
        if (last) { __builtin_amdgcn_fence(__ATOMIC_ACQUIRE, "agent"); asm volatile("s_waitcnt vmcnt(0)" ::: "memory");
            float* y = C.out + O_YS + (size_t)row * DM + strip * 32 + c8; float acc[8]; ld8f(y, acc);
#pragma unroll
            for (int q = 0; q < 4; ++q) { const gu64* pp = (const gu64*)(PART + ((size_t)(strip * 4 + q) * 128 + row) * 32 + c8);
#pragma unroll
                for (int k = 0; k < 4; ++k) { const unsigned long long w = __hip_atomic_load(pp + k, RLX_AGENT); acc[2 * k] += __uint_as_float((unsigned)w); acc[2 * k + 1] += __uint_as_float((unsigned)(w >> 32)); } }
            st8f(y, acc); }
    }
}

__device__ __forceinline__ void fused_cmp_unit(const Ctx& C, int L, const epi::EpiCmp& E) {
    using pg8::bf16x8; using pg8::f32x4; using pg8::HTB;
    LAS unsigned char* lds = C.lds + RING_OFF;
    const Ctx Lf = fresh(C);
    const int tid = Lf.tid, wid = C.wave, lane = Lf.lane, wr = wid >> 2, wc = wid & 3, fr = lane & 15, fq = lane >> 4;
    const int b = L >> 1, kv = L & 1;
    const int* pt = (const int*)C.in[IN_PT] + b * 16;
    unsigned aofg[2][2], voffB[2];
#pragma unroll
    for (int i = 0; i < 2; ++i) { int R, Cx; pg8::stage_rc(tid * 16 + i * 8192, R, Cx);
        const unsigned page = (unsigned)pt[R >> 3];
#pragma unroll
        for (int h = 0; h < 2; ++h) aofg[h][i] = (((page * 128u + (unsigned)(R & 7) * 16u) * 512u) + (unsigned)((kv * 2 + h) * 128 + Cx)) * 4u;
        voffB[i] = (unsigned)(R * 64 + Cx) * 2u; }
    const char* cA = (const char*)C.in[IN_CCMP];
    const char* cB = (const char*)(C.ws + WS_WC) + (size_t)kv * 32 * 32768;
    const size_t hstepB = 16384;
    const int aoff = pg8::lds_byte(wr * 64 + fr, fq * 8), boff = pg8::lds_byte(wc * 32 + fr, fq * 8);
#define FC_SA(bf, h) (((bf) * 2 + (h)) * HTB)
#define FC_SB(bf, h) ((4 + (bf) * 2 + (h)) * HTB)
#define FC_LOADA(kt) do { const unsigned ko_ = (unsigned)((kt) >> 1) * 2048u + (unsigned)((kt) & 1) * 256u; \
        _Pragma("unroll") for (int h = 0; h < 2; ++h) _Pragma("unroll") for (int i = 0; i < 2; ++i) { const char* p_ = cA + aofg[h][i] + ko_; \
            ar[h][i][0] = *(const GAS f32x4*)p_; ar[h][i][1] = *(const GAS f32x4*)(p_ + 16); } } while (0)
#define FC_WRITEA(bf) do { _Pragma("unroll") for (int h = 0; h < 2; ++h) _Pragma("unroll") for (int i = 0; i < 2; ++i) { v4u w_; \
            w_.x = pk2(ar[h][i][0].x, ar[h][i][0].y); w_.y = pk2(ar[h][i][0].z, ar[h][i][0].w); w_.z = pk2(ar[h][i][1].x, ar[h][i][1].y); w_.w = pk2(ar[h][i][1].z, ar[h][i][1].w); \
            *(LAS v4u*)(lds + FC_SA(bf, h) + tid * 16 + i * 8192) = w_; } } while (0)
#define FC_DMAB(kt, bf) do { _Pragma("unroll") for (int h = 0; h < 2; ++h) _Pragma("unroll") for (int i = 0; i < 2; ++i) \
            __builtin_amdgcn_global_load_lds((const unsigned*)(cB + h * hstepB + (size_t)(kt) * 32768 + voffB[i]), (LAS unsigned*)(lds + FC_SB(bf, h) + wid * 1024 + i * 8192), 16, 0, 0); } while (0)
#define FC_LDA(dst, bf, h) do { _Pragma("unroll") for (int m = 0; m < 4; ++m) _Pragma("unroll") for (int k = 0; k < 2; ++k) dst[m][k] = *(const LAS bf16x8*)(lds + FC_SA(bf, h) + aoff + m * 2048 + k * 1024); } while (0)
#define FC_LDB(dst, bf, h) do { _Pragma("unroll") for (int n = 0; n < 2; ++n) _Pragma("unroll") for (int k = 0; k < 2; ++k) dst[n][k] = *(const LAS bf16x8*)(lds + FC_SB(bf, h) + boff + n * 2048 + k * 1024); } while (0)
#define FC_MMA(ai, bj, At_, Bt_) do { _Pragma("unroll") for (int m = 0; m < 4; ++m) _Pragma("unroll") for (int n = 0; n < 2; ++n) _Pragma("unroll") for (int k = 0; k < 2; ++k) \
        acc[ai][bj][m][n] = __builtin_amdgcn_mfma_f32_16x16x32_bf16(Bt_[n][k], At_[m][k], acc[ai][bj][m][n], 0, 0, 0); } while (0)
    f32x4 acc[2][2][4][2];
#pragma unroll
    for (int a = 0; a < 2; ++a)
#pragma unroll
        for (int bb = 0; bb < 2; ++bb)
#pragma unroll
            for (int m = 0; m < 4; ++m)
#pragma unroll
                for (int n = 0; n < 2; ++n) acc[a][bb][m][n] = (f32x4){0.f, 0.f, 0.f, 0.f};
    f32x4 ar[2][2][2];
    bf16x8 At[4][2], B0[2][2];
    __syncthreads();
    FC_LOADA(0); FC_DMAB(0, 0); FC_WRITEA(0);
    asm volatile("s_waitcnt vmcnt(0) lgkmcnt(0)" ::: "memory"); __syncthreads();
#pragma unroll 1
    for (int kt = 0; kt < 32; ++kt) { const int bf = kt & 1;
        if (kt + 1 < 32) { FC_LOADA(kt + 1); FC_DMAB(kt + 1, bf ^ 1); }
        FC_LDB(B0, bf, 0); FC_LDA(At, bf, 0); FC_MMA(0, 0, At, B0);
        FC_LDA(At, bf, 1); FC_MMA(1, 0, At, B0);
        FC_LDB(B0, bf, 1); FC_MMA(1, 1, At, B0);
        FC_LDA(At, bf, 0); FC_MMA(0, 1, At, B0);
        if (kt + 1 < 32) FC_WRITEA(bf ^ 1);
        asm volatile("s_waitcnt vmcnt(0) lgkmcnt(0)" ::: "memory"); __syncthreads();
    }
    const pg8::Unit u{L, kv};
    { const Ctx Le = fresh(C); E(acc, u, wr, wc, Le.lane & 15, Le.lane >> 4); }
#undef FC_SA
#undef FC_SB
#undef FC_LOADA
#undef FC_WRITEA
#undef FC_DMAB
#undef FC_LDA
#undef FC_LDB
#undef FC_MMA
}

constexpr int LATE_P1 = 4096;
constexpr int WINCOPY_P2 = 0;
constexpr int LATE_P2 = I_LATE - LATE_P1;
constexpr int LATE_P12 = LATE_P1 + LATE_P2;
constexpr int NLATE_W = (I_LATE - LATE_P12 + 31) / 32, P5_HEAVY = 160, P5_SAMP0 = P5_HEAVY, P5_LIGHT0 = P5_SAMP0 + 256, P5_STREAM0 = P5_LIGHT0 + (256 - P5_HEAVY),
              P5_ITEMS = P5_STREAM0 + NLATE_W + WINCOPY_ITEMS - WINCOPY_P2;
__device__ __forceinline__ void p5_attn_flash(const Ctx& C, const int it_lo = 0, const int it_hi = P5_ITEMS) {
    unsigned char* ws = C.ws; gu32* ctl = (gu32*)(ws + WS_CTL); gu32* qa = ctl + CW_Q5;
    LAS float* scr = (LAS float*)(C.lds + RING_OFF + C.wave * 16384);
    for (;;) {
        gu32* qa_ = qa; unsigned qo_ = AT_WS + 2048; asm volatile("" : "+s"(qa_), "+s"(qo_));
        LAS unsigned* qf_ = (LAS unsigned*)(C.lds + qo_);
        __syncthreads();
        if (C.wave == 0 && lane_now() == 0) qf_[0] = __hip_atomic_fetch_add(qa_, 1u, __ATOMIC_RELAXED, __HIP_MEMORY_SCOPE_AGENT);
        __syncthreads();
        const int it = __builtin_amdgcn_readfirstlane((int)qf_[0]) + it_lo;
        if (it >= it_hi) break;
        const Ctx L = fresh(C);
        if (it < P5_HEAVY || (it >= P5_LIGHT0 && it < P5_STREAM0)) { const int un = it < P5_HEAVY ? it : it - P5_LIGHT0 + P5_HEAVY;
            const int qb_ = 63 - (un >> 2), bg = un & 3; flash_unit(L, bg >> 1, bg & 1, qb_); }
        else if (it < P5_LIGHT0) { const int si = it - P5_SAMP0, b = si >> 1, g = si & 1, row = MPROMPT + b;
            AttItem ai{(const bf16*)(ws + WS_QN) + (size_t)row * DQ + g * 512, PASTLEN, 127, (const bf16*)(ws + WS_KCS) + (size_t)(b * 2 + g) * 128 * 128, (const bf16*)(ws + WS_VCS) + (size_t)(b * 2 + g) * 128 * 128, 33,
                       (const float*)(ws + WS_GN) + (size_t)row * 32 + g * 12, (bf16*)(ws + WS_SOB) + (size_t)b * LDS_G + g * 512, (const float*)(ws + WS_BLUT) + g * 4 * 132};
            SampleKV kv{C.in[IN_CSEL] + g * 128, (const int*)C.in[IN_PT] + b * 16, C.out + O_SSEL + (size_t)b * 512 + g * 128, C.in[IN_WINB] + (size_t)b * 512 * 512 + g * 128,
                        (const float*)(ws + WS_KVWR) + (size_t)row * 512 + g * 128};
            nsa_item<SampleKV>(L, ai, kv, C.in[IN_GK] + 128, C.in[IN_GK] + 256); }
        else if (it < P5_STREAM0 + NLATE_W) { const int base = LATE_P12 + (it - P5_STREAM0) * 32;
#pragma unroll 1
            for (int k = 0; k < 4; ++k) { const int r = base + k * 8 + C.wave; if (r < I_LATE) w_item_late(L, r, scr); } }
        else wincopy_item(L, WINCOPY_P2 + it - P5_STREAM0 - NLATE_W);
    }
}

#ifndef MK_N_LAUNCHES
#define MK_N_LAUNCHES 1
#endif
constexpr int NPHASES = 10;

__device__ __forceinline__ void ph1(const Ctx& C, LAS unsigned char* ring) { unsigned char* ws = C.ws;
    pg8::Gemm g{(const bf16*)(ws + WS_XB), (const bf16*)(ws + WS_WIN), MPROMPT, NINP, DM, LD2, LD2, 1, 1}; pg8::StaticOrder S; S.init(MPROMPT, NINP, C.G, (int)blockIdx.x);
    epi::EpiIn E{(const float*)(ws + WS_RSTD1), (bf16*)(ws + WS_U), (bf16*)(ws + WS_VG), (float*)(ws + WS_VSS), (float*)(ws + WS_QRAW), (float*)(ws + WS_KVWR),
                 (bf16*)(ws + WS_GA), (bf16*)(ws + WS_GB), (float*)(ws + WS_GN), C.out, (bf16*)(ws + WS_ACP)};
    const int nu = (MPROMPT / 256) * (NINP / 256), full = nu % C.G, nlight = full ? C.G - full : C.G, idx = full ? (int)blockIdx.x - full : (int)blockIdx.x;
    const bool sfirst = idx >= 0 && (C.G % 8 == 0) && (blockIdx.x & 1);
    if (sfirst) s_in(C, idx, nlight);
    pg8::gemm_phase<epi::EpiIn, pg8::StaticOrder, true, true>(ring, g, S, E, fresh(C).tid);
    { if (idx >= 0) { if (!sfirst) s_in(fresh(C), idx, nlight);
          const Ctx L = fresh(C); LAS float* scr = (LAS float*)(C.lds + RING_OFF + C.wave * 16384); __syncthreads();
          for (int r = idx * NWAVES + C.wave; r < LATE_P1; r += nlight * NWAVES) w_item_late(L, r, scr); } } }
__device__ __forceinline__ void ph2(const Ctx& C, LAS unsigned char* ring) { unsigned char* ws = C.ws;
    { const int skip = C.G > 32 ? 16 : 0; if ((int)blockIdx.x >= skip) p2_post(C, (int)blockIdx.x - skip, C.G - skip); }
    { epi::EpiCmp E{(float*)(ws + WS_YCS), 127};
      for (int Lu = (int)blockIdx.x; Lu < 256; Lu += C.G) { fused_cmp_unit(C, Lu, E);
          asm volatile("s_waitcnt vmcnt(0)" ::: "memory"); __syncthreads();
          const Ctx Lc = fresh(C);
          cmp_combine_rows(Lc, false, Lu * 256, 256); } }
    __syncthreads();
    const int ngb = C.G > 16 ? 8 : 0;
    if (ngb == 0 || (int)blockIdx.x < ngb) {
        { pg8::Gemm g{(const bf16*)(ws + WS_ACP), (const bf16*)(ws + WS_WC), 2048, 512, 2048, LD2, LD2, 1, 1}; epi::CmpOrder S{8, C.G, (int)blockIdx.x, 1};
          epi::EpiCmp E{(float*)(ws + WS_YCP), 255};
          const Ctx Lg = fresh(C); pg8::gemm_phase<epi::EpiCmp, epi::CmpOrder, true, true>(ring, g, S, E, Lg.tid); }
        asm volatile("s_waitcnt vmcnt(0)" ::: "memory"); __syncthreads();
        const Ctx Lc = fresh(C);
        for (int L = (int)blockIdx.x; L < 8; L += C.G) cmp_combine_rows(Lc, true, L * 256, 256); }
    { const Ctx Ls = fresh(C);
      if (ngb == 0) p4_sgu(Ls, (int)blockIdx.x, C.G); else if ((int)blockIdx.x >= ngb) p4_sgu(Ls, (int)blockIdx.x - ngb, C.G - ngb); }
    { const int skip = C.G > 32 ? 16 : 0;
      if ((int)blockIdx.x >= skip) { const Ctx L = fresh(C); LAS float* scr = (LAS float*)(C.lds + RING_OFF + C.wave * 16384); __syncthreads();
          for (int r = LATE_P1 + ((int)blockIdx.x - skip) * NWAVES + C.wave; r < LATE_P12; r += (C.G - skip) * NWAVES) w_item_late(L, r, scr);
          for (int c = (int)blockIdx.x - skip; c < WINCOPY_P2; c += C.G - skip) wincopy_item(L, c); } } }
__device__ __forceinline__ void ph6(const Ctx& C, LAS unsigned char* ring) { unsigned char* ws = C.ws;
    const bool odd64 = (C.G % 8 == 0) && C.G >= 128;
    if (odd64) { if ((blockIdx.x & 1) && blockIdx.x < 128) s_proj(C, (int)blockIdx.x >> 1, 64); }
    { pg8::Gemm g{(const bf16*)(ws + WS_OA), (const bf16*)(ws + WS_WG), MPROMPT, DM, DG, LD1, LD1, 1, 1}; pg8::StaticOrder S; S.init(MPROMPT, DM, C.G, (int)blockIdx.x);
      epi::EpiMixA E{(const bf16*)(ws + WS_GA), (bf16*)(ws + WS_MIXA)};
      pg8::gemm_phase<epi::EpiMixA, pg8::StaticOrder, true, true>(ring, g, S, E, fresh(C).tid); }
    { pg8::Gemm g{(const bf16*)(ws + WS_OB), (const bf16*)(ws + WS_WN), MPROMPT, DM, DQ, LD1, LD1, 1, 1}; pg8::StaticOrder S; S.init(MPROMPT, DM, C.G, (int)blockIdx.x);
      epi::EpiMixB E{(const bf16*)(ws + WS_GB), (const bf16*)(ws + WS_MIXA), (bf16*)(ws + WS_MIX)};
      pg8::gemm_phase<epi::EpiMixB, pg8::StaticOrder, true, true>(ring, g, S, E, fresh(C).tid); }
    if (!odd64) s_proj(fresh(C), (int)blockIdx.x, C.G); }
__device__ __forceinline__ void ph7(const Ctx& C, LAS unsigned char* ring) { unsigned char* ws = C.ws;
    pg8::Gemm g{(const bf16*)(ws + WS_MIX), (const bf16*)(ws + WS_WO), MPROMPT, DM, DM, LD2, LD2, 1, 1}; pg8::StaticOrder S; S.init(MPROMPT, DM, C.G, (int)blockIdx.x);
    epi::EpiOut E{C.in[IN_XP], C.in[IN_XS], C.out, (bf16*)(ws + WS_X1B), (float*)(ws + WS_X1SS)};
    const bool odd64 = (C.G % 8 == 0) && C.G >= 128;
    if (odd64) { if ((blockIdx.x & 1) && blockIdx.x < 128) s_out(C, (int)blockIdx.x >> 1, 64); }
    pg8::gemm_phase<epi::EpiOut, pg8::StaticOrder, true, true>(ring, g, S, E, fresh(C).tid);
    if (!odd64) s_out(fresh(C), (int)blockIdx.x, C.G); }
__device__ __forceinline__ void ph8(const Ctx& C, LAS unsigned char* ring) { unsigned char* ws = C.ws;
    pg8::Gemm g{(const bf16*)(ws + WS_X1B), (const bf16*)(ws + WS_WUP), MPROMPT, DFF, DM, LD2, LD2, 1, 1}; pg8::StaticOrder S; S.init(MPROMPT, DFF, C.G, (int)blockIdx.x);
    epi::EpiUp E{(const float*)(ws + WS_X1SS), (bf16*)(ws + WS_H)};
    const bool first = (C.G % 8 == 0) && (blockIdx.x & 1);
    if (first) s_up(C);
    pg8::gemm_phase<epi::EpiUp, pg8::StaticOrder, true, true>(ring, g, S, E, fresh(C).tid);
    if (!first) s_up(fresh(C)); }
template <bool DUMMY>
__device__ __forceinline__ void ph9(const Ctx& C, LAS unsigned char* ring) { unsigned char* ws = C.ws;
    pg8::Gemm g{(const bf16*)(ws + WS_H), (const bf16*)(ws + WS_WDN), MPROMPT, DM, DFF, LD8, LD8, 1, 1}; pg8::StaticOrder S; S.init(MPROMPT, DM, C.G, (int)blockIdx.x);
    epi::EpiDown E{DUMMY ? (float*)(ws + WS_DUMMY) : C.out, (const bf16*)(ws + WS_X1B)};
    const bool first = (C.G % 8 == 0) && (blockIdx.x & 1);
    if (!DUMMY && first) s_down(C);
    pg8::gemm_phase<epi::EpiDown, pg8::StaticOrder, true, true>(ring, g, S, E, fresh(C).tid);
    if (!DUMMY && !first) s_down(fresh(C)); }

struct Args { const float* in[24]; float* out; unsigned char* ws; int ph_lo, ph_hi; };
static_assert(sizeof(Args) == 24 * 8 + 8 + 8 + 8, "no padding bytes in the kernel argument struct");

__global__ void __launch_bounds__(NWAVES * 64, 2) nsa_fwd(Args args) {
    extern __shared__ __attribute__((aligned(16))) unsigned char lds_raw[];
    Ctx C;
    C.in = args.in;
    C.out = args.out; C.ws = args.ws; C.lds = (LAS unsigned char*)lds_raw;
    C.tid = threadIdx.x; C.lane = C.tid & 63; C.wave = __builtin_amdgcn_readfirstlane(C.tid >> 6);
    C.G = gridDim.x; { const int bx = blockIdx.x; C.vcu = (C.G % 8 == 0) ? (bx % 8) * (C.G / 8) + bx / 8 : bx; }
    volatile LAS unsigned* MISC = (volatile LAS unsigned*)(C.lds + MISC_OFF);
    gu32* ctl = (gu32*)(args.ws + WS_CTL);
    for (int u = C.tid; u < (LDS_BYTES - LDSCTL_OFF) / 4; u += NWAVES * 64) ((LAS unsigned*)(C.lds + LDSCTL_OFF))[u] = 0u;
    __syncthreads();
    const int lo = args.ph_lo, hi = args.ph_hi;
    XcdBarrier bar; bar.bar = (unsigned*)(ctl + CW_BAR); bar.x = 0; bar.w = 0; bar.st = nullptr;
    if (hi - lo > 1) bar = xcd_barrier_post((unsigned*)(ctl + CW_BAR), MISC + 8);
#ifndef ONLY_PHASES
#define ONLY_PHASES 0x3ff
#endif
#define IN(k) (((ONLY_PHASES >> (k)) & 1) && lo <= (k) && (k) < hi)
#ifndef PROBE_SLACK
#define PROBE_SLACK -1
#endif
#ifndef PROBE_SLACK_PH
#define PROBE_SLACK_PH 2
#endif
#if PROBE_SLACK >= 0
    unsigned long long ps0_ = 0;
#define SEAM2(k, n) do { if (IN(k) && IN(n)) { if ((k) == PROBE_SLACK_PH) { __syncthreads(); ps0_ = __builtin_amdgcn_s_memrealtime(); } xcd_barrier(bar); \
        if ((k) == PROBE_SLACK_PH) { if ((int)blockIdx.x == PROBE_SLACK && C.wave == 0) { const unsigned long long d_ = __builtin_amdgcn_s_memrealtime() - ps0_, t0_ = __builtin_amdgcn_s_memrealtime(); \
                while (__builtin_amdgcn_s_memrealtime() - t0_ < d_ * 10ull) __builtin_amdgcn_s_sleep(16); } \
            xcd_barrier(bar); } } } while (0)
#else
#define SEAM2(k, n) do { if (IN(k) && IN(n)) xcd_barrier(bar); } while (0)
#endif
#define SEAM(k) SEAM2(k, (k) + 1)
    LAS unsigned char* ring = C.lds + RING_OFF;

#define PROBE2(k, call) do { if ((PROBE_MASK >> (k)) & 1) { xcd_barrier(bar); call; } } while (0)
    if (IN(0)) { p0_prologue(fresh(C)); PROBE2(0, p0_prologue(fresh(C))); } SEAM(0);
    if (IN(1)) { ph1(fresh(C), ring); PROBE2(1, ph1(fresh(C), ring)); } SEAM(1);
    if (IN(2)) { ph2(fresh(C), ring); PROBE2(2, ph2(fresh(C), ring)); } SEAM2(2, 5);
    if (IN(5)) { p5_attn_flash(fresh(C));
#define P5_RERUN(lo_, hi_) do { xcd_barrier(bar); if (blockIdx.x == 0 && C.wave == 0 && lane_now() == 0) __hip_atomic_store(ctl + CW_Q5, 0u, RLX_AGENT); xcd_barrier(bar); p5_attn_flash(fresh(C), lo_, hi_); } while (0)
        if ((PROBE_MASK >> 5) & 1) P5_RERUN(0, P5_ITEMS);
        if ((PROBE_MASK >> 13) & 1) { P5_RERUN(0, P5_HEAVY); }
        if ((PROBE_MASK >> 14) & 1) { P5_RERUN(P5_SAMP0, P5_LIGHT0); }
        if ((PROBE_MASK >> 15) & 1) { P5_RERUN(P5_STREAM0, P5_ITEMS); }
} SEAM(5);
    if (IN(6)) { ph6(fresh(C), ring); PROBE2(6, ph6(fresh(C), ring)); } SEAM(6);
    if (IN(7)) { ph7(fresh(C), ring); PROBE2(7, ph7(fresh(C), ring)); } SEAM(7);
#if (PROBE_MASK >> 20) & 1
    long long pc0_ = 0; unsigned long long pr0_ = 0; if (IN(8)) { pc0_ = clock64(); pr0_ = __builtin_amdgcn_s_memrealtime(); }
#endif
    if (IN(8)) { ph8(fresh(C), ring); PROBE2(8, ph8(fresh(C), ring)); }
#if (PROBE_MASK >> 20) & 1
    if (IN(8) && blockIdx.x == 0 && C.wave == 0) { const long long dc_ = clock64() - pc0_; const unsigned long long dr_ = __builtin_amdgcn_s_memrealtime() - pr0_;
        const unsigned long long mhz_ = (unsigned long long)dc_ * 100ull / (dr_ ? dr_ : 1ull); const unsigned long long t0_ = __builtin_amdgcn_s_memrealtime();
        while (__builtin_amdgcn_s_memrealtime() - t0_ < mhz_ * 100ull) __builtin_amdgcn_s_sleep(16); }
#endif
    SEAM(8);
    if (IN(9)) { PROBE2(9, ph9<true>(fresh(C), ring)); if ((PROBE_MASK >> 9) & 1) xcd_barrier(bar); ph9<false>(fresh(C), ring); }
#undef PROBE2
#undef IN
#undef SEAM
#undef SEAM2
}

extern "C" void kernel_launch(void* const* d_in, const int* in_sizes, int n_in, void* d_out, int out_size, void* d_ws, size_t ws_size, hipStream_t stream) {
    static int grid = 0;
    if (grid == 0) {
        if (n_in != 24 || out_size != (int)O_END || ws_size < WS_END) {
            fprintf(stderr, "kernel_launch: built for 24 inputs, %zu outputs, >= %zu bytes of workspace; got n_in %d out %d ws %zu; nothing launched\n", (size_t)O_END, (size_t)WS_END, n_in, out_size, ws_size);
            grid = -1; return; }
        int dev = 0, cus = 0, per_cu = 0;
        if (hipGetDevice(&dev) != hipSuccess || hipDeviceGetAttribute(&cus, hipDeviceAttributeMultiprocessorCount, dev) != hipSuccess) { fprintf(stderr, "kernel_launch: device query failed\n"); grid = -1; return; }
        if (hipFuncSetAttribute((const void*)nsa_fwd, hipFuncAttributeMaxDynamicSharedMemorySize, LDS_BYTES) != hipSuccess) { fprintf(stderr, "kernel_launch: hipFuncSetAttribute failed\n"); grid = -1; return; }
        if (hipOccupancyMaxActiveBlocksPerMultiprocessor(&per_cu, (const void*)nsa_fwd, NWAVES * 64, LDS_BYTES) != hipSuccess || per_cu < 1)
            fprintf(stderr, "kernel_launch: note: occupancy query reports %d workgroups per CU\n", per_cu);
        (void)hipGetLastError();
        grid = cus;
    }
    if (grid < 0) return;
    if (hipMemsetAsync((char*)d_ws + WS_CTL, 0, CTL_ZERO_BYTES, stream) != hipSuccess) { fprintf(stderr, "kernel_launch: memset failed\n"); return; }
    Args a{};
    for (int i = 0; i < 24; ++i) a.in[i] = (const float*)d_in[i];
    a.out = (float*)d_out; a.ws = (unsigned char*)d_ws;
    const int nl = MK_N_LAUNCHES;
    for (int li = 0; li < nl; ++li) {
        a.ph_lo = nl == 1 ? 0 : li; a.ph_hi = nl == 1 ? NPHASES : li + 1;
        hipLaunchKernelGGL(nsa_fwd, dim3(grid), dim3(NWAVES * 64), LDS_BYTES, stream, a);
        const hipError_t le = hipPeekAtLastError();
        if (le != hipSuccess) { fprintf(stderr, "kernel_launch: launch %d failed: %s\n", li, hipGetErrorName(le)); break; }
    }
}
```

```cpp
#include <hip/hip_runtime.h>
#include <cstdio>
#include <cstdint>
namespace pg8 {
#define PG8_LAS __attribute__((address_space(3)))
typedef unsigned short bf16_t;
typedef short bf16x8 __attribute__((ext_vector_type(8)));
typedef float f32x4 __attribute__((ext_vector_type(4)));
typedef unsigned u32x4 __attribute__((ext_vector_type(4)));
constexpr int BM = 256, BK = 64, HALF = 128, HTB = HALF * BK * 2  , STAGE_BYTES = 8 * HTB, NXCD = 8, WGM = 8;

__host__ __device__ __forceinline__ int lds_byte(int r, int c) { const int st = (r >> 4) * 2 + (c >> 5), rr = r & 15, cc = c & 31, ob = rr * 64 + cc * 2; return st * 1024 + (ob ^ (((ob >> 9) & 1) << 5)); }
__host__ __device__ __forceinline__ void stage_rc(int b, int& R, int& C) { const int st = b / 1024, sb = b % 1024, swz = sb ^ (((sb >> 9) & 1) << 5); R = (st >> 1) * 16 + swz / 64; C = (st & 1) * 32 + (swz % 64) / 2; }
__host__ __device__ __forceinline__ int perm32(int rho) { const int n = rho >> 4, i = rho & 15; return 8 * (i >> 2) + 4 * n + (i & 3); }

struct Unit { int pm, pn; };
struct Gemm { const bf16_t* A; const bf16_t* Bt; int M, N, K, lda, ldb; int tileA = 0, tileB = 0; };

struct StaticOrder {
    int nM, nN, nwg, G, c;
    __host__ __device__ void init(int M, int N, int G_, int c_) { nM = M / BM; nN = N / BM; nwg = nM * nN; G = G_; c = c_; }
    __host__ __device__ bool next(int i, Unit& u) const {
        const long L = (long)i * G + c; if (L >= nwg) return false;
        int wgid = (int)L; { const int q = nwg / NXCD, r = nwg % NXCD, xcd = wgid % NXCD, off = wgid / NXCD; wgid = (xcd < r ? xcd * (q + 1) : r * (q + 1) + (xcd - r) * q) + off; }
        const int nig = WGM * nN, gid = wgid / nig, fm = gid * WGM, gsz = (nM - fm) < WGM ? (nM - fm) : WGM;
        u.pm = fm + ((wgid % nig) % gsz); u.pn = (wgid % nig) / gsz; return true;
    }
    __device__ __forceinline__ void a_ready(const Unit&) const {}
    __device__ __forceinline__ void done(const Unit&) const {}
};

__device__ __forceinline__ unsigned cvt_pk_bf16(float lo, float hi) { unsigned r; asm volatile("v_cvt_pk_bf16_f32 %0, %1, %2" : "=v"(r) : "v"(lo), "v"(hi)); return r; }
typedef float f32x2 __attribute__((ext_vector_type(2)));
template <class Epi, class Sched, bool ALIGN_EPI = false, bool SP2 = false>
__device__ __forceinline__ void gemm_phase(PG8_LAS unsigned char* lds, const Gemm g, const Sched& S, const Epi& E, const int tid) {
    const int wid = __builtin_amdgcn_readfirstlane(tid >> 6), lane = tid & 63, wr = wid >> 2, wc = wid & 3, fr = lane & 15, fq = lane >> 4;
    const int K = g.K, nt = K / BK;
    unsigned voffA[2], voffB[2];
#pragma unroll
    for (int i = 0; i < 2; ++i) { int R, C; stage_rc(tid * 16 + i * 8192, R, C); const int Rb = Epi::PERM ? ((R & ~31) + perm32(R & 31)) : R;
        voffA[i] = (unsigned)(R * (g.tileA ? 64 : g.lda) + C) * 2u; voffB[i] = (unsigned)(Rb * (g.tileB ? 64 : g.ldb) + C) * 2u; }
    const size_t kstepA = g.tileA ? (size_t)32768 : (size_t)(BK * 2), kstepB = g.tileB ? (size_t)32768 : (size_t)(BK * 2);
    const size_t hstepA = g.tileA ? (size_t)16384 : (size_t)HALF * g.lda * 2, hstepB = g.tileB ? (size_t)16384 : (size_t)HALF * g.ldb * 2;
    const size_t tstepA = g.tileA ? (size_t)(g.K / BK) * 32768 : 2 * hstepA, tstepB = g.tileB ? (size_t)(g.K / BK) * 32768 : 2 * hstepB;
    const unsigned ldsw = (unsigned)wid * 1024u;
    const int aoff = lds_byte(wr * 64 + fr, fq * 8), boff = lds_byte(wc * 32 + fr, fq * 8);
#define PG8_SA(b, h) (((b) * 2 + (h)) * HTB)
#define PG8_SB(b, h) ((4 + (b) * 2 + (h)) * HTB)
#define PG8_STAGE(bufoff, gbase, voff) do { _Pragma("unroll") for (int _i = 0; _i < 2; ++_i) \
        __builtin_amdgcn_global_load_lds((const unsigned*)((const char*)(gbase) + (voff)[_i]), (PG8_LAS unsigned*)(lds + (bufoff) + ldsw + _i * 8192), 16, 0, 0); } while (0)
#define PG8_LDA(dst, b, h) do { _Pragma("unroll") for (int m = 0; m < 4; ++m) _Pragma("unroll") for (int k = 0; k < 2; ++k) dst[m][k] = *(const PG8_LAS bf16x8*)(lds + PG8_SA(b, h) + aoff + m * 2048 + k * 1024); } while (0)
#define PG8_LDB(dst, b, h) do { _Pragma("unroll") for (int n = 0; n < 2; ++n) _Pragma("unroll") for (int k = 0; k < 2; ++k) dst[n][k] = *(const PG8_LAS bf16x8*)(lds + PG8_SB(b, h) + boff + n * 2048 + k * 1024); } while (0)
#define PG8_MMA(ai, bj, At, Bt) do { __builtin_amdgcn_s_setprio(1); _Pragma("unroll") for (int m = 0; m < 4; ++m) _Pragma("unroll") for (int n = 0; n < 2; ++n) _Pragma("unroll") for (int k = 0; k < 2; ++k) \
        acc[ai][bj][m][n] = __builtin_amdgcn_mfma_f32_16x16x32_bf16(Bt[n][k], At[m][k], acc[ai][bj][m][n], 0, 0, 0); __builtin_amdgcn_s_setprio(0); } while (0)
#define PG8_WAIT_V(n) asm volatile("s_waitcnt vmcnt(" #n ")" ::: "memory")
#define PG8_WAIT_L(n) asm volatile("s_waitcnt lgkmcnt(" #n ")" ::: "memory")
#define PG8_BAR __builtin_amdgcn_s_barrier()
#define PG8_SCHED __builtin_amdgcn_sched_barrier(0)
    Unit cur, nxt; int ui = 0;
    if (!S.next(0, cur)) return;
    f32x4 acc[2][2][4][2];
#pragma unroll
    for (int a = 0; a < 2; ++a)
#pragma unroll
        for (int b = 0; b < 2; ++b)
#pragma unroll
            for (int m = 0; m < 4; ++m)
#pragma unroll
                for (int n = 0; n < 2; ++n) acc[a][b][m][n] = (f32x4){0.f, 0.f, 0.f, 0.f};
    bf16x8 At[4][2], B0[2][2], B1[2][2];
    const char* cA = (const char*)g.A + (size_t)cur.pm * tstepA; const char* cB = (const char*)g.Bt + (size_t)cur.pn * tstepB;
    S.a_ready(cur);
    if constexpr (SP2) {
        PG8_STAGE(PG8_SB(0, 0), cB, voffB); PG8_STAGE(PG8_SB(0, 1), cB + hstepB, voffB); PG8_STAGE(PG8_SA(0, 0), cA, voffA); PG8_STAGE(PG8_SA(0, 1), cA + hstepA, voffA);
        if (wr == 1) PG8_BAR;
        PG8_WAIT_V(2); PG8_BAR;
        PG8_STAGE(PG8_SB(1, 0), cB + kstepB, voffB); PG8_STAGE(PG8_SA(1, 0), cA + kstepA, voffA); PG8_STAGE(PG8_SB(1, 1), cB + hstepB + kstepB, voffB);
        PG8_WAIT_V(6); PG8_BAR;
    } else {
        PG8_STAGE(PG8_SB(0, 0), cB, voffB); PG8_STAGE(PG8_SA(0, 0), cA, voffA); PG8_STAGE(PG8_SB(0, 1), cB + hstepB, voffB); PG8_STAGE(PG8_SA(0, 1), cA + hstepA, voffA);
        if (wr == 1) PG8_BAR;
        PG8_WAIT_V(4); PG8_BAR;
        PG8_STAGE(PG8_SB(1, 0), cB + kstepB, voffB); PG8_STAGE(PG8_SA(1, 0), cA + kstepA, voffA); PG8_STAGE(PG8_SB(1, 1), cB + hstepB + kstepB, voffB);
        PG8_WAIT_V(6); PG8_BAR;
    }
    for (;;) {
        const bool has_next = S.next(ui + 1, nxt);
        const char* nA = has_next ? (const char*)g.A + (size_t)nxt.pm * tstepA : cA; const char* nB = has_next ? (const char*)g.Bt + (size_t)nxt.pn * tstepB : cB;
        for (int t = 0; t < nt; t += 2) {
            const bool last = (t == nt - 2);
            const char* a1 = cA + (size_t)(t + 1) * kstepA;
            const char* a2 = last ? nA : cA + (size_t)(t + 2) * kstepA; const char* b2 = last ? nB : cB + (size_t)(t + 2) * kstepB;
            const char* a3 = a2 + kstepA; const char* b3 = b2 + kstepB;
            if (last && has_next) S.a_ready(nxt);
            if constexpr (SP2) {
            PG8_LDB(B0, 0, 0); PG8_LDB(B1, 0, 1); PG8_SCHED; PG8_LDA(At, 0, 0); PG8_STAGE(PG8_SA(1, 1), a1 + hstepA, voffA);
            PG8_WAIT_V(8); PG8_WAIT_L(0); PG8_BAR; PG8_MMA(0, 0, At, B0); PG8_MMA(0, 1, At, B1); PG8_BAR; PG8_SCHED;
            PG8_LDA(At, 0, 1); PG8_STAGE(PG8_SB(0, 0), b2, voffB); PG8_STAGE(PG8_SB(0, 1), b2 + hstepB, voffB); PG8_STAGE(PG8_SA(0, 0), a2, voffA);
            PG8_WAIT_V(8); PG8_WAIT_L(0); PG8_BAR; PG8_MMA(1, 0, At, B0); PG8_MMA(1, 1, At, B1); PG8_BAR; PG8_SCHED;
            PG8_LDB(B0, 1, 0); PG8_LDB(B1, 1, 1); PG8_SCHED; PG8_LDA(At, 1, 0); PG8_STAGE(PG8_SA(0, 1), a2 + hstepA, voffA);
            PG8_WAIT_V(8); PG8_WAIT_L(0); PG8_BAR; PG8_MMA(0, 0, At, B0); PG8_MMA(0, 1, At, B1); PG8_BAR; PG8_SCHED;
            PG8_LDA(At, 1, 1); PG8_STAGE(PG8_SB(1, 0), b3, voffB); PG8_STAGE(PG8_SB(1, 1), b3 + hstepB, voffB); PG8_STAGE(PG8_SA(1, 0), a3, voffA);
            PG8_WAIT_V(8); PG8_WAIT_L(0); PG8_BAR; PG8_MMA(1, 0, At, B0); PG8_MMA(1, 1, At, B1); PG8_BAR; PG8_SCHED;
            } else {
            PG8_LDB(B0, 0, 0); PG8_SCHED; PG8_LDA(At, 0, 0); PG8_STAGE(PG8_SA(1, 1), a1 + hstepA, voffA);
            PG8_WAIT_L(8); PG8_BAR; PG8_WAIT_L(0); PG8_MMA(0, 0, At, B0); PG8_BAR; PG8_SCHED;
            PG8_LDB(B1, 0, 1); PG8_STAGE(PG8_SB(0, 0), b2, voffB);
            PG8_BAR; PG8_WAIT_L(0); PG8_MMA(0, 1, At, B1); PG8_BAR;
            PG8_LDA(At, 0, 1); PG8_STAGE(PG8_SA(0, 0), a2, voffA);
            PG8_BAR; PG8_WAIT_L(0); PG8_MMA(1, 0, At, B0); PG8_BAR; PG8_SCHED;
            PG8_STAGE(PG8_SB(0, 1), b2 + hstepB, voffB);
            PG8_WAIT_V(6); PG8_BAR; PG8_MMA(1, 1, At, B1); PG8_BAR;
            PG8_LDB(B0, 1, 0); PG8_SCHED; PG8_LDA(At, 1, 0); PG8_STAGE(PG8_SA(0, 1), a2 + hstepA, voffA);
            PG8_WAIT_L(8); PG8_BAR; PG8_WAIT_L(0); PG8_MMA(0, 0, At, B0); PG8_BAR; PG8_SCHED;
            PG8_LDB(B1, 1, 1); PG8_STAGE(PG8_SB(1, 0), b3, voffB);
            PG8_BAR; PG8_WAIT_L(0); PG8_MMA(0, 1, At, B1); PG8_BAR;
            PG8_LDA(At, 1, 1); PG8_STAGE(PG8_SA(1, 0), a3, voffA);
            PG8_BAR; PG8_WAIT_L(0); PG8_MMA(1, 0, At, B0); PG8_BAR; PG8_SCHED;
            PG8_STAGE(PG8_SB(1, 1), b3 + hstepB, voffB);
            PG8_WAIT_V(6); PG8_BAR; PG8_MMA(1, 1, At, B1); PG8_BAR;
            }
        }
        if constexpr (ALIGN_EPI) { if (wr == 0) PG8_BAR; }
        if constexpr (!Epi::AFTER_DRAIN) { E(acc, cur, wr, wc, fr, fq); S.done(cur); }
        if (!has_next) break;
#pragma unroll
        for (int a = 0; a < 2; ++a)
#pragma unroll
            for (int b = 0; b < 2; ++b)
#pragma unroll
                for (int m = 0; m < 4; ++m)
#pragma unroll
                    for (int n = 0; n < 2; ++n) acc[a][b][m][n] = (f32x4){0.f, 0.f, 0.f, 0.f};
        cur = nxt; cA = nA; cB = nB; ++ui;
        if constexpr (ALIGN_EPI) { if (wr == 1) PG8_BAR; }
    }
    PG8_WAIT_V(0);
    if constexpr (!ALIGN_EPI) { if (wr == 0) PG8_BAR; }
    PG8_BAR;
    if constexpr (Epi::AFTER_DRAIN) { E.fused(acc, cur, wr, wc, fr, fq, lds, wid, lane); S.done(cur); }
#undef PG8_SA
#undef PG8_SB
#undef PG8_STAGE
#undef PG8_LDA
#undef PG8_LDB
#undef PG8_MMA
#undef PG8_WAIT_V
#undef PG8_WAIT_L
#undef PG8_BAR
#undef PG8_SCHED
}
}
#define GAS __attribute__((address_space(1)))
#define LAS __attribute__((address_space(3)))
typedef unsigned short bf16;
typedef unsigned v4u __attribute__((ext_vector_type(4)));
typedef float f32x4 __attribute__((ext_vector_type(4)));
typedef short bf16x8 __attribute__((ext_vector_type(8)));
typedef GAS unsigned gu32;
typedef GAS unsigned long long gu64;
#define RLX_AGENT __ATOMIC_RELAXED, __HIP_MEMORY_SCOPE_AGENT
#define LDS_WAIT() asm volatile("s_waitcnt lgkmcnt(0)" ::: "memory")
#define VM_WAIT() asm volatile("s_waitcnt vmcnt(0)" ::: "memory")
__device__ __forceinline__ unsigned long long rt() { return __builtin_amdgcn_s_memrealtime(); }
__device__ __forceinline__ unsigned f2bf(float f) { unsigned u = __builtin_bit_cast(unsigned, f); return (u + 0x7fffu + ((u >> 16) & 1u)) >> 16; }
__device__ __forceinline__ unsigned pk2(float lo, float hi) { return f2bf(lo) | (f2bf(hi) << 16); }

#define XB_TMO      128
#define XB_XCNT(j)  (256  + 64 * (j))
#define XB_XSUB(j)  (1280 + 64 * (j))
#define XB_XGEN(j)  (2304 + 64 * (j))
#define XB_TOP      3328
#define XB_TOPGEN   3392
#define XCD_BAR_WORDS 3456
#define XB_SPIN_CAP (1u << 24)

__device__ __forceinline__ unsigned xb_ld(unsigned* p)              { return __hip_atomic_load(p, __ATOMIC_RELAXED, __HIP_MEMORY_SCOPE_AGENT); }
__device__ __forceinline__ unsigned xb_add(unsigned* p, unsigned v) { return __hip_atomic_fetch_add(p, v, __ATOMIC_RELAXED, __HIP_MEMORY_SCOPE_AGENT); }
__device__ __forceinline__ unsigned xb_xcc_id() { return (unsigned)__builtin_amdgcn_s_getreg((3 << 11) | 20) & 0xFu; }
#define XB_SPIN(cond, bar) do { unsigned _sp = 0; while (cond) { __builtin_amdgcn_s_sleep(1); \
    if ((++_sp & 255u) == 0u) { if (xb_ld(&(bar)[XB_TMO])) break; if (_sp > XB_SPIN_CAP) { atomicAdd(&(bar)[XB_TMO], 1u); break; } } } } while (0)

__device__ __forceinline__ unsigned xb_lane() { unsigned l_; asm volatile("v_mbcnt_lo_u32_b32 %0, -1, 0\n\tv_mbcnt_hi_u32_b32 %0, -1, %0" : "=&v"(l_)); return l_; }
struct XcdBarrier {
    unsigned* bar; unsigned x; unsigned w;
    volatile LAS unsigned* st;
};

__device__ __forceinline__ XcdBarrier xcd_barrier_post(unsigned* bar, volatile LAS unsigned* st) {
    XcdBarrier b; b.bar = bar; b.x = xb_xcc_id(); b.st = st; b.w = (unsigned)__builtin_amdgcn_readfirstlane(threadIdx.x >> 6);
    if (threadIdx.x == 0) (void)xb_add(&bar[XB_XCNT(b.x)], 1u);
    return b;
}
__device__ __forceinline__ void xcd_barrier_complete(unsigned* bar, unsigned x, unsigned& nloc, unsigned& nx) {
    const unsigned G = gridDim.x * gridDim.y * gridDim.z;
    unsigned sum, cnt, mine, sp = 0u;
    for (;;) {
        sum = 0u; cnt = 0u; mine = 0u;
#pragma unroll
        for (unsigned j = 0; j < 16; ++j) { const unsigned c = xb_ld(&bar[XB_XCNT(j)]); sum += c; cnt += (c > 0u) ? 1u : 0u; mine = (j == x) ? c : mine; }
        if (sum == G) break;
        __builtin_amdgcn_s_sleep(1);
        if ((++sp & 255u) == 0u) { if (xb_ld(&bar[XB_TMO])) break; if (sp > XB_SPIN_CAP) { atomicAdd(&bar[XB_TMO], 1u); break; } }
    }
    nloc = mine > 0u ? mine : 1u; nx = cnt > 0u ? cnt : 1u;
}

__device__ __forceinline__ void xcd_barrier(const XcdBarrier& b) {
    asm volatile("s_waitcnt vmcnt(0)" ::: "memory");
    __syncthreads();
    if (b.w == 0u && xb_lane() == 0u) {
        unsigned* bar = b.bar;
        __builtin_amdgcn_s_waitcnt(0);
        unsigned nloc = b.st[0], nx = b.st[1];
        if (nloc == 0u) { xcd_barrier_complete(bar, b.x, nloc, nx); b.st[0] = nloc; b.st[1] = nx; }
        const unsigned old = xb_add(&bar[XB_XSUB(b.x)], 1u);
        const unsigned gen = old / nloc;
        if (old + 1u == (gen + 1u) * nloc) {
            __builtin_amdgcn_fence(__ATOMIC_RELEASE, "agent");
            asm volatile("s_waitcnt vmcnt(0)" ::: "memory");
            const unsigned og = xb_add(&bar[XB_TOP], 1u);
            const unsigned tg = og / nx;
            if (og + 1u == (tg + 1u) * nx) xb_add(&bar[XB_TOPGEN], 1u);
            else XB_SPIN(xb_ld(&bar[XB_TOPGEN]) == tg, bar);
            __builtin_amdgcn_fence(__ATOMIC_ACQUIRE, "agent");
            xb_add(&bar[XB_XGEN(b.x)], 1u);
            asm volatile("s_waitcnt vmcnt(0)" ::: "memory");
        } else {
            XB_SPIN(xb_ld(&bar[XB_XGEN(b.x)]) == gen, bar);
            __builtin_amdgcn_fence(__ATOMIC_ACQUIRE, "agent");
            asm volatile("s_waitcnt vmcnt(0)" ::: "memory");
        }
    }
    __syncthreads();
}
#ifndef PROBE_MASK
#define PROBE_MASK 0
#endif

constexpr int T = 4096, NBATCH = 2, MPROMPT = 8192, MSAMP = 128, MREAL = 8320, MPAD = 8448;
constexpr int DM = 2048, DG = 1024, DQ = 1024, DFF = 8192, NIN = 8728, NINP = 8960;
constexpr int PASTLEN = 2048;
constexpr float EPS = 1e-6f;
constexpr float LOG2E = 1.4426950408889634f;
constexpr float QSCALE = 0.08838834764831845f * 1.4426950408889634f;
constexpr int NWAVES = 8;
constexpr int LD2 = DM + 64, LD1 = DG + 64, LD8 = DFF + 64;

constexpr size_t O_YP = 0, O_YS = 16777216, O_PCMP = O_YS + 262144, O_PSEL = O_PCMP + 4194304, O_PWIN = O_PSEL + 4194304,
                 O_PSGU = O_PWIN + 524288, O_SCMP = O_PSGU + 262144, O_SSEL = O_SCMP + 65536, O_SWIN = O_SSEL + 65536,
                 O_SSGU = O_SWIN + 33554432, O_END = O_SSGU + 131072;
static_assert(O_END == 60030976, "output size");

constexpr size_t MiB = 1ull << 20;
constexpr size_t al(size_t x) { return (x + MiB - 1) / MiB * MiB; }
constexpr size_t WS_CTL = 0, CTL_ZERO_BYTES = 1 * MiB;
constexpr size_t WS_WIN  = 1 * MiB;
constexpr size_t WS_WG   = WS_WIN  + al((size_t)NINP * LD2 * 2);
constexpr size_t WS_WN   = WS_WG   + al((size_t)DM * LD1 * 2);
constexpr size_t WS_WO   = WS_WN   + al((size_t)DM * LD1 * 2);
constexpr size_t WS_WUP  = WS_WO   + al((size_t)DM * LD2 * 2);
constexpr size_t WS_WDN  = WS_WUP  + al((size_t)DFF * LD2 * 2);
constexpr size_t WS_WC   = WS_WDN  + al((size_t)DM * LD8 * 2);
constexpr size_t WS_XB   = WS_WC   + al((size_t)512 * LD2 * 2);
constexpr size_t WS_RSTD1= WS_XB   + al((size_t)MPAD * LD2 * 2);
constexpr size_t WS_U    = WS_RSTD1+ al((size_t)MPAD * 4);
constexpr size_t WS_VG   = WS_U    + al((size_t)MPAD * DG * 2);
constexpr size_t WS_VSS  = WS_VG   + al((size_t)MPAD * DG * 2);
constexpr size_t WS_RSTDV= WS_VSS  + al((size_t)MPAD * 32 * 4);
constexpr size_t WS_QRAW = WS_RSTDV+ al((size_t)MPAD * 4);
constexpr size_t WS_KVWR = WS_QRAW + al((size_t)MPAD * DQ * 4);
constexpr size_t WS_GA   = WS_KVWR + al((size_t)MPAD * 512 * 4);
constexpr size_t WS_GB   = WS_GA   + al((size_t)MPAD * DM * 2);
constexpr size_t WS_GN   = WS_GB   + al((size_t)MPAD * DM * 2);
constexpr size_t WS_QN   = WS_GN   + al((size_t)MPAD * 32 * 4);
constexpr size_t WS_KS   = WS_QN   + al((size_t)MPAD * DQ * 2);
constexpr size_t WS_VS   = WS_KS   + 4 * MiB;
constexpr size_t WS_KW   = WS_VS   + 4 * MiB;
constexpr size_t WS_VW   = WS_KW   + 4 * MiB;
constexpr size_t WS_ACP  = WS_VW   + 4 * MiB;
constexpr size_t WS_ACS  = WS_ACP  + al((size_t)2048 * LD2 * 2);
constexpr size_t WS_YCP  = WS_ACS  + al((size_t)65536 * LD2 * 2);
constexpr size_t WS_YCS  = WS_YCP  + 2 * MiB;
constexpr size_t WS_KCP  = WS_YCS  + 64 * MiB;
constexpr size_t WS_VCP  = WS_KCP  + 1 * MiB;
constexpr size_t WS_KCS  = WS_VCP  + 1 * MiB;
constexpr size_t WS_VCS  = WS_KCS  + 8 * MiB;
constexpr size_t WS_CBP  = WS_VCS  + 8 * MiB;
constexpr size_t WS_WMB  = WS_CBP  + 1 * MiB;
constexpr size_t WS_BLUT = WS_WMB  + 1 * MiB;
constexpr size_t WS_OA   = WS_BLUT + 1 * MiB;
constexpr size_t WS_OB   = WS_OA   + al((size_t)MPAD * LD1 * 2);
constexpr size_t WS_MIXA = WS_OB   + al((size_t)MPAD * LD1 * 2);
constexpr size_t WS_MIX  = WS_MIXA + al((size_t)MPAD * DM * 2);
constexpr size_t WS_X1B  = WS_MIX  + al((size_t)MPAD * LD2 * 2);
constexpr size_t WS_X1F  = WS_X1B  + al((size_t)MPAD * LD2 * 2);
constexpr size_t WS_X1SS = WS_X1F  + al((size_t)128 * DM * 4);
constexpr size_t WS_H    = WS_X1SS + al((size_t)MPAD * 32 * 4);
constexpr size_t WS_OT   = WS_H    + al((size_t)MPAD * LD8 * 2);
constexpr size_t WS_SPART= WS_OT   + 32 * MiB;
constexpr int LDS_X = DM + 64, LDS_G = DG + 64, LDS_H = DFF + 64;
constexpr size_t WS_SXB  = WS_SPART+ 4 * MiB;
constexpr size_t WS_SOA  = WS_SXB  + 1 * MiB;
constexpr size_t WS_SOB  = WS_SOA  + 1 * MiB;
constexpr size_t WS_SMIX = WS_SOB  + 1 * MiB;
constexpr size_t WS_SX1B = WS_SMIX + 1 * MiB;
constexpr size_t WS_SH   = WS_SX1B + 1 * MiB;
constexpr size_t WS_DUMMY= WS_SH   + 3 * MiB;
constexpr size_t WS_END  = WS_DUMMY+ 72 * MiB;

constexpr int CW_TMO = 0, CW_CODE = 1;
constexpr int CW_BAR = 4096;
constexpr int CW_Q5 = 8192;
constexpr int CW_FLAG = 16384;
constexpr int CW_TICK = 65536;
static_assert((CW_TICK + 64 * 64) * 4 <= (int)CTL_ZERO_BYTES && (CW_BAR + 16 * 3456) * 4 <= (int)CTL_ZERO_BYTES, "CTL words inside the memset region");

constexpr int RING_OFF = 0, RING_BYTES = 131072;
constexpr int LDSCTL_OFF = RING_BYTES, MISC_OFF = LDSCTL_OFF + 320;
constexpr int LDS_BYTES = 147456;
static_assert(MISC_OFF + 128 <= LDS_BYTES, "LDS map");

__constant__ unsigned char kBkt[128] = {0, 1, 2, 3, 4, 5, 6, 7, 8, 9, 10, 11, 12, 13, 14, 15, 16, 16, 16, 17, 17, 18, 18, 18, 19, 19, 19, 20, 20, 20, 20, 21, 21, 21, 21, 22, 22, 22, 22, 22, 23, 23, 23, 23, 23, 23, 24, 24, 24, 24, 24, 24, 25, 25, 25, 25, 25, 25, 25, 26, 26, 26, 26, 26, 26, 26, 26, 27, 27, 27, 27, 27, 27, 27, 27, 27, 27, 28, 28, 28, 28, 28, 28, 28, 28, 28, 28, 29, 29, 29, 29, 29, 29, 29, 29, 29, 29, 29, 29, 30, 30, 30, 30, 30, 30, 30, 30, 30, 30, 30, 30, 30, 30, 31, 31, 31, 31, 31, 31, 31, 31, 31, 31, 31, 31, 31, 31, 31};

__host__ __device__ __forceinline__ size_t tm_idx(int row, int col, int nkt) { return ((size_t)((row >> 8) * nkt + (col >> 6)) * 256 + (row & 255)) * 64 + (col & 63); }

typedef unsigned v2u __attribute__((ext_vector_type(2)));
struct Ctx {
    const float* const* in; float* out; unsigned char* ws;
    LAS unsigned char* lds;
    int tid, lane, wave, vcu, G;
};
__device__ __forceinline__ int lane_now() { int l_; asm volatile("v_mbcnt_lo_u32_b32 %0, -1, 0\n\tv_mbcnt_hi_u32_b32 %0, -1, %0" : "=&v"(l_) : : "memory"); return l_; }
__device__ __forceinline__ Ctx fresh(const Ctx& C) { Ctx L = C; const int l_ = lane_now(); L.lane = l_; L.tid = C.wave * 64 + l_; return L; }
#define IN_XP 0
#define IN_XS 1
#define IN_CCMP 2
#define IN_CSEL 3
#define IN_WINB 4
#define IN_PT 5
#define IN_RELB 6
#define IN_GMIX 7
#define IN_WIN 8
#define IN_GSGU 9
#define IN_WSGU 10
#define IN_BSGU 11
#define IN_GQ 12
#define IN_GK 13
#define IN_POSK 14
#define IN_WCK 15
#define IN_POSV 16
#define IN_WCV 17
#define IN_WPG 18
#define IN_WPN 19
#define IN_WOUT 20
#define IN_GMLP 21
#define IN_WUP 22
#define IN_WDN 23

__device__ __forceinline__ float bf2f(unsigned short b) { return __uint_as_float((unsigned)b << 16); }
__device__ __forceinline__ float bflo(unsigned w) { return __uint_as_float(w << 16); }
__device__ __forceinline__ float bfhi(unsigned w) { return __uint_as_float(w & 0xffff0000u); }
__device__ __forceinline__ void unpack8(v4u w, float (&f)[8]) {
    f[0] = bflo(w.x); f[1] = bfhi(w.x); f[2] = bflo(w.y); f[3] = bfhi(w.y); f[4] = bflo(w.z); f[5] = bfhi(w.z); f[6] = bflo(w.w); f[7] = bfhi(w.w);
}
__device__ __forceinline__ v4u pack8f(const float (&f)[8]) { v4u w; w.x = pk2(f[0], f[1]); w.y = pk2(f[2], f[3]); w.z = pk2(f[4], f[5]); w.w = pk2(f[6], f[7]); return w; }
__device__ __forceinline__ float wave_sum(float v) {
#pragma unroll
    for (int o = 1; o < 64; o <<= 1) v += __shfl_xor(v, o);
    return v;
}
__device__ __forceinline__ float wave_max(float v) {
#pragma unroll
    for (int o = 1; o < 64; o <<= 1) v = fmaxf(v, __shfl_xor(v, o));
    return v;
}
__device__ __forceinline__ float sigmoidf_(float x) { return 1.0f / (1.0f + __expf(-x)); }
__device__ __forceinline__ float gelu_tanh(float x) {
    const float u = 0.7978845608028654f * (x + 0.044715f * x * x * x);
    return x / (1.0f + __expf(-2.0f * u));
}

__device__ __forceinline__ void tr_item(const float* W, int ldw, int srccol0, int nvalid, const float* kscale, bf16* WT, int nkt, int dst_row0, int k0, LAS float* scr, int lane) {
    const int n = lane & 31;
    float vv[32];
#pragma unroll
    for (int i = 0; i < 32; ++i) { const int kk = 2 * i + (lane >> 5); vv[i] = (n < nvalid) ? __builtin_nontemporal_load(W + (size_t)(k0 + kk) * ldw + srccol0 + n) : 0.f; }
    if (kscale) {
#pragma unroll
        for (int i = 0; i < 32; ++i) vv[i] *= kscale[k0 + 2 * i + (lane >> 5)]; }
#pragma unroll
    for (int i = 0; i < 32; ++i) scr[(2 * i + (lane >> 5)) * 33 + n] = vv[i];
    LDS_WAIT(); asm volatile("" ::: "memory");
    const int c = lane & 7;
#pragma unroll
    for (int j = 0; j < 4; ++j) { const int nn = (lane >> 3) + 8 * j; const LAS float* s = scr + (8 * c) * 33 + nn;
        v4u o; o.x = pk2(s[0 * 33], s[1 * 33]); o.y = pk2(s[2 * 33], s[3 * 33]); o.z = pk2(s[4 * 33], s[5 * 33]); o.w = pk2(s[6 * 33], s[7 * 33]);
        { const int n_ = dst_row0 + nn; *(GAS v4u*)(WT + ((size_t)((n_ >> 8) * nkt + (k0 >> 6)) * 256 + (n_ & 255)) * 64 + 8 * c) = o; } }
    LDS_WAIT(); asm volatile("" ::: "memory");
}

constexpr int I_IN = 32 * 280, I_PG = 16 * 64, I_PN = 16 * 64, I_OUT = 32 * 64, I_UP = 32 * 256, I_DN = 128 * 64, I_C = 4 * 128;
constexpr int I_LATE = I_PG + I_PN + I_OUT + I_UP + I_DN;
__device__ __forceinline__ void w_item_in(const Ctx& C, int r, LAS float* scr) {
    const int kb = r / 280, nb = r % 280, n0 = nb * 32;
    const int src = n0 < 4608 ? n0 : (n0 < 8704 ? n0 + 24 : n0 - 8704 + 4608);
    const int nv = n0 < 8704 ? 32 : (n0 == 8704 ? 24 : 0);
    tr_item(C.in[IN_WIN], NIN, src, nv, C.in[IN_GMIX], (bf16*)(C.ws + WS_WIN), DM / 64, n0, kb * 64, scr, C.lane);
}
__device__ __forceinline__ void w_item_cmp(const Ctx& C, int r, LAS float* scr) {
    const int sub = r / 128, rr = r % 128, kv = sub >> 1, hf = sub & 1, kb = rr / 4, nb = rr % 4;
    const float* W = (kv ? C.in[IN_WCV] : C.in[IN_WCK]) + (size_t)hf * 2048 * 128;
    tr_item(W, 128, nb * 32, 32, nullptr, (bf16*)(C.ws + WS_WC), 2048 / 64, kv * 256 + hf * 128 + nb * 32, kb * 64, scr, C.lane);
}
__device__ __forceinline__ void w_item_late(const Ctx& C, int r, LAS float* scr) {
    unsigned char* ws = C.ws; const int lane = C.lane;
    if (r < I_PG) { const int kb = r / 64, nb = r % 64; tr_item(C.in[IN_WPG], DM, nb * 32, 32, nullptr, (bf16*)(ws + WS_WG), DG / 64, nb * 32, kb * 64, scr, lane); return; } r -= I_PG;
    if (r < I_PN) { const int kb = r / 64, nb = r % 64; tr_item(C.in[IN_WPN], DM, nb * 32, 32, nullptr, (bf16*)(ws + WS_WN), DQ / 64, nb * 32, kb * 64, scr, lane); return; } r -= I_PN;
    if (r < I_OUT) { const int kb = r / 64, nb = r % 64; tr_item(C.in[IN_WOUT], DM, nb * 32, 32, nullptr, (bf16*)(ws + WS_WO), DM / 64, nb * 32, kb * 64, scr, lane); return; } r -= I_OUT;
    if (r < I_UP) { const int kb = r / 256, nb = r % 256; tr_item(C.in[IN_WUP], DFF, nb * 32, 32, C.in[IN_GMLP], (bf16*)(ws + WS_WUP), DM / 64, nb * 32, kb * 64, scr, lane); return; } r -= I_UP;
    { const int kb = r / 64, nb = r % 64; tr_item(C.in[IN_WDN], DM, nb * 32, 32, nullptr, (bf16*)(ws + WS_WDN), DFF / 64, nb * 32, kb * 64, scr, lane); }
}
__device__ __forceinline__ void gather_item(const Ctx& C, int it) {
    const int lane = C.lane, kvg = lane >> 4, d = (lane & 15) * 8;
    const int b = it >> 7, p = (it >> 3) & 15, sg = it & 7, page = ((const int*)C.in[IN_PT])[b * 16 + p], j = p * 8 + sg;
    const float* src = C.in[IN_CCMP] + ((size_t)page * 128 + sg * 16) * 512 + lane * 8;
    bf16* dst = (bf16*)(C.ws + WS_ACS) + (size_t)((b * 4 + kvg) * 128 + j) * LD2 + d;
#pragma unroll
    for (int h = 0; h < 2; ++h) { f32x4 a[8], c2[8];
#pragma unroll
        for (int s = 0; s < 8; ++s) { a[s] = __builtin_nontemporal_load((const GAS f32x4*)(src + (h * 8 + s) * 512)); c2[s] = __builtin_nontemporal_load((const GAS f32x4*)(src + (h * 8 + s) * 512 + 4)); }
#pragma unroll
        for (int s = 0; s < 8; ++s) { v4u o; o.x = pk2(a[s].x, a[s].y); o.y = pk2(a[s].z, a[s].w); o.z = pk2(c2[s].x, c2[s].y); o.w = pk2(c2[s].z, c2[s].w);
            *(GAS v4u*)(dst + (h * 8 + s) * 128) = o; } }
}
constexpr int WINCOPY_F4 = 128 * 65408, WINCOPY_CHUNK = 16384, WINCOPY_ITEMS = (WINCOPY_F4 + WINCOPY_CHUNK - 1) / WINCOPY_CHUNK;
__device__ __forceinline__ void wincopy_item(const Ctx& C, int chunk) {
    const GAS f32x4* src = (const GAS f32x4*)C.in[IN_WINB]; GAS f32x4* dst = (GAS f32x4*)(C.out + O_SWIN);
    const int base = chunk * WINCOPY_CHUNK + C.tid;
#pragma unroll
    for (int h = 0; h < 2; ++h) { f32x4 v[16];
#pragma unroll
        for (int k = 0; k < 16; ++k) { const int i = base + (h * 16 + k) * NWAVES * 64; if (i < WINCOPY_F4) { const int b = i / 65408, r = i - b * 65408; v[k] = __builtin_nontemporal_load(src + b * 65536 + 128 + r); } }
#pragma unroll
        for (int k = 0; k < 16; ++k) { const int i = base + (h * 16 + k) * NWAVES * 64; if (i < WINCOPY_F4) { const int b = i / 65408, r = i - b * 65408; __builtin_nontemporal_store(v[k], dst + b * 65536 + r); } } }
}

__device__ __forceinline__ void p0_prologue(const Ctx& C) {
    unsigned char* ws = C.ws;
    LAS float* scr = (LAS float*)(C.lds + RING_OFF + C.wave * 16384);
    const int gw = C.vcu * NWAVES + C.wave, NGW = C.G * NWAVES, lane = C.lane;
    for (int rep = 0; rep < (((PROBE_MASK >> 10) & 1) ? 2 : 1); ++rep)
    for (int it = gw; it < I_IN + I_C; it += NGW) { if (it < I_IN) w_item_in(C, it, scr); else w_item_cmp(C, it - I_IN, scr); }
    {
        bf16* XB = (bf16*)(ws + WS_XB); float* RS = (float*)(ws + WS_RSTD1);
        for (int rep = 0; rep < (((PROBE_MASK >> 12) & 1) ? 2 : 1); ++rep)
        for (int m = gw; m < MREAL; m += NGW) {
            const bool pr_ = m < MPROMPT;
            GAS v2u* o8 = pr_ ? (GAS v2u*)(XB + tm_idx(m, 4 * (lane & 15), DM / 64)) + 0 : (GAS v2u*)((bf16*)(ws + WS_SXB) + (size_t)(m - MPROMPT) * LDS_X) + lane;
            const float* xr = m < MPROMPT ? C.in[IN_XP] + (size_t)m * DM : C.in[IN_XS] + (size_t)(m - MPROMPT) * DM;
            const GAS f32x4* x4 = (const GAS f32x4*)xr + lane; f32x4 v[8]; float s = 0.f;
#pragma unroll
            for (int j = 0; j < 8; ++j) { v[j] = x4[64 * j]; s += (v[j].x * v[j].x + v[j].y * v[j].y) + (v[j].z * v[j].z + v[j].w * v[j].w); }
            s = wave_sum(s);
#pragma unroll
            for (int j = 0; j < 8; ++j) o8[pr_ ? (size_t)((lane >> 4) + 4 * j) * 4096 : (size_t)64 * j] = (v2u){pk2(v[j].x, v[j].y), pk2(v[j].z, v[j].w)};
            if (lane == 0) RS[m] = rsqrtf(s * (1.0f / DM) + EPS);
        }
    }
    {
        float* CBP = (float*)(ws + WS_CBP);
        for (int it = gw; it < 64; it += NGW) { const int kv = it >> 5, eb = (it >> 4) & 1, kc = it & 15, e = eb * 64 + lane;
            const float* pos = kv ? C.in[IN_POSV] : C.in[IN_POSK]; const float* W = kv ? C.in[IN_WCV] : C.in[IN_WCK]; float a = 0.f;
#pragma unroll 8
            for (int k = kc * 256; k < kc * 256 + 256; ++k) a += pos[k] * W[(size_t)k * 128 + e];
            CBP[(kv * 16 + kc) * 128 + e] = a; }
    }
    {
        const float* w = C.in[IN_WSGU]; bf16* WMB = (bf16*)(ws + WS_WMB);
        for (int i = gw * 64 + lane; i < 8 * 128 * 128 / 8; i += NGW * 64) { const int e0 = i * 8, t = (e0 >> 7) & 127, s0 = e0 & 127; float f[8];
#pragma unroll
            for (int k = 0; k < 8; ++k) f[k] = (s0 + k <= t) ? w[e0 + k] : 0.f;
            *(GAS v4u*)(WMB + e0) = pack8f(f); }
        float* BL = (float*)(ws + WS_BLUT); const float* rb = C.in[IN_RELB];
        for (int i = gw * 64 + lane; i < 8 * 132; i += NGW * 64) { const int h = i / 132, rel = i % 132; const int bk = rel < 128 ? kBkt[rel] : 31; BL[i] = rb[bk * 8 + h] * LOG2E; }
    }
}

namespace epi {
using pg8::f32x4; using pg8::Unit; using pg8::cvt_pk_bf16;
typedef unsigned u32x4 __attribute__((ext_vector_type(4)));
__device__ __forceinline__ u32x4 pack8v(f32x4 a, f32x4 b) { u32x4 w; w.x = cvt_pk_bf16(a[0], a[1]); w.y = cvt_pk_bf16(a[2], a[3]); w.z = cvt_pk_bf16(b[0], b[1]); w.w = cvt_pk_bf16(b[2], b[3]); return w; }

struct EpiIn {
    static constexpr bool PERM = true, AFTER_DRAIN = false;
    const float* rstd; bf16* U; bf16* VG; float* VSS; float* QRAW; float* KVWR; bf16* GA; bf16* GB; float* GN; float* out; bf16* ACP;
    __device__ __forceinline__ void operator()(const f32x4 (&acc)[2][2][4][2], const Unit& u, int wr, int wc, int fr, int fq) const {
        const int row0 = u.pm * 256 + wr * 64 + fr, cl = wc * 32 + 8 * fq, pn = u.pn;
#pragma unroll
        for (int ai = 0; ai < 2; ++ai)
#pragma unroll
            for (int m = 0; m < 4; ++m) { const int row = row0 + ai * 128 + m * 16; const float rs = rstd[row];
#pragma unroll
                for (int bj = 0; bj < 2; ++bj) { f32x4 v0 = acc[ai][bj][m][0] * rs, v1 = acc[ai][bj][m][1] * rs; const int c = cl + bj * 128;
                    if (pn < 8) {
#pragma unroll
                        for (int k = 0; k < 4; ++k) { v0[k] = gelu_tanh(v0[k]); v1[k] = gelu_tanh(v1[k]); }
                        if (pn < 4) *(u32x4*)(U + (size_t)row * DG + pn * 256 + c) = pack8v(v0, v1);
                        else { *(u32x4*)(VG + (size_t)row * DG + (pn - 4) * 256 + c) = pack8v(v0, v1);
                            float ss = (v0[0] * v0[0] + v0[1] * v0[1]) + (v0[2] * v0[2] + v0[3] * v0[3]) + (v1[0] * v1[0] + v1[1] * v1[1]) + (v1[2] * v1[2] + v1[3] * v1[3]);
                            ss += __shfl_xor(ss, 16); ss += __shfl_xor(ss, 32);
                            if (fq == 0) VSS[(size_t)row * 32 + (pn - 4) * 8 + bj * 4 + wc] = ss; }
                    } else if (pn < 12) { float* q = QRAW + (size_t)row * DQ + (pn - 8) * 256 + c; *(f32x4*)q = v0; *(f32x4*)(q + 4) = v1;
                    } else if (pn < 16) {
                        const int cc = ((pn - 12) & 1) * 256 + c; float* o = nullptr;
                        if (row < MPROMPT) o = out + (pn < 14 ? O_PCMP : O_PSEL) + (size_t)row * 512 + cc;
                        else if (row < MREAL) o = out + (pn < 14 ? O_SCMP : O_SSEL) + (size_t)(row - MPROMPT) * 512 + cc;
                        if (o) { *(f32x4*)o = v0; *(f32x4*)(o + 4) = v1; }
                        if (pn < 14 && row < MPROMPT) {
                            const int b_ = row >> 12, t_ = row & 4095;
                            *(u32x4*)(ACP + tm_idx(((b_ * 2 + (cc >> 8)) * 2 + ((cc >> 7) & 1)) * 256 + (t_ >> 4), (t_ & 15) * 128 + (cc & 127), 2048 / 64)) = pack8v(v0, v1); }
                    } else if (pn < 18) { float* o = KVWR + (size_t)row * 512 + (pn - 16) * 256 + c; *(f32x4*)o = v0; *(f32x4*)(o + 4) = v1;
                    } else if (pn < 34) {
#pragma unroll
                        for (int k = 0; k < 4; ++k) { v0[k] = sigmoidf_(v0[k]); v1[k] = sigmoidf_(v1[k]); }
                        bf16* g = (pn < 26 ? GA + (size_t)row * DM + (pn - 18) * 256 : GB + (size_t)row * DM + (pn - 26) * 256) + c; *(u32x4*)g = pack8v(v0, v1);
                    } else { if (c < 24) {
#pragma unroll
                        for (int k = 0; k < 4; ++k) { v0[k] = sigmoidf_(v0[k]); v1[k] = sigmoidf_(v1[k]); }
                        float* o = GN + (size_t)row * 32 + c; *(f32x4*)o = v0; *(f32x4*)(o + 4) = v1; } }
                } }
    }
};
struct EpiCmp {
    static constexpr bool PERM = false, AFTER_DRAIN = false;
    float* YC; int segmask;
    __device__ __forceinline__ void operator()(const f32x4 (&acc)[2][2][4][2], const Unit& u, int wr, int wc, int fr, int fq) const {
        const int row0 = u.pm * 256 + wr * 64 + fr, cl = wc * 32 + 4 * fq;
#pragma unroll
        for (int ai = 0; ai < 2; ++ai)
#pragma unroll
            for (int m = 0; m < 4; ++m) { const int row = row0 + ai * 128 + m * 16;
#pragma unroll
                for (int n = 0; n < 2; ++n) { *(f32x4*)(YC + (size_t)row * 256 + cl + n * 16) = acc[ai][0][m][n];
                    if ((row & segmask) != 0) *(f32x4*)(YC + (size_t)(row - 1) * 256 + 128 + cl + n * 16) = acc[ai][1][m][n]; } }
    }
};
struct EpiMixA {
    static constexpr bool PERM = true, AFTER_DRAIN = false;
    const bf16* GA; bf16* MIXA;
    __device__ __forceinline__ void operator()(const f32x4 (&acc)[2][2][4][2], const Unit& u, int wr, int wc, int fr, int fq) const {
        const int row0 = u.pm * 256 + wr * 64 + fr, c0 = u.pn * 256 + wc * 32 + 8 * fq;
#pragma unroll
        for (int ai = 0; ai < 2; ++ai) { v4u gv[4][2];
#pragma unroll
            for (int m = 0; m < 4; ++m)
#pragma unroll
                for (int bj = 0; bj < 2; ++bj) gv[m][bj] = *(const v4u*)(GA + (size_t)(row0 + ai * 128 + m * 16) * DM + c0 + bj * 128);
#pragma unroll
            for (int m = 0; m < 4; ++m) { const size_t ro = (size_t)(row0 + ai * 128 + m * 16) * DM;
#pragma unroll
                for (int bj = 0; bj < 2; ++bj) { const size_t o = ro + c0 + bj * 128; float g[8]; unpack8(gv[m][bj], g);
                    f32x4 v0 = acc[ai][bj][m][0], v1 = acc[ai][bj][m][1];
                    v0[0] *= g[0]; v0[1] *= g[1]; v0[2] *= g[2]; v0[3] *= g[3]; v1[0] *= g[4]; v1[1] *= g[5]; v1[2] *= g[6]; v1[3] *= g[7];
                    *(u32x4*)(MIXA + o) = pack8v(v0, v1); } } }
    }
};
struct EpiMixB {
    static constexpr bool PERM = true, AFTER_DRAIN = false;
    const bf16* GB; const bf16* MIXA; bf16* MIX;
    __device__ __forceinline__ void operator()(const f32x4 (&acc)[2][2][4][2], const Unit& u, int wr, int wc, int fr, int fq) const {
        const int row0 = u.pm * 256 + wr * 64 + fr, c0 = u.pn * 256 + wc * 32 + 8 * fq;
#pragma unroll
        for (int ai = 0; ai < 2; ++ai) { v4u gv[4][2], av[4][2];
#pragma unroll
            for (int m = 0; m < 4; ++m)
#pragma unroll
                for (int bj = 0; bj < 2; ++bj) { const size_t o = (size_t)(row0 + ai * 128 + m * 16) * DM + c0 + bj * 128; gv[m][bj] = *(const v4u*)(GB + o); av[m][bj] = *(const v4u*)(MIXA + o); }
#pragma unroll
            for (int m = 0; m < 4; ++m)
#pragma unroll
                for (int bj = 0; bj < 2; ++bj) { float g[8], a[8]; unpack8(gv[m][bj], g); unpack8(av[m][bj], a);
                    f32x4 v0 = acc[ai][bj][m][0], v1 = acc[ai][bj][m][1];
                    v0[0] = a[0] + v0[0] * g[0]; v0[1] = a[1] + v0[1] * g[1]; v0[2] = a[2] + v0[2] * g[2]; v0[3] = a[3] + v0[3] * g[3];
                    v1[0] = a[4] + v1[0] * g[4]; v1[1] = a[5] + v1[1] * g[5]; v1[2] = a[6] + v1[2] * g[6]; v1[3] = a[7] + v1[3] * g[7];
                    *(u32x4*)(MIX + tm_idx(row0 + ai * 128 + m * 16, c0 + bj * 128, DM / 64)) = pack8v(v0, v1); } }
    }
};
struct EpiOut {
    static constexpr bool PERM = true, AFTER_DRAIN = false;
    const float* xp; const float* xs; float* out; bf16* X1B; float* SS;
    __device__ __forceinline__ void operator()(const f32x4 (&acc)[2][2][4][2], const Unit& u, int wr, int wc, int fr, int fq) const {
        const int row0 = u.pm * 256 + wr * 64 + fr, c0 = u.pn * 256 + wc * 32 + 8 * fq;
#pragma unroll
        for (int ai = 0; ai < 2; ++ai) { f32x4 xv[4][2][2];
#pragma unroll
            for (int m = 0; m < 4; ++m)
#pragma unroll
                for (int bj = 0; bj < 2; ++bj) { const float* xr = xp + (size_t)(row0 + ai * 128 + m * 16) * DM + c0 + bj * 128; xv[m][bj][0] = *(const f32x4*)xr; xv[m][bj][1] = *(const f32x4*)(xr + 4); }
#pragma unroll
            for (int m = 0; m < 4; ++m) { const int row = row0 + ai * 128 + m * 16; float ss = 0.f;
#pragma unroll
                for (int bj = 0; bj < 2; ++bj) { const int c = c0 + bj * 128; const f32x4 v0 = acc[ai][bj][m][0] + xv[m][bj][0], v1 = acc[ai][bj][m][1] + xv[m][bj][1];
                    *(u32x4*)(X1B + tm_idx(row, c, DM / 64)) = pack8v(v0, v1);
                    ss += (v0[0] * v0[0] + v0[1] * v0[1]) + (v0[2] * v0[2] + v0[3] * v0[3]) + (v1[0] * v1[0] + v1[1] * v1[1]) + (v1[2] * v1[2] + v1[3] * v1[3]); }
                ss += __shfl_xor(ss, 16); ss += __shfl_xor(ss, 32);
                if (fq == 0) SS[(size_t)row * 32 + u.pn * 4 + wc] = ss; } }
    }
};
struct EpiUp {
    static constexpr bool PERM = true, AFTER_DRAIN = false;
    const float* SS; bf16* H;
    __device__ __forceinline__ void operator()(const f32x4 (&acc)[2][2][4][2], const Unit& u, int wr, int wc, int fr, int fq) const {
        const int row0 = u.pm * 256 + wr * 64 + fr, c0 = u.pn * 256 + wc * 32 + 8 * fq;
#pragma unroll
        for (int ai = 0; ai < 2; ++ai)
#pragma unroll
            for (int m = 0; m < 4; ++m) { const int row = row0 + ai * 128 + m * 16; const f32x4* sp = (const f32x4*)(SS + (size_t)row * 32) + 2 * fq;
                const f32x4 s4 = sp[0] + sp[1]; float st = (s4[0] + s4[1]) + (s4[2] + s4[3]); st += __shfl_xor(st, 16); st += __shfl_xor(st, 32);
                const float rs = rsqrtf(st * (1.0f / DM) + EPS);
#pragma unroll
                for (int bj = 0; bj < 2; ++bj) { f32x4 v0 = acc[ai][bj][m][0] * rs, v1 = acc[ai][bj][m][1] * rs;
#pragma unroll
                    for (int k = 0; k < 4; ++k) { const float a = fmaxf(v0[k], 0.f), b = fmaxf(v1[k], 0.f); v0[k] = a * a; v1[k] = b * b; }
                    { const int col = c0 + bj * 128; *(u32x4*)(H + ((size_t)((row >> 8) * (DFF / 64) + (col >> 6)) * 256 + (row & 255)) * 64 + (col & 63)) = pack8v(v0, v1); } } }
    }
};
struct EpiDown {
    static constexpr bool PERM = true, AFTER_DRAIN = false;
    float* out; const bf16* X1B;
    __device__ __forceinline__ void operator()(const f32x4 (&acc)[2][2][4][2], const Unit& u, int wr, int wc, int fr, int fq) const {
        const int row0 = u.pm * 256 + wr * 64 + fr, c0 = u.pn * 256 + wc * 32 + 8 * fq;
#pragma unroll
        for (int ai = 0; ai < 2; ++ai) { u32x4 xv[4][2];
#pragma unroll
            for (int m = 0; m < 4; ++m)
#pragma unroll
                for (int bj = 0; bj < 2; ++bj) xv[m][bj] = *(const u32x4*)(X1B + tm_idx(row0 + ai * 128 + m * 16, c0 + bj * 128, DM / 64));
#pragma unroll
            for (int m = 0; m < 4; ++m)
#pragma unroll
                for (int bj = 0; bj < 2; ++bj) { float* p = out + O_YP + (size_t)(row0 + ai * 128 + m * 16) * DM + c0 + bj * 128; const u32x4 w = xv[m][bj];
                    const f32x4 x0 = {__uint_as_float(w.x << 16), __uint_as_float(w.x & 0xffff0000u), __uint_as_float(w.y << 16), __uint_as_float(w.y & 0xffff0000u)};
                    const f32x4 x1 = {__uint_as_float(w.z << 16), __uint_as_float(w.z & 0xffff0000u), __uint_as_float(w.w << 16), __uint_as_float(w.w & 0xffff0000u)};
                    *(f32x4*)p = x0 + acc[ai][bj][m][0]; *(f32x4*)(p + 4) = x1 + acc[ai][bj][m][1]; } }
    }
};
struct CmpOrder {
    int n, G, c, shift;
    __device__ __forceinline__ bool next(int i, Unit& u) const { const int L = i * G + c; if (L >= n) return false; u.pm = L; u.pn = (L >> shift) & 1; return true; }
    __device__ __forceinline__ void a_ready(const Unit&) const {}
    __device__ __forceinline__ void done(const Unit&) const {}
};
}

__device__ __forceinline__ float grp_sum8(float v) { v += __shfl_xor(v, 1); v += __shfl_xor(v, 2); v += __shfl_xor(v, 4); return v; }
__device__ __forceinline__ float grp_sum16(float v) { v = grp_sum8(v); v += __shfl_xor(v, 8); return v; }
__device__ __forceinline__ float grp_sum32(float v) { v = grp_sum16(v); v += __shfl_xor(v, 16); return v; }

__device__ __forceinline__ void p2_post(const Ctx& C, int idx, int nblk) {
    unsigned char* ws = C.ws; const int gw = idx * NWAVES + C.wave, NGW = nblk * NWAVES, lane = C.lane;
    const float* QRAW = (const float*)(ws + WS_QRAW); bf16* QN = (bf16*)(ws + WS_QN); const float* KVWR = (const float*)(ws + WS_KVWR);
    const float* gq = C.in[IN_GQ]; const float* gk = C.in[IN_GK];
    const int kv = lane >> 5, g = (lane >> 4) & 1, d = (lane & 15) * 8;
    for (int row = gw; row < MREAL; row += NGW) {
        const bool pr = row < MPROMPT; const int b = row >> 12, t = row & 4095, bs = row - MPROMPT;
        const GAS f32x4* q4 = (const GAS f32x4*)(QRAW + (size_t)row * DQ + lane * 16); f32x4 v[4];
#pragma unroll
        for (int j2 = 0; j2 < 4; ++j2) v[j2] = q4[j2];
        const float* wsrc = KVWR + (size_t)row * 512 + lane * 8; const f32x4 wa = *(const GAS f32x4*)wsrc, wc2 = *(const GAS f32x4*)(wsrc + 4);
        f32x4 sa = {0.f, 0.f, 0.f, 0.f}, sc2 = sa;
        if (pr) { const float* ssrc = C.out + O_PSEL + (size_t)row * 512 + lane * 8; sa = *(const GAS f32x4*)ssrc; sc2 = *(const GAS f32x4*)(ssrc + 4);
 }
        float vs = lane < 32 ? ((const float*)(ws + WS_VSS))[(size_t)row * 32 + lane] : 0.f;
        { float ss = 0.f;
#pragma unroll
          for (int j2 = 0; j2 < 4; ++j2) ss += (v[j2].x * v[j2].x + v[j2].y * v[j2].y) + (v[j2].z * v[j2].z + v[j2].w * v[j2].w);
          ss = grp_sum8(ss); const float rs = rsqrtf(ss * (1.0f / 128) + EPS) * QSCALE; const float* gg = gq + (lane & 7) * 16; float f[16];
#pragma unroll
          for (int j2 = 0; j2 < 4; ++j2) { f[4 * j2] = v[j2].x * rs * gg[4 * j2]; f[4 * j2 + 1] = v[j2].y * rs * gg[4 * j2 + 1]; f[4 * j2 + 2] = v[j2].z * rs * gg[4 * j2 + 2]; f[4 * j2 + 3] = v[j2].w * rs * gg[4 * j2 + 3]; }
          GAS v4u* o = (GAS v4u*)(QN + (size_t)row * DQ + lane * 16);
          o[0] = (v4u){pk2(f[0], f[1]), pk2(f[2], f[3]), pk2(f[4], f[5]), pk2(f[6], f[7])}; o[1] = (v4u){pk2(f[8], f[9]), pk2(f[10], f[11]), pk2(f[12], f[13]), pk2(f[14], f[15])}; }
        if (pr) { float ss = (sa.x * sa.x + sa.y * sa.y) + (sa.z * sa.z + sa.w * sa.w) + (sc2.x * sc2.x + sc2.y * sc2.y) + (sc2.z * sc2.z + sc2.w * sc2.w); ss = grp_sum16(ss);
            const float rs = kv == 0 ? rsqrtf(ss * (1.0f / 128) + EPS) : 1.f; const float* gg = gk + 128 + d; float f[8] = {sa.x, sa.y, sa.z, sa.w, sc2.x, sc2.y, sc2.z, sc2.w};
#pragma unroll
            for (int k = 0; k < 8; ++k) f[k] = kv == 0 ? f[k] * rs * gg[k] : f[k];
            bf16* dst = (bf16*)(ws + (kv == 0 ? WS_KS : WS_VS)) + ((size_t)(b * 2 + g) * T + t) * 128 + d; *(GAS v4u*)dst = pack8f(f); }
        if (pr) { float ss = (wa.x * wa.x + wa.y * wa.y) + (wa.z * wa.z + wa.w * wa.w) + (wc2.x * wc2.x + wc2.y * wc2.y) + (wc2.z * wc2.z + wc2.w * wc2.w); ss = grp_sum16(ss);
            const float rs = kv == 0 ? rsqrtf(ss * (1.0f / 128) + EPS) : 1.f; const float* gg = gk + 256 + d; float f[8] = {wa.x, wa.y, wa.z, wa.w, wc2.x, wc2.y, wc2.z, wc2.w};
#pragma unroll
            for (int k = 0; k < 8; ++k) f[k] = kv == 0 ? f[k] * rs * gg[k] : f[k];
            bf16* dst = (bf16*)(ws + (kv == 0 ? WS_KW : WS_VW)) + ((size_t)(b * 2 + g) * T + t) * 128 + d; *(GAS v4u*)dst = pack8f(f);
            if (t >= T - 512) { float* o = C.out + O_PWIN + ((size_t)b * 512 + (t - (T - 512))) * 512 + lane * 8; *(GAS f32x4*)o = wa; *(GAS f32x4*)(o + 4) = wc2; }
        } else { float* o = C.out + O_SWIN + ((size_t)bs * 512 + 511) * 512 + lane * 8; *(GAS f32x4*)o = wa; *(GAS f32x4*)(o + 4) = wc2; }
        { vs = wave_sum(vs); if (lane == 0) ((float*)(ws + WS_RSTDV))[row] = rsqrtf(vs * (1.0f / DG) + EPS); }
    }
}

__device__ __forceinline__ float shx(float v, int mask, int lane) { return __int_as_float(__builtin_amdgcn_ds_bpermute((lane ^ mask) << 2, __float_as_int(v))); }
template <bool WT = false>
__device__ __forceinline__ void cmp_combine_rows(const Ctx& C, bool pr, int row0, int nrows) {
    unsigned char* ws = C.ws; const int hw = C.wave * 2 + (C.lane >> 5), l32 = C.lane & 31, e = l32 * 4;
    const float* CBP = (const float*)(ws + WS_CBP); const float* gk0 = C.in[IN_GK];
    f32x4 cb0 = {0.f, 0.f, 0.f, 0.f}, cb1 = {0.f, 0.f, 0.f, 0.f};
#pragma unroll
    for (int kc = 0; kc < 16; ++kc) { cb0 += *(const GAS f32x4*)(CBP + kc * 128 + e); cb1 += *(const GAS f32x4*)(CBP + (16 + kc) * 128 + e); }
    const f32x4 g4 = *(const GAS f32x4*)(gk0 + e);
    const int segs = pr ? 256 : 128;
    for (int rr = row0 + hw; rr < row0 + nrows; rr += 16) {
        const int j = rr & (segs - 1), grp = rr / segs, g = grp & 1, kv = (grp >> 1) & 1, b = grp >> 2;
        const float* Y = (const float*)(ws + (pr ? WS_YCP : WS_YCS)) + (size_t)rr * 256;
        f32x4 v = {0.f, 0.f, 0.f, 0.f};
        if (j < segs - 1) { v = *(const GAS f32x4*)(Y + e) + *(const GAS f32x4*)(Y + 128 + e) + (kv ? cb1 : cb0); }
        float ss = (v.x * v.x + v.y * v.y) + (v.z * v.z + v.w * v.w);
#pragma unroll
        for (int o = 1; o < 32; o <<= 1) ss += shx(ss, o, C.lane);
        if (kv == 0) { const float rs = rsqrtf(ss * (1.0f / 128) + EPS); v = v * rs * g4; }
        bf16* dst = (bf16*)(ws + (pr ? (kv ? WS_VCP : WS_KCP) : (kv ? WS_VCS : WS_KCS))) + ((size_t)(b * 2 + g) * segs + j) * 128 + e;
        if (WT) __hip_atomic_store((gu64*)dst, ((unsigned long long)pk2(v.z, v.w) << 32) | pk2(v.x, v.y), RLX_AGENT); else *(GAS v2u*)dst = (v2u){pk2(v.x, v.y), pk2(v.z, v.w)};
    }
}

typedef short s16x4 __attribute__((ext_vector_type(4)));
typedef float f32x16 __attribute__((ext_vector_type(16)));
__device__ __forceinline__ int v_st(int k, int c) { const int kk = (k & ~0xC) | ((k & 4) << 1) | ((k & 8) >> 1); return ((kk >> 3) * 4 + (c >> 5)) * 512 + ((kk & 7) * 32 + (c & 31)) * 2; }
__device__ __forceinline__ int v_rd_base(int lane) { return ((lane & 3) << 3) | (((lane >> 2) & 3) << 6) | (((lane >> 4) & 1) << 5) | (((lane >> 5) & 1) << 8); }
constexpr int v_rd_off(int d0, int ks, int half) { return d0 * 512 + ks * 4096 + half * 2048; }
__device__ __forceinline__ int crow(int r, int hi) { return (r & 3) + 8 * (r >> 2) + 4 * hi; }
#define SBAR() __builtin_amdgcn_sched_barrier(0)
__device__ __forceinline__ void pv_tile(f32x16* o, int vb0, bf16x8 pa0, bf16x8 pa1, bf16x8 pa2, bf16x8 pa3) {
#define TRRD(dst, off) asm volatile("ds_read_b64_tr_b16 %0, %1 offset:%2" : "=&v"(dst) : "v"(vb0), "i"(off) : "memory")
#define PV_D0(d0) do { s16x4 l0, l1, l2, l3, h0, h1, h2, h3; constexpr int b_ = v_rd_off(d0, 0, 0); \
        TRRD(l0, b_); TRRD(h0, b_ + 2048); TRRD(l1, b_ + 4096); TRRD(h1, b_ + 6144); TRRD(l2, b_ + 8192); TRRD(h2, b_ + 10240); TRRD(l3, b_ + 12288); TRRD(h3, b_ + 14336); \
        asm volatile("s_waitcnt lgkmcnt(0)" ::: "memory"); SBAR(); \
        o[d0] = __builtin_amdgcn_mfma_f32_32x32x16_bf16(pa0, (bf16x8){l0[0], l0[1], l0[2], l0[3], h0[0], h0[1], h0[2], h0[3]}, o[d0], 0, 0, 0); \
        o[d0] = __builtin_amdgcn_mfma_f32_32x32x16_bf16(pa1, (bf16x8){l1[0], l1[1], l1[2], l1[3], h1[0], h1[1], h1[2], h1[3]}, o[d0], 0, 0, 0); \
        o[d0] = __builtin_amdgcn_mfma_f32_32x32x16_bf16(pa2, (bf16x8){l2[0], l2[1], l2[2], l2[3], h2[0], h2[1], h2[2], h2[3]}, o[d0], 0, 0, 0); \
        o[d0] = __builtin_amdgcn_mfma_f32_32x32x16_bf16(pa3, (bf16x8){l3[0], l3[1], l3[2], l3[3], h3[0], h3[1], h3[2], h3[3]}, o[d0], 0, 0, 0); } while (0)
    PV_D0(0); PV_D0(1); PV_D0(2); PV_D0(3);
#undef PV_D0
#undef TRRD
}

__device__ __forceinline__ float rstd_v(const float* VSS, int row) { const GAS f32x4* p = (const GAS f32x4*)(VSS + (size_t)row * 32); f32x4 s = p[0];
#pragma unroll
    for (int k = 1; k < 8; ++k) s += p[k];
    return rsqrtf(((s.x + s.y) + (s.z + s.w)) * (1.0f / DG) + EPS); }
__device__ __forceinline__ void p4_sgu(const Ctx& C, int idx, int nblk) {
    unsigned char* ws = C.ws; const int tid = C.tid, lane = C.lane, wave = C.wave, r32 = lane & 31, hi = lane >> 5;
    const bf16* U = (const bf16*)(ws + WS_U); const bf16* VG = (const bf16*)(ws + WS_VG); const float* VSS = (const float*)(ws + WS_VSS);
    const bf16* WMB = (const bf16*)(ws + WS_WMB); bf16* OA = (bf16*)(ws + WS_OA);
    const float* gs = C.in[IN_GSGU]; const float* bs = C.in[IN_BSGU];
    LAS unsigned char* Vl = C.lds + RING_OFF;
    for (int unit = idx; unit < 256; unit += nblk) {
        const int n = unit >> 2, gp = unit & 3, rowbase = n * 128; const bool last = (n & 31) == 31; const int bb = n >> 5;
        __syncthreads();
        { const int sr = tid >> 4, sc = (tid & 15) * 8;
#pragma unroll
          for (int gl = 0; gl < 2; ++gl) { const int g = gp * 2 + gl; float gg[8];
#pragma unroll
              for (int k = 0; k < 8; ++k) gg[k] = gs[g * 128 + sc + k];
#pragma unroll
              for (int q = 0; q < 4; ++q) { const int s = q * 32 + sr, st = s >> 6, row = rowbase + s; float f[8];
                  unpack8(*(const GAS v4u*)(VG + (size_t)row * DG + g * 128 + sc), f); const float rs = rstd_v(VSS, row);
#pragma unroll
                  for (int k = 0; k < 8; ++k) f[k] = f[k] * rs * gg[k];
                  *(LAS v4u*)(Vl + (gl * 2 + st) * 16384 + v_st(s & 63, sc)) = pack8f(f);
                  if (last) { float* o = C.out + O_PSGU + ((size_t)bb * 128 + s) * DG + g * 128 + sc; *(GAS f32x4*)o = (f32x4){f[0], f[1], f[2], f[3]}; *(GAS f32x4*)(o + 4) = (f32x4){f[4], f[5], f[6], f[7]}; } } } }
        __syncthreads();
        const int tb = wave & 3, gl = wave >> 2, g = gp * 2 + gl;
        f32x16 o[4];
#pragma unroll
        for (int d0 = 0; d0 < 4; ++d0)
#pragma unroll
            for (int r = 0; r < 16; ++r) o[d0][r] = 0.f;
#pragma unroll
        for (int st = 0; st < 2; ++st) if (64 * st <= 32 * tb + 31) {
            const bf16* wp = WMB + ((size_t)g * 128 + tb * 32 + r32) * 128 + st * 64 + hi * 8;
            const bf16x8 pa0 = *(const GAS bf16x8*)(wp), pa1 = *(const GAS bf16x8*)(wp + 16), pa2 = *(const GAS bf16x8*)(wp + 32), pa3 = *(const GAS bf16x8*)(wp + 48);
            const int vb0 = (int)(unsigned)(uintptr_t)(Vl + (gl * 2 + st) * 16384) + v_rd_base(lane);
            pv_tile(o, vb0, pa0, pa1, pa2, pa3);
        }
#pragma unroll
        for (int r = 0; r < 16; ++r) { const int trow = tb * 32 + crow(r, hi); const float bv = bs[g * 128 + trow]; const size_t ro = (size_t)(rowbase + trow) * DG + g * 128, roa = (size_t)(rowbase + trow) * LD1 + g * 128;
#pragma unroll
            for (int d0 = 0; d0 < 4; ++d0) { const int c = d0 * 32 + r32; const float v = (o[d0][r] + bv) * bf2f(U[ro + c]); const float vn = __shfl_xor(v, 1);
                if ((r32 & 1) == 0) *(GAS unsigned*)(OA + tm_idx(rowbase + trow, g * 128 + c, DG / 64)) = pk2(v, vn); } }
    }
    { const int gt = idx * 512 + tid, NT = nblk * 512; const float* w = C.in[IN_WSGU];
      for (int i = gt; i < MSAMP * DG / 8; i += NT) { const int r = i >> 7, c = (i & 127) * 8, row = MPROMPT + r, g = c >> 7; float f[8], uu[8];
          unpack8(*(const GAS v4u*)(VG + (size_t)row * DG + c), f); unpack8(*(const GAS v4u*)(U + (size_t)row * DG + c), uu); const float rs = rstd_v(VSS, row), w00 = w[g * 16384], b0 = bs[g * 128];
#pragma unroll
          for (int k = 0; k < 8; ++k) { f[k] = f[k] * rs * gs[c + k]; uu[k] = uu[k] * (w00 * f[k] + b0); }
          float* o = C.out + O_SSGU + (size_t)r * DG + c; *(GAS f32x4*)o = (f32x4){f[0], f[1], f[2], f[3]}; *(GAS f32x4*)(o + 4) = (f32x4){f[4], f[5], f[6], f[7]};
          *(GAS v4u*)((bf16*)(ws + WS_SOA) + (size_t)r * LDS_G + c) = pack8f(uu); } }
}

struct AttItem { const bf16* q; int t; int ncmp; const bf16* kc; const bf16* vc; int nblk; const float* gates; bf16* out; const float* blut; };

__device__ __forceinline__ void ld8f(const float* p, float (&f)[8]) { const f32x4 a = *(const GAS f32x4*)p, b = *(const GAS f32x4*)(p + 4); f[0] = a.x; f[1] = a.y; f[2] = a.z; f[3] = a.w; f[4] = b.x; f[5] = b.y; f[6] = b.z; f[7] = b.w; }
struct PromptKV {
    const bf16 *ks, *vs, *kw, *vw;
    static constexpr bool NORM = false;
    __device__ __forceinline__ void selK(int pos, int d8, float (&k)[8]) const { unpack8(*(const GAS v4u*)(ks + (size_t)pos * 128 + d8), k); }
    __device__ __forceinline__ void selV(int pos, int d8, float (&k)[8]) const { unpack8(*(const GAS v4u*)(vs + (size_t)pos * 128 + d8), k); }
    __device__ __forceinline__ void winK(int pos, int d8, float (&k)[8]) const { unpack8(*(const GAS v4u*)(kw + (size_t)pos * 128 + d8), k); }
    __device__ __forceinline__ void winV(int pos, int d8, float (&k)[8]) const { unpack8(*(const GAS v4u*)(vw + (size_t)pos * 128 + d8), k); }
};
struct SampleKV {
    const float* csel; const int* pt; const float* nsel; const float* win; const float* nwin;
    static constexpr bool NORM = true;
    __device__ __forceinline__ const float* selp(int pos) const { return pos < PASTLEN ? csel + ((size_t)pt[pos >> 7] * 128 + (pos & 127)) * 512 : nsel; }
    __device__ __forceinline__ const float* winp(int pos) const { return pos < PASTLEN ? win + (size_t)(pos - (PASTLEN - 512)) * 512 : nwin; }
    __device__ __forceinline__ void selK(int pos, int d8, float (&k)[8]) const { ld8f(selp(pos) + d8, k); }
    __device__ __forceinline__ void selV(int pos, int d8, float (&k)[8]) const { ld8f(selp(pos) + 256 + d8, k); }
    __device__ __forceinline__ void winK(int pos, int d8, float (&k)[8]) const { ld8f(winp(pos) + d8, k); }
    __device__ __forceinline__ void winV(int pos, int d8, float (&k)[8]) const { ld8f(winp(pos) + 256 + d8, k); }
};
#define DPP_ADD(x, ctrl) ((x) + __int_as_float(__builtin_amdgcn_update_dpp(0, __float_as_int(x), (ctrl), 0xF, 0xF, true)))
__device__ __forceinline__ float row_sum16(float x) { x = DPP_ADD(x, 0xB1); x = DPP_ADD(x, 0x4E); x = DPP_ADD(x, 0x141); x = DPP_ADD(x, 0x140); return x; }
template <bool NORM>
__device__ __forceinline__ void score4(const float (&k)[8], const float (&gkv)[8], const float (&q)[4][8], float (&s)[4]) {
    float kk[8]; float ss = 0.f;
#pragma unroll
    for (int i = 0; i < 8; ++i) { if (NORM) { ss += k[i] * k[i]; kk[i] = k[i] * gkv[i]; } else kk[i] = k[i]; }
#pragma unroll
    for (int h = 0; h < 4; ++h) { float a = 0.f;
#pragma unroll
        for (int i = 0; i < 8; ++i) a += q[h][i] * kk[i];
        s[h] = row_sum16(a); }
    if (NORM) { ss = row_sum16(ss); const float rs = rsqrtf(ss * (1.0f / 128) + EPS);
#pragma unroll
        for (int h = 0; h < 4; ++h) s[h] *= rs; }
}
__device__ __forceinline__ void online4(const float (&s)[4], bool valid, float (&m)[4], float (&l)[4], float (&o)[4][8], const float (&v)[8]) {
#pragma unroll
    for (int h = 0; h < 4; ++h) { const float sv = valid ? s[h] : -__builtin_inff(); const float mn = fmaxf(m[h], sv);
        const float al = __builtin_amdgcn_exp2f(m[h] - mn), p = __builtin_amdgcn_exp2f(sv - mn); m[h] = mn; l[h] = l[h] * al + p;
#pragma unroll
        for (int i = 0; i < 8; ++i) o[h][i] = o[h][i] * al + p * v[i]; }
}
__device__ __forceinline__ void merge_store(float (&m)[4], float (&l)[4], float (&o)[4][8], LAS float* Cmb, int wave, int lane) {
#pragma unroll
    for (int h = 0; h < 4; ++h) { float M = fmaxf(m[h], __shfl_xor(m[h], 16)); M = fmaxf(M, __shfl_xor(M, 32));
        const float sc = __builtin_amdgcn_exp2f(m[h] - M); float ll = l[h] * sc; ll += __shfl_xor(ll, 16); ll += __shfl_xor(ll, 32);
        LAS float* dst = Cmb + (wave * 4 + h) * 132;
#pragma unroll
        for (int i = 0; i < 8; ++i) { float x = o[h][i] * sc; x += __shfl_xor(x, 16); x += __shfl_xor(x, 32); if (lane < 16) dst[lane * 8 + i] = x; }
        if (lane == 0) { dst[128] = M; dst[129] = ll; } }
}
__device__ __forceinline__ float combine8(const LAS float* Cmb, int hh, int dd) {
    float M = -1e30f;
#pragma unroll
    for (int w = 0; w < 8; ++w) M = fmaxf(M, Cmb[(w * 4 + hh) * 132 + 128]);
    float L = 0.f, O = 0.f;
#pragma unroll
    for (int w = 0; w < 8; ++w) { const LAS float* p = Cmb + (w * 4 + hh) * 132; const float sc = __builtin_amdgcn_exp2f(p[128] - M); L += p[129] * sc; O += p[dd] * sc; }
    return L > 0.f ? O / L : 0.f;
}

template <class KV, bool WIN>
__device__ __forceinline__ void nsa_stream(const KV& kv, int total, int wave, int grp, int d8, int t, int wlo, const LAS int* sl, const float (&gkv)[8], const float (&q)[4][8],
                                           const float* blut, float (&m)[4], float (&l)[4], float (&o)[4][8]) {
    const int nper = total > wave ? (total - wave + 7) >> 3 : 0;
    float kA[2][8], vA[2][8], kB[2][8], vB[2][8]; int ppA[2], ppB[2]; bool okA[2], okB[2];
#define NS_LOAD(K_, V_, PP_, OK_, i0_) do { _Pragma("unroll") for (int u = 0; u < 2; ++u) { const int ch = wave + 8 * ((i0_) + u); const bool in = (i0_) + u < nper; \
            int pos; if (WIN) pos = wlo + ch * 4 + grp; else pos = sl[in ? (ch >> 4) : 0] * 64 + (ch & 15) * 4 + grp; \
            OK_[u] = in && pos <= t; PP_[u] = OK_[u] ? pos : t; \
            if (WIN) { kv.winK(PP_[u], d8, K_[u]); kv.winV(PP_[u], d8, V_[u]); } else { kv.selK(PP_[u], d8, K_[u]); kv.selV(PP_[u], d8, V_[u]); } } } while (0)
#define NS_COMP(K_, V_, PP_, OK_, i0_) do { _Pragma("unroll") for (int u = 0; u < 2; ++u) if ((i0_) + u < nper) { float sc[4]; score4<KV::NORM>(K_[u], gkv, q, sc); \
            const int rel = t - PP_[u]; const int ri = rel > 128 ? 128 : rel; \
            _Pragma("unroll") for (int h = 0; h < 4; ++h) sc[h] += blut[h * 132 + ri]; \
            online4(sc, OK_[u], m, l, o, V_[u]); } } while (0)
    if (nper > 0) NS_LOAD(kA, vA, ppA, okA, 0);
    for (int i0 = 0; i0 < nper; i0 += 4) {
        if (i0 + 2 < nper) NS_LOAD(kB, vB, ppB, okB, i0 + 2);
        NS_COMP(kA, vA, ppA, okA, i0);
        if (i0 + 4 < nper) NS_LOAD(kA, vA, ppA, okA, i0 + 4);
        if (i0 + 2 < nper) NS_COMP(kB, vB, ppB, okB, i0 + 2);
    }
#undef NS_LOAD
#undef NS_COMP
}

template <class KV>
__device__ __forceinline__ void nsa_item(const Ctx& C, const AttItem& it, const KV& kv, const float* gk1, const float* gk2) {
    const int tid = C.tid, lane = C.lane, wave = C.wave, grp = lane >> 4, d8 = (lane & 15) * 8, t = it.t;
    LAS float* Sc = (LAS float*)(C.lds + RING_OFF);
    LAS float* Cmb = (LAS float*)(C.lds + RING_OFF + 4096);
    LAS int* sl = (LAS int*)(C.lds + RING_OFF + 4096 + 16896);
    const float NEG = -__builtin_inff();
    float q[4][8];
#pragma unroll
    for (int h = 0; h < 4; ++h) unpack8(*(const GAS v4u*)(it.q + h * 128 + d8), q[h]);
    const int hh = tid >> 7, dd = tid & 127;
    const float g0 = it.gates[hh * 3 + 0], g1 = it.gates[hh * 3 + 1], g2 = it.gates[hh * 3 + 2];
    float res = 0.f;
    float m[4], l[4], o[4][8], gkv[8];
#pragma unroll
    for (int i = 0; i < 8; ++i) gkv[i] = 1.f;

    int nvis = t >= 31 ? (t - 31) / 16 + 1 : 0; if (nvis > it.ncmp) nvis = it.ncmp;
    const int nch = (nvis + 3) >> 2;
    for (int ch = wave; ch < 64; ch += 8) {
        const int c = ch * 4 + grp; float s[4] = {NEG, NEG, NEG, NEG};
        if (ch < nch) {
            const bool valid = c < nvis; const int cc = valid ? c : 0; float k[8]; unpack8(*(const GAS v4u*)(it.kc + (size_t)cc * 128 + d8), k);
            float sc[4]; score4<false>(k, gkv, q, sc);
            const int rel = t - (16 * c + 31); const int ri = rel < 0 ? 0 : (rel > 128 ? 128 : rel);
#pragma unroll
            for (int h = 0; h < 4; ++h) s[h] = valid ? sc[h] + it.blut[h * 132 + ri] : NEG;
        }
        if ((lane & 15) == 0) {
#pragma unroll
            for (int h = 0; h < 4; ++h) Sc[h * 256 + c] = s[h]; }
    }
    __syncthreads();
    float mh[4], il[4];
#pragma unroll
    for (int h = 0; h < 4; ++h) { const f32x4 v = *(const LAS f32x4*)(Sc + h * 256 + lane * 4); float mx = fmaxf(fmaxf(v.x, v.y), fmaxf(v.z, v.w)); mx = fmaxf(wave_max(mx), -1e30f);
        float e = (__builtin_amdgcn_exp2f(v.x - mx) + __builtin_amdgcn_exp2f(v.y - mx)) + (__builtin_amdgcn_exp2f(v.z - mx) + __builtin_amdgcn_exp2f(v.w - mx)); e = wave_sum(e);
        mh[h] = mx; il[h] = e > 0.f ? 1.0f / e : 0.f; }
    float imp = 0.f;
#pragma unroll
    for (int h = 0; h < 4; ++h) { float a = 0.f;
#pragma unroll
        for (int k = 0; k < 5; ++k) { const int c = 4 * lane - 1 + k; if (c >= 0) a += __builtin_amdgcn_exp2f(Sc[h * 256 + c] - mh[h]); }
        imp += a * il[h]; }
    unsigned long long mask;
    { const int j = lane, cur = t >> 6; const bool forced = (j == 0) || (j == cur) || (j == cur - 1), elig = 64 * j <= t, exists = j < it.nblk;
      const float val = exists ? (forced ? 1e6f : (elig ? imp : -1.f)) : -2.f; int rank = 0;
      const int key = (int)((__float_as_uint(val) & ~63u) | (unsigned)(63 - j));
#pragma unroll
      for (int jp = 0; jp < 64; ++jp) rank += (__builtin_amdgcn_readlane(key, jp) > key) ? 1 : 0;
      const bool sel_ = rank < 16 && elig && exists; mask = __ballot(sel_);
      if (wave == 0 && sel_) sl[__builtin_popcountll(mask & ((1ull << j) - 1ull))] = j; }
#pragma unroll
    for (int h = 0; h < 4; ++h) { m[h] = mh[h]; l[h] = 0.f;
#pragma unroll
        for (int i = 0; i < 8; ++i) o[h][i] = 0.f; }
    for (int ch = wave; ch < nch; ch += 8) {
        const int c = ch * 4 + grp; const bool valid = c < nvis; const int cc = valid ? c : 0; float v[8]; unpack8(*(const GAS v4u*)(it.vc + (size_t)cc * 128 + d8), v);
#pragma unroll
        for (int h = 0; h < 4; ++h) { const float p = valid ? __builtin_amdgcn_exp2f(Sc[h * 256 + cc] - mh[h]) : 0.f; l[h] += p;
#pragma unroll
            for (int i = 0; i < 8; ++i) o[h][i] += p * v[i]; }
    }
    merge_store(m, l, o, Cmb, wave, lane);
    __syncthreads();
    res += g0 * combine8(Cmb, hh, dd);
    __syncthreads();

#pragma unroll
    for (int h = 0; h < 4; ++h) { m[h] = -1e30f; l[h] = 0.f;
#pragma unroll
        for (int i = 0; i < 8; ++i) o[h][i] = 0.f; }
    if (KV::NORM) {
#pragma unroll
        for (int i = 0; i < 8; ++i) gkv[i] = gk1[d8 + i]; }
    nsa_stream<KV, false>(kv, __builtin_popcountll(mask) * 16, wave, grp, d8, t, 0, sl, gkv, q, it.blut, m, l, o);
    merge_store(m, l, o, Cmb, wave, lane);
    __syncthreads();
    res += g1 * combine8(Cmb, hh, dd);
    __syncthreads();

#pragma unroll
    for (int h = 0; h < 4; ++h) { m[h] = -1e30f; l[h] = 0.f;
#pragma unroll
        for (int i = 0; i < 8; ++i) o[h][i] = 0.f; }
    if (KV::NORM) {
#pragma unroll
        for (int i = 0; i < 8; ++i) gkv[i] = gk2[d8 + i]; }
    const int wlo = t - 511 < 0 ? 0 : t - 511, nchw = (t - wlo + 4) >> 2;
    nsa_stream<KV, true>(kv, nchw, wave, grp, d8, t, wlo, sl, gkv, q, it.blut, m, l, o);
    merge_store(m, l, o, Cmb, wave, lane);
    __syncthreads();
    res += g2 * combine8(Cmb, hh, dd);
    it.out[hh * 128 + dd] = (bf16)f2bf(res);
    __syncthreads();
}


#define KSWZ(row, colB) ((row) * 256 + ((colB) ^ (((row) & 7) << 4)))
constexpr int AT_V = 0, AT_K = 32768, AT_PC = 65536, AT_X = 131584, AT_BLUT = AT_X, AT_SELM = AT_X + 2176, AT_WS = AT_SELM + 512;
static_assert(AT_WS + 8 * 256 + 64 <= LDS_BYTES && AT_X >= MISC_OFF + 128 && AT_PC + 64 * 256 * 4 <= LDSCTL_OFF, "attention LDS map");

__device__ __forceinline__ unsigned cvtpk(float lo, float hi) { unsigned r; asm volatile("v_cvt_pk_bf16_f32 %0, %1, %2" : "=v"(r) : "v"(lo), "v"(hi)); return r; }
__device__ __forceinline__ float swap_max(float x) { auto rr = __builtin_amdgcn_permlane32_swap(__float_as_uint(x), __float_as_uint(x), false, false); return fmaxf(__uint_as_float(rr[0]), __uint_as_float(rr[1])); }
__device__ __forceinline__ float swap_add(float x) { auto rr = __builtin_amdgcn_permlane32_swap(__float_as_uint(x), __float_as_uint(x), false, false); return __uint_as_float(rr[0]) + __uint_as_float(rr[1]); }
__device__ __forceinline__ float quad_sum(float x) {
    x += __int_as_float(__builtin_amdgcn_update_dpp(0, __float_as_int(x), 0xB1, 0xF, 0xF, true));
    x += __int_as_float(__builtin_amdgcn_update_dpp(0, __float_as_int(x), 0x4E, 0xF, 0xF, true));
    return x;
}
__device__ __forceinline__ void qkt_tile(f32x16& p0, f32x16& p1, const LAS unsigned char* Kt, int r32, int hi, const bf16x8 (&qr)[8]) {
#pragma unroll
    for (int r = 0; r < 16; ++r) { p0[r] = 0.f; p1[r] = 0.f; }
    const LAS unsigned char* kb[4];
#pragma unroll
    for (int dd = 0; dd < 4; ++dd) kb[dd] = Kt + KSWZ(r32, (dd * 16 + hi * 8) * 2);
#pragma unroll
    for (int d0 = 0; d0 < 8; ++d0) { const LAS unsigned char* a = kb[d0 & 3] + (d0 >> 2) * 128;
        const bf16x8 b0 = *(const LAS bf16x8*)a, b1 = *(const LAS bf16x8*)(a + 32 * 256);
        p0 = __builtin_amdgcn_mfma_f32_32x32x16_bf16(b0, qr[d0], p0, 0, 0, 0);
        p1 = __builtin_amdgcn_mfma_f32_32x32x16_bf16(b1, qr[d0], p1, 0, 0, 0); }
}
template <int MODE>
__device__ __forceinline__ void fix_tile(f32x16& p0, f32x16& p1, int tile, int tq, int tmin, int head, int hi, bool bit, const LAS float* lut) {
    const float NEG = -__builtin_inff(); const float c31 = lut[head * 132 + 128];
    bool fast;
    if (MODE == 0) fast = tmin - 16 * (64 * tile + 63) - 31 >= 128;
    else if (MODE == 2) fast = tmin - (64 * tile + 63) >= 128;
    else fast = (tmin - (64 * tile + 63) >= 128) && (tmin + 7 - 64 * tile < 512);
    if (fast) {
        if (MODE == 2) {
#pragma unroll
            for (int r = 0; r < 16; ++r) { p0[r] = bit ? p0[r] + c31 : NEG; p1[r] = bit ? p1[r] + c31 : NEG; }
        } else {
#pragma unroll
            for (int r = 0; r < 16; ++r) { p0[r] += c31; p1[r] += c31; }
        }
        return;
    }
    const LAS float* lh = lut + head * 132;
#pragma unroll
    for (int hf = 0; hf < 2; ++hf)
#pragma unroll
        for (int r = 0; r < 16; ++r) { const int cr = (r & 3) + 8 * (r >> 2); int rel;
            if (MODE == 0) rel = tq - 31 - 16 * (64 * tile + 32 * hf + 4 * hi + cr); else rel = tq - (64 * tile + 32 * hf + 4 * hi + cr);
            bool valid;
            if (MODE == 0) valid = rel >= 0; else if (MODE == 2) valid = rel >= 0 && bit; else valid = (unsigned)rel < 512u;
            const int ri = rel < 0 ? 0 : (rel > 128 ? 128 : rel); const float bv = lh[ri];
            if (hf == 0) p0[r] = valid ? p0[r] + bv : NEG; else p1[r] = valid ? p1[r] + bv : NEG; }
}
__device__ __forceinline__ void softmax_tile(f32x16& p0, f32x16& p1, float& m_reg, float& l_reg, float& alpha, bf16x8& pa0, bf16x8& pa1, bf16x8& pa2, bf16x8& pa3) {
    float pmax = p0[0];
#pragma unroll
    for (int r = 1; r < 16; ++r) pmax = fmaxf(pmax, p0[r]);
#pragma unroll
    for (int r = 0; r < 16; ++r) pmax = fmaxf(pmax, p1[r]);
    pmax = swap_max(pmax);
    const float mn = fmaxf(m_reg, pmax); alpha = __builtin_amdgcn_exp2f(m_reg - mn); m_reg = mn;
    float ps = 0.f;
#pragma unroll
    for (int r = 0; r < 16; ++r) { p0[r] = __builtin_amdgcn_exp2f(p0[r] - mn); p1[r] = __builtin_amdgcn_exp2f(p1[r] - mn); ps += p0[r] + p1[r]; }
    ps = swap_add(ps); l_reg = l_reg * alpha + ps;
#define PK4(P, B_, OUT) do { unsigned a0 = cvtpk(P[B_+0], P[B_+1]), a1 = cvtpk(P[B_+2], P[B_+3]); unsigned b0 = cvtpk(P[B_+4], P[B_+5]), b1 = cvtpk(P[B_+6], P[B_+7]); \
        auto r0 = __builtin_amdgcn_permlane32_swap(a0, b0, false, false); auto r1 = __builtin_amdgcn_permlane32_swap(a1, b1, false, false); \
        v4u w = {r0[0], r1[0], r0[1], r1[1]}; OUT = __builtin_bit_cast(bf16x8, w); } while (0)
    PK4(p0, 0, pa0); PK4(p0, 8, pa1); PK4(p1, 0, pa2); PK4(p1, 8, pa3);
#undef PK4
}

struct FlashSt {
    bf16x8 qr[8];
    int tq, tmin, head;
};
template <int MODE, bool PASS2, int ACC>
__device__ __forceinline__ void flash_branch(const Ctx& C, FlashSt& S, const bf16* Kb, const bf16* Vb, int j_lo, int j_hi, float gate, unsigned long long mymask, unsigned long long wor,
                                             float& m_reg, float& l_reg, float* OT, bf16* OBrow) {
    const int tid = C.tid, lane = C.lane, wave = C.wave, r32 = lane & 31, hi = lane >> 5;
    LAS unsigned char* Vl = C.lds + AT_V; LAS unsigned char* Kl = C.lds + AT_K; LAS float* Pc = (LAS float*)(C.lds + AT_PC);
    const LAS float* lut = (const LAS float*)(C.lds + AT_BLUT); LAS float* wsl = (LAS float*)(C.lds + AT_WS) + wave * 64;
    const int vb0 = (int)(unsigned)(uintptr_t)Vl + v_rd_base(lane);
    f32x16 o[4];
    if (!PASS2) {
#pragma unroll
        for (int d0 = 0; d0 < 4; ++d0)
#pragma unroll
            for (int r = 0; r < 16; ++r) o[d0][r] = 0.f;
        m_reg = -1e30f; l_reg = 0.f; }
    const float inv_l = PASS2 ? (l_reg > 0.f ? 1.0f / l_reg : 0.f) : 0.f;
    const int n = j_hi - j_lo;
    const int lrow = wave * 4 + (lane >> 4);
    const unsigned ksrc = (unsigned)(lrow * 256 + ((((lane & 15) << 4)) ^ ((lrow & 7) << 4)));
    const int vkk = (((wave * 2 + (lane >> 5)) >> 2) << 3) + ((lane & 31) >> 2);
    const int vk = (vkk & ~0xC) | ((vkk & 4) << 1) | ((vkk & 8) >> 1);
    const unsigned vsrc = (unsigned)(vk * 256 + ((((wave * 2 + (lane >> 5)) & 3) * 32 + (lane & 3) * 8) * 2));
#define ST_DMA(tile, bf) do { const char* kp = (const char*)(Kb + (size_t)(tile) * 64 * 128) + ksrc; \
        __builtin_amdgcn_global_load_lds((const unsigned*)kp, (LAS unsigned*)(Kl + (bf) * 16384 + wave * 1024), 16, 0, 0); \
        __builtin_amdgcn_global_load_lds((const unsigned*)(kp + 8192), (LAS unsigned*)(Kl + (bf) * 16384 + 8192 + wave * 1024), 16, 0, 0); \
        if (!PASS2) { const char* vp = (const char*)(Vb + (size_t)(tile) * 64 * 128) + vsrc; \
            __builtin_amdgcn_global_load_lds((const unsigned*)vp, (LAS unsigned*)(Vl + (bf) * 16384 + wave * 1024), 16, 0, 0); \
            __builtin_amdgcn_global_load_lds((const unsigned*)(vp + 8192), (LAS unsigned*)(Vl + (bf) * 16384 + 8192 + wave * 1024), 16, 0, 0); } } while (0)
    if (n > 0) ST_DMA(j_lo, 0);
    asm volatile("s_waitcnt vmcnt(0)" ::: "memory");
    __syncthreads();
    for (int i = 0; i < n; ++i) {
        const int tile = j_lo + i, buf = i & 1;
        if (i + 1 < n) ST_DMA(tile + 1, buf ^ 1);
        bool act;
        if (PASS2) act = true; else if (MODE == 0) act = 16 * (64 * tile) + 31 <= S.tmin + 7; else if (MODE == 2) act = (wor >> tile) & 1ull; else act = true;
        if (act) {
            f32x16 p0, p1; qkt_tile(p0, p1, Kl + buf * 16384, r32, hi, S.qr);
            const bool bit = MODE == 2 ? ((mymask >> tile) & 1ull) != 0ull : true;
            fix_tile<MODE>(p0, p1, tile, S.tq, S.tmin, S.head, hi, bit, lut);
            if (PASS2) {
#pragma unroll
                for (int r = 0; r < 16; ++r) { p0[r] = quad_sum(__builtin_amdgcn_exp2f(p0[r] - m_reg) * inv_l); p1[r] = quad_sum(__builtin_amdgcn_exp2f(p1[r] - m_reg) * inv_l); }
                if ((r32 & 3) == 0) { LAS float* pr = Pc + (wave * 8 + (r32 >> 2)) * 256 + tile * 64 + 4 * hi;
#pragma unroll
                    for (int r = 0; r < 16; ++r) { const int cr = (r & 3) + 8 * (r >> 2); pr[cr] = p0[r]; pr[32 + cr] = p1[r]; } }
            } else {
                float alpha; bf16x8 pa0, pa1, pa2, pa3;
                softmax_tile(p0, p1, m_reg, l_reg, alpha, pa0, pa1, pa2, pa3);
                if (__any(alpha < 1.f)) { if (hi == 0) wsl[r32] = alpha; asm volatile("s_waitcnt lgkmcnt(0)" ::: "memory"); const LAS float* wh = wsl + 4 * hi;
#pragma unroll
                    for (int r = 0; r < 16; ++r) { const float a = wh[(r & 3) + 8 * (r >> 2)];
#pragma unroll
                        for (int d0 = 0; d0 < 4; ++d0) o[d0][r] *= a; }
                    asm volatile("s_waitcnt lgkmcnt(0)" ::: "memory"); }
                pv_tile(o, vb0 + buf * 16384, pa0, pa1, pa2, pa3);
            }
        }
        asm volatile("s_waitcnt vmcnt(0)" ::: "memory");
        __syncthreads();
    }
#undef ST_DMA
    if (!PASS2) {
        const float scl = l_reg > 0.f ? gate / l_reg : 0.f;
        if (hi == 0) wsl[32 + r32] = scl; asm volatile("s_waitcnt lgkmcnt(0)" ::: "memory");
        const LAS float* wh = wsl + 32 + 4 * hi; GAS float* otl = (GAS float*)OT + (size_t)(4 * hi) * 128 + r32; GAS bf16* obl = (GAS bf16*)OBrow + (size_t)hi * 64 + r32;
        asm volatile("" : "+v"(otl), "+v"(obl));
#pragma unroll
        for (int r = 0; r < 16; ++r) { const int cr = (r & 3) + 8 * (r >> 2); const float a = wh[cr];
#pragma unroll
            for (int d0 = 0; d0 < 4; ++d0) { float v = o[d0][r] * a; if (ACC > 0) v += otl[cr * 128 + d0 * 32];
                if (ACC < 2) otl[cr * 128 + d0 * 32] = v;
                else { const float vn = __shfl_xor(v, 1); if ((r32 & 1) == 0) *(GAS unsigned*)(obl + ((r & 3) * 2 + (d0 >> 1)) * 16384 + (2 * (r >> 2)) * 64 + (d0 & 1) * 32) = cvtpk(v, vn); } } }
        asm volatile("s_waitcnt lgkmcnt(0)" ::: "memory");
    }
}

__device__ __forceinline__ void flash_unit(const Ctx& C, int b, int g, int qb) {
    unsigned char* ws = C.ws; const int tid = C.tid, lane = C.lane, wave = C.wave, r32 = lane & 31, hi = lane >> 5, t0 = qb * 64;
    LAS float* lut = (LAS float*)(C.lds + AT_BLUT); LAS float* Pc = (LAS float*)(C.lds + AT_PC); LAS unsigned long long* selm = (LAS unsigned long long*)(C.lds + AT_SELM);
    const float* BL = (const float*)(ws + WS_BLUT) + g * 4 * 132;
    for (int i = tid; i < 4 * 132; i += NWAVES * 64) lut[i] = BL[i];
    FlashSt S; S.tmin = t0 + wave * 8; S.tq = S.tmin + (r32 >> 2); S.head = r32 & 3;
    const int row = b * T + S.tq;
    { const bf16* qp = (const bf16*)(ws + WS_QN) + (size_t)row * DQ + (g * 4 + S.head) * 128 + hi * 8;
#pragma unroll
      for (int d0 = 0; d0 < 8; ++d0) S.qr[d0] = *(const GAS bf16x8*)(qp + d0 * 16); }
    const float* gn = (const float*)(ws + WS_GN) + (size_t)row * 32 + (g * 4 + S.head) * 3; const float gc = gn[0], gsel = gn[1], gw = gn[2];
    const size_t kvb = (size_t)(b * 2 + g) * T * 128, cb = (size_t)(b * 2 + g) * 256 * 128;
    const int cmax = (t0 + 63 - 31) >> 4;
    const int nct = (cmax >> 6) + 1;
    float m_c, l_c;
    float* OT = (float*)(ws + WS_OT) + ((size_t)blockIdx.x * 8 + wave) * 32 * 128;
    bf16* OBrow = (bf16*)(ws + WS_OB) + tm_idx(b * T + S.tmin, g * 512, DQ / 64);
    flash_branch<0, false, 0>(C, S, (const bf16*)(ws + WS_KCP) + cb, (const bf16*)(ws + WS_VCP) + cb, 0, nct, gc, 0ull, 0ull, m_c, l_c, OT, OBrow);
    flash_branch<0, true, 0>(C, S, (const bf16*)(ws + WS_KCP) + cb, nullptr, 0, nct, 0.f, 0ull, 0ull, m_c, l_c, OT, OBrow);
    unsigned long long wor = 0ull;
    { asm volatile("s_waitcnt lgkmcnt(0)" ::: "memory");
      const int ncomp = nct * 64;
#pragma unroll 1
      for (int qi = 0; qi < 8; ++qi) { const int ql = wave * 8 + qi, t = t0 + ql; const LAS float* pr = Pc + ql * 256; float imp = 0.f;
#pragma unroll
          for (int k = 0; k < 5; ++k) { const int c = 4 * lane - 1 + k; if (c >= 0 && c < ncomp) imp += pr[c]; }
          const int j = lane, cur = t >> 6; const bool forced = (j == 0) || (j == cur) || (j == cur - 1), elig = 64 * j <= t;
          const float val = forced ? 1e6f : (elig ? imp : -1.f); int rank = 0;
          const int key = (int)((__float_as_uint(val) & ~63u) | (unsigned)(63 - j));
#pragma unroll
          for (int jp = 0; jp < 64; ++jp) rank += (__builtin_amdgcn_readlane(key, jp) > key) ? 1 : 0;
          const unsigned long long mk = __ballot(rank < 16 && elig); wor |= mk;
          if (lane == 0) selm[ql] = mk; }
      asm volatile("s_waitcnt lgkmcnt(0)" ::: "memory"); }
    const unsigned long long mymask = selm[wave * 8 + (r32 >> 2)];
    float m_s, l_s;
    flash_branch<2, false, 1>(C, S, (const bf16*)(ws + WS_KS) + kvb, (const bf16*)(ws + WS_VS) + kvb, 0, qb + 1, gsel, mymask, wor, m_s, l_s, OT, OBrow);
    flash_branch<3, false, 2>(C, S, (const bf16*)(ws + WS_KW) + kvb, (const bf16*)(ws + WS_VW) + kvb, qb >= 8 ? qb - 8 : 0, qb + 1, gw, 0ull, 0ull, m_s, l_s, OT, OBrow);
    __syncthreads();
}


template <bool SPLIT = false>
__device__ __forceinline__ void skinny_core(const Ctx& C, const bf16* A, int lda, const bf16* Bs, int kbeg, int Kw, float (&out)[8], float* out2 = nullptr) {
    const int lane = C.lane, wave = C.wave, r32 = lane & 31, hi = lane >> 5, tid = C.tid;
    f32x16 acc[4];
#pragma unroll
    for (int rb = 0; rb < 4; ++rb)
#pragma unroll
        for (int r = 0; r < 16; ++r) acc[rb][r] = 0.f;
    const GAS bf16* ap0 = (const GAS bf16*)A + (size_t)r32 * lda + kbeg + hi * 32;
    const GAS bf16* bp = (const GAS bf16*)Bs + (size_t)r32 * 64 + (size_t)(kbeg >> 6) * 16384 + hi * 32;
    const GAS bf16* ap1 = ap0 + (size_t)32 * lda; const GAS bf16* ap2 = ap0 + (size_t)64 * lda; const GAS bf16* ap3 = ap0 + (size_t)96 * lda;
    asm volatile("" : "+v"(ap0), "+v"(ap1), "+v"(ap2), "+v"(ap3), "+v"(bp));
    bf16x8 a0[4][2], b0[2], a1[4][2], b1[2];
#define SK_OFF(st) ((((st) >> 1) << 6) + (((st) & 1) << 4))
#define SK_LOAD(a, b, st) do { const int k_ = SK_OFF(st), kb_ = (((st) >> 1) << 14) + (((st) & 1) << 4); _Pragma("unroll") for (int j = 0; j < 2; ++j) b[j] = *(const GAS bf16x8*)(bp + kb_ + 8 * j); \
        _Pragma("unroll") for (int j = 0; j < 2; ++j) { a[0][j] = *(const GAS bf16x8*)(ap0 + k_ + 8 * j); a[1][j] = *(const GAS bf16x8*)(ap1 + k_ + 8 * j); a[2][j] = *(const GAS bf16x8*)(ap2 + k_ + 8 * j); a[3][j] = *(const GAS bf16x8*)(ap3 + k_ + 8 * j); } } while (0)
#define SK_MMA(a, b) do { _Pragma("unroll") for (int j = 0; j < 2; ++j) _Pragma("unroll") for (int rb = 0; rb < 4; ++rb) acc[rb] = __builtin_amdgcn_mfma_f32_32x32x16_bf16(a[rb][j], b[j], acc[rb], 0, 0, 0); } while (0)
    const int ns = Kw >> 5;
    SK_LOAD(a0, b0, 0);
    for (int st = 0; st < ns; st += 2) {
        if (st + 1 < ns) SK_LOAD(a1, b1, st + 1);
        SK_MMA(a0, b0);
        if (st + 2 < ns) SK_LOAD(a0, b0, st + 2);
        if (st + 1 < ns) SK_MMA(a1, b1);
    }
#undef SK_OFF
#undef SK_LOAD
#undef SK_MMA
    LAS float* Red = (LAS float*)(C.lds + RING_OFF);
    LAS float* wr_ = Red + (wave * 128 + 4 * hi) * 32 + r32;
#pragma unroll
    for (int rb = 0; rb < 4; ++rb)
#pragma unroll
        for (int r = 0; r < 16; ++r) wr_[(32 * rb + (r & 3) + 8 * (r >> 2)) * 32] = acc[rb][r];
    __syncthreads();
    const LAS float* rd = Red + (tid >> 2) * 32 + (tid & 3) * 8;
    f32x4 s0 = *(const LAS f32x4*)rd, s1 = *(const LAS f32x4*)(rd + 4);
#pragma unroll
    for (int w = 1; w < (SPLIT ? 4 : 8); ++w) { s0 += *(const LAS f32x4*)(rd + w * 4096); s1 += *(const LAS f32x4*)(rd + w * 4096 + 4); }
    out[0] = s0.x; out[1] = s0.y; out[2] = s0.z; out[3] = s0.w; out[4] = s1.x; out[5] = s1.y; out[6] = s1.z; out[7] = s1.w;
    if (SPLIT) { f32x4 t0 = *(const LAS f32x4*)(rd + 4 * 4096), t1 = *(const LAS f32x4*)(rd + 4 * 4096 + 4);
#pragma unroll
        for (int w = 5; w < 8; ++w) { t0 += *(const LAS f32x4*)(rd + w * 4096); t1 += *(const LAS f32x4*)(rd + w * 4096 + 4); }
        out2[0] = t0.x; out2[1] = t0.y; out2[2] = t0.z; out2[3] = t0.w; out2[4] = t1.x; out2[5] = t1.y; out2[6] = t1.z; out2[7] = t1.w; }
    __syncthreads();
}
__device__ __forceinline__ void st8f(float* p, const float (&v)[8]) { *(GAS f32x4*)p = (f32x4){v[0], v[1], v[2], v[3]}; *(GAS f32x4*)(p + 4) = (f32x4){v[4], v[5], v[6], v[7]}; }

__device__ __forceinline__ void s_in(const Ctx& C, int idx, int nblk) {
    unsigned char* ws = C.ws; const int tid = C.tid, row = tid >> 2, c8 = (tid & 3) * 8, rg = MPROMPT + row;
    const float rs = ((const float*)(ws + WS_RSTD1))[rg];
    for (int u = idx; u < 273; u += nblk) {
        float v[8]; skinny_core(C, (const bf16*)(ws + WS_SXB), LDS_X, (const bf16*)(ws + WS_WIN) + ((size_t)(u >> 3) * (DM / 64) * 256 + (u & 7) * 32) * 64, C.wave * 256, 256, v);
        const int n = u * 32 + c8;
#pragma unroll
        for (int k = 0; k < 8; ++k) v[k] *= rs;
        if (n < 2048) {
#pragma unroll
            for (int k = 0; k < 8; ++k) v[k] = gelu_tanh(v[k]);
            if (n < 1024) *(GAS v4u*)((bf16*)(ws + WS_U) + (size_t)rg * DG + n) = pack8f(v);
            else { *(GAS v4u*)((bf16*)(ws + WS_VG) + (size_t)rg * DG + n - 1024) = pack8f(v); float ss = 0.f;
#pragma unroll
                for (int k = 0; k < 8; ++k) ss += v[k] * v[k];
                ss += __shfl_xor(ss, 1); ss += __shfl_xor(ss, 2);
                if ((tid & 3) == 0) ((float*)(ws + WS_VSS))[(size_t)rg * 32 + (n - 1024) / 32] = ss; }
        } else if (n < 3072) st8f((float*)(ws + WS_QRAW) + (size_t)rg * DQ + n - 2048, v);
        else if (n < 3584) st8f(C.out + O_SCMP + (size_t)row * 512 + n - 3072, v);
        else if (n < 4096) st8f(C.out + O_SSEL + (size_t)row * 512 + n - 3584, v);
        else if (n < 4608) st8f((float*)(ws + WS_KVWR) + (size_t)rg * 512 + n - 4096, v);
        else if (n < 8704) {
#pragma unroll
            for (int k = 0; k < 8; ++k) v[k] = sigmoidf_(v[k]);
            if (n < 6656) *(GAS v4u*)((bf16*)(ws + WS_GA) + (size_t)rg * DM + n - 4608) = pack8f(v); else *(GAS v4u*)((bf16*)(ws + WS_GB) + (size_t)rg * DM + n - 6656) = pack8f(v);
        } else if (n < 8728) {
#pragma unroll
            for (int k = 0; k < 8; ++k) v[k] = sigmoidf_(v[k]);
            st8f((float*)(ws + WS_GN) + (size_t)rg * 32 + n - 8704, v); }
    }
}
__device__ __forceinline__ void s_proj(const Ctx& C, int idx, int nblk) {
    unsigned char* ws = C.ws; const int tid = C.tid, row = tid >> 2, c8 = (tid & 3) * 8, rg = MPROMPT + row;
    for (int u = idx; u < 64; u += nblk) {
        float a[8], b[8], ga[8], gb[8]; const int n = u * 32 + c8;
        { const bool pb = C.wave >= 4;
          skinny_core<true>(C, (const bf16*)(ws + (pb ? WS_SOB : WS_SOA)), LDS_G, (const bf16*)(ws + (pb ? WS_WN : WS_WG)) + ((size_t)(u >> 3) * (DG / 64) * 256 + (u & 7) * 32) * 64, (C.wave & 3) * 256, 256, a, b); }
        unpack8(*(const GAS v4u*)((const bf16*)(ws + WS_GA) + (size_t)rg * DM + n), ga); unpack8(*(const GAS v4u*)((const bf16*)(ws + WS_GB) + (size_t)rg * DM + n), gb);
#pragma unroll
        for (int k = 0; k < 8; ++k) a[k] = ga[k] * a[k] + gb[k] * b[k];
        *(GAS v4u*)((bf16*)(ws + WS_SMIX) + (size_t)row * LDS_X + n) = pack8f(a);
    }
}
__device__ __forceinline__ void s_out(const Ctx& C, int idx, int nblk) {
    unsigned char* ws = C.ws; const int tid = C.tid, row = tid >> 2, c8 = (tid & 3) * 8, rg = MPROMPT + row;
    for (int u = idx; u < 64; u += nblk) {
        float v[8], x[8]; const int n = u * 32 + c8;
        skinny_core(C, (const bf16*)(ws + WS_SMIX), LDS_X, (const bf16*)(ws + WS_WO) + ((size_t)(u >> 3) * (DM / 64) * 256 + (u & 7) * 32) * 64, C.wave * 256, 256, v);
        ld8f(C.in[IN_XS] + (size_t)row * DM + n, x); float ss = 0.f;
#pragma unroll
        for (int k = 0; k < 8; ++k) { v[k] += x[k]; ss += v[k] * v[k]; }
        st8f(C.out + O_YS + (size_t)row * DM + n, v); *(GAS v4u*)((bf16*)(ws + WS_SX1B) + (size_t)row * LDS_X + n) = pack8f(v);
        ss += __shfl_xor(ss, 1); ss += __shfl_xor(ss, 2);
        if ((tid & 3) == 0) ((float*)(ws + WS_X1SS))[(size_t)MPROMPT * 32 + row * 64 + u] = ss;
    }
}
__device__ __forceinline__ void s_up(const Ctx& C) {
    unsigned char* ws = C.ws; const int tid = C.tid, row = tid >> 2, c8 = (tid & 3) * 8, rg = MPROMPT + row;
    float rs; { const GAS f32x4* sp = (const GAS f32x4*)((const float*)(ws + WS_X1SS) + (size_t)MPROMPT * 32 + row * 64); f32x4 s4 = sp[0];
#pragma unroll
        for (int k = 1; k < 16; ++k) s4 += sp[k];
        rs = rsqrtf(((s4.x + s4.y) + (s4.z + s4.w)) * (1.0f / DM) + EPS); }
    for (int u = blockIdx.x; u < 256; u += C.G) {
        float v[8]; skinny_core(C, (const bf16*)(ws + WS_SX1B), LDS_X, (const bf16*)(ws + WS_WUP) + ((size_t)(u >> 3) * (DM / 64) * 256 + (u & 7) * 32) * 64, C.wave * 256, 256, v);
#pragma unroll
        for (int k = 0; k < 8; ++k) { const float a = fmaxf(v[k] * rs, 0.f); v[k] = a * a; }
        *(GAS v4u*)((bf16*)(ws + WS_SH) + (size_t)row * LDS_H + u * 32 + c8) = pack8f(v);
    }
}
__device__ __forceinline__ void s_down(const Ctx& C) {
    unsigned char* ws = C.ws; const int tid = C.tid, row = tid >> 2, c8 = (tid & 3) * 8, rg = MPROMPT + row;
    float* PART = (float*)(ws + WS_SPART); gu32* tick = (gu32*)(ws + WS_CTL) + CW_TICK; LAS unsigned* flag = (LAS unsigned*)(C.lds + AT_X);
    for (int u = blockIdx.x; u < 256; u += C.G) { const int strip = u >> 2, kq = u & 3;
        float v[8]; skinny_core(C, (const bf16*)(ws + WS_SH), LDS_H, (const bf16*)(ws + WS_WDN) + ((size_t)(strip >> 3) * (DFF / 64) * 256 + (strip & 7) * 32) * 64, kq * 2048 + C.wave * 256, 256, v);
        { gu64* pp = (gu64*)(PART + ((size_t)(strip * 4 + kq) * 128 + row) * 32 + c8);
#pragma unroll
          for (int q = 0; q < 4; ++q) __hip_atomic_store(pp + q, ((unsigned long long)__float_as_uint(v[2 * q + 1]) << 32) | __float_as_uint(v[2 * q]), RLX_AGENT); }
        asm volatile("s_waitcnt vmcnt(0)" ::: "memory"); __syncthreads();
        if (tid == 0) { const unsigned old = __hip_atomic_fetch_add(tick + strip * 64, 1u, __ATOMIC_RELAXED, __HIP_MEMORY_SCOPE_AGENT); flag[0] = old; }
        __syncthreads();
        const bool last = flag[0] == 3u;
        __syncthreads();
        if (last) { __builtin_amdgcn_fence(__ATOMIC_ACQUIRE, "agent"); asm volatile("s_waitcnt vmcnt(0)" ::: "memory");
            float* y = C.out + O_YS + (size_t)row * DM + strip * 32 + c8; float acc[8]; ld8f(y, acc);
#pragma unroll
            for (int q = 0; q < 4; ++q) { const gu64* pp = (const gu64*)(PART + ((size_t)(strip * 4 + q) * 128 + row) * 32 + c8);
#pragma unroll
                for (int k = 0; k < 4; ++k) { const unsigned long long w = __hip_atomic_load(pp + k, RLX_AGENT); acc[2 * k] += __uint_as_float((unsigned)w); acc[2 * k + 1] += __uint_as_float((unsigned)(w >> 32)); } }
            st8f(y, acc); }
    }
}

__device__ __forceinline__ void fused_cmp_unit(const Ctx& C, int L, const epi::EpiCmp& E) {
    using pg8::bf16x8; using pg8::f32x4; using pg8::HTB;
    LAS unsigned char* lds = C.lds + RING_OFF;
    const Ctx Lf = fresh(C);
    const int tid = Lf.tid, wid = C.wave, lane = Lf.lane, wr = wid >> 2, wc = wid & 3, fr = lane & 15, fq = lane >> 4;
    const int b = L >> 1, kv = L & 1;
    const int* pt = (const int*)C.in[IN_PT] + b * 16;
    unsigned aofg[2][2], voffB[2];
#pragma unroll
    for (int i = 0; i < 2; ++i) { int R, Cx; pg8::stage_rc(tid * 16 + i * 8192, R, Cx);
        const unsigned page = (unsigned)pt[R >> 3];
#pragma unroll
        for (int h = 0; h < 2; ++h) aofg[h][i] = (((page * 128u + (unsigned)(R & 7) * 16u) * 512u) + (unsigned)((kv * 2 + h) * 128 + Cx)) * 4u;
        voffB[i] = (unsigned)(R * 64 + Cx) * 2u; }
    const char* cA = (const char*)C.in[IN_CCMP];
    const char* cB = (const char*)(C.ws + WS_WC) + (size_t)kv * 32 * 32768;
    const size_t hstepB = 16384;
    const int aoff = pg8::lds_byte(wr * 64 + fr, fq * 8), boff = pg8::lds_byte(wc * 32 + fr, fq * 8);
#define FC_SA(bf, h) (((bf) * 2 + (h)) * HTB)
#define FC_SB(bf, h) ((4 + (bf) * 2 + (h)) * HTB)
#define FC_LOADA(kt) do { const unsigned ko_ = (unsigned)((kt) >> 1) * 2048u + (unsigned)((kt) & 1) * 256u; \
        _Pragma("unroll") for (int h = 0; h < 2; ++h) _Pragma("unroll") for (int i = 0; i < 2; ++i) { const char* p_ = cA + aofg[h][i] + ko_; \
            ar[h][i][0] = *(const GAS f32x4*)p_; ar[h][i][1] = *(const GAS f32x4*)(p_ + 16); } } while (0)
#define FC_WRITEA(bf) do { _Pragma("unroll") for (int h = 0; h < 2; ++h) _Pragma("unroll") for (int i = 0; i < 2; ++i) { v4u w_; \
            w_.x = pk2(ar[h][i][0].x, ar[h][i][0].y); w_.y = pk2(ar[h][i][0].z, ar[h][i][0].w); w_.z = pk2(ar[h][i][1].x, ar[h][i][1].y); w_.w = pk2(ar[h][i][1].z, ar[h][i][1].w); \
            *(LAS v4u*)(lds + FC_SA(bf, h) + tid * 16 + i * 8192) = w_; } } while (0)
#define FC_DMAB(kt, bf) do { _Pragma("unroll") for (int h = 0; h < 2; ++h) _Pragma("unroll") for (int i = 0; i < 2; ++i) \
            __builtin_amdgcn_global_load_lds((const unsigned*)(cB + h * hstepB + (size_t)(kt) * 32768 + voffB[i]), (LAS unsigned*)(lds + FC_SB(bf, h) + wid * 1024 + i * 8192), 16, 0, 0); } while (0)
#define FC_LDA(dst, bf, h) do { _Pragma("unroll") for (int m = 0; m < 4; ++m) _Pragma("unroll") for (int k = 0; k < 2; ++k) dst[m][k] = *(const LAS bf16x8*)(lds + FC_SA(bf, h) + aoff + m * 2048 + k * 1024); } while (0)
#define FC_LDB(dst, bf, h) do { _Pragma("unroll") for (int n = 0; n < 2; ++n) _Pragma("unroll") for (int k = 0; k < 2; ++k) dst[n][k] = *(const LAS bf16x8*)(lds + FC_SB(bf, h) + boff + n * 2048 + k * 1024); } while (0)
#define FC_MMA(ai, bj, At_, Bt_) do { _Pragma("unroll") for (int m = 0; m < 4; ++m) _Pragma("unroll") for (int n = 0; n < 2; ++n) _Pragma("unroll") for (int k = 0; k < 2; ++k) \
        acc[ai][bj][m][n] = __builtin_amdgcn_mfma_f32_16x16x32_bf16(Bt_[n][k], At_[m][k], acc[ai][bj][m][n], 0, 0, 0); } while (0)
    f32x4 acc[2][2][4][2];
#pragma unroll
    for (int a = 0; a < 2; ++a)
#pragma unroll
        for (int bb = 0; bb < 2; ++bb)
#pragma unroll
            for (int m = 0; m < 4; ++m)
#pragma unroll
                for (int n = 0; n < 2; ++n) acc[a][bb][m][n] = (f32x4){0.f, 0.f, 0.f, 0.f};
    f32x4 ar[2][2][2];
    bf16x8 At[4][2], B0[2][2];
    __syncthreads();
    FC_LOADA(0); FC_DMAB(0, 0); FC_WRITEA(0);
    asm volatile("s_waitcnt vmcnt(0) lgkmcnt(0)" ::: "memory"); __syncthreads();
#pragma unroll 1
    for (int kt = 0; kt < 32; ++kt) { const int bf = kt & 1;
        if (kt + 1 < 32) { FC_LOADA(kt + 1); FC_DMAB(kt + 1, bf ^ 1); }
        FC_LDB(B0, bf, 0); FC_LDA(At, bf, 0); FC_MMA(0, 0, At, B0);
        FC_LDA(At, bf, 1); FC_MMA(1, 0, At, B0);
        FC_LDB(B0, bf, 1); FC_MMA(1, 1, At, B0);
        FC_LDA(At, bf, 0); FC_MMA(0, 1, At, B0);
        if (kt + 1 < 32) FC_WRITEA(bf ^ 1);
        asm volatile("s_waitcnt vmcnt(0) lgkmcnt(0)" ::: "memory"); __syncthreads();
    }
    const pg8::Unit u{L, kv};
    { const Ctx Le = fresh(C); E(acc, u, wr, wc, Le.lane & 15, Le.lane >> 4); }
#undef FC_SA
#undef FC_SB
#undef FC_LOADA
#undef FC_WRITEA
#undef FC_DMAB
#undef FC_LDA
#undef FC_LDB
#undef FC_MMA
}

constexpr int LATE_P1 = 4096;
constexpr int WINCOPY_P2 = 0;
constexpr int LATE_P2 = I_LATE - LATE_P1;
constexpr int LATE_P12 = LATE_P1 + LATE_P2;
constexpr int NLATE_W = (I_LATE - LATE_P12 + 31) / 32, P5_HEAVY = 160, P5_SAMP0 = P5_HEAVY, P5_LIGHT0 = P5_SAMP0 + 256, P5_STREAM0 = P5_LIGHT0 + (256 - P5_HEAVY),
              P5_ITEMS = P5_STREAM0 + NLATE_W + WINCOPY_ITEMS - WINCOPY_P2;
__device__ __forceinline__ void p5_attn_flash(const Ctx& C, const int it_lo = 0, const int it_hi = P5_ITEMS) {
    unsigned char* ws = C.ws; gu32* ctl = (gu32*)(ws + WS_CTL); gu32* qa = ctl + CW_Q5;
    LAS float* scr = (LAS float*)(C.lds + RING_OFF + C.wave * 16384);
    for (;;) {
        gu32* qa_ = qa; unsigned qo_ = AT_WS + 2048; asm volatile("" : "+s"(qa_), "+s"(qo_));
        LAS unsigned* qf_ = (LAS unsigned*)(C.lds + qo_);
        __syncthreads();
        if (C.wave == 0 && lane_now() == 0) qf_[0] = __hip_atomic_fetch_add(qa_, 1u, __ATOMIC_RELAXED, __HIP_MEMORY_SCOPE_AGENT);
        __syncthreads();
        const int it = __builtin_amdgcn_readfirstlane((int)qf_[0]) + it_lo;
        if (it >= it_hi) break;
        const Ctx L = fresh(C);
        if (it < P5_HEAVY || (it >= P5_LIGHT0 && it < P5_STREAM0)) { const int un = it < P5_HEAVY ? it : it - P5_LIGHT0 + P5_HEAVY;
            const int qb_ = 63 - (un >> 2), bg = un & 3; flash_unit(L, bg >> 1, bg & 1, qb_); }
        else if (it < P5_LIGHT0) { const int si = it - P5_SAMP0, b = si >> 1, g = si & 1, row = MPROMPT + b;
            AttItem ai{(const bf16*)(ws + WS_QN) + (size_t)row * DQ + g * 512, PASTLEN, 127, (const bf16*)(ws + WS_KCS) + (size_t)(b * 2 + g) * 128 * 128, (const bf16*)(ws + WS_VCS) + (size_t)(b * 2 + g) * 128 * 128, 33,
                       (const float*)(ws + WS_GN) + (size_t)row * 32 + g * 12, (bf16*)(ws + WS_SOB) + (size_t)b * LDS_G + g * 512, (const float*)(ws + WS_BLUT) + g * 4 * 132};
            SampleKV kv{C.in[IN_CSEL] + g * 128, (const int*)C.in[IN_PT] + b * 16, C.out + O_SSEL + (size_t)b * 512 + g * 128, C.in[IN_WINB] + (size_t)b * 512 * 512 + g * 128,
                        (const float*)(ws + WS_KVWR) + (size_t)row * 512 + g * 128};
            nsa_item<SampleKV>(L, ai, kv, C.in[IN_GK] + 128, C.in[IN_GK] + 256); }
        else if (it < P5_STREAM0 + NLATE_W) { const int base = LATE_P12 + (it - P5_STREAM0) * 32;
#pragma unroll 1
            for (int k = 0; k < 4; ++k) { const int r = base + k * 8 + C.wave; if (r < I_LATE) w_item_late(L, r, scr); } }
        else wincopy_item(L, WINCOPY_P2 + it - P5_STREAM0 - NLATE_W);
    }
}

#ifndef MK_N_LAUNCHES
#define MK_N_LAUNCHES 1
#endif
constexpr int NPHASES = 10;

__device__ __forceinline__ void ph1(const Ctx& C, LAS unsigned char* ring) { unsigned char* ws = C.ws;
    pg8::Gemm g{(const bf16*)(ws + WS_XB), (const bf16*)(ws + WS_WIN), MPROMPT, NINP, DM, LD2, LD2, 1, 1}; pg8::StaticOrder S; S.init(MPROMPT, NINP, C.G, (int)blockIdx.x);
    epi::EpiIn E{(const float*)(ws + WS_RSTD1), (bf16*)(ws + WS_U), (bf16*)(ws + WS_VG), (float*)(ws + WS_VSS), (float*)(ws + WS_QRAW), (float*)(ws + WS_KVWR),
                 (bf16*)(ws + WS_GA), (bf16*)(ws + WS_GB), (float*)(ws + WS_GN), C.out, (bf16*)(ws + WS_ACP)};
    const int nu = (MPROMPT / 256) * (NINP / 256), full = nu % C.G, nlight = full ? C.G - full : C.G, idx = full ? (int)blockIdx.x - full : (int)blockIdx.x;
    const bool sfirst = idx >= 0 && (C.G % 8 == 0) && (blockIdx.x & 1);
    if (sfirst) s_in(C, idx, nlight);
    pg8::gemm_phase<epi::EpiIn, pg8::StaticOrder, true, true>(ring, g, S, E, fresh(C).tid);
    { if (idx >= 0) { if (!sfirst) s_in(fresh(C), idx, nlight);
          const Ctx L = fresh(C); LAS float* scr = (LAS float*)(C.lds + RING_OFF + C.wave * 16384); __syncthreads();
          for (int r = idx * NWAVES + C.wave; r < LATE_P1; r += nlight * NWAVES) w_item_late(L, r, scr); } } }
__device__ __forceinline__ void ph2(const Ctx& C, LAS unsigned char* ring) { unsigned char* ws = C.ws;
    { const int skip = C.G > 32 ? 16 : 0; if ((int)blockIdx.x >= skip) p2_post(C, (int)blockIdx.x - skip, C.G - skip); }
    const bool sgu_first = (C.G % 8 == 0) && C.G > 32 && (blockIdx.x & 1) && blockIdx.x >= 16;
    if (sgu_first) { p4_sgu(fresh(C), (int)blockIdx.x - 8, C.G - 8); __syncthreads();
        const Ctx L = fresh(C); LAS float* scr = (LAS float*)(C.lds + RING_OFF + C.wave * 16384);
        for (int r = LATE_P1 + ((int)blockIdx.x - 16) * NWAVES + C.wave; r < LATE_P12; r += (C.G - 16) * NWAVES) w_item_late(L, r, scr);
        __syncthreads(); }
    { epi::EpiCmp E{(float*)(ws + WS_YCS), 127};
      for (int Lu = (int)blockIdx.x; Lu < 256; Lu += C.G) { fused_cmp_unit(C, Lu, E);
          asm volatile("s_waitcnt vmcnt(0)" ::: "memory"); __syncthreads();
          const Ctx Lc = fresh(C);
          cmp_combine_rows(Lc, false, Lu * 256, 256); } }
    __syncthreads();
    const int ngb = C.G > 16 ? 8 : 0;
    if (ngb == 0 || (int)blockIdx.x < ngb) {
        { pg8::Gemm g{(const bf16*)(ws + WS_ACP), (const bf16*)(ws + WS_WC), 2048, 512, 2048, LD2, LD2, 1, 1}; epi::CmpOrder S{8, C.G, (int)blockIdx.x, 1};
          epi::EpiCmp E{(float*)(ws + WS_YCP), 255};
          const Ctx Lg = fresh(C); pg8::gemm_phase<epi::EpiCmp, epi::CmpOrder, true, true>(ring, g, S, E, Lg.tid); }
        asm volatile("s_waitcnt vmcnt(0)" ::: "memory"); __syncthreads();
        const Ctx Lc = fresh(C);
        for (int L = (int)blockIdx.x; L < 8; L += C.G) cmp_combine_rows(Lc, true, L * 256, 256); }
    { const Ctx Ls = fresh(C);
      if (ngb == 0) p4_sgu(Ls, (int)blockIdx.x, C.G); else if ((int)blockIdx.x >= ngb && !sgu_first) p4_sgu(Ls, (int)blockIdx.x - ngb, C.G - ngb); }
    { const int skip = C.G > 32 ? 16 : 0;
      if ((int)blockIdx.x >= skip && !sgu_first) { const Ctx L = fresh(C); LAS float* scr = (LAS float*)(C.lds + RING_OFF + C.wave * 16384); __syncthreads();
          for (int r = LATE_P1 + ((int)blockIdx.x - skip) * NWAVES + C.wave; r < LATE_P12; r += (C.G - skip) * NWAVES) w_item_late(L, r, scr);
          for (int c = (int)blockIdx.x - skip; c < WINCOPY_P2; c += C.G - skip) wincopy_item(L, c); } } }
__device__ __forceinline__ void ph6(const Ctx& C, LAS unsigned char* ring) { unsigned char* ws = C.ws;
    const bool odd64 = (C.G % 8 == 0) && C.G >= 128;
    if (odd64) { if ((blockIdx.x & 1) && blockIdx.x < 128) s_proj(C, (int)blockIdx.x >> 1, 64); }
    { pg8::Gemm g{(const bf16*)(ws + WS_OA), (const bf16*)(ws + WS_WG), MPROMPT, DM, DG, LD1, LD1, 1, 1}; pg8::StaticOrder S; S.init(MPROMPT, DM, C.G, (int)blockIdx.x);
      epi::EpiMixA E{(const bf16*)(ws + WS_GA), (bf16*)(ws + WS_MIXA)};
      pg8::gemm_phase<epi::EpiMixA, pg8::StaticOrder, true, true>(ring, g, S, E, fresh(C).tid); }
    { pg8::Gemm g{(const bf16*)(ws + WS_OB), (const bf16*)(ws + WS_WN), MPROMPT, DM, DQ, LD1, LD1, 1, 1}; pg8::StaticOrder S; S.init(MPROMPT, DM, C.G, (int)blockIdx.x);
      epi::EpiMixB E{(const bf16*)(ws + WS_GB), (const bf16*)(ws + WS_MIXA), (bf16*)(ws + WS_MIX)};
      pg8::gemm_phase<epi::EpiMixB, pg8::StaticOrder, true, true>(ring, g, S, E, fresh(C).tid); }
    if (!odd64) s_proj(fresh(C), (int)blockIdx.x, C.G); }
__device__ __forceinline__ void ph7(const Ctx& C, LAS unsigned char* ring) { unsigned char* ws = C.ws;
    pg8::Gemm g{(const bf16*)(ws + WS_MIX), (const bf16*)(ws + WS_WO), MPROMPT, DM, DM, LD2, LD2, 1, 1}; pg8::StaticOrder S; S.init(MPROMPT, DM, C.G, (int)blockIdx.x);
    epi::EpiOut E{C.in[IN_XP], C.in[IN_XS], C.out, (bf16*)(ws + WS_X1B), (float*)(ws + WS_X1SS)};
    const bool odd64 = (C.G % 8 == 0) && C.G >= 128;
    if (odd64) { if ((blockIdx.x & 1) && blockIdx.x < 128) s_out(C, (int)blockIdx.x >> 1, 64); }
    pg8::gemm_phase<epi::EpiOut, pg8::StaticOrder, true, true>(ring, g, S, E, fresh(C).tid);
    if (!odd64) s_out(fresh(C), (int)blockIdx.x, C.G); }
__device__ __forceinline__ void ph8(const Ctx& C, LAS unsigned char* ring) { unsigned char* ws = C.ws;
    pg8::Gemm g{(const bf16*)(ws + WS_X1B), (const bf16*)(ws + WS_WUP), MPROMPT, DFF, DM, LD2, LD2, 1, 1}; pg8::StaticOrder S; S.init(MPROMPT, DFF, C.G, (int)blockIdx.x);
    epi::EpiUp E{(const float*)(ws + WS_X1SS), (bf16*)(ws + WS_H)};
    const bool first = (C.G % 8 == 0) && (blockIdx.x & 1);
    if (first) s_up(C);
    pg8::gemm_phase<epi::EpiUp, pg8::StaticOrder, true, true>(ring, g, S, E, fresh(C).tid);
    if (!first) s_up(fresh(C)); }
template <bool DUMMY>
__device__ __forceinline__ void ph9(const Ctx& C, LAS unsigned char* ring) { unsigned char* ws = C.ws;
    pg8::Gemm g{(const bf16*)(ws + WS_H), (const bf16*)(ws + WS_WDN), MPROMPT, DM, DFF, LD8, LD8, 1, 1}; pg8::StaticOrder S; S.init(MPROMPT, DM, C.G, (int)blockIdx.x);
    epi::EpiDown E{DUMMY ? (float*)(ws + WS_DUMMY) : C.out, (const bf16*)(ws + WS_X1B)};
    const bool first = (C.G % 8 == 0) && (blockIdx.x & 1);
    if (!DUMMY && first) s_down(C);
    pg8::gemm_phase<epi::EpiDown, pg8::StaticOrder, true, true>(ring, g, S, E, fresh(C).tid);
    if (!DUMMY && !first) s_down(fresh(C)); }

struct Args { const float* in[24]; float* out; unsigned char* ws; int ph_lo, ph_hi; };
static_assert(sizeof(Args) == 24 * 8 + 8 + 8 + 8, "no padding bytes in the kernel argument struct");

__global__ void __launch_bounds__(NWAVES * 64, 2) nsa_fwd(Args args) {
    extern __shared__ __attribute__((aligned(16))) unsigned char lds_raw[];
    Ctx C;
    C.in = args.in;
    C.out = args.out; C.ws = args.ws; C.lds = (LAS unsigned char*)lds_raw;
    C.tid = threadIdx.x; C.lane = C.tid & 63; C.wave = __builtin_amdgcn_readfirstlane(C.tid >> 6);
    C.G = gridDim.x; { const int bx = blockIdx.x; C.vcu = (C.G % 8 == 0) ? (bx % 8) * (C.G / 8) + bx / 8 : bx; }
    volatile LAS unsigned* MISC = (volatile LAS unsigned*)(C.lds + MISC_OFF);
    gu32* ctl = (gu32*)(args.ws + WS_CTL);
    for (int u = C.tid; u < (LDS_BYTES - LDSCTL_OFF) / 4; u += NWAVES * 64) ((LAS unsigned*)(C.lds + LDSCTL_OFF))[u] = 0u;
    __syncthreads();
    const int lo = args.ph_lo, hi = args.ph_hi;
    XcdBarrier bar; bar.bar = (unsigned*)(ctl + CW_BAR); bar.x = 0; bar.w = 0; bar.st = nullptr;
    if (hi - lo > 1) bar = xcd_barrier_post((unsigned*)(ctl + CW_BAR), MISC + 8);
#ifndef ONLY_PHASES
#define ONLY_PHASES 0x3ff
#endif
#define IN(k) (((ONLY_PHASES >> (k)) & 1) && lo <= (k) && (k) < hi)
#ifndef PROBE_SLACK
#define PROBE_SLACK -1
#endif
#ifndef PROBE_SLACK_PH
#define PROBE_SLACK_PH 2
#endif
#if PROBE_SLACK >= 0
    unsigned long long ps0_ = 0;
#define SEAM2(k, n) do { if (IN(k) && IN(n)) { if ((k) == PROBE_SLACK_PH) { __syncthreads(); ps0_ = __builtin_amdgcn_s_memrealtime(); } xcd_barrier(bar); \
        if ((k) == PROBE_SLACK_PH) { if ((int)blockIdx.x == PROBE_SLACK && C.wave == 0) { const unsigned long long d_ = __builtin_amdgcn_s_memrealtime() - ps0_, t0_ = __builtin_amdgcn_s_memrealtime(); \
                while (__builtin_amdgcn_s_memrealtime() - t0_ < d_ * 10ull) __builtin_amdgcn_s_sleep(16); } \
            xcd_barrier(bar); } } } while (0)
#else
#define SEAM2(k, n) do { if (IN(k) && IN(n)) xcd_barrier(bar); } while (0)
#endif
#define SEAM(k) SEAM2(k, (k) + 1)
    LAS unsigned char* ring = C.lds + RING_OFF;

#define PROBE2(k, call) do { if ((PROBE_MASK >> (k)) & 1) { xcd_barrier(bar); call; } } while (0)
    if (IN(0)) { p0_prologue(fresh(C)); PROBE2(0, p0_prologue(fresh(C))); } SEAM(0);
    if (IN(1)) { ph1(fresh(C), ring); PROBE2(1, ph1(fresh(C), ring)); } SEAM(1);
    if (IN(2)) { ph2(fresh(C), ring); PROBE2(2, ph2(fresh(C), ring)); } SEAM2(2, 5);
    if (IN(5)) { p5_attn_flash(fresh(C));
#define P5_RERUN(lo_, hi_) do { xcd_barrier(bar); if (blockIdx.x == 0 && C.wave == 0 && lane_now() == 0) __hip_atomic_store(ctl + CW_Q5, 0u, RLX_AGENT); xcd_barrier(bar); p5_attn_flash(fresh(C), lo_, hi_); } while (0)
        if ((PROBE_MASK >> 5) & 1) P5_RERUN(0, P5_ITEMS);
        if ((PROBE_MASK >> 13) & 1) { P5_RERUN(0, P5_HEAVY); }
        if ((PROBE_MASK >> 14) & 1) { P5_RERUN(P5_SAMP0, P5_LIGHT0); }
        if ((PROBE_MASK >> 15) & 1) { P5_RERUN(P5_STREAM0, P5_ITEMS); }
} SEAM(5);
    if (IN(6)) { ph6(fresh(C), ring); PROBE2(6, ph6(fresh(C), ring)); } SEAM(6);
    if (IN(7)) { ph7(fresh(C), ring); PROBE2(7, ph7(fresh(C), ring)); } SEAM(7);
#if (PROBE_MASK >> 20) & 1
    long long pc0_ = 0; unsigned long long pr0_ = 0; if (IN(8)) { pc0_ = clock64(); pr0_ = __builtin_amdgcn_s_memrealtime(); }
#endif
    if (IN(8)) { ph8(fresh(C), ring); PROBE2(8, ph8(fresh(C), ring)); }
#if (PROBE_MASK >> 20) & 1
    if (IN(8) && blockIdx.x == 0 && C.wave == 0) { const long long dc_ = clock64() - pc0_; const unsigned long long dr_ = __builtin_amdgcn_s_memrealtime() - pr0_;
        const unsigned long long mhz_ = (unsigned long long)dc_ * 100ull / (dr_ ? dr_ : 1ull); const unsigned long long t0_ = __builtin_amdgcn_s_memrealtime();
        while (__builtin_amdgcn_s_memrealtime() - t0_ < mhz_ * 100ull) __builtin_amdgcn_s_sleep(16); }
#endif
    SEAM(8);
    if (IN(9)) { PROBE2(9, ph9<true>(fresh(C), ring)); if ((PROBE_MASK >> 9) & 1) xcd_barrier(bar); ph9<false>(fresh(C), ring); }
#undef PROBE2
#undef IN
#undef SEAM
#undef SEAM2
}

extern "C" void kernel_launch(void* const* d_in, const int* in_sizes, int n_in, void* d_out, int out_size, void* d_ws, size_t ws_size, hipStream_t stream) {
    static int grid = 0;
    if (grid == 0) {
        if (n_in != 24 || out_size != (int)O_END || ws_size < WS_END) {
            fprintf(stderr, "kernel_launch: built for 24 inputs, %zu outputs, >= %zu bytes of workspace; got n_in %d out %d ws %zu; nothing launched\n", (size_t)O_END, (size_t)WS_END, n_in, out_size, ws_size);
            grid = -1; return; }
        int dev = 0, cus = 0, per_cu = 0;
        if (hipGetDevice(&dev) != hipSuccess || hipDeviceGetAttribute(&cus, hipDeviceAttributeMultiprocessorCount, dev) != hipSuccess) { fprintf(stderr, "kernel_launch: device query failed\n"); grid = -1; return; }
        if (hipFuncSetAttribute((const void*)nsa_fwd, hipFuncAttributeMaxDynamicSharedMemorySize, LDS_BYTES) != hipSuccess) { fprintf(stderr, "kernel_launch: hipFuncSetAttribute failed\n"); grid = -1; return; }
        if (hipOccupancyMaxActiveBlocksPerMultiprocessor(&per_cu, (const void*)nsa_fwd, NWAVES * 64, LDS_BYTES) != hipSuccess || per_cu < 1)
            fprintf(stderr, "kernel_launch: note: occupancy query reports %d workgroups per CU\n", per_cu);
        (void)hipGetLastError();
        grid = cus;
    }
    if (grid < 0) return;
    if (hipMemsetAsync((char*)d_ws + WS_CTL, 0, CTL_ZERO_BYTES, stream) != hipSuccess) { fprintf(stderr, "kernel_launch: memset failed\n"); return; }
    Args a{};
    for (int i = 0; i < 24; ++i) a.in[i] = (const float*)d_in[i];
    a.out = (float*)d_out; a.ws = (unsigned char*)d_ws;
    const int nl = MK_N_LAUNCHES;
    for (int li = 0; li < nl; ++li) {
        a.ph_lo = nl == 1 ? 0 : li; a.ph_hi = nl == 1 ? NPHASES : li + 1;
        hipLaunchKernelGGL(nsa_fwd, dim3(grid), dim3(NWAVES * 64), LDS_BYTES, stream, a);
        const hipError_t le = hipPeekAtLastError();
        if (le != hipSuccess) { fprintf(stderr, "kernel_launch: launch %d failed: %s\n", li, hipGetErrorName(le)); break; }
    }
}
```
